# Optimizing an MI355X kernel written in HIP

```python
import jax, jax.numpy as jnp
from jax import lax
import numpy as np

D_MODEL = 1024
BATCH = 8
SEQ = 2048
DEPTH = 1
DEC_BATCH = 128
DEC_SEQ = 1
PAST_LEN = 16384
PAGE_SIZE = 128

D_RNN = D_MODEL
RG_BLOCKS = 8
RG_BLOCK_W = D_RNN // RG_BLOCKS
RG_C = 8.0
CONV_W = 4
DN_HEADS = 8
DN_DK = 128
DN_DV = 128
DN_QK = DN_HEADS * DN_DK
DN_V = DN_HEADS * DN_DV
DN_QKV = 2 * DN_QK + DN_V
DN_CHUNK = 64
D_FF = 2816
N_ADA = 9
EPS = 1e-6
IN_SPLITS = (D_RNN, D_RNN, DN_QKV, DN_HEADS, DN_HEADS, DN_V, D_MODEL, D_MODEL)
D_IN = D_RNN * 2 + DN_QKV + 2 * DN_HEADS + DN_V + 2 * D_MODEL

kernel_name = 'hybrid_rglru_gdn_macaron_adaln_step'


def rmsnorm(x, g):
    xf = x.astype(jnp.float32)
    y = xf * lax.rsqrt(jnp.mean(xf * xf, axis=-1, keepdims=True) + EPS)
    return (y * g.astype(jnp.float32)).astype(x.dtype)


def l2norm(x):
    xf = x.astype(jnp.float32)
    return xf * lax.rsqrt(jnp.sum(xf * xf, axis=-1, keepdims=True) + EPS)


def modulate(h, shift, scale):
    return h * (1.0 + scale) + shift


def swiglu(h, w_up, w_down):
    gv = h @ w_up
    return (jax.nn.silu(gv[..., :D_FF]) * gv[..., D_FF:]) @ w_down


def split_cols(z, sizes):
    out, start = [], 0
    for s in sizes:
        out.append(z[..., start:start + s])
        start += s
    return out


def causal_dwconv(x, buf, w, b):
    L = x.shape[1]
    xp = jnp.concatenate([buf.astype(x.dtype), x], axis=1)
    y = xp[:, 0:L] * w[0]
    for j in range(1, CONV_W):
        y = y + xp[:, j:j + L] * w[j]
    if b is not None:
        y = y + b
    return y, xp[:, -(CONV_W - 1):]


def rglru(x, h0, w_a, b_a, w_x, b_x, lam, reset_first):
    B, L, _ = x.shape
    xb = x.reshape(B, L, RG_BLOCKS, RG_BLOCK_W)
    r = jax.nn.sigmoid(jnp.einsum('blnc,ncd->blnd', xb, w_a).reshape(B, L, D_RNN) + b_a)
    i = jax.nn.sigmoid(jnp.einsum('blnc,ncd->blnd', xb, w_x).reshape(B, L, D_RNN) + b_x)
    log_a = -RG_C * r.astype(jnp.float32) * jax.nn.softplus(-lam.astype(jnp.float32))
    a = jnp.exp(log_a)
    mult = jnp.sqrt(-jnp.expm1(2.0 * log_a))
    if reset_first:
        mult = mult.at[:, 0].set(1.0)
    bterm = mult * (i * x).astype(jnp.float32)
    bterm = bterm.at[:, 0].add(a[:, 0] * h0.astype(jnp.float32))

    def combine(lhs, rhs):
        a1, b1 = lhs
        a2, b2 = rhs
        return a1 * a2, a2 * b1 + b2

    _, h = lax.associative_scan(combine, (a, bterm), axis=1)
    return h.astype(x.dtype), h[:, -1].astype(x.dtype)


def gated_delta_rule(q, k, v, g, beta, S0):
    B, L = q.shape[0], q.shape[1]
    C = min(DN_CHUNK, L)
    n = -(-L // C)
    pad = n * C - L

    def prep(t):
        t = jnp.pad(t, [(0, 0), (0, pad)] + [(0, 0)] * (t.ndim - 2))
        t = t.reshape((B, n, C) + t.shape[2:])
        return jnp.moveaxis(t, 3, 1)

    q, k, v, g, beta = prep(q), prep(k), prep(v), prep(g), prep(beta)
    gcum = jnp.cumsum(g, axis=-1)
    idx = jnp.arange(C)
    incl = idx[:, None] >= idx[None, :]
    strict = idx[:, None] > idx[None, :]
    decay = jnp.exp(jnp.where(incl, gcum[..., :, None] - gcum[..., None, :], -jnp.inf))
    kb = k * beta[..., None]
    lmat = jnp.where(strict, jnp.einsum('bhnik,bhnjk->bhnij', kb, k) * decay, 0.0)
    tmat = lmat + jnp.eye(C, dtype=lmat.dtype)
    rhs = jnp.concatenate([v * beta[..., None], kb * jnp.exp(gcum)[..., None]], axis=-1)
    sol = lax.linalg.triangular_solve(tmat, rhs, left_side=True, lower=True, unit_diagonal=True)
    u, w = sol[..., :DN_DV], sol[..., DN_DV:]
    attn = jnp.einsum('bhnik,bhnjk->bhnij', q, k) * decay
    q_dec = q * jnp.exp(gcum)[..., None]
    g_last = gcum[..., -1]
    k_dec = k * jnp.exp(g_last[..., None] - gcum)[..., None]

    def step(S, xs):
        u_c, w_c, attn_c, qd_c, kd_c, gl_c = xs
        v_new = u_c - jnp.einsum('bhck,bhkv->bhcv', w_c, S)
        o = jnp.einsum('bhck,bhkv->bhcv', qd_c, S) + jnp.einsum('bhij,bhjv->bhiv', attn_c, v_new)
        S = S * jnp.exp(gl_c)[..., None, None] + jnp.einsum('bhck,bhcv->bhkv', kd_c, v_new)
        return S, o

    xs = (jnp.moveaxis(u, 2, 0), jnp.moveaxis(w, 2, 0), jnp.moveaxis(attn, 2, 0),
          jnp.moveaxis(q_dec, 2, 0), jnp.moveaxis(k_dec, 2, 0), jnp.moveaxis(g_last, 2, 0))
    S, o = lax.scan(step, S0.astype(jnp.float32), xs)
    o = jnp.moveaxis(o, 0, 2)
    o = jnp.moveaxis(o, 1, 3).reshape(B, n * C, DN_HEADS, DN_DV)[:, :L]
    return o, S


def layer(x, c, h0, conv_rnn0, S0, conv_qkv0, reset_first, p):
    B, L, _ = x.shape
    ada = (c @ p['w_ada'] + p['b_ada']).reshape(B, N_ADA, D_MODEL)[:, :, None, :]
    sh1, sc1, gt1 = ada[:, 0], ada[:, 1], ada[:, 2]
    sh2, sc2, gt2 = ada[:, 3], ada[:, 4], ada[:, 5]
    sh3, sc3, gt3 = ada[:, 6], ada[:, 7], ada[:, 8]

    h = modulate(rmsnorm(x, p['norm_ffn1']), sh1, sc1)
    x = x + 0.5 * gt1 * swiglu(h, p['w_ffn1_up'], p['w_ffn1_down'])

    h = modulate(rmsnorm(x, p['norm_mix']), sh2, sc2)
    z = h @ p['w_in']
    xr, gr, qkv, a_logit, b_logit, zg, mg_a, mg_b = split_cols(z, IN_SPLITS)

    xr, conv_rnn_new = causal_dwconv(xr, conv_rnn0, p['conv_rnn_w'], p['conv_rnn_b'])
    yr, h_new = rglru(xr, h0, p['rg_w_a'], p['rg_b_a'], p['rg_w_x'], p['rg_b_x'], p['rg_lambda'], reset_first)
    o_a = yr * jax.nn.gelu(gr)

    qkv, conv_qkv_new = causal_dwconv(qkv, conv_qkv0, p['conv_qkv_w'], None)
    qkv = jax.nn.silu(qkv)
    q, k, v = split_cols(qkv, (DN_QK, DN_QK, DN_V))
    q = l2norm(q.reshape(B, L, DN_HEADS, DN_DK)) * (DN_DK ** -0.5)
    k = l2norm(k.reshape(B, L, DN_HEADS, DN_DK))
    v = v.reshape(B, L, DN_HEADS, DN_DV).astype(jnp.float32)
    g = -jnp.exp(p['dn_a_log'].astype(jnp.float32)) * jax.nn.softplus(
        a_logit.astype(jnp.float32) + p['dn_dt_bias'].astype(jnp.float32))
    beta = jax.nn.sigmoid(b_logit.astype(jnp.float32))
    o, S_new = gated_delta_rule(q, k, v, g, beta, S0)
    o = rmsnorm(o, p['dn_norm']) * jax.nn.silu(zg.reshape(B, L, DN_HEADS, DN_DV).astype(jnp.float32))
    o_b = o.reshape(B, L, DN_V).astype(x.dtype)

    y_a = o_a @ p['w_branch'][0]
    y_b = o_b @ p['w_branch'][1]
    merged = jax.nn.sigmoid(mg_a) * y_a + jax.nn.sigmoid(mg_b) * y_b
    x = x + gt2 * (merged @ p['w_out'])

    h = modulate(rmsnorm(x, p['norm_ffn2']), sh3, sc3)
    x = x + 0.5 * gt3 * swiglu(h, p['w_ffn2_up'], p['w_ffn2_down'])
    return x, h_new, conv_rnn_new, S_new.astype(x.dtype), conv_qkv_new


def setup_inputs(seed: int = 0) -> dict:
    key = jax.random.key(seed)
    ks = jax.random.split(key, 40)
    f32 = jnp.float32
    nrm = lambda k, s, sc: jax.random.normal(k, s, f32) * sc
    a0 = jax.random.uniform(ks[30], (DEPTH, D_RNN), f32, 0.9, 0.999)
    s0 = a0 ** (1.0 / RG_C)
    dt = jnp.exp(jax.random.uniform(ks[31], (DEPTH, DN_HEADS), f32, np.log(1e-3), np.log(1e-1)))
    return {
        'x_prompt': nrm(ks[0], (BATCH, SEQ, D_MODEL), 1.0),
        'x_sample': nrm(ks[1], (DEC_BATCH, DEC_SEQ, D_MODEL), 1.0),
        'c_prompt': nrm(ks[2], (BATCH, D_MODEL), 1.0),
        'c_sample': nrm(ks[3], (DEC_BATCH, D_MODEL), 1.0),
        'state_rglru_h': nrm(ks[4], (DEPTH, DEC_BATCH, D_RNN), 0.5),
        'state_rglru_conv': nrm(ks[5], (DEPTH, DEC_BATCH, CONV_W - 1, D_RNN), 1.0),
        'state_delta_S': nrm(ks[6], (DEPTH, DEC_BATCH, DN_HEADS, DN_DK, DN_DV), 0.05),
        'state_delta_conv': nrm(ks[7], (DEPTH, DEC_BATCH, CONV_W - 1, DN_QKV), 1.0),
        'w_ada': nrm(ks[8], (DEPTH, D_MODEL, N_ADA * D_MODEL), 0.5 * D_MODEL ** -0.5),
        'b_ada': nrm(ks[9], (DEPTH, N_ADA * D_MODEL), 0.1),
        'norm_ffn1': 1.0 + nrm(ks[10], (DEPTH, D_MODEL), 0.02),
        'w_ffn1_up': nrm(ks[11], (DEPTH, D_MODEL, 2 * D_FF), D_MODEL ** -0.5),
        'w_ffn1_down': nrm(ks[12], (DEPTH, D_FF, D_MODEL), D_FF ** -0.5),
        'norm_mix': 1.0 + nrm(ks[13], (DEPTH, D_MODEL), 0.02),
        'w_in': nrm(ks[14], (DEPTH, D_MODEL, D_IN), D_MODEL ** -0.5),
        'conv_rnn_w': nrm(ks[15], (DEPTH, CONV_W, D_RNN), CONV_W ** -0.5),
        'conv_rnn_b': nrm(ks[16], (DEPTH, D_RNN), 0.02),
        'rg_w_a': nrm(ks[17], (DEPTH, RG_BLOCKS, RG_BLOCK_W, RG_BLOCK_W), RG_BLOCK_W ** -0.5),
        'rg_b_a': nrm(ks[18], (DEPTH, D_RNN), 0.02),
        'rg_w_x': nrm(ks[19], (DEPTH, RG_BLOCKS, RG_BLOCK_W, RG_BLOCK_W), RG_BLOCK_W ** -0.5),
        'rg_b_x': nrm(ks[20], (DEPTH, D_RNN), 0.02),
        'rg_lambda': jnp.log(s0) - jnp.log1p(-s0),
        'conv_qkv_w': nrm(ks[21], (DEPTH, CONV_W, DN_QKV), CONV_W ** -0.5),
        'dn_a_log': jnp.log(jax.random.uniform(ks[22], (DEPTH, DN_HEADS), f32, 1.0, 16.0)),
        'dn_dt_bias': dt + jnp.log(-jnp.expm1(-dt)),
        'dn_norm': 1.0 + nrm(ks[23], (DEPTH, DN_DV), 0.02),
        'w_branch': nrm(ks[24], (DEPTH, 2, D_RNN, D_MODEL), D_RNN ** -0.5),
        'w_out': nrm(ks[25], (DEPTH, D_MODEL, D_MODEL), D_MODEL ** -0.5),
        'norm_ffn2': 1.0 + nrm(ks[26], (DEPTH, D_MODEL), 0.02),
        'w_ffn2_up': nrm(ks[27], (DEPTH, D_MODEL, 2 * D_FF), D_MODEL ** -0.5),
        'w_ffn2_down': nrm(ks[28], (DEPTH, D_FF, D_MODEL), D_FF ** -0.5),
        'norm_final': 1.0 + nrm(ks[29], (D_MODEL,), 0.02),
    }


def reference(x_prompt, x_sample, c_prompt, c_sample, state_rglru_h, state_rglru_conv, state_delta_S,
              state_delta_conv, w_ada, b_ada, norm_ffn1, w_ffn1_up, w_ffn1_down, norm_mix, w_in,
              conv_rnn_w, conv_rnn_b, rg_w_a, rg_b_a, rg_w_x, rg_b_x, rg_lambda, conv_qkv_w,
              dn_a_log, dn_dt_bias, dn_norm, w_branch, w_out, norm_ffn2, w_ffn2_up, w_ffn2_down,
              norm_final):
    dt = x_prompt.dtype
    xp, xs = x_prompt, x_sample
    hp, cp, sp, qp = [], [], [], []
    hs, cs, ss, qs = [], [], [], []
    for l in range(DEPTH):
        p = {
            'w_ada': w_ada[l], 'b_ada': b_ada[l], 'norm_ffn1': norm_ffn1[l], 'w_ffn1_up': w_ffn1_up[l],
            'w_ffn1_down': w_ffn1_down[l], 'norm_mix': norm_mix[l], 'w_in': w_in[l],
            'conv_rnn_w': conv_rnn_w[l], 'conv_rnn_b': conv_rnn_b[l], 'rg_w_a': rg_w_a[l], 'rg_b_a': rg_b_a[l],
            'rg_w_x': rg_w_x[l], 'rg_b_x': rg_b_x[l], 'rg_lambda': rg_lambda[l], 'conv_qkv_w': conv_qkv_w[l],
            'dn_a_log': dn_a_log[l], 'dn_dt_bias': dn_dt_bias[l], 'dn_norm': dn_norm[l],
            'w_branch': w_branch[l], 'w_out': w_out[l], 'norm_ffn2': norm_ffn2[l],
            'w_ffn2_up': w_ffn2_up[l], 'w_ffn2_down': w_ffn2_down[l],
        }
        xp, h1, c1, s1, q1 = layer(
            xp, c_prompt,
            jnp.zeros((BATCH, D_RNN), dt),
            jnp.zeros((BATCH, CONV_W - 1, D_RNN), dt),
            jnp.zeros((BATCH, DN_HEADS, DN_DK, DN_DV), dt),
            jnp.zeros((BATCH, CONV_W - 1, DN_QKV), dt),
            True, p)
        xs, h2, c2, s2, q2 = layer(
            xs, c_sample, state_rglru_h[l], state_rglru_conv[l], state_delta_S[l], state_delta_conv[l],
            False, p)
        hp.append(h1); cp.append(c1); sp.append(s1); qp.append(q1)
        hs.append(h2); cs.append(c2); ss.append(s2); qs.append(q2)
    y_prompt = rmsnorm(xp, norm_final)
    y_sample = rmsnorm(xs, norm_final)
    return (y_prompt, y_sample,
            jnp.stack(hp), jnp.stack(cp), jnp.stack(sp), jnp.stack(qp),
            jnp.stack(hs), jnp.stack(cs), jnp.stack(ss), jnp.stack(qs))
```

```cpp
#include <hip/hip_runtime.h>
#include <hip/hip_cooperative_groups.h>
#include <cstdio>
#include <cstdint>
namespace cg = cooperative_groups;

#define LAS __attribute__((address_space(3)))
typedef unsigned short bf16;
typedef short bf16x8 __attribute__((ext_vector_type(8)));
typedef float f32x4 __attribute__((ext_vector_type(4)));
typedef float f32x16 __attribute__((ext_vector_type(16)));
typedef unsigned u32x4 __attribute__((ext_vector_type(4)));
typedef unsigned u32x2 __attribute__((ext_vector_type(2)));

constexpr int D = 1024, SEQ = 2048, NB = 8, MPR = NB * SEQ, NS = 128, M = MPR + NS, MPAD = 16640;
constexpr int FF = 2816, NADA = 9216, NCOND = NB + NS, NIN = 8448, NH = 8;
constexpr float EPS = 1e-6f;
constexpr int NWAVES = 8, NTHR = 512;

constexpr size_t MiB = 1u << 20;
constexpr size_t ZB = (size_t)M * D * 2;
constexpr size_t WS_WUP2 = 1 * MiB;
constexpr size_t WS_WDN2 = 12 * MiB;
constexpr size_t WS_WIN = WS_WDN2 + (size_t)D * FF * 2;
constexpr size_t WS_WBR = 34 * MiB;
constexpr size_t WS_WOUT = 38 * MiB;
constexpr size_t WS_WRG = 40 * MiB;
constexpr size_t WS_CB = WS_WRG + 512 * 1024;
constexpr size_t WS_ADA = 41 * MiB;
constexpr size_t WS_ABL = 46 * MiB;
constexpr size_t WS_H = 48 * MiB;
constexpr size_t WS_Z = WS_H + ZB;
constexpr size_t WS_ACT = WS_Z;
constexpr size_t WS_WUP1 = WS_Z + 96 * MiB;
constexpr size_t WS_WDN1 = WS_Z + 107 * MiB;
constexpr size_t WS_WADA = WS_Z + 113 * MiB;
constexpr size_t WS_END = WS_Z + 6 * ZB + 1 * MiB;
static_assert(WS_WIN + (size_t)NIN * D * 2 <= WS_WBR, "ws map");
static_assert((size_t)M * 16 * 4 <= 2 * MiB, "ws map");
static_assert((size_t)MPAD * FF * 2 <= 96 * MiB, "ws map");
static_assert(WS_WADA + (size_t)NADA * D * 2 <= WS_Z + 6 * ZB, "ws map");

constexpr size_t O_Y = 0, O_HP = (size_t)M * D, O_CRP = O_HP + NB * D, O_SP = O_CRP + NB * 3 * D, O_CQP = O_SP + (size_t)NB * NH * 128 * 128,
                 O_HS = O_CQP + NB * 3 * 3072, O_CRS = O_HS + NS * D, O_SS = O_CRS + NS * 3 * D, O_CQS = O_SS + (size_t)NS * NH * 128 * 128,
                 O_END = O_CQS + (size_t)NS * 3 * 3072;
static_assert(2 * ZB <= (O_END - O_SS) * 4, "scratch in d_out");
constexpr size_t OSB = O_SS * 4 + 2 * ZB, OSB_HK = OSB, OSB_HV = OSB + 3 * MiB / 2, OSB_NK = OSB + 3 * MiB, OSB_NQ = OSB + 7 * MiB / 2;
static_assert(OSB + 4 * MiB <= O_END * 4, "d_out scratch");

__device__ __forceinline__ unsigned pk2(float lo, float hi);
__device__ __forceinline__ unsigned f2bf(float f) { return pk2(f, f) & 0xffffu; }
typedef float f32x2_t __attribute__((ext_vector_type(2))); typedef __bf16 bf16x2_t __attribute__((ext_vector_type(2)));
__device__ __forceinline__ unsigned pk2(float lo, float hi) { f32x2_t v = {lo, hi}; bf16x2_t b = __builtin_convertvector(v, bf16x2_t); return __builtin_bit_cast(unsigned, b); }
__device__ __forceinline__ float bf2f(unsigned short b) { return __builtin_bit_cast(float, (unsigned)b << 16); }
__device__ __forceinline__ float bflo(unsigned u) { return __builtin_bit_cast(float, u << 16); }
__device__ __forceinline__ float bfhi(unsigned u) { return __builtin_bit_cast(float, u & 0xffff0000u); }
__device__ __forceinline__ float rcp_f(float x) { return __builtin_amdgcn_rcpf(x); }
__device__ __forceinline__ float rsq_f(float x) { return __builtin_amdgcn_rsqf(x); }
__device__ __forceinline__ float sigmoid_f(float x) { return rcp_f(1.f + __expf(-x)); }
__device__ __forceinline__ float neg_expm1_f(float x) {
    const float p = -x * (1.f + x * (0.5f + x * (0.16666667f + x * (0.041666668f + x * (0.0083333338f + x * 0.0013888889f)))));
    return x > -0.3f ? p : 1.f - __expf(x);
}
__device__ __forceinline__ float silu_f(float x) { return x * sigmoid_f(x); }
__device__ __forceinline__ float gelu_tanh_f(float x) { return x * sigmoid_f(1.5957691216057308f * (x + 0.044715f * x * x * x)); }
__device__ __forceinline__ float softplus_f(float x) { return x > 20.f ? x : log1pf(__expf(x)); }
template <int CTRL> __device__ __forceinline__ float dpp_f(float x) {
    return __builtin_bit_cast(float, __builtin_amdgcn_update_dpp(0, __builtin_bit_cast(int, x), CTRL, 0xF, 0xF, true));
}
__device__ __forceinline__ float red8(float x) { x += dpp_f<0xB1>(x); x += dpp_f<0x4E>(x); x += dpp_f<0x141>(x); return x; }
__device__ __forceinline__ float red16(float x) { x = red8(x); x += dpp_f<0x140>(x); return x; }
__device__ __forceinline__ float wave_sum(float v) { v = red16(v);
    return ((__builtin_bit_cast(float, __builtin_amdgcn_readlane(__builtin_bit_cast(int, v), 0)) + __builtin_bit_cast(float, __builtin_amdgcn_readlane(__builtin_bit_cast(int, v), 16))) +
            (__builtin_bit_cast(float, __builtin_amdgcn_readlane(__builtin_bit_cast(int, v), 32)) + __builtin_bit_cast(float, __builtin_amdgcn_readlane(__builtin_bit_cast(int, v), 48)))); }
__device__ __forceinline__ int lane_now();
__device__ __forceinline__ int opq(int x);
__device__ __forceinline__ float shfl_xor_l(float v, int o) { const int idx = (opq(lane_now()) ^ o) << 2; return __builtin_bit_cast(float, __builtin_amdgcn_ds_bpermute(idx, __builtin_bit_cast(int, v))); }
__device__ __forceinline__ void unpack8(const u32x4 u, float* x) { x[0] = bflo(u.x); x[1] = bfhi(u.x); x[2] = bflo(u.y); x[3] = bfhi(u.y); x[4] = bflo(u.z); x[5] = bfhi(u.z); x[6] = bflo(u.w); x[7] = bfhi(u.w); }
__device__ __forceinline__ bf16x8 pack8(float a0, float a1, float a2, float a3, float a4, float a5, float a6, float a7) {
    u32x4 w; w.x = pk2(a0, a1); w.y = pk2(a2, a3); w.z = pk2(a4, a5); w.w = pk2(a6, a7); return __builtin_bit_cast(bf16x8, w);
}
#define LDS_WAIT() asm volatile("s_waitcnt lgkmcnt(0)" ::: "memory")
__device__ __forceinline__ int lane_now() { return (int)__builtin_amdgcn_mbcnt_hi(~0u, __builtin_amdgcn_mbcnt_lo(~0u, 0u)); }
__device__ __forceinline__ int opq(int x) { asm volatile("" : "+v"(x)); return x; }

namespace pg8 {
constexpr int BM = 256, BK = 64, HALF = 128, HTB = HALF * BK * 2, NXCD = 8, WGM = 4;
__host__ __device__ __forceinline__ int lds_byte(int r, int c) { const int st = (r >> 4) * 2 + (c >> 5), rr = r & 15, cc = c & 31, ob = rr * 64 + cc * 2; return st * 1024 + (ob ^ (((ob >> 9) & 1) << 5)); }
__host__ __device__ __forceinline__ void stage_rc(int b, int& R, int& C) { const int st = b / 1024, sb = b % 1024, swz = sb ^ (((sb >> 9) & 1) << 5); R = (st >> 1) * 16 + swz / 64; C = (st & 1) * 32 + (swz % 64) / 2; }
__host__ __device__ __forceinline__ int perm32(int rho) { const int n = rho >> 4, i = rho & 15; return 8 * (i >> 2) + 4 * n + (i & 3); }

struct Unit { int pm, pn, sub; };
struct Gemm { const bf16* A0; const bf16* B0; const bf16* A1; const bf16* B1; int K; };

struct StaticOrder {
    int nM, nN, nwg, G, c;
    __device__ void init(int Mp, int N, int G_, int c_) { nM = Mp / BM; nN = N / BM; nwg = nM * nN; G = G_; c = c_; }
    __device__ bool next(int i, Unit& u) const {
        const long L = (long)i * G + c; if (L >= nwg) return false;
        int wgid = (int)L; { const int q = nwg / NXCD, r = nwg % NXCD, xcd = wgid % NXCD, off = wgid / NXCD; wgid = (xcd < r ? xcd * (q + 1) : r * (q + 1) + (xcd - r) * q) + off; }
        const int nig = WGM * nN, gid = wgid / nig, fm = gid * WGM, gsz = (nM - fm) < WGM ? (nM - fm) : WGM;
        u.pm = fm + ((wgid % nig) % gsz); u.pn = (wgid % nig) / gsz; u.sub = 0; return true;
    }
};
struct PairOrder {
    StaticOrder base;
    __device__ bool next(int i, Unit& u) const { const bool ok = base.next(i >> 1, u); u.sub = i & 1; return ok; }
};

template <class Epi, class Sched>
__device__ __forceinline__ void gemm_phase(LAS unsigned char* lds, const Gemm g, const Sched& S, const Epi& E, int wid) {
    const int lane = opq(lane_now()), tid = (wid << 6) | lane, wr = wid >> 2, wc = wid & 3, fr = lane & 15, fq = lane >> 4;
    const int K = g.K, nt = K / BK;
    unsigned voffA[2], voffB[2];
#pragma unroll
    for (int i = 0; i < 2; ++i) { int R, C; stage_rc(tid * 16 + i * 8192, R, C); const int Rb = (R & ~31) + perm32(R & 31);
        voffA[i] = (unsigned)(R * K + C) * 2u; voffB[i] = (unsigned)(Rb * K + C) * 2u; }
    const size_t kstep = (size_t)(BK * 2);
    const size_t hstep = (size_t)HALF * K * 2;
    const size_t tstep = 2 * hstep;
    const unsigned ldsw = (unsigned)wid * 1024u;
    const int aoff = lds_byte(wr * 64 + fr, fq * 8), boff = lds_byte(wc * 32 + fr, fq * 8);
#define PG8_SA(b, h) (((b) * 2 + (h)) * HTB)
#define PG8_SB(b, h) ((4 + (b) * 2 + (h)) * HTB)
#define PG8_STAGE(bufoff, gbase, voff) do { _Pragma("unroll") for (int _i = 0; _i < 2; ++_i) \
        __builtin_amdgcn_global_load_lds((const unsigned*)((const char*)(gbase) + (voff)[_i]), (LAS unsigned*)(lds + (bufoff) + ldsw + _i * 8192), 16, 0, 0); } while (0)
#define PG8_LDA(dst, b, h) do { _Pragma("unroll") for (int m = 0; m < 4; ++m) _Pragma("unroll") for (int k = 0; k < 2; ++k) dst[m][k] = *(const LAS bf16x8*)(lds + PG8_SA(b, h) + aoff + m * 2048 + k * 1024); } while (0)
#define PG8_LDB(dst, b, h) do { _Pragma("unroll") for (int n = 0; n < 2; ++n) _Pragma("unroll") for (int k = 0; k < 2; ++k) dst[n][k] = *(const LAS bf16x8*)(lds + PG8_SB(b, h) + boff + n * 2048 + k * 1024); } while (0)
#define PG8_MMA(ai, bj, At, Bt) do { __builtin_amdgcn_s_setprio(1); _Pragma("unroll") for (int m = 0; m < 4; ++m) _Pragma("unroll") for (int n = 0; n < 2; ++n) _Pragma("unroll") for (int k = 0; k < 2; ++k) \
        acc[ai][bj][m][n] = __builtin_amdgcn_mfma_f32_16x16x32_bf16(Bt[n][k], At[m][k], acc[ai][bj][m][n], 0, 0, 0); __builtin_amdgcn_s_setprio(0); } while (0)
#define PG8_WAIT_V(n) asm volatile("s_waitcnt vmcnt(" #n ")" ::: "memory")
#define PG8_WAIT_L(n) asm volatile("s_waitcnt lgkmcnt(" #n ")" ::: "memory")
#define PG8_BAR __builtin_amdgcn_s_barrier()
#define PG8_SCHED __builtin_amdgcn_sched_barrier(0)
#define PG8_ZERO() do { _Pragma("unroll") for (int a = 0; a < 2; ++a) _Pragma("unroll") for (int b = 0; b < 2; ++b) _Pragma("unroll") for (int m = 0; m < 4; ++m) _Pragma("unroll") for (int n = 0; n < 2; ++n) acc[a][b][m][n] = (f32x4){0.f, 0.f, 0.f, 0.f}; } while (0)
    Unit cur, nxt; int ui = 0;
    if (!S.next(0, cur)) return;
    f32x4 acc[2][2][4][2];
    PG8_ZERO();
    bf16x8 At[4][2], B0[2][2], B1[2][2];
    const char* cA = (const char*)(cur.sub ? g.A1 : g.A0) + (size_t)cur.pm * tstep; const char* cB = (const char*)(cur.sub ? g.B1 : g.B0) + (size_t)cur.pn * tstep;
    PG8_STAGE(PG8_SB(0, 0), cB, voffB); PG8_STAGE(PG8_SB(0, 1), cB + hstep, voffB); PG8_STAGE(PG8_SA(0, 0), cA, voffA); PG8_STAGE(PG8_SA(0, 1), cA + hstep, voffA);
    if (wr == 1) PG8_BAR;
    PG8_WAIT_V(2); PG8_BAR;
    PG8_STAGE(PG8_SB(1, 0), cB + kstep, voffB); PG8_STAGE(PG8_SA(1, 0), cA + kstep, voffA); PG8_STAGE(PG8_SB(1, 1), cB + hstep + kstep, voffB);
    PG8_WAIT_V(6); PG8_BAR;
    for (;;) {
        const bool has_next = S.next(ui + 1, nxt);
        const char* nA = has_next ? (const char*)(nxt.sub ? g.A1 : g.A0) + (size_t)nxt.pm * tstep : cA; const char* nB = has_next ? (const char*)(nxt.sub ? g.B1 : g.B0) + (size_t)nxt.pn * tstep : cB;
        for (int t = 0; t < nt; t += 2) {
            const bool last = (t == nt - 2);
            const char* a1 = cA + (size_t)(t + 1) * kstep;
            const char* a2 = last ? nA : cA + (size_t)(t + 2) * kstep; const char* b2 = last ? nB : cB + (size_t)(t + 2) * kstep;
            const char* a3 = a2 + kstep; const char* b3 = b2 + kstep;
            PG8_LDB(B0, 0, 0); PG8_LDB(B1, 0, 1); PG8_SCHED; PG8_LDA(At, 0, 0); PG8_STAGE(PG8_SA(1, 1), a1 + hstep, voffA);
            PG8_WAIT_V(8); PG8_WAIT_L(0); PG8_BAR; PG8_MMA(0, 0, At, B0); PG8_MMA(0, 1, At, B1); PG8_BAR; PG8_SCHED;
            PG8_LDA(At, 0, 1); PG8_STAGE(PG8_SB(0, 0), b2, voffB); PG8_STAGE(PG8_SB(0, 1), b2 + hstep, voffB); PG8_STAGE(PG8_SA(0, 0), a2, voffA);
            PG8_WAIT_V(8); PG8_WAIT_L(0); PG8_BAR; PG8_MMA(1, 0, At, B0); PG8_MMA(1, 1, At, B1); PG8_BAR; PG8_SCHED;
            PG8_LDB(B0, 1, 0); PG8_LDB(B1, 1, 1); PG8_SCHED; PG8_LDA(At, 1, 0); PG8_STAGE(PG8_SA(0, 1), a2 + hstep, voffA);
            PG8_WAIT_V(8); PG8_WAIT_L(0); PG8_BAR; PG8_MMA(0, 0, At, B0); PG8_MMA(0, 1, At, B1); PG8_BAR; PG8_SCHED;
            PG8_LDA(At, 1, 1); PG8_STAGE(PG8_SB(1, 0), b3, voffB); PG8_STAGE(PG8_SB(1, 1), b3 + hstep, voffB); PG8_STAGE(PG8_SA(1, 0), a3, voffA);
            PG8_WAIT_V(8); PG8_WAIT_L(0); PG8_BAR; PG8_MMA(1, 0, At, B0); PG8_MMA(1, 1, At, B1); PG8_BAR; PG8_SCHED;
        }
        if (wr == 0) PG8_BAR;
        bool keep = false;
        if constexpr (Epi::KEEP) { if (cur.sub == 0) { E.mid(acc, cur, wr, wc, fr, fq); keep = true; } else E(acc, cur, wr, wc, fr, fq); }
        else E(acc, cur, wr, wc, fr, fq);
        if (!has_next) break;
        if (!keep) PG8_ZERO();
        cur = nxt; cA = nA; cB = nB; ++ui;
        if (wr == 1) PG8_BAR;
    }
    PG8_WAIT_V(0);
    PG8_BAR;
#undef PG8_SA
#undef PG8_SB
#undef PG8_STAGE
#undef PG8_LDA
#undef PG8_LDB
#undef PG8_MMA
#undef PG8_WAIT_V
#undef PG8_WAIT_L
#undef PG8_BAR
#undef PG8_SCHED
#undef PG8_ZERO
}
}

typedef f32x4 AccT[2][2][4][2];
__device__ __forceinline__ int cond_of_row(int row) { return row < MPR ? (row >> 11) : (NB + row - MPR); }

struct EpiAda {
    static constexpr bool KEEP = false;
    float* ada; const float* bias;
    __device__ __forceinline__ void operator()(const AccT& acc, const pg8::Unit& u, int wr, int wc, int fr, int fq) const {
#pragma unroll
        for (int ai = 0; ai < 2; ++ai)
#pragma unroll
            for (int m = 0; m < 4; ++m) { const int row = u.pm * 256 + ai * 128 + wr * 64 + m * 16 + fr; if (row >= NCOND) continue;
#pragma unroll
                for (int bj = 0; bj < 2; ++bj)
#pragma unroll
                    for (int n = 0; n < 2; ++n) { const int col = u.pn * 256 + bj * 128 + wc * 32 + 8 * fq + 4 * n;
                        *(f32x4*)(ada + (size_t)row * NADA + col) = acc[ai][bj][m][n] + *(const f32x4*)(bias + col); } }
    }
};
struct EpiSwiglu {
    static constexpr bool KEEP = false;
    bf16* act;
    __device__ __forceinline__ void operator()(const AccT& acc, const pg8::Unit& u, int wr, int wc, int fr, int fq) const {
#pragma unroll
        for (int ai = 0; ai < 2; ++ai)
#pragma unroll
            for (int m = 0; m < 4; ++m) { const int row = u.pm * 256 + ai * 128 + wr * 64 + m * 16 + fr; if (row >= M) continue;
                const f32x4 g0 = acc[ai][0][m][0], g1 = acc[ai][0][m][1], v0 = acc[ai][1][m][0], v1 = acc[ai][1][m][1];
                u32x4 w; w.x = pk2(silu_f(g0[0]) * v0[0], silu_f(g0[1]) * v0[1]); w.y = pk2(silu_f(g0[2]) * v0[2], silu_f(g0[3]) * v0[3]);
                w.z = pk2(silu_f(g1[0]) * v1[0], silu_f(g1[1]) * v1[1]); w.w = pk2(silu_f(g1[2]) * v1[2], silu_f(g1[3]) * v1[3]);
                *(u32x4*)(act + (size_t)row * FF + u.pn * 128 + wc * 32 + 8 * fq) = w; }
    }
};
struct EpiResid {
    static constexpr bool KEEP = false;
    float* X; const float* xp; const float* xs; const float* gate; float coef;
    __device__ __forceinline__ void operator()(const AccT& acc, const pg8::Unit& u, int wr, int wc, int fr, int fq) const {
#pragma unroll
        for (int ai = 0; ai < 2; ++ai)
#pragma unroll
            for (int m = 0; m < 4; ++m) { const int row = u.pm * 256 + ai * 128 + wr * 64 + m * 16 + fr; if (row >= M) continue;
                const float* xin = xp ? (row < MPR ? xp + (size_t)row * D : xs + (size_t)(row - MPR) * D) : X + (size_t)row * D;
                const float* gt = gate + (size_t)cond_of_row(row) * NADA;
#pragma unroll
                for (int bj = 0; bj < 2; ++bj)
#pragma unroll
                    for (int n = 0; n < 2; ++n) { const int col = u.pn * 256 + bj * 128 + wc * 32 + 8 * fq + 4 * n;
                        const f32x4 xv = *(const f32x4*)(xin + col), gv = *(const f32x4*)(gt + col);
                        *(f32x4*)(X + (size_t)row * D + col) = xv + (gv * coef) * acc[ai][bj][m][n]; } }
    }
};
constexpr size_t WS_CNT = 14336, WS_PART = 65536;
template <int MODE> struct EpiResidNorm {
    static constexpr bool KEEP = false;
    float* X; const float* xp; const float* gate; float coef; const float* gvec; const float* shift; bf16* Hout; float* part; unsigned* cnt; LAS float* sred;
    __device__ __forceinline__ void operator()(AccT& acc, const pg8::Unit& u, int wr, int wc, int fr_, int fq_) const {
        const int fr = opq(fr_), fq = opq(fq_);
        const int tid = wr * 256 + wc * 64 + fq * 16 + fr, bidx = u.pm >> 3;
        const float* gt = gate + (size_t)bidx * NADA;
        float ss[2][4]; int zoff = 0;
#pragma unroll
        for (int ai = 0; ai < 2; ++ai)
#pragma unroll
            for (int m = 0; m < 4; ++m) { const int row = u.pm * 256 + ai * 128 + wr * 64 + m * 16 + fr + zoff;
                const float* xin = xp ? xp + (size_t)row * D : X + (size_t)row * D; float sacc = 0.f;
#pragma unroll
                for (int bj = 0; bj < 2; ++bj)
#pragma unroll
                    for (int n = 0; n < 2; ++n) { const int col = u.pn * 256 + bj * 128 + wc * 32 + 8 * fq + 4 * n;
                        const f32x4 xv = *(const f32x4*)(xin + col), gv = *(const f32x4*)(gt + col);
                        const f32x4 xn = xv + (gv * coef) * acc[ai][bj][m][n]; acc[ai][bj][m][n] = xn;
                        if (MODE == 0) *(f32x4*)(X + (size_t)row * D + col) = xn;
                        sacc += (xn[0] * xn[0] + xn[1] * xn[1]) + (xn[2] * xn[2] + xn[3] * xn[3]); }
                asm volatile("" : "+v"(zoff) : "v"(sacc));
                sacc += shfl_xor_l(sacc, 16); sacc += shfl_xor_l(sacc, 32);
                ss[ai][m] = sacc; __builtin_amdgcn_sched_barrier(0); }
        if (fq == 0) {
#pragma unroll
            for (int ai = 0; ai < 2; ++ai)
#pragma unroll
                for (int m = 0; m < 4; ++m) sred[wc * 256 + ai * 128 + wr * 64 + m * 16 + fr] = ss[ai][m]; }
        __syncthreads();
        if (tid < 256) __hip_atomic_store((unsigned*)part + ((size_t)u.pm * 4 + u.pn) * 256 + tid, __builtin_bit_cast(unsigned, (sred[tid] + sred[256 + tid]) + (sred[512 + tid] + sred[768 + tid])), __ATOMIC_RELAXED, __HIP_MEMORY_SCOPE_AGENT);
        asm volatile("s_waitcnt vmcnt(0)" ::: "memory");
        __syncthreads();
        if (tid == 0) { __hip_atomic_fetch_add(cnt + u.pm, 1u, __ATOMIC_RELAXED, __HIP_MEMORY_SCOPE_AGENT);
            unsigned sp = 0; while (__hip_atomic_load(cnt + u.pm, __ATOMIC_RELAXED, __HIP_MEMORY_SCOPE_AGENT) < 4u && ++sp < (1u << 24)) __builtin_amdgcn_s_sleep(1); }
        __syncthreads();
        if (tid < 256) { unsigned* pp = (unsigned*)part + (size_t)u.pm * 4 * 256 + tid;
            const float p0 = __builtin_bit_cast(float, __hip_atomic_load(pp, __ATOMIC_RELAXED, __HIP_MEMORY_SCOPE_AGENT)), p1 = __builtin_bit_cast(float, __hip_atomic_load(pp + 256, __ATOMIC_RELAXED, __HIP_MEMORY_SCOPE_AGENT));
            const float p2 = __builtin_bit_cast(float, __hip_atomic_load(pp + 512, __ATOMIC_RELAXED, __HIP_MEMORY_SCOPE_AGENT)), p3 = __builtin_bit_cast(float, __hip_atomic_load(pp + 768, __ATOMIC_RELAXED, __HIP_MEMORY_SCOPE_AGENT));
            sred[1024 + tid] = rsq_f(((p0 + p1) + (p2 + p3)) * (1.f / D) + EPS); }
        __syncthreads();
        const float* sh = MODE == 0 ? shift + (size_t)bidx * NADA : nullptr;
#pragma unroll
        for (int bj = 0; bj < 2; ++bj) { const int col = u.pn * 256 + bj * 128 + wc * 32 + 8 * fq;
            const f32x4 g0 = *(const f32x4*)(gvec + col), g1 = *(const f32x4*)(gvec + col + 4);
            f32x4 a0 = g0, a1 = g1, b0 = {0.f, 0.f, 0.f, 0.f}, b1 = b0;
            if (MODE == 0) { a0 = g0 * (*(const f32x4*)(sh + D + col) + 1.f); a1 = g1 * (*(const f32x4*)(sh + D + col + 4) + 1.f); b0 = *(const f32x4*)(sh + col); b1 = *(const f32x4*)(sh + col + 4); }
#pragma unroll
            for (int ai = 0; ai < 2; ++ai)
#pragma unroll
                for (int m = 0; m < 4; ++m) { const int rl = ai * 128 + wr * 64 + m * 16 + fr; const size_t row = (size_t)u.pm * 256 + rl; const float rstd = sred[1024 + rl];
                    const f32x4 y0 = acc[ai][bj][m][0] * rstd * a0 + b0, y1 = acc[ai][bj][m][1] * rstd * a1 + b1;
                    if (MODE == 0) *(bf16x8*)(Hout + row * D + col) = pack8(y0[0], y0[1], y0[2], y0[3], y1[0], y1[1], y1[2], y1[3]);
                    else { *(f32x4*)(X + row * D + col) = y0; *(f32x4*)(X + row * D + col + 4) = y1; }
                    __builtin_amdgcn_sched_barrier(0); }
        }
        __syncthreads();
    }
};
struct EpiIn {
    static constexpr bool KEEP = false;
    bf16* z; bf16* mg; float* abl; float* out;
    __device__ __forceinline__ void operator()(const AccT& acc, const pg8::Unit& u, int wr, int wc, int fr, int fq) const {
        const int bi = u.pn >> 2;
        if (bi == 8) {
            if (wc == 0 && fq < 2) {
#pragma unroll
                for (int ai = 0; ai < 2; ++ai)
#pragma unroll
                    for (int m = 0; m < 4; ++m) { const int row = u.pm * 256 + ai * 128 + wr * 64 + m * 16 + fr; if (row >= M) continue;
                        *(f32x4*)(abl + (size_t)row * 16 + 8 * fq) = acc[ai][0][m][0]; *(f32x4*)(abl + (size_t)row * 16 + 8 * fq + 4) = acc[ai][0][m][1]; }
            }
            return;
        }
        bf16* base = bi < 6 ? z + (size_t)bi * (ZB / 2) : mg + (size_t)(bi - 6) * (ZB / 2);
        const int act = (bi == 1) ? 1 : (bi == 5) ? 2 : (bi >= 6) ? 3 : 0;
        const int colt = (u.pn & 3) * 256 + wc * 32 + 8 * fq;
#pragma unroll
        for (int ai = 0; ai < 2; ++ai)
#pragma unroll
            for (int m = 0; m < 4; ++m) { const int row = u.pm * 256 + ai * 128 + wr * 64 + m * 16 + fr; if (row >= M) continue;
#pragma unroll
                for (int bj = 0; bj < 2; ++bj) { f32x4 v0 = acc[ai][bj][m][0], v1 = acc[ai][bj][m][1];
                    if (act == 1) {
#pragma unroll
                        for (int j = 0; j < 4; ++j) { v0[j] = gelu_tanh_f(v0[j]); v1[j] = gelu_tanh_f(v1[j]); } }
                    else if (act == 2) {
#pragma unroll
                        for (int j = 0; j < 4; ++j) { v0[j] = silu_f(v0[j]); v1[j] = silu_f(v1[j]); } }
                    else if (act == 3) {
#pragma unroll
                        for (int j = 0; j < 4; ++j) { v0[j] = sigmoid_f(v0[j]); v1[j] = sigmoid_f(v1[j]); } }
                    u32x4 w; w.x = pk2(v0[0], v0[1]); w.y = pk2(v0[2], v0[3]); w.z = pk2(v1[0], v1[1]); w.w = pk2(v1[2], v1[3]);
                    *(u32x4*)(base + (size_t)row * D + colt + bj * 128) = w;
                    if (act == 0 && row < MPR) { const int rs = row & (SEQ - 1), r64 = row & 63, bb = row >> 11, col = colt + bj * 128;
                        if (bi >= 3 && r64 >= 61 && rs < SEQ - 3)
                            *(u32x4*)((bf16*)((unsigned char*)out + (bi == 3 ? OSB_HK : OSB_HV)) + ((size_t)(bb * 32 + (rs >> 6) + 1) * 3 + (r64 - 61)) * D + col) = w;
                        if (rs >= SEQ - 3) { float* dst = bi == 0 ? out + O_CRP + ((size_t)bb * 3 + (rs - (SEQ - 3))) * D + col : out + O_CQP + ((size_t)bb * 3 + (rs - (SEQ - 3))) * 3072 + (bi - 2) * 1024 + col;
                            *(f32x4*)dst = v0; *(f32x4*)(dst + 4) = v1; } }
                } }
    }
};
struct EpiBranch {
    static constexpr bool KEEP = true;
    const bf16* mga; const bf16* mgb; bf16* G;
    __device__ __forceinline__ void mid(AccT& acc, const pg8::Unit& u, int wr, int wc, int fr, int fq) const {
#pragma unroll
        for (int ai = 0; ai < 2; ++ai)
#pragma unroll
            for (int m = 0; m < 4; ++m) { int row = u.pm * 256 + ai * 128 + wr * 64 + m * 16 + fr; if (row >= M) row = M - 1;
#pragma unroll
                for (int bj = 0; bj < 2; ++bj) { const size_t o = (size_t)row * D + u.pn * 256 + bj * 128 + wc * 32 + 8 * fq;
                    const u32x4 a = *(const u32x4*)(mga + o), b = *(const u32x4*)(mgb + o);
                    f32x4 r0, r1;
                    r0[0] = bflo(a.x) * rcp_f(bflo(b.x)); r0[1] = bfhi(a.x) * rcp_f(bfhi(b.x)); r0[2] = bflo(a.y) * rcp_f(bflo(b.y)); r0[3] = bfhi(a.y) * rcp_f(bfhi(b.y));
                    r1[0] = bflo(a.z) * rcp_f(bflo(b.z)); r1[1] = bfhi(a.z) * rcp_f(bfhi(b.z)); r1[2] = bflo(a.w) * rcp_f(bflo(b.w)); r1[3] = bfhi(a.w) * rcp_f(bfhi(b.w));
                    acc[ai][bj][m][0] = acc[ai][bj][m][0] * r0; acc[ai][bj][m][1] = acc[ai][bj][m][1] * r1; } }
    }
    __device__ __forceinline__ void operator()(const AccT& acc, const pg8::Unit& u, int wr, int wc, int fr, int fq) const {
#pragma unroll
        for (int ai = 0; ai < 2; ++ai)
#pragma unroll
            for (int m = 0; m < 4; ++m) { const int row = u.pm * 256 + ai * 128 + wr * 64 + m * 16 + fr; if (row >= M) continue;
#pragma unroll
                for (int bj = 0; bj < 2; ++bj) { const size_t o = (size_t)row * D + u.pn * 256 + bj * 128 + wc * 32 + 8 * fq;
                    const u32x4 b = *(const u32x4*)(mgb + o);
                    const f32x4 v0 = acc[ai][bj][m][0], v1 = acc[ai][bj][m][1];
                    u32x4 w; w.x = pk2(v0[0] * bflo(b.x), v0[1] * bfhi(b.x)); w.y = pk2(v0[2] * bflo(b.y), v0[3] * bfhi(b.y));
                    w.z = pk2(v1[0] * bflo(b.z), v1[1] * bfhi(b.z)); w.w = pk2(v1[2] * bflo(b.w), v1[3] * bfhi(b.w));
                    *(u32x4*)(G + o) = w; } }
    }
};

__device__ __forceinline__ f32x4 mini_partial(const bf16* A, const bf16* Bt, int K, int row0, int col0, int ks, int lane) {
    const int kq = K >> 2;
    const bf16* ap = A + (size_t)(MPR + row0 + (lane & 15)) * K + ks * kq + (lane >> 4) * 8;
    const bf16* bp = Bt + (size_t)(col0 + (lane & 15)) * K + ks * kq + (lane >> 4) * 8;
    f32x4 acc = {0.f, 0.f, 0.f, 0.f};
#pragma unroll 1
    for (int k0 = 0; k0 < kq; k0 += 256) {
        bf16x8 a[8], b[8];
#pragma unroll
        for (int i = 0; i < 8; ++i) if (k0 + 32 * i < kq) { a[i] = *(const bf16x8*)(ap + k0 + 32 * i); b[i] = *(const bf16x8*)(bp + k0 + 32 * i); }
#pragma unroll
        for (int i = 0; i < 8; ++i) if (k0 + 32 * i < kq) acc = __builtin_amdgcn_mfma_f32_16x16x32_bf16(b[i], a[i], acc, 0, 0, 0);
    }
    return acc;
}
template <class F>
__device__ __forceinline__ void mini_gemm(LAS unsigned char* lds, const bf16* A0, const bf16* B0, const bf16* A1, const bf16* B1, int K, int wg, int G, int tid_, const F& epi) {
    const int tid = opq(tid_), lane = tid & 63, wave = tid >> 6, ks = wave & 3;
    LAS f32x4* red = (LAS f32x4*)lds;
    for (int t0 = wg * 2; t0 < 512; t0 += G * 2) {
        const int tile = t0 + (wave >> 2), row0 = (tile >> 6) * 16, col0 = (tile & 63) * 16;
        f32x4 p0 = mini_partial(A0, B0, K, row0, col0, ks, lane), p1 = {0.f, 0.f, 0.f, 0.f};
        if (A1) p1 = mini_partial(A1, B1, K, row0, col0, ks, lane);
        red[(wave * 2) * 64 + lane] = p0; red[(wave * 2 + 1) * 64 + lane] = p1;
        __syncthreads();
        if (ks == 0) {
#pragma unroll
            for (int w = 1; w < 4; ++w) { p0 = p0 + red[((wave + w) * 2) * 64 + lane]; p1 = p1 + red[((wave + w) * 2 + 1) * 64 + lane]; }
            epi(MPR + row0 + (lane & 15), col0 + 4 * (lane >> 4), p0, p1);
        }
        __syncthreads();
    }
}

struct Params { const float* in[32]; float* out; unsigned char* ws; };
constexpr int LDS_BYTES = 147456;
#ifndef PHM
#define PHM 0xFFFF
#endif
#ifndef P7M
#define P7M 0xF
#endif

struct Ctx {
    const float* const* in; float* out; unsigned char* ws; LAS unsigned char* lds;
    int tid, lane, wave, wg, G;
};
#define KAS __attribute__((address_space(4)))
typedef const float* cfptr_t; typedef float* fptr_t; typedef unsigned char* ucptr_t;
__device__ __forceinline__ const float* karg_in(int k) { return *(volatile KAS cfptr_t*)((const KAS char*)__builtin_amdgcn_kernarg_segment_ptr() + 8 * k); }
__device__ __forceinline__ float* karg_out() { return *(volatile KAS fptr_t*)((const KAS char*)__builtin_amdgcn_kernarg_segment_ptr() + 256); }
__device__ __forceinline__ unsigned char* karg_ws() { return *(volatile KAS ucptr_t*)((const KAS char*)__builtin_amdgcn_kernarg_segment_ptr() + 264); }
#define INP(k) karg_in(k)

template <int MODE>
__device__ __forceinline__ void sample_norm_rows(const float* gvec, int ish, int gw, int lane) {
    if (gw >= NS) return;
    const int row = MPR + gw; float* X = karg_out() + (size_t)row * D;
    f32x4 v[4]; float s = 0.f;
#pragma unroll
    for (int j = 0; j < 4; ++j) { v[j] = *(const f32x4*)(X + 4 * (lane + 64 * j)); s += (v[j][0] * v[j][0] + v[j][1] * v[j][1]) + (v[j][2] * v[j][2] + v[j][3] * v[j][3]); }
    const float rstd = rsq_f(wave_sum(s) * (1.f / D) + EPS);
    const float* sh = (const float*)(karg_ws() + WS_ADA) + (size_t)cond_of_row(row) * NADA + ish * D;
#pragma unroll
    for (int j = 0; j < 4; ++j) { const int col = 4 * (lane + 64 * j); const f32x4 g = *(const f32x4*)(gvec + col);
        if (MODE == 0) { const f32x4 y = (v[j] * rstd * g) * (*(const f32x4*)(sh + D + col) + 1.f) + *(const f32x4*)(sh + col);
            u32x2 o; o.x = pk2(y[0], y[1]); o.y = pk2(y[2], y[3]); *(u32x2*)((bf16*)(karg_ws() + WS_H) + (size_t)row * D + col) = o; }
        else *(f32x4*)(X + col) = v[j] * rstd * g; }
}
__device__ __forceinline__ void transpose_item(const float* W, int ldw, int k0, int n0, int nvalid, bf16* WT, int ldt, int drow0, LAS float* scr, int lane) {
    const int cc = lane & 31;
#pragma unroll 8
    for (int i = 0; i < 32; ++i) { const int kk = 2 * i + (lane >> 5); scr[kk * 33 + cc] = (cc < nvalid) ? W[(size_t)(k0 + kk) * ldw + n0 + cc] : 0.f; }
    LDS_WAIT(); asm volatile("" ::: "memory");
    const int c = lane & 7;
#pragma unroll
    for (int j = 0; j < 4; ++j) { const int n = (lane >> 3) + 8 * j; const LAS float* s = scr + (8 * c) * 33 + n;
        u32x4 o; o.x = pk2(s[0 * 33], s[1 * 33]); o.y = pk2(s[2 * 33], s[3 * 33]); o.z = pk2(s[4 * 33], s[5 * 33]); o.w = pk2(s[6 * 33], s[7 * 33]);
        if (n < nvalid) *(u32x4*)(WT + (size_t)(drow0 + n) * ldt + k0 + 8 * c) = o; }
    LDS_WAIT(); asm volatile("" ::: "memory");
}

template <int PART>
__device__ __forceinline__ void prologue(const Params& P, LAS unsigned char* lds, int gw, int NGW, int wave, int lane) {
    LAS float* scr = (LAS float*)(lds + wave * 16384);
    unsigned char* ws = karg_ws();
    constexpr int I_UP = 16 * 176, I_DN = 44 * 32, I_IN = 16 * 257, I_BR = 2 * 16 * 32, I_OUT = 16 * 32, I_ADA = 16 * 288, I_RG = 128;
    constexpr int NITEMS = 2 * I_UP + 2 * I_DN + I_IN + I_BR + I_OUT + I_ADA + I_RG;
    constexpr int I_FIRST = 2 * I_UP + 2 * I_DN + I_IN + I_BR + I_OUT;
    for (int it = gw; it < NITEMS; it += NGW) {
        int r = it;
        if (PART == 0) { if (r >= I_ADA) break; r += I_FIRST; } else { if (r >= NITEMS - I_ADA) break; if (r >= I_FIRST) r += I_ADA; }
        if (r < 2 * I_UP) { const int which = r / I_UP; r -= which * I_UP; const int kb = r / 176, nb = r % 176, n0 = nb * 32; const int half = n0 >= FF ? 1 : 0, np = n0 - half * FF;
            transpose_item(INP(which ? 29 : 11), 2 * FF, kb * 64, n0, 32, (bf16*)(ws + (which ? WS_WUP2 : WS_WUP1)), D, (np >> 7) * 256 + half * 128 + (np & 127), scr, lane); continue; }
        r -= 2 * I_UP;
        if (r < 2 * I_DN) { const int which = r / I_DN; r -= which * I_DN; const int kb = r / 32, nb = r % 32;
            transpose_item(INP(which ? 30 : 12), D, kb * 64, nb * 32, 32, (bf16*)(ws + (which ? WS_WDN2 : WS_WDN1)), FF, nb * 32, scr, lane); continue; }
        r -= 2 * I_DN;
        if (r < I_IN) { const int kb = r / 257, nb = r % 257; int n0, nv, dr;
            if (nb < 160) { n0 = nb * 32; nv = 32; dr = n0; } else if (nb == 160) { n0 = 5120; nv = 16; dr = 8192; } else { n0 = 5136 + (nb - 161) * 32; nv = 32; dr = 5120 + (nb - 161) * 32; }
            transpose_item(INP(14), 8208, kb * 64, n0, nv, (bf16*)(ws + WS_WIN), D, dr, scr, lane); continue; }
        r -= I_IN;
        if (r < I_BR) { const int which = r / 512; r -= which * 512; const int kb = r / 32, nb = r % 32;
            transpose_item(INP(26) + (size_t)which * D * D, D, kb * 64, nb * 32, 32, (bf16*)(ws + WS_WBR), D, which * D + nb * 32, scr, lane); continue; }
        r -= I_BR;
        if (r < I_OUT) { const int kb = r / 32, nb = r % 32; transpose_item(INP(27), D, kb * 64, nb * 32, 32, (bf16*)(ws + WS_WOUT), D, nb * 32, scr, lane); continue; }
        r -= I_OUT;
        if (r < I_ADA) { const int kb = r / 288, nb = r % 288; transpose_item(INP(8), NADA, kb * 64, nb * 32, 32, (bf16*)(ws + WS_WADA), D, nb * 32, scr, lane); continue; }
        r -= I_ADA;
        { const int gx = r >> 6, n = (r >> 3) & 7, kb = (r >> 2) & 1, nb = r & 3;
          transpose_item(INP(gx ? 19 : 17) + (size_t)n * 128 * 128, 128, kb * 64, nb * 32, 32, (bf16*)(ws + WS_WRG), 128, n * 256 + gx * 128 + nb * 32, scr, lane); }
    }
    bf16* cb = (bf16*)(ws + WS_CB);
    if (PART == 0) for (int row = gw; row < 256; row += NGW) {
        const float* src = row < NB ? INP(2) + (size_t)row * D : (row < NCOND ? INP(3) + (size_t)(row - NB) * D : nullptr);
#pragma unroll
        for (int j = 0; j < 4; ++j) { const int col = 4 * (lane + 64 * j); f32x4 v = src ? *(const f32x4*)(src + col) : (f32x4){0.f, 0.f, 0.f, 0.f};
            u32x2 o; o.x = pk2(v[0], v[1]); o.y = pk2(v[2], v[3]); *(u32x2*)(cb + (size_t)row * D + col) = o; }
    }
}

template <int MODE>
__device__ __forceinline__ void norm_mod_pass(const Params& P, const float* gvec, int ish, int gw, int NGW, int lane) {
    const float* ada = (const float*)(karg_ws() + WS_ADA); bf16* H = (bf16*)(karg_ws() + WS_H);
    const float* xp = INP(0); const float* xs = INP(1); const float* X = karg_out();
    for (int row0 = 2 * gw; row0 < M; row0 += 2 * NGW) {
        f32x4 v[2][4]; float s[2] = {0.f, 0.f};
#pragma unroll
        for (int u = 0; u < 2; ++u) { const int row = row0 + u;
            const float* xr = MODE == 0 ? (row < MPR ? xp + (size_t)row * D : xs + (size_t)(row - MPR) * D) : X + (size_t)row * D;
#pragma unroll
            for (int j = 0; j < 4; ++j) v[u][j] = *(const f32x4*)(xr + 4 * (lane + 64 * j)); }
#pragma unroll
        for (int u = 0; u < 2; ++u)
#pragma unroll
            for (int j = 0; j < 4; ++j) s[u] += (v[u][j][0] * v[u][j][0] + v[u][j][1] * v[u][j][1]) + (v[u][j][2] * v[u][j][2] + v[u][j][3] * v[u][j][3]);
        s[0] = wave_sum(s[0]); s[1] = wave_sum(s[1]);
#pragma unroll
        for (int u = 0; u < 2; ++u) { const int row = row0 + u; const float rstd = rsq_f(s[u] * (1.f / D) + EPS);
            const float* sh = ada + (size_t)cond_of_row(row) * NADA + ish * D; const float* sc = sh + D;
#pragma unroll
            for (int j = 0; j < 4; ++j) { const int col = 4 * (lane + 64 * j); const f32x4 g = *(const f32x4*)(gvec + col), a = *(const f32x4*)(sc + col), bb = *(const f32x4*)(sh + col);
                const f32x4 y = (v[u][j] * rstd * g) * (a + 1.f) + bb; u32x2 o; o.x = pk2(y[0], y[1]); o.y = pk2(y[2], y[3]); *(u32x2*)(H + (size_t)row * D + col) = o; } }
    }
}
__device__ __forceinline__ void final_norm_pass(const Params& P, int gw, int NGW, int lane) {
    const float* gvec = INP(31); float* X = karg_out();
    for (int row0 = 2 * gw; row0 < M; row0 += 2 * NGW) {
        f32x4 v[2][4]; float s[2] = {0.f, 0.f};
#pragma unroll
        for (int u = 0; u < 2; ++u)
#pragma unroll
            for (int j = 0; j < 4; ++j) v[u][j] = *(const f32x4*)(X + (size_t)(row0 + u) * D + 4 * (lane + 64 * j));
#pragma unroll
        for (int u = 0; u < 2; ++u)
#pragma unroll
            for (int j = 0; j < 4; ++j) s[u] += (v[u][j][0] * v[u][j][0] + v[u][j][1] * v[u][j][1]) + (v[u][j][2] * v[u][j][2] + v[u][j][3] * v[u][j][3]);
        s[0] = wave_sum(s[0]); s[1] = wave_sum(s[1]);
#pragma unroll
        for (int u = 0; u < 2; ++u) { const float rstd = rsq_f(s[u] * (1.f / D) + EPS);
#pragma unroll
            for (int j = 0; j < 4; ++j) { const int col = 4 * (lane + 64 * j); *(f32x4*)(X + (size_t)(row0 + u) * D + col) = v[u][j] * rstd * *(const f32x4*)(gvec + col); } }
    }
}
__device__ __forceinline__ void onorm_pass(const Params& P, int gw, int NGW, int lane) {
    const bf16* O = (const bf16*)(karg_ws() + WS_H); bf16* ZG = (bf16*)(karg_ws() + WS_Z + 5 * ZB); const float* dn = INP(25);
    const int dc = (lane & 7) * 16;
    for (int row0 = 2 * gw; row0 < M; row0 += 2 * NGW) {
        u32x4 a[2][2], z[2][2];
#pragma unroll
        for (int u = 0; u < 2; ++u) { const size_t o = (size_t)(row0 + u) * D + lane * 16;
            a[u][0] = *(const u32x4*)(O + o); a[u][1] = *(const u32x4*)(O + o + 8); z[u][0] = *(const u32x4*)(ZG + o); z[u][1] = *(const u32x4*)(ZG + o + 8); }
#pragma unroll
        for (int u = 0; u < 2; ++u) { const size_t o = (size_t)(row0 + u) * D + lane * 16;
            float v[16], zz[16]; unpack8(a[u][0], v); unpack8(a[u][1], v + 8); unpack8(z[u][0], zz); unpack8(z[u][1], zz + 8);
            float s = 0.f;
#pragma unroll
            for (int e = 0; e < 16; ++e) s += v[e] * v[e];
            s = red8(s);
            const float rstd = rsq_f(s * (1.f / 128.f) + EPS);
#pragma unroll
            for (int e = 0; e < 16; ++e) v[e] = v[e] * rstd * dn[dc + e] * zz[e];
            *(bf16x8*)(ZG + o) = pack8(v[0], v[1], v[2], v[3], v[4], v[5], v[6], v[7]); *(bf16x8*)(ZG + o + 8) = pack8(v[8], v[9], v[10], v[11], v[12], v[13], v[14], v[15]); }
    }
}

constexpr int SS_TAIL = 530;
constexpr int RG_SPLIT = 8;
constexpr size_t WS_HCARRY = 917504;
__device__ __forceinline__ void rglru_task(const Params& P, LAS unsigned char* lds, int b, int n, int qd, int tid, int t0, int t1) {
    const int lane = tid & 63, wave = tid >> 6;
    LAS bf16* xcA = (LAS bf16*)lds;
    LAS float* xcf = (LAS float*)(lds + 34816);
    LAS float* rb = (LAS float*)(lds + 51200);
    LAS float* ib = (LAS float*)(lds + 67584);
    LAS float* segA = (LAS float*)(lds + 83968);
    LAS float* segB = (LAS float*)(lds + 86016);
    LAS float* hc = (LAS float*)(lds + 88064);
    LAS float* cw = (LAS float*)(lds + 88192);
    LAS bf16* rawt = (LAS bf16*)(lds + 90752);
    bf16* XR = (bf16*)(karg_ws() + WS_Z); bf16* GR = (bf16*)(karg_ws() + WS_Z + ZB);
    const bf16* WRG = (const bf16*)(karg_ws() + WS_WRG);
    const int cb0 = n * 128, oc0 = cb0 + qd * 32;
    const bool prompt = b >= 0;
    for (int i = tid; i < 640; i += NTHR) cw[i] = i < 512 ? INP(15)[(size_t)(i >> 7) * D + cb0 + (i & 127)] : INP(16)[cb0 + (i - 512)];
    if (tid < 32) hc[tid] = t0 > 0 ? ((const float*)(karg_ws() + WS_HCARRY))[(size_t)b * D + oc0 + tid] : 0.f;
    const int tb = wave & 3, cbk = wave >> 2;
    bf16x8 Bf[8];
    { const bf16* wrow = WRG + (size_t)(n * 256 + cbk * 128 + qd * 32 + (lane & 31)) * 128 + (lane >> 5) * 8;
#pragma unroll
      for (int ks = 0; ks < 8; ++ks) Bf[ks] = *(const bf16x8*)(wrow + ks * 16); }
    const float gbias = INP(cbk ? 20 : 18)[oc0 + (lane & 31)];
    const int ch = tid & 31, seg = tid >> 5;
    const float sp = softplus_f(-INP(21)[oc0 + ch]);
    float hlast = 0.f;
    u32x4 pre[5];
#define RG_RAW_LOAD(tile_) do { _Pragma("unroll") for (int i = 0; i < 5; ++i) { const int q = tid + 512 * i, row = q >> 4, c16 = q & 15, tl = (tile_) * 128 - 3 + row; \
        pre[i] = (q < 131 * 16 && tl >= 0) ? *(const u32x4*)(XR + ((size_t)b * SEQ + tl) * D + cb0 + c16 * 8) : (u32x4){0u, 0u, 0u, 0u}; } } while (0)
#define RG_RAW_STORE() do { _Pragma("unroll") for (int i = 0; i < 5; ++i) { const int q = tid + 512 * i; if (q < 131 * 16) *(LAS u32x4*)(rawt + (q >> 4) * 136 + (q & 15) * 8) = pre[i]; } } while (0)
    if (prompt) { RG_RAW_LOAD(t0); RG_RAW_STORE(); }
    __syncthreads();
    const int ntiles = t1;
    for (int tile = t0; tile < ntiles; ++tile) {
        const int row0 = prompt ? b * SEQ + tile * 128 : MPR;
        if (prompt && tile + 1 < ntiles) RG_RAW_LOAD(tile + 1);
        { const int t = tid >> 2, cq = tid & 3, c0 = cq * 32;
#pragma unroll 2
          for (int q = 0; q < 4; ++q) {
              const int cc = c0 + q * 8;
              float a[8];
#pragma unroll
              for (int e = 0; e < 8; ++e) a[e] = cw[512 + cc + e];
#pragma unroll
              for (int j = 0; j < 4; ++j) {
                  if (prompt || j == 3) {
                      {
                          const u32x4 u = prompt ? *(const LAS u32x4*)(rawt + (t + j) * 136 + cc) : *(const u32x4*)(XR + (size_t)(MPR + t) * D + cb0 + cc);
                          const float x8[8] = {bflo(u.x), bfhi(u.x), bflo(u.y), bfhi(u.y), bflo(u.z), bfhi(u.z), bflo(u.w), bfhi(u.w)};
#pragma unroll
                          for (int e = 0; e < 8; ++e) a[e] += x8[e] * cw[j * 128 + cc + e];
                      }
                  } else {
                      const float* p = INP(5) + ((size_t)t * 3 + j) * D + cb0 + cc;
                      const f32x4 u0 = *(const f32x4*)p, u1 = *(const f32x4*)(p + 4);
#pragma unroll
                      for (int e = 0; e < 4; ++e) { a[e] += u0[e] * cw[j * 128 + cc + e]; a[4 + e] += u1[e] * cw[j * 128 + cc + 4 + e]; }
                  }
              }
              u32x4 w; w.x = pk2(a[0], a[1]); w.y = pk2(a[2], a[3]); w.z = pk2(a[4], a[5]); w.w = pk2(a[6], a[7]);
              *(LAS u32x4*)(xcA + t * 136 + cc) = w;
              if (cq == qd) { *(LAS f32x4*)(xcf + t * 32 + q * 8) = (f32x4){a[0], a[1], a[2], a[3]}; *(LAS f32x4*)(xcf + t * 32 + q * 8 + 4) = (f32x4){a[4], a[5], a[6], a[7]}; }
          }
        }
        __syncthreads();
        { f32x16 c;
#pragma unroll
          for (int r = 0; r < 16; ++r) c[r] = 0.f;
          const LAS bf16* ap = xcA + (tb * 32 + (lane & 31)) * 136 + (lane >> 5) * 8;
#pragma unroll
          for (int ks = 0; ks < 8; ++ks) { const bf16x8 af = *(const LAS bf16x8*)(ap + ks * 16); c = __builtin_amdgcn_mfma_f32_32x32x16_bf16(af, Bf[ks], c, 0, 0, 0); }
          LAS float* dst = cbk ? ib : rb;
#pragma unroll
          for (int r = 0; r < 16; ++r) { const int tok = tb * 32 + (r & 3) + 8 * (r >> 2) + 4 * (lane >> 5); dst[tok * 32 + (lane & 31)] = sigmoid_f(c[r] + gbias); }
        }
        __syncthreads();
        float Aacc = 1.f, h = 0.f;
#pragma unroll 4
        for (int e = 0; e < 8; ++e) { const int t = seg * 8 + e;
            const float r = rb[t * 32 + ch], ig = ib[t * 32 + ch], x = xcf[t * 32 + ch];
            const float la = -8.f * r * sp; const float a = __expf(la); float mult = __builtin_amdgcn_sqrtf(neg_expm1_f(2.f * la));
            if (prompt && tile == 0 && t == 0) mult = 1.f;
            const float bt = mult * ig * x;
            rb[t * 32 + ch] = a; ib[t * 32 + ch] = bt;
            h = a * h + bt; Aacc *= a;
        }
        float hin = 0.f;
        if (prompt) {
            segA[seg * 32 + ch] = Aacc; segB[seg * 32 + ch] = h;
            __syncthreads();
            hin = hc[ch];
            float sa[15], sb[15];
#pragma unroll
            for (int s = 0; s < 15; ++s) { sa[s] = segA[s * 32 + ch]; sb[s] = segB[s * 32 + ch]; }
#pragma unroll
            for (int s = 0; s < 15; ++s) hin = s < seg ? sa[s] * hin + sb[s] : hin;
        }
        h = hin;
        { float gr[8], h0v[8];
#pragma unroll
          for (int e = 0; e < 8; ++e) { const int t = seg * 8 + e; gr[e] = bf2f(GR[(size_t)(row0 + t) * D + oc0 + ch]); h0v[e] = prompt ? 0.f : INP(4)[(size_t)t * D + oc0 + ch]; }
#pragma unroll
          for (int e = 0; e < 8; ++e) { const int t = seg * 8 + e;
              const float a = rb[t * 32 + ch], bt = ib[t * 32 + ch];
              if (prompt) h = a * h + bt; else h = a * h0v[e] + bt;
              GR[(size_t)(row0 + t) * D + oc0 + ch] = (bf16)f2bf(h * gr[e]);
              if (!prompt) { karg_out()[O_HS + (size_t)t * D + oc0 + ch] = h;
                  const float* cs = INP(5) + (size_t)t * 3 * D + oc0 + ch; float* co = karg_out() + O_CRS + (size_t)t * 3 * D + oc0 + ch;
                  co[0] = cs[D]; co[D] = cs[2 * D]; co[2 * D] = bf2f(XR[(size_t)(MPR + t) * D + oc0 + ch]); }
          } }
        hlast = h;
        if (prompt && tile + 1 < ntiles) RG_RAW_STORE();
        __syncthreads();
        if (prompt && seg == 15) hc[ch] = hlast;
    }
    if (prompt && seg == 15) { if (t1 == 16) karg_out()[O_HP + (size_t)b * D + oc0 + ch] = hlast; else ((float*)(karg_ws() + WS_HCARRY))[(size_t)b * D + oc0 + ch] = hlast; }
    __syncthreads();
}

constexpr size_t WS_TINV = WS_WIN, WS_ATT = WS_WIN + 8 * MiB, WS_GC = WS_CB, WS_BETA = 47 * MiB + 65536;
static_assert(WS_ABL + (size_t)M * 16 * 4 <= WS_BETA && WS_BETA + 64 * 2048 * 4 <= WS_H, "ws map (beta)");
__device__ __forceinline__ int perm16(int e) { return (e & ~12) | ((e >> 1) & 4) | ((e << 1) & 8); }

__device__ __forceinline__ void conv8(const bf16* p, int tl, const LAS float* w, float* a) {
#pragma unroll
    for (int e = 0; e < 8; ++e) a[e] = 0.f;
#pragma unroll
    for (int j = 0; j < 4; ++j) {
        const bool ok = tl - 3 + j >= 0;
        const u32x4 u = *(const u32x4*)(ok ? p - (ptrdiff_t)(3 - j) * D : p);
        f32x4 w0 = *(const LAS f32x4*)(w + j * 128), w1 = *(const LAS f32x4*)(w + j * 128 + 4);
        if (!ok) { w0 = (f32x4){0.f, 0.f, 0.f, 0.f}; w1 = w0; }
        a[0] += bflo(u.x) * w0[0]; a[1] += bfhi(u.x) * w0[1]; a[2] += bflo(u.y) * w0[2]; a[3] += bfhi(u.y) * w0[3];
        a[4] += bflo(u.z) * w1[0]; a[5] += bfhi(u.z) * w1[1]; a[6] += bflo(u.w) * w1[2]; a[7] += bfhi(u.w) * w1[3];
    }
#pragma unroll
    for (int e = 0; e < 8; ++e) a[e] = silu_f(a[e]);
}

__device__ __forceinline__ void conv8h(const bf16* p, const bf16* halo, int nloc, const LAS float* w, float* a) {
#pragma unroll
    for (int e = 0; e < 8; ++e) a[e] = 0.f;
#pragma unroll
    for (int j = 0; j < 4; ++j) {
        const int r = nloc - 3 + j;
        const u32x4 u = *(const u32x4*)(r >= 0 ? p - (ptrdiff_t)(3 - j) * D : halo + (r + 3) * D);
        const f32x4 w0 = *(const LAS f32x4*)(w + j * 128), w1 = *(const LAS f32x4*)(w + j * 128 + 4);
        a[0] += bflo(u.x) * w0[0]; a[1] += bfhi(u.x) * w0[1]; a[2] += bflo(u.y) * w0[2]; a[3] += bfhi(u.y) * w0[3];
        a[4] += bflo(u.z) * w1[0]; a[5] += bfhi(u.z) * w1[1]; a[6] += bflo(u.w) * w1[2]; a[7] += bfhi(u.w) * w1[3];
    }
#pragma unroll
    for (int e = 0; e < 8; ++e) a[e] = silu_f(a[e]);
}
__device__ __forceinline__ void delta_prep_wave(const Params& P, LAS unsigned char* lds, int idx, int wave, int lane) {
    const int bh = idx >> 5, b = bh >> 3, h = bh & 7, span = idx & 31, n = lane & 31, hh = lane >> 5;
    const LAS float* wq = (const LAS float*)lds; const LAS float* wk = wq + 512; const LAS float* wv = wq + 1024;
    LAS float* Lm = (LAS float*)(lds + 6144 + wave * 10240);
    LAS float* gcs = Lm + 2 * 1152; LAS float* bts = gcs + 64;
    const bf16* Qb = (const bf16*)(karg_ws() + WS_Z + 2 * ZB); bf16* Kb = (bf16*)(karg_ws() + WS_Z + 3 * ZB); bf16* Vb = (bf16*)(karg_ws() + WS_Z + 4 * ZB);
    bf16* QT = (bf16*)(karg_ws() + WS_H);
    const bf16* HK = (const bf16*)((const unsigned char*)karg_out() + OSB_HK) + (size_t)(b * 32 + span) * 3 * D + h * 128;
    const bf16* HV = (const bf16*)((const unsigned char*)karg_out() + OSB_HV) + (size_t)(b * 32 + span) * 3 * D + h * 128;
    const float* ABL = (const float*)(karg_ws() + WS_ABL);
    bf16* TINV = (bf16*)(karg_ws() + WS_TINV); bf16* ATT = (bf16*)(karg_ws() + WS_ATT);
    { const size_t row = (size_t)b * SEQ + span * 64 + lane;
      float g = -__expf(INP(23)[h]) * softplus_f(ABL[row * 16 + h] + INP(24)[h]); const float be = sigmoid_f(ABL[row * 16 + 8 + h]);
#pragma unroll
      for (int off = 1; off < 32; off <<= 1) { const float t = __shfl_up(g, off); if (n >= off) g += t; }
      gcs[lane] = g; bts[lane] = be;
      ((float*)(karg_ws() + WS_GC))[(size_t)bh * SEQ + span * 64 + lane] = g; ((float*)(karg_ws() + WS_BETA))[(size_t)bh * SEQ + span * 64 + lane] = be; }
    LAS float* nks = bts + 64; LAS float* nqs = nks + 64;
#pragma unroll 1
    for (int it = 7; it >= 0; --it) {
        const int nloc = it * 8 + (lane >> 3), tl = span * 64 + nloc, d0 = (lane & 7) * 16; const size_t ro = ((size_t)b * SEQ + tl) * D + h * 128 + d0;
        float kv[16], qv[16], vv[16];
        conv8h(Kb + ro, HK + d0, nloc, wk + d0, kv); conv8h(Kb + ro + 8, HK + d0 + 8, nloc, wk + d0 + 8, kv + 8);
        conv8(Qb + ro, tl, wq + d0, qv); conv8(Qb + ro + 8, tl, wq + d0 + 8, qv + 8);
        conv8h(Vb + ro, HV + d0, nloc, wv + d0, vv); conv8h(Vb + ro + 8, HV + d0 + 8, nloc, wv + d0 + 8, vv + 8);
        float ssk = 0.f, ssq = 0.f;
#pragma unroll
        for (int e = 0; e < 16; ++e) { ssk += kv[e] * kv[e]; ssq += qv[e] * qv[e]; }
        ssk = red8(ssk); ssq = red8(ssq);
        if ((lane & 7) == 0) { const float nkj = rsq_f(ssk + EPS), nqj = 0.08838834764831845f * rsq_f(ssq + EPS); nks[nloc] = nkj; nqs[nloc] = nqj;
            ((float*)((unsigned char*)karg_out() + OSB_NK))[(size_t)bh * SEQ + tl] = nkj; ((float*)((unsigned char*)karg_out() + OSB_NQ))[(size_t)bh * SEQ + tl] = nqj; }
        *(bf16x8*)(Kb + ro) = pack8(kv[0], kv[1], kv[2], kv[3], kv[4], kv[5], kv[6], kv[7]); *(bf16x8*)(Kb + ro + 8) = pack8(kv[8], kv[9], kv[10], kv[11], kv[12], kv[13], kv[14], kv[15]);
        *(bf16x8*)(QT + ro) = pack8(qv[0], qv[1], qv[2], qv[3], qv[4], qv[5], qv[6], qv[7]); *(bf16x8*)(QT + ro + 8) = pack8(qv[8], qv[9], qv[10], qv[11], qv[12], qv[13], qv[14], qv[15]);
        *(bf16x8*)(Vb + ro) = pack8(vv[0], vv[1], vv[2], vv[3], vv[4], vv[5], vv[6], vv[7]); *(bf16x8*)(Vb + ro + 8) = pack8(vv[8], vv[9], vv[10], vv[11], vv[12], vv[13], vv[14], vv[15]);
    }
    asm volatile("s_waitcnt vmcnt(0)" ::: "memory"); __builtin_amdgcn_fence(__ATOMIC_ACQUIRE, "agent");
#pragma unroll 1
    for (int tile = 0; tile < 2; ++tile) {
        const int tl = span * 64 + tile * 32 + n; const size_t ro = ((size_t)b * SEQ + tl) * D + h * 128 + 8 * hh;
        f32x16 ckk, cqk;
#pragma unroll
        for (int r = 0; r < 16; ++r) { ckk[r] = 0.f; cqk[r] = 0.f; }
#pragma unroll
        for (int s8 = 0; s8 < 8; ++s8) {
            const bf16x8 kf = *(const bf16x8*)(Kb + ro + 16 * s8), qf = *(const bf16x8*)(QT + ro + 16 * s8);
            ckk = __builtin_amdgcn_mfma_f32_32x32x16_bf16(kf, kf, ckk, 0, 0, 0); cqk = __builtin_amdgcn_mfma_f32_32x32x16_bf16(qf, kf, cqk, 0, 0, 0);
        }
        const float nkj = nks[tile * 32 + n];
        const float gcj = gcs[tile * 32 + n];
        bf16* att = ATT + ((size_t)bh * 64 + span * 2 + tile) * 1024 + perm16(n);
#pragma unroll
        for (int r = 0; r < 16; ++r) { const int i = (r & 3) + 8 * (r >> 2) + 4 * hh;
            const float dm = i >= n ? __expf(gcs[tile * 32 + i] - gcj) * nkj : 0.f;
            Lm[tile * 1152 + i * 36 + n] = i > n ? bts[tile * 32 + i] * nks[tile * 32 + i] * ckk[r] * dm : 0.f;
            att[i * 32] = (bf16)f2bf(nqs[tile * 32 + i] * cqk[r] * dm); }
    }
    LDS_WAIT(); asm volatile("" ::: "memory");
    { int loff = hh * 1152;
      float x[32];
#pragma unroll
      for (int i = 0; i < 32; ++i) { float sacc = (i == n) ? 1.f : 0.f;
          const LAS float* Lb = Lm + loff;
#pragma unroll
          for (int j4 = 0; j4 < (i + 3) / 4; ++j4) { const f32x4 l = *(const LAS f32x4*)(Lb + i * 36 + 4 * j4);
#pragma unroll
              for (int jj = 0; jj < 4; ++jj) if (4 * j4 + jj < i) sacc -= l[jj] * x[4 * j4 + jj]; }
          x[i] = sacc;
          if ((i & 1) == 1) asm volatile("" : "+v"(loff) : "v"(sacc)); }
      bf16* ti = TINV + ((size_t)bh * 64 + span * 2 + hh) * 1024 + perm16(n);
#pragma unroll
      for (int i = 0; i < 32; ++i) ti[i * 32] = (bf16)f2bf(x[i]); }
    LDS_WAIT(); asm volatile("" ::: "memory");
}

constexpr int DR_KB = 0, DR_QD = 8704, DR_KDT = 17408, DR_TI = 27648, DR_AT = 30208, DR_VB = 32768, DR_EGL = 49664, DR_BUF = 49680;
struct DeltaPre { u32x4 k0, k1, q0, q1, v0, v1, tia; float gct, gl, bet, nk, nq; };
__device__ __forceinline__ void delta_pre_load(int b, int h, int c, int pt, DeltaPre& dp) {
    const int bh = b * 8 + h, tt = pt >> 3, d0 = (pt & 7) * 16; const size_t t = (size_t)bh * SEQ + c * 32 + tt;
    const size_t ro = ((size_t)b * SEQ + c * 32 + tt) * D + h * 128 + d0;
    const bf16* Kt = (const bf16*)(karg_ws() + WS_Z + 3 * ZB) + ro; const bf16* Qt = (const bf16*)(karg_ws() + WS_H) + ro; const bf16* Vt = (const bf16*)(karg_ws() + WS_Z + 4 * ZB) + ro;
    dp.k0 = *(const u32x4*)Kt; dp.k1 = *(const u32x4*)(Kt + 8); dp.q0 = *(const u32x4*)Qt; dp.q1 = *(const u32x4*)(Qt + 8); dp.v0 = *(const u32x4*)Vt; dp.v1 = *(const u32x4*)(Vt + 8);
    const float* GC = (const float*)(karg_ws() + WS_GC);
    dp.gct = GC[t]; dp.gl = GC[(size_t)bh * SEQ + c * 32 + 31]; dp.bet = ((const float*)(karg_ws() + WS_BETA))[t];
    dp.nk = ((const float*)((const unsigned char*)karg_out() + OSB_NK))[t]; dp.nq = ((const float*)((const unsigned char*)karg_out() + OSB_NQ))[t];
    dp.tia = *(const u32x4*)((const bf16*)(karg_ws() + (pt < 128 ? WS_TINV : WS_ATT)) + ((size_t)bh * 64 + c) * 1024 + (pt & 127) * 8);
}
__device__ __forceinline__ void delta_rec_stage(LAS unsigned char* buf, int pt, const DeltaPre& dp) {
    const int tt = pt >> 3, dg = pt & 7, d0 = dg * 16;
    { LAS bf16* dst = (LAS bf16*)(buf + (pt < 128 ? DR_TI : DR_AT)) + ((pt & 127) >> 2) * 40 + (pt & 3) * 8; *(LAS u32x4*)dst = dp.tia; }
    if (pt == 0) *(LAS float*)(buf + DR_EGL) = __expf(dp.gl);
    const float eg = __expf(dp.gct), ekd = __expf(dp.gl - dp.gct);
    const float fq = dp.nq * eg, fkb = dp.nk * dp.bet * eg, fkd = dp.nk * ekd, bet = dp.bet;
    float k[16], q[16], v[16];
    unpack8(dp.k0, k); unpack8(dp.k1, k + 8); unpack8(dp.q0, q); unpack8(dp.q1, q + 8); unpack8(dp.v0, v); unpack8(dp.v1, v + 8);
    LAS bf16* KB = (LAS bf16*)(buf + DR_KB) + tt * 136 + d0; LAS bf16* QD = (LAS bf16*)(buf + DR_QD) + tt * 136 + d0;
    *(LAS bf16x8*)KB = pack8(k[0] * fkb, k[1] * fkb, k[2] * fkb, k[3] * fkb, k[8] * fkb, k[9] * fkb, k[10] * fkb, k[11] * fkb);
    *(LAS bf16x8*)(KB + 8) = pack8(k[4] * fkb, k[5] * fkb, k[6] * fkb, k[7] * fkb, k[12] * fkb, k[13] * fkb, k[14] * fkb, k[15] * fkb);
    *(LAS bf16x8*)QD = pack8(q[0] * fq, q[1] * fq, q[2] * fq, q[3] * fq, q[8] * fq, q[9] * fq, q[10] * fq, q[11] * fq);
    *(LAS bf16x8*)(QD + 8) = pack8(q[4] * fq, q[5] * fq, q[6] * fq, q[7] * fq, q[12] * fq, q[13] * fq, q[14] * fq, q[15] * fq);
    LAS bf16* KDT = (LAS bf16*)(buf + DR_KDT) + d0 * 40 + perm16(tt);
#pragma unroll
    for (int e = 0; e < 16; ++e) KDT[e * 40] = (bf16)f2bf(k[e] * fkd);
    LAS float* VB = (LAS float*)(buf + DR_VB) + tt * 132 + d0;
#pragma unroll
    for (int e4 = 0; e4 < 4; ++e4) *(LAS f32x4*)(VB + 4 * e4) = (f32x4){v[4 * e4] * bet, v[4 * e4 + 1] * bet, v[4 * e4 + 2] * bet, v[4 * e4 + 3] * bet};
}

constexpr int DR_OB = 2 * DR_BUF;
static_assert(DR_OB + 2 * 32 * 132 * 4 <= LDS_BYTES - 64, "delta recurrence LDS map");
__device__ __forceinline__ void delta_out_norm(const LAS float* ob, int pt, const float* dn16, const u32x4 z0, const u32x4 z1, bf16* dst) {
    const LAS float* p = ob + (pt >> 3) * 132 + (pt & 7) * 16;
    float o[16], z[16];
#pragma unroll
    for (int e4 = 0; e4 < 4; ++e4) { const f32x4 t = *(const LAS f32x4*)(p + 4 * e4); o[4 * e4] = t[0]; o[4 * e4 + 1] = t[1]; o[4 * e4 + 2] = t[2]; o[4 * e4 + 3] = t[3]; }
    float ss = 0.f;
#pragma unroll
    for (int e = 0; e < 16; ++e) ss += o[e] * o[e];
    ss = red8(ss);
    const float rstd = rsq_f(ss * (1.f / 128.f) + EPS);
    unpack8(z0, z); unpack8(z1, z + 8);
#pragma unroll
    for (int e = 0; e < 16; ++e) o[e] = o[e] * rstd * dn16[e] * z[e];
    *(bf16x8*)dst = pack8(o[0], o[1], o[2], o[3], o[4], o[5], o[6], o[7]); *(bf16x8*)(dst + 8) = pack8(o[8], o[9], o[10], o[11], o[12], o[13], o[14], o[15]);
}
__device__ __forceinline__ void delta_rec_task(const Params& P, LAS unsigned char* lds, int b, int h, int tid) {
    const int lane = tid & 63, wave = tid >> 6, n = lane & 31, hh = lane >> 5, bh = b * 8 + h, pt = tid - 256;
    const bool producer = wave >= 4;
    constexpr int NC = SEQ / 32;
    f32x16 S[4];
#pragma unroll
    for (int kb = 0; kb < 4; ++kb)
#pragma unroll
        for (int r = 0; r < 16; ++r) S[kb][r] = 0.f;
    DeltaPre dcur, dnxt;
    if (producer) { delta_pre_load(b, h, 0, pt, dcur); delta_pre_load(b, h, 1, pt, dnxt); delta_rec_stage(lds, pt, dcur); dcur = dnxt; }
    __syncthreads();
    if (producer) {
        const int pt = opq(tid) - 256;
        float dn16[16];
#pragma unroll
        for (int e = 0; e < 16; ++e) dn16[e] = INP(25)[(pt & 7) * 16 + e];
        bf16* zgp = (bf16*)(karg_ws() + WS_Z + 5 * ZB) + ((size_t)b * SEQ + (pt >> 3)) * D + h * 128 + (pt & 7) * 16;
        u32x4 zc0 = {0u, 0u, 0u, 0u}, zc1 = zc0, zn0, zn1;
        for (int c = 0; c < NC; ++c) {
            if (c + 2 < NC) delta_pre_load(b, h, c + 2, pt, dnxt);
            zn0 = *(const u32x4*)(zgp + (size_t)c * 32 * D); zn1 = *(const u32x4*)(zgp + (size_t)c * 32 * D + 8);
            if (c + 1 < NC) delta_rec_stage(lds + ((c + 1) & 1) * DR_BUF, pt, dcur);
            if (c > 0) delta_out_norm((const LAS float*)(lds + DR_OB) + ((c - 1) & 1) * 32 * 132, pt, dn16, zc0, zc1, zgp + (size_t)(c - 1) * 32 * D);
            dcur = dnxt; zc0 = zn0; zc1 = zn1;
            __syncthreads();
        }
        delta_out_norm((const LAS float*)(lds + DR_OB) + ((NC - 1) & 1) * 32 * 132, pt, dn16, zc0, zc1, zgp + (size_t)(NC - 1) * 32 * D);
    } else {
        const int lane = opq(tid) & 63, n = lane & 31, hh = lane >> 5;
        for (int c = 0; c < NC; ++c) {
            LAS unsigned char* buf = lds + (c & 1) * DR_BUF;
            const int vb = wave;
            bf16x8 SB[8];
#pragma unroll
            for (int s = 0; s < 8; ++s) { const int kb = s >> 1, o = 8 * (s & 1); SB[s] = pack8(S[kb][o], S[kb][o + 1], S[kb][o + 2], S[kb][o + 3], S[kb][o + 4], S[kb][o + 5], S[kb][o + 6], S[kb][o + 7]); }
            f32x16 X1, P1;
#pragma unroll
            for (int r = 0; r < 16; ++r) { X1[r] = 0.f; P1[r] = 0.f; }
            const LAS bf16* KB = (const LAS bf16*)(buf + DR_KB) + n * 136 + 8 * hh; const LAS bf16* QD = (const LAS bf16*)(buf + DR_QD) + n * 136 + 8 * hh;
#pragma unroll
            for (int s = 0; s < 8; ++s) { X1 = __builtin_amdgcn_mfma_f32_32x32x16_bf16(*(const LAS bf16x8*)(KB + 16 * s), SB[s], X1, 0, 0, 0);
                P1 = __builtin_amdgcn_mfma_f32_32x32x16_bf16(*(const LAS bf16x8*)(QD + 16 * s), SB[s], P1, 0, 0, 0); }
            const LAS float* VB = (const LAS float*)(buf + DR_VB) + 32 * vb + n;
            float Y[16];
#pragma unroll
            for (int r = 0; r < 16; ++r) Y[r] = VB[((r & 3) + 8 * (r >> 2) + 4 * hh) * 132] - X1[r];
            const bf16x8 YB0 = pack8(Y[0], Y[1], Y[2], Y[3], Y[4], Y[5], Y[6], Y[7]), YB1 = pack8(Y[8], Y[9], Y[10], Y[11], Y[12], Y[13], Y[14], Y[15]);
            f32x16 VN;
#pragma unroll
            for (int r = 0; r < 16; ++r) VN[r] = 0.f;
            const LAS bf16* TI = (const LAS bf16*)(buf + DR_TI) + n * 40 + 8 * hh; const LAS bf16* AT = (const LAS bf16*)(buf + DR_AT) + n * 40 + 8 * hh;
            VN = __builtin_amdgcn_mfma_f32_32x32x16_bf16(*(const LAS bf16x8*)TI, YB0, VN, 0, 0, 0);
            VN = __builtin_amdgcn_mfma_f32_32x32x16_bf16(*(const LAS bf16x8*)(TI + 16), YB1, VN, 0, 0, 0);
            const bf16x8 VB0 = pack8(VN[0], VN[1], VN[2], VN[3], VN[4], VN[5], VN[6], VN[7]), VB1 = pack8(VN[8], VN[9], VN[10], VN[11], VN[12], VN[13], VN[14], VN[15]);
            P1 = __builtin_amdgcn_mfma_f32_32x32x16_bf16(*(const LAS bf16x8*)AT, VB0, P1, 0, 0, 0);
            P1 = __builtin_amdgcn_mfma_f32_32x32x16_bf16(*(const LAS bf16x8*)(AT + 16), VB1, P1, 0, 0, 0);
            const float egl = *(const LAS float*)(buf + DR_EGL);
            const LAS bf16* KDT = (const LAS bf16*)(buf + DR_KDT) + n * 40 + 8 * hh;
#pragma unroll
            for (int kb = 0; kb < 4; ++kb) {
#pragma unroll
                for (int r = 0; r < 16; ++r) S[kb][r] *= egl;
                S[kb] = __builtin_amdgcn_mfma_f32_32x32x16_bf16(*(const LAS bf16x8*)(KDT + kb * 32 * 40), VB0, S[kb], 0, 0, 0);
                S[kb] = __builtin_amdgcn_mfma_f32_32x32x16_bf16(*(const LAS bf16x8*)(KDT + kb * 32 * 40 + 16), VB1, S[kb], 0, 0, 0); }
            LAS float* op = (LAS float*)(lds + DR_OB) + (c & 1) * 32 * 132 + 4 * hh * 132 + 32 * vb + n;
#pragma unroll
            for (int r = 0; r < 16; ++r) op[((r & 3) + 8 * (r >> 2)) * 132] = P1[r];
            __syncthreads();
        }
    }
    if (!producer) { float* So = karg_out() + O_SP + ((size_t)bh * 128 + 4 * hh) * 128 + 32 * wave + n;
#pragma unroll
        for (int kb = 0; kb < 4; ++kb)
#pragma unroll
            for (int r = 0; r < 16; ++r) So[(size_t)(32 * kb + (r & 3) + 8 * (r >> 2)) * 128] = S[kb][r]; }
    __syncthreads();
}

template <int MODE>
__device__ __forceinline__ void delta_sample_item(const Params& P, LAS unsigned char* lds, int item, int tid) {
    LAS float* tmp = (LAS float*)lds;
    LAS float* scl = (LAS float*)(lds + 1536);
    LAS float* rpk = (LAS float*)(lds + 2048);
    LAS float* rpq = (LAS float*)(lds + 4096);
    const int bs = item >> 3, h = item & 7, lane = tid & 63, wave = tid >> 6; const size_t row = (size_t)MPR + bs;
    const bf16* Zq = (const bf16*)(karg_ws() + WS_Z + 2 * ZB);
    if (tid < 384) { const int which = tid >> 7, d = tid & 127; const int c3 = which * 1024 + h * 128 + d;
        const float raw = bf2f(Zq[(size_t)which * (ZB / 2) + row * D + h * 128 + d]);
        const float* cs = INP(7) + (size_t)bs * 3 * 3072 + c3; const float* w = INP(22) + c3;
        tmp[tid] = silu_f(cs[0] * w[0] + cs[3072] * w[3072] + cs[2 * 3072] * w[2 * 3072] + raw * w[3 * 3072]); }
    __syncthreads();
    if (wave < 3) { float s;
        if (wave == 0) s = tmp[lane] * tmp[lane] + tmp[lane + 64] * tmp[lane + 64];
        else if (wave == 1) s = tmp[128 + lane] * tmp[128 + lane] + tmp[192 + lane] * tmp[192 + lane];
        else s = tmp[lane] * tmp[128 + lane] + tmp[64 + lane] * tmp[192 + lane];
        s = wave_sum(s);
        if (lane == 0) scl[wave] = wave == 0 ? rsq_f(s + EPS) * 0.08838834764831845f : (wave == 1 ? rsq_f(s + EPS) : s); }
    __syncthreads();
    const float sq = scl[0], sk = scl[1], kq = scl[2] * sq * sk;
    const int v = tid & 127, kg = tid >> 7;
    const float* S0 = INP(6) + ((size_t)(bs * NH + h) * 128 + kg * 32) * 128 + v;
    float S[32];
#pragma unroll
    for (int j = 0; j < 32; ++j) S[j] = S0[(size_t)j * 128];
    float pk = 0.f, pq = 0.f;
#pragma unroll
    for (int j = 0; j < 32; ++j) { pk += S[j] * tmp[128 + kg * 32 + j]; pq += S[j] * tmp[kg * 32 + j]; }
    rpk[kg * 128 + v] = pk * sk; rpq[kg * 128 + v] = pq * sq;
    __syncthreads();
    pk = (rpk[v] + rpk[128 + v]) + (rpk[256 + v] + rpk[384 + v]); pq = (rpq[v] + rpq[128 + v]) + (rpq[256 + v] + rpq[384 + v]);
    const float* ABL = (const float*)(karg_ws() + WS_ABL);
    const float al = ABL[row * 16 + h], bl = ABL[row * 16 + 8 + h];
    const float dc = __expf(-__expf(INP(23)[h]) * softplus_f(al + INP(24)[h])), be = sigmoid_f(bl);
    const float delta = be * (tmp[256 + v] - dc * pk);
    if (MODE == 0) {
        const float o = dc * pq + kq * delta; const float so = wave_sum(o * o);
        if (lane == 0 && wave < 2) scl[4 + wave] = so;
        __syncthreads();
        if (kg == 0) { bf16* zp = (bf16*)(karg_ws() + WS_Z + 5 * ZB) + row * D + h * 128 + v;
            *zp = (bf16)f2bf(o * rsq_f((scl[4] + scl[5]) * (1.f / 128.f) + EPS) * INP(25)[v] * bf2f(*zp)); } }
    else { float* So = karg_out() + O_SS + ((size_t)(bs * NH + h) * 128 + kg * 32) * 128 + v;
#pragma unroll
        for (int j = 0; j < 32; ++j) So[(size_t)j * 128] = dc * S[j] + (tmp[128 + kg * 32 + j] * sk) * delta; }
    __syncthreads();
}

#define XB_TMO      128
#define XB_XCNT(j)  (256  + 64 * (j))
#define XB_XSUB(j)  (1280 + 64 * (j))
#define XB_XGEN(j)  (2304 + 64 * (j))
#define XB_TOP      3328
#define XB_TOPGEN   3392
#define XCD_BAR_WORDS 3456
#define XB_SPIN_CAP (1u << 22)
__device__ __forceinline__ unsigned xb_ld(unsigned* p)              { return __hip_atomic_load(p, __ATOMIC_RELAXED, __HIP_MEMORY_SCOPE_AGENT); }
__device__ __forceinline__ unsigned xb_add(unsigned* p, unsigned v) { return __hip_atomic_fetch_add(p, v, __ATOMIC_RELAXED, __HIP_MEMORY_SCOPE_AGENT); }
__device__ __forceinline__ unsigned xb_xcc_id() { return (unsigned)__builtin_amdgcn_s_getreg((3 << 11) | 20) & 0xFu; }
#define XB_SPIN(cond, bar) do { unsigned _sp = 0; while (cond) { __builtin_amdgcn_s_sleep(1); \
    if ((++_sp & 255u) == 0u) { if (xb_ld(&(bar)[XB_TMO])) break; if (_sp > XB_SPIN_CAP) { atomicAdd(&(bar)[XB_TMO], 1u); break; } } } } while (0)
struct XcdBarrier { unsigned* bar; unsigned x; volatile LAS unsigned* st; };
__device__ __forceinline__ XcdBarrier xcd_barrier_post(unsigned* bar, volatile LAS unsigned* st, bool leader) {
    XcdBarrier b; b.bar = bar; b.x = xb_xcc_id(); b.st = st;
    if (leader) (void)xb_add(&bar[XB_XCNT(b.x)], 1u);
    return b;
}
__device__ __forceinline__ void xcd_barrier_complete(unsigned* bar, unsigned x, unsigned& nloc, unsigned& nx) {
    const unsigned G = gridDim.x * gridDim.y * gridDim.z;
    unsigned sum, cnt, mine, sp = 0u;
    for (;;) {
        sum = 0u; cnt = 0u; mine = 0u;
#pragma unroll
        for (unsigned j = 0; j < 16; ++j) { const unsigned c = xb_ld(&bar[XB_XCNT(j)]); sum += c; cnt += (c > 0u) ? 1u : 0u; mine = (j == x) ? c : mine; }
        if (sum == G) break;
        __builtin_amdgcn_s_sleep(1);
        if ((++sp & 255u) == 0u) { if (xb_ld(&bar[XB_TMO])) break; if (sp > XB_SPIN_CAP) { atomicAdd(&bar[XB_TMO], 1u); break; } }
    }
    nloc = mine > 0u ? mine : 1u; nx = cnt > 0u ? cnt : 1u;
}
__device__ __forceinline__ void xcd_barrier(const XcdBarrier& b, bool leader) {
    asm volatile("s_waitcnt vmcnt(0)" ::: "memory");
    __syncthreads();
    if (leader) {
        unsigned* bar = b.bar;
        __builtin_amdgcn_s_waitcnt(0);
        unsigned nloc = b.st[0], nx = b.st[1];
        if (nloc == 0u) { xcd_barrier_complete(bar, b.x, nloc, nx); b.st[0] = nloc; b.st[1] = nx; }
        const unsigned old = xb_add(&bar[XB_XSUB(b.x)], 1u);
        const unsigned gen = old / nloc;
        if (old + 1u == (gen + 1u) * nloc) {
            __builtin_amdgcn_fence(__ATOMIC_RELEASE, "agent");
            asm volatile("s_waitcnt vmcnt(0)" ::: "memory");
            const unsigned og = xb_add(&bar[XB_TOP], 1u);
            const unsigned tg = og / nx;
            if (og + 1u == (tg + 1u) * nx) xb_add(&bar[XB_TOPGEN], 1u);
            else XB_SPIN(xb_ld(&bar[XB_TOPGEN]) == tg, bar);
            __builtin_amdgcn_fence(__ATOMIC_ACQUIRE, "agent");
            xb_add(&bar[XB_XGEN(b.x)], 1u);
            asm volatile("s_waitcnt vmcnt(0)" ::: "memory");
        } else {
            XB_SPIN(xb_ld(&bar[XB_XGEN(b.x)]) == gen, bar);
            __builtin_amdgcn_fence(__ATOMIC_ACQUIRE, "agent");
            asm volatile("s_waitcnt vmcnt(0)" ::: "memory");
        }
    }
    __syncthreads();
}

__global__ void __launch_bounds__(NTHR, 2) fwd_megakernel(Params P) {
    extern __shared__ __attribute__((aligned(16))) unsigned char lds_raw[];
    LAS unsigned char* lds = (LAS unsigned char*)lds_raw;
    cg::grid_group grid = cg::this_grid();
    const int wave = __builtin_amdgcn_readfirstlane((int)threadIdx.x >> 6);
#define lane opq(lane_now())
#define tid opq((wave << 6) | lane_now())
    const int G = gridDim.x, wg = blockIdx.x;
    const int gw = wg * NWAVES + wave, NGW = G * NWAVES;
    unsigned char* ws = karg_ws();
    float* ADA = (float*)(ws + WS_ADA);
    bf16* H = (bf16*)(ws + WS_H);
    bf16* Z = (bf16*)(ws + WS_Z);
    bf16* ACT = (bf16*)(ws + WS_ACT);
    bf16* MG = (bf16*)(karg_out() + O_SS);
    volatile LAS unsigned* MISC = (volatile LAS unsigned*)(lds + LDS_BYTES - 64);
    if (tid < 16) MISC[tid] = 0u;
    __syncthreads();
    const XcdBarrier xbar = xcd_barrier_post((unsigned*)ws, MISC, wave == 0 && lane_now() == 0);
#define GBAR() xcd_barrier(xbar, wave == 0 && lane_now() == 0)

    if constexpr ((PHM >> 0) & 1) {
    prologue<0>(P, lds, gw, NGW, wave, lane);
    }
    GBAR();
    if constexpr ((PHM >> 1) & 1) {
    { pg8::Gemm g{(const bf16*)(ws + WS_CB), (const bf16*)(ws + WS_WADA), nullptr, nullptr, D}; pg8::StaticOrder S; S.init(256, NADA, G, wg);
      EpiAda E{ADA, INP(9)}; pg8::gemm_phase(lds, g, S, E, wave);
      if (wg >= 36) prologue<1>(P, lds, (wg - 36) * NWAVES + wave, (G - 36) * NWAVES, wave, lane); }
    }
    GBAR();
    if constexpr ((PHM >> 2) & 1) {
    norm_mod_pass<0>(P, INP(10), 0, gw, NGW, lane);
    { const int gt = wg * NTHR + tid;
      if (gt < 2 * NB * 3 * (D / 8)) { const int m = gt / (NB * 3 * (D / 8)), r = gt % (NB * 3 * (D / 8)), c8 = r & 127, j = (r >> 7) % 3, bb = (r >> 7) / 3;
          *(u32x4*)((bf16*)((unsigned char*)karg_out() + (m ? OSB_HV : OSB_HK)) + ((size_t)(bb * 32) * 3 + j) * D + c8 * 8) = (u32x4){0u, 0u, 0u, 0u}; } }
    }
    GBAR();
    if constexpr ((PHM >> 3) & 1) {
    { pg8::Gemm g{H, (const bf16*)(ws + WS_WUP1), nullptr, nullptr, D}; pg8::StaticOrder S; S.init(MPAD, 2 * FF, G, wg);
      EpiSwiglu E{ACT}; pg8::gemm_phase(lds, g, S, E, wave); }
    }
    GBAR();
    if constexpr ((PHM >> 4) & 1) {
    { pg8::Gemm g{ACT, (const bf16*)(ws + WS_WDN1), nullptr, nullptr, FF}; pg8::StaticOrder S; S.init(MPR, D, G, wg);
      EpiResidNorm<0> E{karg_out(), INP(0), ADA + 2 * D, 0.5f, INP(13), ADA + 3 * D, H, (float*)(ws + WS_PART), (unsigned*)(ws + WS_CNT), (LAS float*)(lds + 131072)}; pg8::gemm_phase(lds, g, S, E, wave);
      float* X = karg_out(); const float* xs = INP(1); const float* gate = ADA + 2 * D;
      mini_gemm(lds, ACT, (const bf16*)(ws + WS_WDN1), nullptr, nullptr, FF, wg, G, tid, [=](int row, int col, f32x4 v, f32x4) {
          const f32x4 xv = *(const f32x4*)(xs + (size_t)(row - MPR) * D + col), gv = *(const f32x4*)(gate + (size_t)cond_of_row(row) * NADA + col);
          *(f32x4*)(X + (size_t)row * D + col) = xv + (gv * 0.5f) * v; }); }
    }
    GBAR();
    if constexpr ((PHM >> 5) & 1) {
    sample_norm_rows<0>(INP(13), 3, gw, lane);
    }
    GBAR();
    if constexpr ((PHM >> 6) & 1) {
    { pg8::Gemm g{H, (const bf16*)(ws + WS_WIN), nullptr, nullptr, D}; pg8::StaticOrder S; S.init(MPAD, NIN, G, wg);
      EpiIn E{Z, MG, (float*)(ws + WS_ABL), karg_out()}; pg8::gemm_phase(lds, g, S, E, wave); }
    }
    GBAR();
    if constexpr ((PHM >> 7) & 1) {
        { const int bh0 = (wg * NWAVES) >> 5, h0 = bh0 & 7; LAS float* w = (LAS float*)lds; const float* cwq = INP(22);
          for (int i = tid; i < 1536; i += NTHR) { const int which = i >> 9, j = (i >> 7) & 3, d = i & 127; w[i] = cwq[(size_t)j * 3072 + which * 1024 + h0 * 128 + d]; }
          __syncthreads();
          delta_prep_wave(P, lds, gw, wave, lane);
          __syncthreads(); }
        for (int task = wg; task < 256; task += G) rglru_task(P, lds, task >> 5, (task >> 2) & 7, task & 3, tid, 0, RG_SPLIT);
    }
    GBAR();
    if constexpr ((PHM >> 7) & 1) {
        if (wg < 64) delta_rec_task(P, lds, wg >> 3, wg & 7, tid);
        else {
            for (int task = wg - 64; task < 256; task += G - 64) rglru_task(P, lds, task >> 5, (task >> 2) & 7, task & 3, tid, RG_SPLIT, 16);
            if (wg < 96) rglru_task(P, lds, -1, (wg - 64) >> 2, (wg - 64) & 3, tid, 0, 1);
            if (wg >= 128) for (int item = wg - 128; item < NS * NH; item += G - 128) delta_sample_item<0>(P, lds, item, tid);
        }
    }
    GBAR();
    if constexpr ((PHM >> 9) & 1) {
    { pg8::Gemm g{Z + 1 * (ZB / 2), (const bf16*)(ws + WS_WBR), Z + 5 * (ZB / 2), (const bf16*)(ws + WS_WBR) + (size_t)D * D, D};
      pg8::PairOrder S; S.base.init(MPR, D, G, wg);
      EpiBranch E{MG, MG + ZB / 2, Z}; pg8::gemm_phase(lds, g, S, E, wave);
      const bf16* mga = MG; const bf16* mgb = MG + ZB / 2; bf16* Gm = Z;
      mini_gemm(lds, g.A0, g.B0, g.A1, g.B1, D, wg, G, tid, [=](int row, int col, f32x4 ya, f32x4 yb) {
          const size_t o = (size_t)row * D + col; const u32x2 a = *(const u32x2*)(mga + o), b = *(const u32x2*)(mgb + o);
          u32x2 w; w.x = pk2(bflo(a.x) * ya[0] + bflo(b.x) * yb[0], bfhi(a.x) * ya[1] + bfhi(b.x) * yb[1]);
          w.y = pk2(bflo(a.y) * ya[2] + bflo(b.y) * yb[2], bfhi(a.y) * ya[3] + bfhi(b.y) * yb[3]);
          *(u32x2*)(Gm + o) = w; }); }
    }
    GBAR();
    if constexpr ((PHM >> 10) & 1) {
    { pg8::Gemm g{Z, (const bf16*)(ws + WS_WOUT), nullptr, nullptr, D}; pg8::StaticOrder S; S.init(MPR, D, G, wg);
      EpiResidNorm<0> E{karg_out(), nullptr, ADA + 5 * D, 1.0f, INP(28), ADA + 6 * D, H, (float*)(ws + WS_PART) + 65536, (unsigned*)(ws + WS_CNT) + 64, (LAS float*)(lds + 131072)}; pg8::gemm_phase(lds, g, S, E, wave);
      float* X = karg_out(); const float* gate = ADA + 5 * D;
      mini_gemm(lds, Z, (const bf16*)(ws + WS_WOUT), nullptr, nullptr, D, wg, G, tid, [=](int row, int col, f32x4 v, f32x4) {
          float* xp = X + (size_t)row * D + col; const f32x4 gv = *(const f32x4*)(gate + (size_t)cond_of_row(row) * NADA + col);
          *(f32x4*)xp = *(const f32x4*)xp + gv * v; }); }
    }
    GBAR();
    if constexpr ((PHM >> 11) & 1) {
    sample_norm_rows<0>(INP(28), 6, gw, lane);
    {
        for (int item = (G == 256 ? SS_TAIL : 0) + wg; item < NS * NH; item += G) delta_sample_item<1>(P, lds, item, tid);
        const int gt = wg * NTHR + tid, NGT = G * NTHR;
        for (int i = gt; i < NS * 3 * 3072; i += NGT) { const int bs = i / 9216, j = (i / 3072) % 3, c3 = i % 3072;
            karg_out()[O_CQS + i] = j < 2 ? INP(7)[(size_t)bs * 9216 + (j + 1) * 3072 + c3] : bf2f(Z[(size_t)(2 + (c3 >> 10)) * (ZB / 2) + ((size_t)MPR + bs) * D + (c3 & 1023)]); }
    }
    }
    GBAR();
    if constexpr ((PHM >> 12) & 1) {
    { pg8::Gemm g{H, (const bf16*)(ws + WS_WUP2), nullptr, nullptr, D}; pg8::StaticOrder S; S.init(MPAD, 2 * FF, G, wg);
      EpiSwiglu E{ACT}; pg8::gemm_phase(lds, g, S, E, wave);
      if (G == 256 && wg >= 150) for (int item = wg - 150; item < SS_TAIL; item += 106) delta_sample_item<1>(P, lds, item, tid); }
    }
    GBAR();
    if constexpr ((PHM >> 13) & 1) {
    { pg8::Gemm g{ACT, (const bf16*)(ws + WS_WDN2), nullptr, nullptr, FF}; pg8::StaticOrder S; S.init(MPR, D, G, wg);
      EpiResidNorm<1> E{karg_out(), nullptr, ADA + 8 * D, 0.5f, INP(31), nullptr, nullptr, (float*)(ws + WS_PART) + 131072, (unsigned*)(ws + WS_CNT) + 128, (LAS float*)(lds + 131072)}; pg8::gemm_phase(lds, g, S, E, wave);
      float* X = karg_out(); const float* gate = ADA + 8 * D;
      mini_gemm(lds, ACT, (const bf16*)(ws + WS_WDN2), nullptr, nullptr, FF, wg, G, tid, [=](int row, int col, f32x4 v, f32x4) {
          float* xp = X + (size_t)row * D + col; const f32x4 gv = *(const f32x4*)(gate + (size_t)cond_of_row(row) * NADA + col);
          *(f32x4*)xp = *(const f32x4*)xp + (gv * 0.5f) * v; }); }
    }
    GBAR();
    if constexpr ((PHM >> 14) & 1) {
    sample_norm_rows<1>(INP(31), 0, gw, lane);
    }
}

extern "C" void kernel_launch(void* const* d_in, const int* in_sizes, int n_in, void* d_out, int out_size, void* d_ws, size_t ws_size, hipStream_t stream) {
    static int grid = 0;
    if (grid == 0) {
        if (n_in != 32 || (size_t)out_size != O_END || ws_size < WS_END) { fprintf(stderr, "kernel_launch: unexpected shapes: n_in %d out %d ws %zu (need %zu)\n", n_in, out_size, ws_size, (size_t)WS_END); grid = -1; return; }
        int dev = 0, cus = 0, per_cu = 0;
        hipGetDevice(&dev); hipDeviceGetAttribute(&cus, hipDeviceAttributeMultiprocessorCount, dev);
        if (hipFuncSetAttribute((const void*)fwd_megakernel, hipFuncAttributeMaxDynamicSharedMemorySize, LDS_BYTES) != hipSuccess) { fprintf(stderr, "kernel_launch: hipFuncSetAttribute failed\n"); grid = -1; return; }
        if (hipOccupancyMaxActiveBlocksPerMultiprocessor(&per_cu, (const void*)fwd_megakernel, NTHR, LDS_BYTES) != hipSuccess || per_cu < 1) { fprintf(stderr, "kernel_launch: occupancy query says %d\n", per_cu); per_cu = 1; }
        (void)hipGetLastError();
        grid = cus * 1;
        if (grid > 256) grid = 256;
    }
    if (grid < 0) return;
    if (hipMemsetAsync(d_ws, 0, 16384, stream) != hipSuccess) { fprintf(stderr, "kernel_launch: memset failed\n"); return; }
    Params p{};
    for (int i = 0; i < 32; ++i) p.in[i] = (const float*)d_in[i];
    p.out = (float*)d_out; p.ws = (unsigned char*)d_ws;
    void* args[] = {&p};
    hipError_t e = hipLaunchCooperativeKernel((const void*)fwd_megakernel, dim3(grid), dim3(NTHR), args, LDS_BYTES, stream);
    if (e != hipSuccess) fprintf(stderr, "kernel_launch: cooperative launch failed: %s (grid %d)\n", hipGetErrorString(e), grid);
}
```

```cpp
#include <hip/hip_runtime.h>
#include <hip/hip_cooperative_groups.h>
#include <cstdio>
#include <cstdint>
namespace cg = cooperative_groups;

#define LAS __attribute__((address_space(3)))
typedef unsigned short bf16;
typedef short bf16x8 __attribute__((ext_vector_type(8)));
typedef float f32x4 __attribute__((ext_vector_type(4)));
typedef float f32x16 __attribute__((ext_vector_type(16)));
typedef unsigned u32x4 __attribute__((ext_vector_type(4)));
typedef unsigned u32x2 __attribute__((ext_vector_type(2)));

constexpr int D = 1024, SEQ = 2048, NB = 8, MPR = NB * SEQ, NS = 128, M = MPR + NS, MPAD = 16640;
constexpr int FF = 2816, NADA = 9216, NCOND = NB + NS, NIN = 8448, NH = 8;
constexpr float EPS = 1e-6f;
constexpr int NWAVES = 8, NTHR = 512;

constexpr size_t MiB = 1u << 20;
constexpr size_t ZB = (size_t)M * D * 2;
constexpr size_t WS_WUP2 = 1 * MiB;
constexpr size_t WS_WDN2 = 12 * MiB;
constexpr size_t WS_WIN = WS_WDN2 + (size_t)D * FF * 2;
constexpr size_t WS_WBR = 34 * MiB;
constexpr size_t WS_WOUT = 38 * MiB;
constexpr size_t WS_WRG = 40 * MiB;
constexpr size_t WS_CB = WS_WRG + 512 * 1024;
constexpr size_t WS_ADA = 41 * MiB;
constexpr size_t WS_ABL = 46 * MiB;
constexpr size_t WS_H = 48 * MiB;
constexpr size_t WS_Z = WS_H + ZB;
constexpr size_t WS_ACT = WS_Z;
constexpr size_t WS_WUP1 = WS_Z + 96 * MiB;
constexpr size_t WS_WDN1 = WS_Z + 107 * MiB;
constexpr size_t WS_WADA = WS_Z + 113 * MiB;
constexpr size_t WS_END = WS_Z + 6 * ZB + 1 * MiB;
static_assert(WS_WIN + (size_t)NIN * D * 2 <= WS_WBR, "ws map");
static_assert((size_t)M * 16 * 4 <= 2 * MiB, "ws map");
static_assert((size_t)MPAD * FF * 2 <= 96 * MiB, "ws map");
static_assert(WS_WADA + (size_t)NADA * D * 2 <= WS_Z + 6 * ZB, "ws map");

constexpr size_t O_Y = 0, O_HP = (size_t)M * D, O_CRP = O_HP + NB * D, O_SP = O_CRP + NB * 3 * D, O_CQP = O_SP + (size_t)NB * NH * 128 * 128,
                 O_HS = O_CQP + NB * 3 * 3072, O_CRS = O_HS + NS * D, O_SS = O_CRS + NS * 3 * D, O_CQS = O_SS + (size_t)NS * NH * 128 * 128,
                 O_END = O_CQS + (size_t)NS * 3 * 3072;
static_assert(2 * ZB <= (O_END - O_SS) * 4, "scratch in d_out");
constexpr size_t OSB = O_SS * 4 + 2 * ZB, OSB_HK = OSB, OSB_HV = OSB + 3 * MiB / 2, OSB_NK = OSB + 3 * MiB, OSB_NQ = OSB + 7 * MiB / 2;
static_assert(OSB + 4 * MiB <= O_END * 4, "d_out scratch");

__device__ __forceinline__ unsigned pk2(float lo, float hi);
__device__ __forceinline__ unsigned f2bf(float f) { return pk2(f, f) & 0xffffu; }
typedef float f32x2_t __attribute__((ext_vector_type(2))); typedef __bf16 bf16x2_t __attribute__((ext_vector_type(2)));
__device__ __forceinline__ unsigned pk2(float lo, float hi) { f32x2_t v = {lo, hi}; bf16x2_t b = __builtin_convertvector(v, bf16x2_t); return __builtin_bit_cast(unsigned, b); }
__device__ __forceinline__ float bf2f(unsigned short b) { return __builtin_bit_cast(float, (unsigned)b << 16); }
__device__ __forceinline__ float bflo(unsigned u) { return __builtin_bit_cast(float, u << 16); }
__device__ __forceinline__ float bfhi(unsigned u) { return __builtin_bit_cast(float, u & 0xffff0000u); }
__device__ __forceinline__ float rcp_f(float x) { return __builtin_amdgcn_rcpf(x); }
__device__ __forceinline__ float rsq_f(float x) { return __builtin_amdgcn_rsqf(x); }
__device__ __forceinline__ float sigmoid_f(float x) { return rcp_f(1.f + __expf(-x)); }
__device__ __forceinline__ float neg_expm1_f(float x) {
    const float p = -x * (1.f + x * (0.5f + x * (0.16666667f + x * (0.041666668f + x * (0.0083333338f + x * 0.0013888889f)))));
    return x > -0.3f ? p : 1.f - __expf(x);
}
__device__ __forceinline__ float silu_f(float x) { return x * sigmoid_f(x); }
__device__ __forceinline__ float gelu_tanh_f(float x) { return x * sigmoid_f(1.5957691216057308f * (x + 0.044715f * x * x * x)); }
__device__ __forceinline__ float softplus_f(float x) { return x > 20.f ? x : log1pf(__expf(x)); }
template <int CTRL> __device__ __forceinline__ float dpp_f(float x) {
    return __builtin_bit_cast(float, __builtin_amdgcn_update_dpp(0, __builtin_bit_cast(int, x), CTRL, 0xF, 0xF, true));
}
__device__ __forceinline__ float red8(float x) { x += dpp_f<0xB1>(x); x += dpp_f<0x4E>(x); x += dpp_f<0x141>(x); return x; }
__device__ __forceinline__ float red16(float x) { x = red8(x); x += dpp_f<0x140>(x); return x; }
__device__ __forceinline__ float wave_sum(float v) { v = red16(v);
    return ((__builtin_bit_cast(float, __builtin_amdgcn_readlane(__builtin_bit_cast(int, v), 0)) + __builtin_bit_cast(float, __builtin_amdgcn_readlane(__builtin_bit_cast(int, v), 16))) +
            (__builtin_bit_cast(float, __builtin_amdgcn_readlane(__builtin_bit_cast(int, v), 32)) + __builtin_bit_cast(float, __builtin_amdgcn_readlane(__builtin_bit_cast(int, v), 48)))); }
__device__ __forceinline__ int lane_now();
__device__ __forceinline__ int opq(int x);
__device__ __forceinline__ float shfl_xor_l(float v, int o) { const int idx = (opq(lane_now()) ^ o) << 2; return __builtin_bit_cast(float, __builtin_amdgcn_ds_bpermute(idx, __builtin_bit_cast(int, v))); }
__device__ __forceinline__ void unpack8(const u32x4 u, float* x) { x[0] = bflo(u.x); x[1] = bfhi(u.x); x[2] = bflo(u.y); x[3] = bfhi(u.y); x[4] = bflo(u.z); x[5] = bfhi(u.z); x[6] = bflo(u.w); x[7] = bfhi(u.w); }
__device__ __forceinline__ bf16x8 pack8(float a0, float a1, float a2, float a3, float a4, float a5, float a6, float a7) {
    u32x4 w; w.x = pk2(a0, a1); w.y = pk2(a2, a3); w.z = pk2(a4, a5); w.w = pk2(a6, a7); return __builtin_bit_cast(bf16x8, w);
}
#define LDS_WAIT() asm volatile("s_waitcnt lgkmcnt(0)" ::: "memory")
__device__ __forceinline__ int lane_now() { return (int)__builtin_amdgcn_mbcnt_hi(~0u, __builtin_amdgcn_mbcnt_lo(~0u, 0u)); }
__device__ __forceinline__ int opq(int x) { asm volatile("" : "+v"(x)); return x; }

namespace pg8 {
constexpr int BM = 256, BK = 64, HALF = 128, HTB = HALF * BK * 2, NXCD = 8, WGM = 4;
__host__ __device__ __forceinline__ int lds_byte(int r, int c) { const int st = (r >> 4) * 2 + (c >> 5), rr = r & 15, cc = c & 31, ob = rr * 64 + cc * 2; return st * 1024 + (ob ^ (((ob >> 9) & 1) << 5)); }
__host__ __device__ __forceinline__ void stage_rc(int b, int& R, int& C) { const int st = b / 1024, sb = b % 1024, swz = sb ^ (((sb >> 9) & 1) << 5); R = (st >> 1) * 16 + swz / 64; C = (st & 1) * 32 + (swz % 64) / 2; }
__host__ __device__ __forceinline__ int perm32(int rho) { const int n = rho >> 4, i = rho & 15; return 8 * (i >> 2) + 4 * n + (i & 3); }

struct Unit { int pm, pn, sub; };
struct Gemm { const bf16* A0; const bf16* B0; const bf16* A1; const bf16* B1; int K; };

struct StaticOrder {
    int nM, nN, nwg, G, c;
    __device__ void init(int Mp, int N, int G_, int c_) { nM = Mp / BM; nN = N / BM; nwg = nM * nN; G = G_; c = c_; }
    __device__ bool next(int i, Unit& u) const {
        const long L = (long)i * G + c; if (L >= nwg) return false;
        int wgid = (int)L; { const int q = nwg / NXCD, r = nwg % NXCD, xcd = wgid % NXCD, off = wgid / NXCD; wgid = (xcd < r ? xcd * (q + 1) : r * (q + 1) + (xcd - r) * q) + off; }
        const int nig = WGM * nN, gid = wgid / nig, fm = gid * WGM, gsz = (nM - fm) < WGM ? (nM - fm) : WGM;
        u.pm = fm + ((wgid % nig) % gsz); u.pn = (wgid % nig) / gsz; u.sub = 0; return true;
    }
};
struct PairOrder {
    StaticOrder base;
    __device__ bool next(int i, Unit& u) const { const bool ok = base.next(i >> 1, u); u.sub = i & 1; return ok; }
};

template <class Epi, class Sched>
__device__ __forceinline__ void gemm_phase(LAS unsigned char* lds, const Gemm g, const Sched& S, const Epi& E, int wid) {
    const int lane = opq(lane_now()), tid = (wid << 6) | lane, wr = wid >> 2, wc = wid & 3, fr = lane & 15, fq = lane >> 4;
    const int K = g.K, nt = K / BK;
    unsigned voffA[2], voffB[2];
#pragma unroll
    for (int i = 0; i < 2; ++i) { int R, C; stage_rc(tid * 16 + i * 8192, R, C); const int Rb = (R & ~31) + perm32(R & 31);
        voffA[i] = (unsigned)(R * K + C) * 2u; voffB[i] = (unsigned)(Rb * K + C) * 2u; }
    const size_t kstep = (size_t)(BK * 2);
    const size_t hstep = (size_t)HALF * K * 2;
    const size_t tstep = 2 * hstep;
    const unsigned ldsw = (unsigned)wid * 1024u;
    const int aoff = lds_byte(wr * 64 + fr, fq * 8), boff = lds_byte(wc * 32 + fr, fq * 8);
#define PG8_SA(b, h) (((b) * 2 + (h)) * HTB)
#define PG8_SB(b, h) ((4 + (b) * 2 + (h)) * HTB)
#define PG8_STAGE(bufoff, gbase, voff) do { _Pragma("unroll") for (int _i = 0; _i < 2; ++_i) \
        __builtin_amdgcn_global_load_lds((const unsigned*)((const char*)(gbase) + (voff)[_i]), (LAS unsigned*)(lds + (bufoff) + ldsw + _i * 8192), 16, 0, 0); } while (0)
#define PG8_LDA(dst, b, h) do { _Pragma("unroll") for (int m = 0; m < 4; ++m) _Pragma("unroll") for (int k = 0; k < 2; ++k) dst[m][k] = *(const LAS bf16x8*)(lds + PG8_SA(b, h) + aoff + m * 2048 + k * 1024); } while (0)
#define PG8_LDB(dst, b, h) do { _Pragma("unroll") for (int n = 0; n < 2; ++n) _Pragma("unroll") for (int k = 0; k < 2; ++k) dst[n][k] = *(const LAS bf16x8*)(lds + PG8_SB(b, h) + boff + n * 2048 + k * 1024); } while (0)
#define PG8_MMA(ai, bj, At, Bt) do { __builtin_amdgcn_s_setprio(1); _Pragma("unroll") for (int m = 0; m < 4; ++m) _Pragma("unroll") for (int n = 0; n < 2; ++n) _Pragma("unroll") for (int k = 0; k < 2; ++k) \
        acc[ai][bj][m][n] = __builtin_amdgcn_mfma_f32_16x16x32_bf16(Bt[n][k], At[m][k], acc[ai][bj][m][n], 0, 0, 0); __builtin_amdgcn_s_setprio(0); } while (0)
#define PG8_WAIT_V(n) asm volatile("s_waitcnt vmcnt(" #n ")" ::: "memory")
#define PG8_WAIT_L(n) asm volatile("s_waitcnt lgkmcnt(" #n ")" ::: "memory")
#define PG8_BAR __builtin_amdgcn_s_barrier()
#define PG8_SCHED __builtin_amdgcn_sched_barrier(0)
#define PG8_ZERO() do { _Pragma("unroll") for (int a = 0; a < 2; ++a) _Pragma("unroll") for (int b = 0; b < 2; ++b) _Pragma("unroll") for (int m = 0; m < 4; ++m) _Pragma("unroll") for (int n = 0; n < 2; ++n) acc[a][b][m][n] = (f32x4){0.f, 0.f, 0.f, 0.f}; } while (0)
    Unit cur, nxt; int ui = 0;
    if (!S.next(0, cur)) return;
    f32x4 acc[2][2][4][2];
    PG8_ZERO();
    bf16x8 At[4][2], B0[2][2], B1[2][2];
    const char* cA = (const char*)(cur.sub ? g.A1 : g.A0) + (size_t)cur.pm * tstep; const char* cB = (const char*)(cur.sub ? g.B1 : g.B0) + (size_t)cur.pn * tstep;
    PG8_STAGE(PG8_SB(0, 0), cB, voffB); PG8_STAGE(PG8_SB(0, 1), cB + hstep, voffB); PG8_STAGE(PG8_SA(0, 0), cA, voffA); PG8_STAGE(PG8_SA(0, 1), cA + hstep, voffA);
    if (wr == 1) PG8_BAR;
    PG8_WAIT_V(2); PG8_BAR;
    PG8_STAGE(PG8_SB(1, 0), cB + kstep, voffB); PG8_STAGE(PG8_SA(1, 0), cA + kstep, voffA); PG8_STAGE(PG8_SB(1, 1), cB + hstep + kstep, voffB);
    PG8_WAIT_V(6); PG8_BAR;
    for (;;) {
        const bool has_next = S.next(ui + 1, nxt);
        const char* nA = has_next ? (const char*)(nxt.sub ? g.A1 : g.A0) + (size_t)nxt.pm * tstep : cA; const char* nB = has_next ? (const char*)(nxt.sub ? g.B1 : g.B0) + (size_t)nxt.pn * tstep : cB;
        for (int t = 0; t < nt; t += 2) {
            const bool last = (t == nt - 2);
            const char* a1 = cA + (size_t)(t + 1) * kstep;
            const char* a2 = last ? nA : cA + (size_t)(t + 2) * kstep; const char* b2 = last ? nB : cB + (size_t)(t + 2) * kstep;
            const char* a3 = a2 + kstep; const char* b3 = b2 + kstep;
            PG8_LDB(B0, 0, 0); PG8_LDB(B1, 0, 1); PG8_SCHED; PG8_LDA(At, 0, 0); PG8_STAGE(PG8_SA(1, 1), a1 + hstep, voffA);
            PG8_WAIT_V(8); PG8_WAIT_L(0); PG8_BAR; PG8_MMA(0, 0, At, B0); PG8_MMA(0, 1, At, B1); PG8_BAR; PG8_SCHED;
            PG8_LDA(At, 0, 1); PG8_STAGE(PG8_SB(0, 0), b2, voffB); PG8_STAGE(PG8_SB(0, 1), b2 + hstep, voffB); PG8_STAGE(PG8_SA(0, 0), a2, voffA);
            PG8_WAIT_V(8); PG8_WAIT_L(0); PG8_BAR; PG8_MMA(1, 0, At, B0); PG8_MMA(1, 1, At, B1); PG8_BAR; PG8_SCHED;
            PG8_LDB(B0, 1, 0); PG8_LDB(B1, 1, 1); PG8_SCHED; PG8_LDA(At, 1, 0); PG8_STAGE(PG8_SA(0, 1), a2 + hstep, voffA);
            PG8_WAIT_V(8); PG8_WAIT_L(0); PG8_BAR; PG8_MMA(0, 0, At, B0); PG8_MMA(0, 1, At, B1); PG8_BAR; PG8_SCHED;
            PG8_LDA(At, 1, 1); PG8_STAGE(PG8_SB(1, 0), b3, voffB); PG8_STAGE(PG8_SB(1, 1), b3 + hstep, voffB); PG8_STAGE(PG8_SA(1, 0), a3, voffA);
            PG8_WAIT_V(8); PG8_WAIT_L(0); PG8_BAR; PG8_MMA(1, 0, At, B0); PG8_MMA(1, 1, At, B1); PG8_BAR; PG8_SCHED;
        }
        if (wr == 0) PG8_BAR;
        bool keep = false;
        if constexpr (Epi::KEEP) { if (cur.sub == 0) { E.mid(acc, cur, wr, wc, fr, fq); keep = true; } else E(acc, cur, wr, wc, fr, fq); }
        else E(acc, cur, wr, wc, fr, fq);
        if (!has_next) break;
        if (!keep) PG8_ZERO();
        cur = nxt; cA = nA; cB = nB; ++ui;
        if (wr == 1) PG8_BAR;
    }
    PG8_WAIT_V(0);
    PG8_BAR;
#undef PG8_SA
#undef PG8_SB
#undef PG8_STAGE
#undef PG8_LDA
#undef PG8_LDB
#undef PG8_MMA
#undef PG8_WAIT_V
#undef PG8_WAIT_L
#undef PG8_BAR
#undef PG8_SCHED
#undef PG8_ZERO
}
}

typedef f32x4 AccT[2][2][4][2];
__device__ __forceinline__ int cond_of_row(int row) { return row < MPR ? (row >> 11) : (NB + row - MPR); }

struct EpiAda {
    static constexpr bool KEEP = false;
    float* ada; const float* bias;
    __device__ __forceinline__ void operator()(const AccT& acc, const pg8::Unit& u, int wr, int wc, int fr, int fq) const {
#pragma unroll
        for (int ai = 0; ai < 2; ++ai)
#pragma unroll
            for (int m = 0; m < 4; ++m) { const int row = u.pm * 256 + ai * 128 + wr * 64 + m * 16 + fr; if (row >= NCOND) continue;
#pragma unroll
                for (int bj = 0; bj < 2; ++bj)
#pragma unroll
                    for (int n = 0; n < 2; ++n) { const int col = u.pn * 256 + bj * 128 + wc * 32 + 8 * fq + 4 * n;
                        *(f32x4*)(ada + (size_t)row * NADA + col) = acc[ai][bj][m][n] + *(const f32x4*)(bias + col); } }
    }
};
struct EpiSwiglu {
    static constexpr bool KEEP = false;
    bf16* act;
    __device__ __forceinline__ void operator()(const AccT& acc, const pg8::Unit& u, int wr, int wc, int fr, int fq) const {
#pragma unroll
        for (int ai = 0; ai < 2; ++ai)
#pragma unroll
            for (int m = 0; m < 4; ++m) { const int row = u.pm * 256 + ai * 128 + wr * 64 + m * 16 + fr; if (row >= M) continue;
                const f32x4 g0 = acc[ai][0][m][0], g1 = acc[ai][0][m][1], v0 = acc[ai][1][m][0], v1 = acc[ai][1][m][1];
                u32x4 w; w.x = pk2(silu_f(g0[0]) * v0[0], silu_f(g0[1]) * v0[1]); w.y = pk2(silu_f(g0[2]) * v0[2], silu_f(g0[3]) * v0[3]);
                w.z = pk2(silu_f(g1[0]) * v1[0], silu_f(g1[1]) * v1[1]); w.w = pk2(silu_f(g1[2]) * v1[2], silu_f(g1[3]) * v1[3]);
                *(u32x4*)(act + (size_t)row * FF + u.pn * 128 + wc * 32 + 8 * fq) = w; }
    }
};
struct EpiResid {
    static constexpr bool KEEP = false;
    float* X; const float* xp; const float* xs; const float* gate; float coef;
    __device__ __forceinline__ void operator()(const AccT& acc, const pg8::Unit& u, int wr, int wc, int fr, int fq) const {
#pragma unroll
        for (int ai = 0; ai < 2; ++ai)
#pragma unroll
            for (int m = 0; m < 4; ++m) { const int row = u.pm * 256 + ai * 128 + wr * 64 + m * 16 + fr; if (row >= M) continue;
                const float* xin = xp ? (row < MPR ? xp + (size_t)row * D : xs + (size_t)(row - MPR) * D) : X + (size_t)row * D;
                const float* gt = gate + (size_t)cond_of_row(row) * NADA;
#pragma unroll
                for (int bj = 0; bj < 2; ++bj)
#pragma unroll
                    for (int n = 0; n < 2; ++n) { const int col = u.pn * 256 + bj * 128 + wc * 32 + 8 * fq + 4 * n;
                        const f32x4 xv = *(const f32x4*)(xin + col), gv = *(const f32x4*)(gt + col);
                        *(f32x4*)(X + (size_t)row * D + col) = xv + (gv * coef) * acc[ai][bj][m][n]; } }
    }
};
constexpr size_t WS_CNT = 14336, WS_PART = 65536;
template <int MODE> struct EpiResidNorm {
    static constexpr bool KEEP = false;
    float* X; const float* xp; const float* gate; float coef; const float* gvec; const float* shift; bf16* Hout; float* part; unsigned* cnt; LAS float* sred;
    __device__ __forceinline__ void operator()(AccT& acc, const pg8::Unit& u, int wr, int wc, int fr_, int fq_) const {
        const int fr = opq(fr_), fq = opq(fq_);
        const int tid = wr * 256 + wc * 64 + fq * 16 + fr, bidx = u.pm >> 3;
        const float* gt = gate + (size_t)bidx * NADA;
        float ss[2][4]; int zoff = 0;
#pragma unroll
        for (int ai = 0; ai < 2; ++ai)
#pragma unroll
            for (int m = 0; m < 4; ++m) { const int row = u.pm * 256 + ai * 128 + wr * 64 + m * 16 + fr + zoff;
                const float* xin = xp ? xp + (size_t)row * D : X + (size_t)row * D; float sacc = 0.f;
#pragma unroll
                for (int bj = 0; bj < 2; ++bj)
#pragma unroll
                    for (int n = 0; n < 2; ++n) { const int col = u.pn * 256 + bj * 128 + wc * 32 + 8 * fq + 4 * n;
                        const f32x4 xv = *(const f32x4*)(xin + col), gv = *(const f32x4*)(gt + col);
                        const f32x4 xn = xv + (gv * coef) * acc[ai][bj][m][n]; acc[ai][bj][m][n] = xn;
                        if (MODE == 0) *(f32x4*)(X + (size_t)row * D + col) = xn;
                        sacc += (xn[0] * xn[0] + xn[1] * xn[1]) + (xn[2] * xn[2] + xn[3] * xn[3]); }
                asm volatile("" : "+v"(zoff) : "v"(sacc));
                sacc += shfl_xor_l(sacc, 16); sacc += shfl_xor_l(sacc, 32);
                ss[ai][m] = sacc; __builtin_amdgcn_sched_barrier(0); }
        if (fq == 0) {
#pragma unroll
            for (int ai = 0; ai < 2; ++ai)
#pragma unroll
                for (int m = 0; m < 4; ++m) sred[wc * 256 + ai * 128 + wr * 64 + m * 16 + fr] = ss[ai][m]; }
        __syncthreads();
        if (tid < 256) __hip_atomic_store((unsigned*)part + ((size_t)u.pm * 4 + u.pn) * 256 + tid, __builtin_bit_cast(unsigned, (sred[tid] + sred[256 + tid]) + (sred[512 + tid] + sred[768 + tid])), __ATOMIC_RELAXED, __HIP_MEMORY_SCOPE_AGENT);
        asm volatile("s_waitcnt vmcnt(0)" ::: "memory");
        __syncthreads();
        if (tid == 0) { __hip_atomic_fetch_add(cnt + u.pm, 1u, __ATOMIC_RELAXED, __HIP_MEMORY_SCOPE_AGENT);
            unsigned sp = 0; while (__hip_atomic_load(cnt + u.pm, __ATOMIC_RELAXED, __HIP_MEMORY_SCOPE_AGENT) < 4u && ++sp < (1u << 24)) __builtin_amdgcn_s_sleep(1); }
        __syncthreads();
        if (tid < 256) { unsigned* pp = (unsigned*)part + (size_t)u.pm * 4 * 256 + tid;
            const float p0 = __builtin_bit_cast(float, __hip_atomic_load(pp, __ATOMIC_RELAXED, __HIP_MEMORY_SCOPE_AGENT)), p1 = __builtin_bit_cast(float, __hip_atomic_load(pp + 256, __ATOMIC_RELAXED, __HIP_MEMORY_SCOPE_AGENT));
            const float p2 = __builtin_bit_cast(float, __hip_atomic_load(pp + 512, __ATOMIC_RELAXED, __HIP_MEMORY_SCOPE_AGENT)), p3 = __builtin_bit_cast(float, __hip_atomic_load(pp + 768, __ATOMIC_RELAXED, __HIP_MEMORY_SCOPE_AGENT));
            sred[1024 + tid] = rsq_f(((p0 + p1) + (p2 + p3)) * (1.f / D) + EPS); }
        __syncthreads();
        const float* sh = MODE == 0 ? shift + (size_t)bidx * NADA : nullptr;
#pragma unroll
        for (int bj = 0; bj < 2; ++bj) { const int col = u.pn * 256 + bj * 128 + wc * 32 + 8 * fq;
            const f32x4 g0 = *(const f32x4*)(gvec + col), g1 = *(const f32x4*)(gvec + col + 4);
            f32x4 a0 = g0, a1 = g1, b0 = {0.f, 0.f, 0.f, 0.f}, b1 = b0;
            if (MODE == 0) { a0 = g0 * (*(const f32x4*)(sh + D + col) + 1.f); a1 = g1 * (*(const f32x4*)(sh + D + col + 4) + 1.f); b0 = *(const f32x4*)(sh + col); b1 = *(const f32x4*)(sh + col + 4); }
#pragma unroll
            for (int ai = 0; ai < 2; ++ai)
#pragma unroll
                for (int m = 0; m < 4; ++m) { const int rl = ai * 128 + wr * 64 + m * 16 + fr; const size_t row = (size_t)u.pm * 256 + rl; const float rstd = sred[1024 + rl];
                    const f32x4 y0 = acc[ai][bj][m][0] * rstd * a0 + b0, y1 = acc[ai][bj][m][1] * rstd * a1 + b1;
                    if (MODE == 0) *(bf16x8*)(Hout + row * D + col) = pack8(y0[0], y0[1], y0[2], y0[3], y1[0], y1[1], y1[2], y1[3]);
                    else { *(f32x4*)(X + row * D + col) = y0; *(f32x4*)(X + row * D + col + 4) = y1; }
                    __builtin_amdgcn_sched_barrier(0); }
        }
        __syncthreads();
    }
};
struct EpiIn {
    static constexpr bool KEEP = false;
    bf16* z; bf16* mg; float* abl; float* out;
    __device__ __forceinline__ void operator()(const AccT& acc, const pg8::Unit& u, int wr, int wc, int fr, int fq) const {
        const int bi = u.pn >> 2;
        if (bi == 8) {
            if (wc == 0 && fq < 2) {
#pragma unroll
                for (int ai = 0; ai < 2; ++ai)
#pragma unroll
                    for (int m = 0; m < 4; ++m) { const int row = u.pm * 256 + ai * 128 + wr * 64 + m * 16 + fr; if (row >= M) continue;
                        *(f32x4*)(abl + (size_t)row * 16 + 8 * fq) = acc[ai][0][m][0]; *(f32x4*)(abl + (size_t)row * 16 + 8 * fq + 4) = acc[ai][0][m][1]; }
            }
            return;
        }
        bf16* base = bi < 6 ? z + (size_t)bi * (ZB / 2) : mg + (size_t)(bi - 6) * (ZB / 2);
        const int act = (bi == 1) ? 1 : (bi == 5) ? 2 : (bi >= 6) ? 3 : 0;
        const int colt = (u.pn & 3) * 256 + wc * 32 + 8 * fq;
#pragma unroll
        for (int ai = 0; ai < 2; ++ai)
#pragma unroll
            for (int m = 0; m < 4; ++m) { const int row = u.pm * 256 + ai * 128 + wr * 64 + m * 16 + fr; if (row >= M) continue;
#pragma unroll
                for (int bj = 0; bj < 2; ++bj) { f32x4 v0 = acc[ai][bj][m][0], v1 = acc[ai][bj][m][1];
                    if (act == 1) {
#pragma unroll
                        for (int j = 0; j < 4; ++j) { v0[j] = gelu_tanh_f(v0[j]); v1[j] = gelu_tanh_f(v1[j]); } }
                    else if (act == 2) {
#pragma unroll
                        for (int j = 0; j < 4; ++j) { v0[j] = silu_f(v0[j]); v1[j] = silu_f(v1[j]); } }
                    else if (act == 3) {
#pragma unroll
                        for (int j = 0; j < 4; ++j) { v0[j] = sigmoid_f(v0[j]); v1[j] = sigmoid_f(v1[j]); } }
                    u32x4 w; w.x = pk2(v0[0], v0[1]); w.y = pk2(v0[2], v0[3]); w.z = pk2(v1[0], v1[1]); w.w = pk2(v1[2], v1[3]);
                    *(u32x4*)(base + (size_t)row * D + colt + bj * 128) = w;
                    if (act == 0 && row < MPR) { const int rs = row & (SEQ - 1), r64 = row & 63, bb = row >> 11, col = colt + bj * 128;
                        if (bi >= 3 && r64 >= 61 && rs < SEQ - 3)
                            *(u32x4*)((bf16*)((unsigned char*)out + (bi == 3 ? OSB_HK : OSB_HV)) + ((size_t)(bb * 32 + (rs >> 6) + 1) * 3 + (r64 - 61)) * D + col) = w;
                        if (rs >= SEQ - 3) { float* dst = bi == 0 ? out + O_CRP + ((size_t)bb * 3 + (rs - (SEQ - 3))) * D + col : out + O_CQP + ((size_t)bb * 3 + (rs - (SEQ - 3))) * 3072 + (bi - 2) * 1024 + col;
                            *(f32x4*)dst = v0; *(f32x4*)(dst + 4) = v1; } }
                } }
    }
};
struct EpiBranch {
    static constexpr bool KEEP = true;
    const bf16* mga; const bf16* mgb; bf16* G;
    __device__ __forceinline__ void mid(AccT& acc, const pg8::Unit& u, int wr, int wc, int fr, int fq) const {
#pragma unroll
        for (int ai = 0; ai < 2; ++ai)
#pragma unroll
            for (int m = 0; m < 4; ++m) { int row = u.pm * 256 + ai * 128 + wr * 64 + m * 16 + fr; if (row >= M) row = M - 1;
#pragma unroll
                for (int bj = 0; bj < 2; ++bj) { const size_t o = (size_t)row * D + u.pn * 256 + bj * 128 + wc * 32 + 8 * fq;
                    const u32x4 a = *(const u32x4*)(mga + o), b = *(const u32x4*)(mgb + o);
                    f32x4 r0, r1;
                    r0[0] = bflo(a.x) * rcp_f(bflo(b.x)); r0[1] = bfhi(a.x) * rcp_f(bfhi(b.x)); r0[2] = bflo(a.y) * rcp_f(bflo(b.y)); r0[3] = bfhi(a.y) * rcp_f(bfhi(b.y));
                    r1[0] = bflo(a.z) * rcp_f(bflo(b.z)); r1[1] = bfhi(a.z) * rcp_f(bfhi(b.z)); r1[2] = bflo(a.w) * rcp_f(bflo(b.w)); r1[3] = bfhi(a.w) * rcp_f(bfhi(b.w));
                    acc[ai][bj][m][0] = acc[ai][bj][m][0] * r0; acc[ai][bj][m][1] = acc[ai][bj][m][1] * r1; } }
    }
    __device__ __forceinline__ void operator()(const AccT& acc, const pg8::Unit& u, int wr, int wc, int fr, int fq) const {
#pragma unroll
        for (int ai = 0; ai < 2; ++ai)
#pragma unroll
            for (int m = 0; m < 4; ++m) { const int row = u.pm * 256 + ai * 128 + wr * 64 + m * 16 + fr; if (row >= M) continue;
#pragma unroll
                for (int bj = 0; bj < 2; ++bj) { const size_t o = (size_t)row * D + u.pn * 256 + bj * 128 + wc * 32 + 8 * fq;
                    const u32x4 b = *(const u32x4*)(mgb + o);
                    const f32x4 v0 = acc[ai][bj][m][0], v1 = acc[ai][bj][m][1];
                    u32x4 w; w.x = pk2(v0[0] * bflo(b.x), v0[1] * bfhi(b.x)); w.y = pk2(v0[2] * bflo(b.y), v0[3] * bfhi(b.y));
                    w.z = pk2(v1[0] * bflo(b.z), v1[1] * bfhi(b.z)); w.w = pk2(v1[2] * bflo(b.w), v1[3] * bfhi(b.w));
                    *(u32x4*)(G + o) = w; } }
    }
};

__device__ __forceinline__ f32x4 mini_partial(const bf16* A, const bf16* Bt, int K, int row0, int col0, int ks, int lane) {
    const int kq = K >> 2;
    const bf16* ap = A + (size_t)(MPR + row0 + (lane & 15)) * K + ks * kq + (lane >> 4) * 8;
    const bf16* bp = Bt + (size_t)(col0 + (lane & 15)) * K + ks * kq + (lane >> 4) * 8;
    f32x4 acc = {0.f, 0.f, 0.f, 0.f};
#pragma unroll 1
    for (int k0 = 0; k0 < kq; k0 += 256) {
        bf16x8 a[8], b[8];
#pragma unroll
        for (int i = 0; i < 8; ++i) if (k0 + 32 * i < kq) { a[i] = *(const bf16x8*)(ap + k0 + 32 * i); b[i] = *(const bf16x8*)(bp + k0 + 32 * i); }
#pragma unroll
        for (int i = 0; i < 8; ++i) if (k0 + 32 * i < kq) acc = __builtin_amdgcn_mfma_f32_16x16x32_bf16(b[i], a[i], acc, 0, 0, 0);
    }
    return acc;
}
template <class F>
__device__ __forceinline__ void mini_gemm(LAS unsigned char* lds, const bf16* A0, const bf16* B0, const bf16* A1, const bf16* B1, int K, int wg, int G, int tid_, const F& epi) {
    const int tid = opq(tid_), lane = tid & 63, wave = tid >> 6, ks = wave & 3;
    LAS f32x4* red = (LAS f32x4*)lds;
    for (int t0 = wg * 2; t0 < 512; t0 += G * 2) {
        const int tile = t0 + (wave >> 2), row0 = (tile >> 6) * 16, col0 = (tile & 63) * 16;
        f32x4 p0 = mini_partial(A0, B0, K, row0, col0, ks, lane), p1 = {0.f, 0.f, 0.f, 0.f};
        if (A1) p1 = mini_partial(A1, B1, K, row0, col0, ks, lane);
        red[(wave * 2) * 64 + lane] = p0; red[(wave * 2 + 1) * 64 + lane] = p1;
        __syncthreads();
        if (ks == 0) {
#pragma unroll
            for (int w = 1; w < 4; ++w) { p0 = p0 + red[((wave + w) * 2) * 64 + lane]; p1 = p1 + red[((wave + w) * 2 + 1) * 64 + lane]; }
            epi(MPR + row0 + (lane & 15), col0 + 4 * (lane >> 4), p0, p1);
        }
        __syncthreads();
    }
}

struct Params { const float* in[32]; float* out; unsigned char* ws; };
constexpr int LDS_BYTES = 147456;
#ifndef PHM
#define PHM 0xFFFF
#endif
#ifndef P7M
#define P7M 0xF
#endif

struct Ctx {
    const float* const* in; float* out; unsigned char* ws; LAS unsigned char* lds;
    int tid, lane, wave, wg, G;
};
#define KAS __attribute__((address_space(4)))
typedef const float* cfptr_t; typedef float* fptr_t; typedef unsigned char* ucptr_t;
__device__ __forceinline__ const float* karg_in(int k) { return *(volatile KAS cfptr_t*)((const KAS char*)__builtin_amdgcn_kernarg_segment_ptr() + 8 * k); }
__device__ __forceinline__ float* karg_out() { return *(volatile KAS fptr_t*)((const KAS char*)__builtin_amdgcn_kernarg_segment_ptr() + 256); }
__device__ __forceinline__ unsigned char* karg_ws() { return *(volatile KAS ucptr_t*)((const KAS char*)__builtin_amdgcn_kernarg_segment_ptr() + 264); }
#define INP(k) karg_in(k)

template <int MODE>
__device__ __forceinline__ void sample_norm_rows(const float* gvec, int ish, int gw, int lane) {
    if (gw >= NS) return;
    const int row = MPR + gw; float* X = karg_out() + (size_t)row * D;
    f32x4 v[4]; float s = 0.f;
#pragma unroll
    for (int j = 0; j < 4; ++j) { v[j] = *(const f32x4*)(X + 4 * (lane + 64 * j)); s += (v[j][0] * v[j][0] + v[j][1] * v[j][1]) + (v[j][2] * v[j][2] + v[j][3] * v[j][3]); }
    const float rstd = rsq_f(wave_sum(s) * (1.f / D) + EPS);
    const float* sh = (const float*)(karg_ws() + WS_ADA) + (size_t)cond_of_row(row) * NADA + ish * D;
#pragma unroll
    for (int j = 0; j < 4; ++j) { const int col = 4 * (lane + 64 * j); const f32x4 g = *(const f32x4*)(gvec + col);
        if (MODE == 0) { const f32x4 y = (v[j] * rstd * g) * (*(const f32x4*)(sh + D + col) + 1.f) + *(const f32x4*)(sh + col);
            u32x2 o; o.x = pk2(y[0], y[1]); o.y = pk2(y[2], y[3]); *(u32x2*)((bf16*)(karg_ws() + WS_H) + (size_t)row * D + col) = o; }
        else *(f32x4*)(X + col) = v[j] * rstd * g; }
}
__device__ __forceinline__ void transpose_item(const float* W, int ldw, int k0, int n0, int nvalid, bf16* WT, int ldt, int drow0, LAS float* scr, int lane) {
    const int cc = lane & 31;
#pragma unroll 8
    for (int i = 0; i < 32; ++i) { const int kk = 2 * i + (lane >> 5); scr[kk * 33 + cc] = (cc < nvalid) ? W[(size_t)(k0 + kk) * ldw + n0 + cc] : 0.f; }
    LDS_WAIT(); asm volatile("" ::: "memory");
    const int c = lane & 7;
#pragma unroll
    for (int j = 0; j < 4; ++j) { const int n = (lane >> 3) + 8 * j; const LAS float* s = scr + (8 * c) * 33 + n;
        u32x4 o; o.x = pk2(s[0 * 33], s[1 * 33]); o.y = pk2(s[2 * 33], s[3 * 33]); o.z = pk2(s[4 * 33], s[5 * 33]); o.w = pk2(s[6 * 33], s[7 * 33]);
        if (n < nvalid) *(u32x4*)(WT + (size_t)(drow0 + n) * ldt + k0 + 8 * c) = o; }
    LDS_WAIT(); asm volatile("" ::: "memory");
}

template <int PART>
__device__ __forceinline__ void prologue(const Params& P, LAS unsigned char* lds, int gw, int NGW, int wave, int lane) {
    LAS float* scr = (LAS float*)(lds + wave * 16384);
    unsigned char* ws = karg_ws();
    constexpr int I_UP = 16 * 176, I_DN = 44 * 32, I_IN = 16 * 257, I_BR = 2 * 16 * 32, I_OUT = 16 * 32, I_ADA = 16 * 288, I_RG = 128;
    constexpr int NITEMS = 2 * I_UP + 2 * I_DN + I_IN + I_BR + I_OUT + I_ADA + I_RG;
    constexpr int I_FIRST = 2 * I_UP + 2 * I_DN + I_IN + I_BR + I_OUT;
    for (int it = gw; it < NITEMS; it += NGW) {
        int r = it;
        if (PART == 0) { if (r >= I_ADA) break; r += I_FIRST; } else { if (r >= NITEMS - I_ADA) break; if (r >= I_FIRST) r += I_ADA; }
        if (r < 2 * I_UP) { const int which = r / I_UP; r -= which * I_UP; const int kb = r / 176, nb = r % 176, n0 = nb * 32; const int half = n0 >= FF ? 1 : 0, np = n0 - half * FF;
            transpose_item(INP(which ? 29 : 11), 2 * FF, kb * 64, n0, 32, (bf16*)(ws + (which ? WS_WUP2 : WS_WUP1)), D, (np >> 7) * 256 + half * 128 + (np & 127), scr, lane); continue; }
        r -= 2 * I_UP;
        if (r < 2 * I_DN) { const int which = r / I_DN; r -= which * I_DN; const int kb = r / 32, nb = r % 32;
            transpose_item(INP(which ? 30 : 12), D, kb * 64, nb * 32, 32, (bf16*)(ws + (which ? WS_WDN2 : WS_WDN1)), FF, nb * 32, scr, lane); continue; }
        r -= 2 * I_DN;
        if (r < I_IN) { const int kb = r / 257, nb = r % 257; int n0, nv, dr;
            if (nb < 160) { n0 = nb * 32; nv = 32; dr = n0; } else if (nb == 160) { n0 = 5120; nv = 16; dr = 8192; } else { n0 = 5136 + (nb - 161) * 32; nv = 32; dr = 5120 + (nb - 161) * 32; }
            transpose_item(INP(14), 8208, kb * 64, n0, nv, (bf16*)(ws + WS_WIN), D, dr, scr, lane); continue; }
        r -= I_IN;
        if (r < I_BR) { const int which = r / 512; r -= which * 512; const int kb = r / 32, nb = r % 32;
            transpose_item(INP(26) + (size_t)which * D * D, D, kb * 64, nb * 32, 32, (bf16*)(ws + WS_WBR), D, which * D + nb * 32, scr, lane); continue; }
        r -= I_BR;
        if (r < I_OUT) { const int kb = r / 32, nb = r % 32; transpose_item(INP(27), D, kb * 64, nb * 32, 32, (bf16*)(ws + WS_WOUT), D, nb * 32, scr, lane); continue; }
        r -= I_OUT;
        if (r < I_ADA) { const int kb = r / 288, nb = r % 288; transpose_item(INP(8), NADA, kb * 64, nb * 32, 32, (bf16*)(ws + WS_WADA), D, nb * 32, scr, lane); continue; }
        r -= I_ADA;
        { const int gx = r >> 6, n = (r >> 3) & 7, kb = (r >> 2) & 1, nb = r & 3;
          transpose_item(INP(gx ? 19 : 17) + (size_t)n * 128 * 128, 128, kb * 64, nb * 32, 32, (bf16*)(ws + WS_WRG), 128, n * 256 + gx * 128 + nb * 32, scr, lane); }
    }
    bf16* cb = (bf16*)(ws + WS_CB);
    if (PART == 0) for (int row = gw; row < 256; row += NGW) {
        const float* src = row < NB ? INP(2) + (size_t)row * D : (row < NCOND ? INP(3) + (size_t)(row - NB) * D : nullptr);
#pragma unroll
        for (int j = 0; j < 4; ++j) { const int col = 4 * (lane + 64 * j); f32x4 v = src ? *(const f32x4*)(src + col) : (f32x4){0.f, 0.f, 0.f, 0.f};
            u32x2 o; o.x = pk2(v[0], v[1]); o.y = pk2(v[2], v[3]); *(u32x2*)(cb + (size_t)row * D + col) = o; }
    }
}

template <int MODE>
__device__ __forceinline__ void norm_mod_pass(const Params& P, const float* gvec, int ish, int gw, int NGW, int lane) {
    const float* ada = (const float*)(karg_ws() + WS_ADA); bf16* H = (bf16*)(karg_ws() + WS_H);
    const float* xp = INP(0); const float* xs = INP(1); const float* X = karg_out();
    for (int row0 = 2 * gw; row0 < M; row0 += 2 * NGW) {
        f32x4 v[2][4]; float s[2] = {0.f, 0.f};
#pragma unroll
        for (int u = 0; u < 2; ++u) { const int row = row0 + u;
            const float* xr = MODE == 0 ? (row < MPR ? xp + (size_t)row * D : xs + (size_t)(row - MPR) * D) : X + (size_t)row * D;
#pragma unroll
            for (int j = 0; j < 4; ++j) v[u][j] = *(const f32x4*)(xr + 4 * (lane + 64 * j)); }
#pragma unroll
        for (int u = 0; u < 2; ++u)
#pragma unroll
            for (int j = 0; j < 4; ++j) s[u] += (v[u][j][0] * v[u][j][0] + v[u][j][1] * v[u][j][1]) + (v[u][j][2] * v[u][j][2] + v[u][j][3] * v[u][j][3]);
        s[0] = wave_sum(s[0]); s[1] = wave_sum(s[1]);
#pragma unroll
        for (int u = 0; u < 2; ++u) { const int row = row0 + u; const float rstd = rsq_f(s[u] * (1.f / D) + EPS);
            const float* sh = ada + (size_t)cond_of_row(row) * NADA + ish * D; const float* sc = sh + D;
#pragma unroll
            for (int j = 0; j < 4; ++j) { const int col = 4 * (lane + 64 * j); const f32x4 g = *(const f32x4*)(gvec + col), a = *(const f32x4*)(sc + col), bb = *(const f32x4*)(sh + col);
                const f32x4 y = (v[u][j] * rstd * g) * (a + 1.f) + bb; u32x2 o; o.x = pk2(y[0], y[1]); o.y = pk2(y[2], y[3]); *(u32x2*)(H + (size_t)row * D + col) = o; } }
    }
}
__device__ __forceinline__ void final_norm_pass(const Params& P, int gw, int NGW, int lane) {
    const float* gvec = INP(31); float* X = karg_out();
    for (int row0 = 2 * gw; row0 < M; row0 += 2 * NGW) {
        f32x4 v[2][4]; float s[2] = {0.f, 0.f};
#pragma unroll
        for (int u = 0; u < 2; ++u)
#pragma unroll
            for (int j = 0; j < 4; ++j) v[u][j] = *(const f32x4*)(X + (size_t)(row0 + u) * D + 4 * (lane + 64 * j));
#pragma unroll
        for (int u = 0; u < 2; ++u)
#pragma unroll
            for (int j = 0; j < 4; ++j) s[u] += (v[u][j][0] * v[u][j][0] + v[u][j][1] * v[u][j][1]) + (v[u][j][2] * v[u][j][2] + v[u][j][3] * v[u][j][3]);
        s[0] = wave_sum(s[0]); s[1] = wave_sum(s[1]);
#pragma unroll
        for (int u = 0; u < 2; ++u) { const float rstd = rsq_f(s[u] * (1.f / D) + EPS);
#pragma unroll
            for (int j = 0; j < 4; ++j) { const int col = 4 * (lane + 64 * j); *(f32x4*)(X + (size_t)(row0 + u) * D + col) = v[u][j] * rstd * *(const f32x4*)(gvec + col); } }
    }
}
__device__ __forceinline__ void onorm_pass(const Params& P, int gw, int NGW, int lane) {
    const bf16* O = (const bf16*)(karg_ws() + WS_H); bf16* ZG = (bf16*)(karg_ws() + WS_Z + 5 * ZB); const float* dn = INP(25);
    const int dc = (lane & 7) * 16;
    for (int row0 = 2 * gw; row0 < M; row0 += 2 * NGW) {
        u32x4 a[2][2], z[2][2];
#pragma unroll
        for (int u = 0; u < 2; ++u) { const size_t o = (size_t)(row0 + u) * D + lane * 16;
            a[u][0] = *(const u32x4*)(O + o); a[u][1] = *(const u32x4*)(O + o + 8); z[u][0] = *(const u32x4*)(ZG + o); z[u][1] = *(const u32x4*)(ZG + o + 8); }
#pragma unroll
        for (int u = 0; u < 2; ++u) { const size_t o = (size_t)(row0 + u) * D + lane * 16;
            float v[16], zz[16]; unpack8(a[u][0], v); unpack8(a[u][1], v + 8); unpack8(z[u][0], zz); unpack8(z[u][1], zz + 8);
            float s = 0.f;
#pragma unroll
            for (int e = 0; e < 16; ++e) s += v[e] * v[e];
            s = red8(s);
            const float rstd = rsq_f(s * (1.f / 128.f) + EPS);
#pragma unroll
            for (int e = 0; e < 16; ++e) v[e] = v[e] * rstd * dn[dc + e] * zz[e];
            *(bf16x8*)(ZG + o) = pack8(v[0], v[1], v[2], v[3], v[4], v[5], v[6], v[7]); *(bf16x8*)(ZG + o + 8) = pack8(v[8], v[9], v[10], v[11], v[12], v[13], v[14], v[15]); }
    }
}

constexpr int SS_TAIL = 530;
constexpr int RG_SPLIT = 8;
constexpr size_t WS_HCARRY = 917504;
__device__ __forceinline__ void rglru_task(const Params& P, LAS unsigned char* lds, int b, int n, int qd, int tid, int t0, int t1) {
    const int lane = tid & 63, wave = tid >> 6;
    LAS bf16* xcA = (LAS bf16*)lds;
    LAS float* xcf = (LAS float*)(lds + 34816);
    LAS float* rb = (LAS float*)(lds + 51200);
    LAS float* ib = (LAS float*)(lds + 67584);
    LAS float* segA = (LAS float*)(lds + 83968);
    LAS float* segB = (LAS float*)(lds + 86016);
    LAS float* hc = (LAS float*)(lds + 88064);
    LAS float* cw = (LAS float*)(lds + 88192);
    LAS bf16* rawt = (LAS bf16*)(lds + 90752);
    bf16* XR = (bf16*)(karg_ws() + WS_Z); bf16* GR = (bf16*)(karg_ws() + WS_Z + ZB);
    const bf16* WRG = (const bf16*)(karg_ws() + WS_WRG);
    const int cb0 = n * 128, oc0 = cb0 + qd * 32;
    const bool prompt = b >= 0;
    for (int i = tid; i < 640; i += NTHR) cw[i] = i < 512 ? INP(15)[(size_t)(i >> 7) * D + cb0 + (i & 127)] : INP(16)[cb0 + (i - 512)];
    if (tid < 32) hc[tid] = t0 > 0 ? ((const float*)(karg_ws() + WS_HCARRY))[(size_t)b * D + oc0 + tid] : 0.f;
    const int tb = wave & 3, cbk = wave >> 2;
    bf16x8 Bf[8];
    { const bf16* wrow = WRG + (size_t)(n * 256 + cbk * 128 + qd * 32 + (lane & 31)) * 128 + (lane >> 5) * 8;
#pragma unroll
      for (int ks = 0; ks < 8; ++ks) Bf[ks] = *(const bf16x8*)(wrow + ks * 16); }
    const float gbias = INP(cbk ? 20 : 18)[oc0 + (lane & 31)];
    const int ch = tid & 31, seg = tid >> 5;
    const float sp = softplus_f(-INP(21)[oc0 + ch]);
    float hlast = 0.f;
    u32x4 pre[5];
#define RG_RAW_LOAD(tile_) do { _Pragma("unroll") for (int i = 0; i < 5; ++i) { const int q = tid + 512 * i, row = q >> 4, c16 = q & 15, tl = (tile_) * 128 - 3 + row; \
        pre[i] = (q < 131 * 16 && tl >= 0) ? *(const u32x4*)(XR + ((size_t)b * SEQ + tl) * D + cb0 + c16 * 8) : (u32x4){0u, 0u, 0u, 0u}; } } while (0)
#define RG_RAW_STORE() do { _Pragma("unroll") for (int i = 0; i < 5; ++i) { const int q = tid + 512 * i; if (q < 131 * 16) *(LAS u32x4*)(rawt + (q >> 4) * 136 + (q & 15) * 8) = pre[i]; } } while (0)
    if (prompt) { RG_RAW_LOAD(t0); RG_RAW_STORE(); }
    __syncthreads();
    const int ntiles = t1;
    for (int tile = t0; tile < ntiles; ++tile) {
        const int row0 = prompt ? b * SEQ + tile * 128 : MPR;
        if (prompt && tile + 1 < ntiles) RG_RAW_LOAD(tile + 1);
        { const int t = tid >> 2, cq = tid & 3, c0 = cq * 32;
#pragma unroll 2
          for (int q = 0; q < 4; ++q) {
              const int cc = c0 + q * 8;
              float a[8];
#pragma unroll
              for (int e = 0; e < 8; ++e) a[e] = cw[512 + cc + e];
#pragma unroll
              for (int j = 0; j < 4; ++j) {
                  if (prompt || j == 3) {
                      {
                          const u32x4 u = prompt ? *(const LAS u32x4*)(rawt + (t + j) * 136 + cc) : *(const u32x4*)(XR + (size_t)(MPR + t) * D + cb0 + cc);
                          const float x8[8] = {bflo(u.x), bfhi(u.x), bflo(u.y), bfhi(u.y), bflo(u.z), bfhi(u.z), bflo(u.w), bfhi(u.w)};
#pragma unroll
                          for (int e = 0; e < 8; ++e) a[e] += x8[e] * cw[j * 128 + cc + e];
                      }
                  } else {
                      const float* p = INP(5) + ((size_t)t * 3 + j) * D + cb0 + cc;
                      const f32x4 u0 = *(const f32x4*)p, u1 = *(const f32x4*)(p + 4);
#pragma unroll
                      for (int e = 0; e < 4; ++e) { a[e] += u0[e] * cw[j * 128 + cc + e]; a[4 + e] += u1[e] * cw[j * 128 + cc + 4 + e]; }
                  }
              }
              u32x4 w; w.x = pk2(a[0], a[1]); w.y = pk2(a[2], a[3]); w.z = pk2(a[4], a[5]); w.w = pk2(a[6], a[7]);
              *(LAS u32x4*)(xcA + t * 136 + cc) = w;
              if (cq == qd) { *(LAS f32x4*)(xcf + t * 32 + q * 8) = (f32x4){a[0], a[1], a[2], a[3]}; *(LAS f32x4*)(xcf + t * 32 + q * 8 + 4) = (f32x4){a[4], a[5], a[6], a[7]}; }
          }
        }
        __syncthreads();
        { f32x16 c;
#pragma unroll
          for (int r = 0; r < 16; ++r) c[r] = 0.f;
          const LAS bf16* ap = xcA + (tb * 32 + (lane & 31)) * 136 + (lane >> 5) * 8;
#pragma unroll
          for (int ks = 0; ks < 8; ++ks) { const bf16x8 af = *(const LAS bf16x8*)(ap + ks * 16); c = __builtin_amdgcn_mfma_f32_32x32x16_bf16(af, Bf[ks], c, 0, 0, 0); }
          LAS float* dst = cbk ? ib : rb;
#pragma unroll
          for (int r = 0; r < 16; ++r) { const int tok = tb * 32 + (r & 3) + 8 * (r >> 2) + 4 * (lane >> 5); dst[tok * 32 + (lane & 31)] = sigmoid_f(c[r] + gbias); }
        }
        __syncthreads();
        float Aacc = 1.f, h = 0.f;
#pragma unroll 4
        for (int e = 0; e < 8; ++e) { const int t = seg * 8 + e;
            const float r = rb[t * 32 + ch], ig = ib[t * 32 + ch], x = xcf[t * 32 + ch];
            const float la = -8.f * r * sp; const float a = __expf(la);
            const float x2 = 2.f * la, ser = -x2 * (1.f + x2 * (0.5f + x2 * (0.16666667f + x2 * (0.041666668f + x2 * (0.0083333338f + x2 * 0.0013888889f)))));
            float mult = __builtin_amdgcn_sqrtf(x2 > -0.3f ? ser : 1.f - a * a);
            if (prompt && tile == 0 && t == 0) mult = 1.f;
            const float bt = mult * ig * x;
            rb[t * 32 + ch] = a; ib[t * 32 + ch] = bt;
            h = a * h + bt; Aacc *= a;
        }
        float hin = 0.f;
        if (prompt) {
            segA[seg * 32 + ch] = Aacc; segB[seg * 32 + ch] = h;
            __syncthreads();
            hin = hc[ch];
            float sa[15], sb[15];
#pragma unroll
            for (int s = 0; s < 15; ++s) { sa[s] = segA[s * 32 + ch]; sb[s] = segB[s * 32 + ch]; }
#pragma unroll
            for (int s = 0; s < 15; ++s) hin = s < seg ? sa[s] * hin + sb[s] : hin;
        }
        h = hin;
        { float gr[8], h0v[8];
#pragma unroll
          for (int e = 0; e < 8; ++e) { const int t = seg * 8 + e; gr[e] = bf2f(GR[(size_t)(row0 + t) * D + oc0 + ch]); h0v[e] = prompt ? 0.f : INP(4)[(size_t)t * D + oc0 + ch]; }
#pragma unroll
          for (int e = 0; e < 8; ++e) { const int t = seg * 8 + e;
              const float a = rb[t * 32 + ch], bt = ib[t * 32 + ch];
              if (prompt) h = a * h + bt; else h = a * h0v[e] + bt;
              GR[(size_t)(row0 + t) * D + oc0 + ch] = (bf16)f2bf(h * gr[e]);
              if (!prompt) { karg_out()[O_HS + (size_t)t * D + oc0 + ch] = h;
                  const float* cs = INP(5) + (size_t)t * 3 * D + oc0 + ch; float* co = karg_out() + O_CRS + (size_t)t * 3 * D + oc0 + ch;
                  co[0] = cs[D]; co[D] = cs[2 * D]; co[2 * D] = bf2f(XR[(size_t)(MPR + t) * D + oc0 + ch]); }
          } }
        hlast = h;
        if (prompt && tile + 1 < ntiles) RG_RAW_STORE();
        __syncthreads();
        if (prompt && seg == 15) hc[ch] = hlast;
    }
    if (prompt && seg == 15) { if (t1 == 16) karg_out()[O_HP + (size_t)b * D + oc0 + ch] = hlast; else ((float*)(karg_ws() + WS_HCARRY))[(size_t)b * D + oc0 + ch] = hlast; }
    __syncthreads();
}

constexpr size_t WS_TINV = WS_WIN, WS_ATT = WS_WIN + 8 * MiB, WS_GC = WS_CB, WS_BETA = 47 * MiB + 65536;
static_assert(WS_ABL + (size_t)M * 16 * 4 <= WS_BETA && WS_BETA + 64 * 2048 * 4 <= WS_H, "ws map (beta)");
__device__ __forceinline__ int perm16(int e) { return (e & ~12) | ((e >> 1) & 4) | ((e << 1) & 8); }

__device__ __forceinline__ void conv8(const bf16* p, int tl, const LAS float* w, float* a) {
#pragma unroll
    for (int e = 0; e < 8; ++e) a[e] = 0.f;
#pragma unroll
    for (int j = 0; j < 4; ++j) {
        const bool ok = tl - 3 + j >= 0;
        const u32x4 u = *(const u32x4*)(ok ? p - (ptrdiff_t)(3 - j) * D : p);
        f32x4 w0 = *(const LAS f32x4*)(w + j * 128), w1 = *(const LAS f32x4*)(w + j * 128 + 4);
        if (!ok) { w0 = (f32x4){0.f, 0.f, 0.f, 0.f}; w1 = w0; }
        a[0] += bflo(u.x) * w0[0]; a[1] += bfhi(u.x) * w0[1]; a[2] += bflo(u.y) * w0[2]; a[3] += bfhi(u.y) * w0[3];
        a[4] += bflo(u.z) * w1[0]; a[5] += bfhi(u.z) * w1[1]; a[6] += bflo(u.w) * w1[2]; a[7] += bfhi(u.w) * w1[3];
    }
#pragma unroll
    for (int e = 0; e < 8; ++e) a[e] = silu_f(a[e]);
}

__device__ __forceinline__ void conv8h(const bf16* p, const bf16* halo, int nloc, const LAS float* w, float* a) {
#pragma unroll
    for (int e = 0; e < 8; ++e) a[e] = 0.f;
#pragma unroll
    for (int j = 0; j < 4; ++j) {
        const int r = nloc - 3 + j;
        const u32x4 u = *(const u32x4*)(r >= 0 ? p - (ptrdiff_t)(3 - j) * D : halo + (r + 3) * D);
        const f32x4 w0 = *(const LAS f32x4*)(w + j * 128), w1 = *(const LAS f32x4*)(w + j * 128 + 4);
        a[0] += bflo(u.x) * w0[0]; a[1] += bfhi(u.x) * w0[1]; a[2] += bflo(u.y) * w0[2]; a[3] += bfhi(u.y) * w0[3];
        a[4] += bflo(u.z) * w1[0]; a[5] += bfhi(u.z) * w1[1]; a[6] += bflo(u.w) * w1[2]; a[7] += bfhi(u.w) * w1[3];
    }
#pragma unroll
    for (int e = 0; e < 8; ++e) a[e] = silu_f(a[e]);
}
__device__ __forceinline__ void delta_prep_wave(const Params& P, LAS unsigned char* lds, int idx, int wave, int lane) {
    const int bh = idx >> 5, b = bh >> 3, h = bh & 7, span = idx & 31, n = lane & 31, hh = lane >> 5;
    const LAS float* wq = (const LAS float*)lds; const LAS float* wk = wq + 512; const LAS float* wv = wq + 1024;
    LAS float* Lm = (LAS float*)(lds + 6144 + wave * 10240);
    LAS float* gcs = Lm + 2 * 1152; LAS float* bts = gcs + 64;
    const bf16* Qb = (const bf16*)(karg_ws() + WS_Z + 2 * ZB); bf16* Kb = (bf16*)(karg_ws() + WS_Z + 3 * ZB); bf16* Vb = (bf16*)(karg_ws() + WS_Z + 4 * ZB);
    bf16* QT = (bf16*)(karg_ws() + WS_H);
    const bf16* HK = (const bf16*)((const unsigned char*)karg_out() + OSB_HK) + (size_t)(b * 32 + span) * 3 * D + h * 128;
    const bf16* HV = (const bf16*)((const unsigned char*)karg_out() + OSB_HV) + (size_t)(b * 32 + span) * 3 * D + h * 128;
    const float* ABL = (const float*)(karg_ws() + WS_ABL);
    bf16* TINV = (bf16*)(karg_ws() + WS_TINV); bf16* ATT = (bf16*)(karg_ws() + WS_ATT);
    { const size_t row = (size_t)b * SEQ + span * 64 + lane;
      float g = -__expf(INP(23)[h]) * softplus_f(ABL[row * 16 + h] + INP(24)[h]); const float be = sigmoid_f(ABL[row * 16 + 8 + h]);
#pragma unroll
      for (int off = 1; off < 32; off <<= 1) { const float t = __shfl_up(g, off); if (n >= off) g += t; }
      gcs[lane] = g; bts[lane] = be;
      ((float*)(karg_ws() + WS_GC))[(size_t)bh * SEQ + span * 64 + lane] = g; ((float*)(karg_ws() + WS_BETA))[(size_t)bh * SEQ + span * 64 + lane] = be; }
    LAS float* nks = bts + 64; LAS float* nqs = nks + 64;
#pragma unroll 1
    for (int it = 7; it >= 0; --it) {
        const int nloc = it * 8 + (lane >> 3), tl = span * 64 + nloc, d0 = (lane & 7) * 16; const size_t ro = ((size_t)b * SEQ + tl) * D + h * 128 + d0;
        float kv[16], qv[16], vv[16];
        conv8h(Kb + ro, HK + d0, nloc, wk + d0, kv); conv8h(Kb + ro + 8, HK + d0 + 8, nloc, wk + d0 + 8, kv + 8);
        conv8(Qb + ro, tl, wq + d0, qv); conv8(Qb + ro + 8, tl, wq + d0 + 8, qv + 8);
        conv8h(Vb + ro, HV + d0, nloc, wv + d0, vv); conv8h(Vb + ro + 8, HV + d0 + 8, nloc, wv + d0 + 8, vv + 8);
        float ssk = 0.f, ssq = 0.f;
#pragma unroll
        for (int e = 0; e < 16; ++e) { ssk += kv[e] * kv[e]; ssq += qv[e] * qv[e]; }
        ssk = red8(ssk); ssq = red8(ssq);
        if ((lane & 7) == 0) { const float nkj = rsq_f(ssk + EPS), nqj = 0.08838834764831845f * rsq_f(ssq + EPS); nks[nloc] = nkj; nqs[nloc] = nqj;
            ((float*)((unsigned char*)karg_out() + OSB_NK))[(size_t)bh * SEQ + tl] = nkj; ((float*)((unsigned char*)karg_out() + OSB_NQ))[(size_t)bh * SEQ + tl] = nqj; }
        *(bf16x8*)(Kb + ro) = pack8(kv[0], kv[1], kv[2], kv[3], kv[4], kv[5], kv[6], kv[7]); *(bf16x8*)(Kb + ro + 8) = pack8(kv[8], kv[9], kv[10], kv[11], kv[12], kv[13], kv[14], kv[15]);
        *(bf16x8*)(QT + ro) = pack8(qv[0], qv[1], qv[2], qv[3], qv[4], qv[5], qv[6], qv[7]); *(bf16x8*)(QT + ro + 8) = pack8(qv[8], qv[9], qv[10], qv[11], qv[12], qv[13], qv[14], qv[15]);
        *(bf16x8*)(Vb + ro) = pack8(vv[0], vv[1], vv[2], vv[3], vv[4], vv[5], vv[6], vv[7]); *(bf16x8*)(Vb + ro + 8) = pack8(vv[8], vv[9], vv[10], vv[11], vv[12], vv[13], vv[14], vv[15]);
    }
    asm volatile("s_waitcnt vmcnt(0)" ::: "memory"); __builtin_amdgcn_fence(__ATOMIC_ACQUIRE, "agent");
#pragma unroll 1
    for (int tile = 0; tile < 2; ++tile) {
        const int tl = span * 64 + tile * 32 + n; const size_t ro = ((size_t)b * SEQ + tl) * D + h * 128 + 8 * hh;
        f32x16 ckk, cqk;
#pragma unroll
        for (int r = 0; r < 16; ++r) { ckk[r] = 0.f; cqk[r] = 0.f; }
#pragma unroll
        for (int s8 = 0; s8 < 8; ++s8) {
            const bf16x8 kf = *(const bf16x8*)(Kb + ro + 16 * s8), qf = *(const bf16x8*)(QT + ro + 16 * s8);
            ckk = __builtin_amdgcn_mfma_f32_32x32x16_bf16(kf, kf, ckk, 0, 0, 0); cqk = __builtin_amdgcn_mfma_f32_32x32x16_bf16(qf, kf, cqk, 0, 0, 0);
        }
        const float nkj = nks[tile * 32 + n];
        const float gcj = gcs[tile * 32 + n];
        bf16* att = ATT + ((size_t)bh * 64 + span * 2 + tile) * 1024 + perm16(n);
#pragma unroll
        for (int r = 0; r < 16; ++r) { const int i = (r & 3) + 8 * (r >> 2) + 4 * hh;
            const float dm = i >= n ? __expf(gcs[tile * 32 + i] - gcj) * nkj : 0.f;
            Lm[tile * 1152 + i * 36 + n] = i > n ? bts[tile * 32 + i] * nks[tile * 32 + i] * ckk[r] * dm : 0.f;
            att[i * 32] = (bf16)f2bf(nqs[tile * 32 + i] * cqk[r] * dm); }
    }
    LDS_WAIT(); asm volatile("" ::: "memory");
    { int loff = hh * 1152;
      float x[32];
#pragma unroll
      for (int i = 0; i < 32; ++i) { float sacc = (i == n) ? 1.f : 0.f;
          const LAS float* Lb = Lm + loff;
#pragma unroll
          for (int j4 = 0; j4 < (i + 3) / 4; ++j4) { const f32x4 l = *(const LAS f32x4*)(Lb + i * 36 + 4 * j4);
#pragma unroll
              for (int jj = 0; jj < 4; ++jj) if (4 * j4 + jj < i) sacc -= l[jj] * x[4 * j4 + jj]; }
          x[i] = sacc;
          if ((i & 1) == 1) asm volatile("" : "+v"(loff) : "v"(sacc)); }
      bf16* ti = TINV + ((size_t)bh * 64 + span * 2 + hh) * 1024 + perm16(n);
#pragma unroll
      for (int i = 0; i < 32; ++i) ti[i * 32] = (bf16)f2bf(x[i]); }
    LDS_WAIT(); asm volatile("" ::: "memory");
}

constexpr int DR_KB = 0, DR_QD = 8704, DR_KDT = 17408, DR_TI = 27648, DR_AT = 30208, DR_VB = 32768, DR_EGL = 49664, DR_BUF = 49680;
struct DeltaPre { u32x4 k0, k1, q0, q1, v0, v1, tia; float gct, gl, bet, nk, nq; };
__device__ __forceinline__ void delta_pre_load(int b, int h, int c, int pt, DeltaPre& dp) {
    const int bh = b * 8 + h, tt = pt >> 3, d0 = (pt & 7) * 16; const size_t t = (size_t)bh * SEQ + c * 32 + tt;
    const size_t ro = ((size_t)b * SEQ + c * 32 + tt) * D + h * 128 + d0;
    const bf16* Kt = (const bf16*)(karg_ws() + WS_Z + 3 * ZB) + ro; const bf16* Qt = (const bf16*)(karg_ws() + WS_H) + ro; const bf16* Vt = (const bf16*)(karg_ws() + WS_Z + 4 * ZB) + ro;
    dp.k0 = *(const u32x4*)Kt; dp.k1 = *(const u32x4*)(Kt + 8); dp.q0 = *(const u32x4*)Qt; dp.q1 = *(const u32x4*)(Qt + 8); dp.v0 = *(const u32x4*)Vt; dp.v1 = *(const u32x4*)(Vt + 8);
    const float* GC = (const float*)(karg_ws() + WS_GC);
    dp.gct = GC[t]; dp.gl = GC[(size_t)bh * SEQ + c * 32 + 31]; dp.bet = ((const float*)(karg_ws() + WS_BETA))[t];
    dp.nk = ((const float*)((const unsigned char*)karg_out() + OSB_NK))[t]; dp.nq = ((const float*)((const unsigned char*)karg_out() + OSB_NQ))[t];
    dp.tia = *(const u32x4*)((const bf16*)(karg_ws() + (pt < 128 ? WS_TINV : WS_ATT)) + ((size_t)bh * 64 + c) * 1024 + (pt & 127) * 8);
}
__device__ __forceinline__ void delta_rec_stage(LAS unsigned char* buf, int pt, const DeltaPre& dp) {
    const int tt = pt >> 3, dg = pt & 7, d0 = dg * 16;
    { LAS bf16* dst = (LAS bf16*)(buf + (pt < 128 ? DR_TI : DR_AT)) + ((pt & 127) >> 2) * 40 + (pt & 3) * 8; *(LAS u32x4*)dst = dp.tia; }
    if (pt == 0) *(LAS float*)(buf + DR_EGL) = __expf(dp.gl);
    const float eg = __expf(dp.gct), ekd = __expf(dp.gl - dp.gct);
    const float fq = dp.nq * eg, fkb = dp.nk * dp.bet * eg, fkd = dp.nk * ekd, bet = dp.bet;
    float k[16], q[16], v[16];
    unpack8(dp.k0, k); unpack8(dp.k1, k + 8); unpack8(dp.q0, q); unpack8(dp.q1, q + 8); unpack8(dp.v0, v); unpack8(dp.v1, v + 8);
    LAS bf16* KB = (LAS bf16*)(buf + DR_KB) + tt * 136 + d0; LAS bf16* QD = (LAS bf16*)(buf + DR_QD) + tt * 136 + d0;
    *(LAS bf16x8*)KB = pack8(k[0] * fkb, k[1] * fkb, k[2] * fkb, k[3] * fkb, k[8] * fkb, k[9] * fkb, k[10] * fkb, k[11] * fkb);
    *(LAS bf16x8*)(KB + 8) = pack8(k[4] * fkb, k[5] * fkb, k[6] * fkb, k[7] * fkb, k[12] * fkb, k[13] * fkb, k[14] * fkb, k[15] * fkb);
    *(LAS bf16x8*)QD = pack8(q[0] * fq, q[1] * fq, q[2] * fq, q[3] * fq, q[8] * fq, q[9] * fq, q[10] * fq, q[11] * fq);
    *(LAS bf16x8*)(QD + 8) = pack8(q[4] * fq, q[5] * fq, q[6] * fq, q[7] * fq, q[12] * fq, q[13] * fq, q[14] * fq, q[15] * fq);
    LAS bf16* KDT = (LAS bf16*)(buf + DR_KDT) + d0 * 40 + perm16(tt);
#pragma unroll
    for (int e = 0; e < 16; ++e) KDT[e * 40] = (bf16)f2bf(k[e] * fkd);
    LAS float* VB = (LAS float*)(buf + DR_VB) + tt * 132 + d0;
#pragma unroll
    for (int e4 = 0; e4 < 4; ++e4) *(LAS f32x4*)(VB + 4 * e4) = (f32x4){v[4 * e4] * bet, v[4 * e4 + 1] * bet, v[4 * e4 + 2] * bet, v[4 * e4 + 3] * bet};
}

constexpr int DR_OB = 2 * DR_BUF;
static_assert(DR_OB + 2 * 32 * 132 * 4 <= LDS_BYTES - 64, "delta recurrence LDS map");
__device__ __forceinline__ void delta_out_norm(const LAS float* ob, int pt, const float* dn16, const u32x4 z0, const u32x4 z1, bf16* dst) {
    const LAS float* p = ob + (pt >> 3) * 132 + (pt & 7) * 16;
    float o[16], z[16];
#pragma unroll
    for (int e4 = 0; e4 < 4; ++e4) { const f32x4 t = *(const LAS f32x4*)(p + 4 * e4); o[4 * e4] = t[0]; o[4 * e4 + 1] = t[1]; o[4 * e4 + 2] = t[2]; o[4 * e4 + 3] = t[3]; }
    float ss = 0.f;
#pragma unroll
    for (int e = 0; e < 16; ++e) ss += o[e] * o[e];
    ss = red8(ss);
    const float rstd = rsq_f(ss * (1.f / 128.f) + EPS);
    unpack8(z0, z); unpack8(z1, z + 8);
#pragma unroll
    for (int e = 0; e < 16; ++e) o[e] = o[e] * rstd * dn16[e] * z[e];
    *(bf16x8*)dst = pack8(o[0], o[1], o[2], o[3], o[4], o[5], o[6], o[7]); *(bf16x8*)(dst + 8) = pack8(o[8], o[9], o[10], o[11], o[12], o[13], o[14], o[15]);
}
__device__ __forceinline__ void delta_rec_task(const Params& P, LAS unsigned char* lds, int b, int h, int tid) {
    const int lane = tid & 63, wave = tid >> 6, n = lane & 31, hh = lane >> 5, bh = b * 8 + h, pt = tid - 256;
    const bool producer = wave >= 4;
    constexpr int NC = SEQ / 32;
    f32x16 S[4];
#pragma unroll
    for (int kb = 0; kb < 4; ++kb)
#pragma unroll
        for (int r = 0; r < 16; ++r) S[kb][r] = 0.f;
    DeltaPre dcur, dnxt;
    if (producer) { delta_pre_load(b, h, 0, pt, dcur); delta_pre_load(b, h, 1, pt, dnxt); delta_rec_stage(lds, pt, dcur); dcur = dnxt; }
    __syncthreads();
    if (producer) {
        const int pt = opq(tid) - 256;
        float dn16[16];
#pragma unroll
        for (int e = 0; e < 16; ++e) dn16[e] = INP(25)[(pt & 7) * 16 + e];
        bf16* zgp = (bf16*)(karg_ws() + WS_Z + 5 * ZB) + ((size_t)b * SEQ + (pt >> 3)) * D + h * 128 + (pt & 7) * 16;
        u32x4 zc0 = {0u, 0u, 0u, 0u}, zc1 = zc0, zn0, zn1;
        for (int c = 0; c < NC; ++c) {
            if (c + 2 < NC) delta_pre_load(b, h, c + 2, pt, dnxt);
            zn0 = *(const u32x4*)(zgp + (size_t)c * 32 * D); zn1 = *(const u32x4*)(zgp + (size_t)c * 32 * D + 8);
            if (c + 1 < NC) delta_rec_stage(lds + ((c + 1) & 1) * DR_BUF, pt, dcur);
            if (c > 0) delta_out_norm((const LAS float*)(lds + DR_OB) + ((c - 1) & 1) * 32 * 132, pt, dn16, zc0, zc1, zgp + (size_t)(c - 1) * 32 * D);
            dcur = dnxt; zc0 = zn0; zc1 = zn1;
            __syncthreads();
        }
        delta_out_norm((const LAS float*)(lds + DR_OB) + ((NC - 1) & 1) * 32 * 132, pt, dn16, zc0, zc1, zgp + (size_t)(NC - 1) * 32 * D);
    } else {
        const int lane = opq(tid) & 63, n = lane & 31, hh = lane >> 5;
        for (int c = 0; c < NC; ++c) {
            LAS unsigned char* buf = lds + (c & 1) * DR_BUF;
            const int vb = wave;
            bf16x8 SB[8];
#pragma unroll
            for (int s = 0; s < 8; ++s) { const int kb = s >> 1, o = 8 * (s & 1); SB[s] = pack8(S[kb][o], S[kb][o + 1], S[kb][o + 2], S[kb][o + 3], S[kb][o + 4], S[kb][o + 5], S[kb][o + 6], S[kb][o + 7]); }
            f32x16 X1, P1;
#pragma unroll
            for (int r = 0; r < 16; ++r) { X1[r] = 0.f; P1[r] = 0.f; }
            const LAS bf16* KB = (const LAS bf16*)(buf + DR_KB) + n * 136 + 8 * hh; const LAS bf16* QD = (const LAS bf16*)(buf + DR_QD) + n * 136 + 8 * hh;
#pragma unroll
            for (int s = 0; s < 8; ++s) { X1 = __builtin_amdgcn_mfma_f32_32x32x16_bf16(*(const LAS bf16x8*)(KB + 16 * s), SB[s], X1, 0, 0, 0);
                P1 = __builtin_amdgcn_mfma_f32_32x32x16_bf16(*(const LAS bf16x8*)(QD + 16 * s), SB[s], P1, 0, 0, 0); }
            const LAS float* VB = (const LAS float*)(buf + DR_VB) + 32 * vb + n;
            float Y[16];
#pragma unroll
            for (int r = 0; r < 16; ++r) Y[r] = VB[((r & 3) + 8 * (r >> 2) + 4 * hh) * 132] - X1[r];
            const bf16x8 YB0 = pack8(Y[0], Y[1], Y[2], Y[3], Y[4], Y[5], Y[6], Y[7]), YB1 = pack8(Y[8], Y[9], Y[10], Y[11], Y[12], Y[13], Y[14], Y[15]);
            f32x16 VN;
#pragma unroll
            for (int r = 0; r < 16; ++r) VN[r] = 0.f;
            const LAS bf16* TI = (const LAS bf16*)(buf + DR_TI) + n * 40 + 8 * hh; const LAS bf16* AT = (const LAS bf16*)(buf + DR_AT) + n * 40 + 8 * hh;
            VN = __builtin_amdgcn_mfma_f32_32x32x16_bf16(*(const LAS bf16x8*)TI, YB0, VN, 0, 0, 0);
            VN = __builtin_amdgcn_mfma_f32_32x32x16_bf16(*(const LAS bf16x8*)(TI + 16), YB1, VN, 0, 0, 0);
            const bf16x8 VB0 = pack8(VN[0], VN[1], VN[2], VN[3], VN[4], VN[5], VN[6], VN[7]), VB1 = pack8(VN[8], VN[9], VN[10], VN[11], VN[12], VN[13], VN[14], VN[15]);
            P1 = __builtin_amdgcn_mfma_f32_32x32x16_bf16(*(const LAS bf16x8*)AT, VB0, P1, 0, 0, 0);
            P1 = __builtin_amdgcn_mfma_f32_32x32x16_bf16(*(const LAS bf16x8*)(AT + 16), VB1, P1, 0, 0, 0);
            const float egl = *(const LAS float*)(buf + DR_EGL);
            const LAS bf16* KDT = (const LAS bf16*)(buf + DR_KDT) + n * 40 + 8 * hh;
#pragma unroll
            for (int kb = 0; kb < 4; ++kb) {
#pragma unroll
                for (int r = 0; r < 16; ++r) S[kb][r] *= egl;
                S[kb] = __builtin_amdgcn_mfma_f32_32x32x16_bf16(*(const LAS bf16x8*)(KDT + kb * 32 * 40), VB0, S[kb], 0, 0, 0);
                S[kb] = __builtin_amdgcn_mfma_f32_32x32x16_bf16(*(const LAS bf16x8*)(KDT + kb * 32 * 40 + 16), VB1, S[kb], 0, 0, 0); }
            LAS float* op = (LAS float*)(lds + DR_OB) + (c & 1) * 32 * 132 + 4 * hh * 132 + 32 * vb + n;
#pragma unroll
            for (int r = 0; r < 16; ++r) op[((r & 3) + 8 * (r >> 2)) * 132] = P1[r];
            __syncthreads();
        }
    }
    if (!producer) { float* So = karg_out() + O_SP + ((size_t)bh * 128 + 4 * hh) * 128 + 32 * wave + n;
#pragma unroll
        for (int kb = 0; kb < 4; ++kb)
#pragma unroll
            for (int r = 0; r < 16; ++r) So[(size_t)(32 * kb + (r & 3) + 8 * (r >> 2)) * 128] = S[kb][r]; }
    __syncthreads();
}

template <int MODE>
__device__ __forceinline__ void delta_sample_item(const Params& P, LAS unsigned char* lds, int item, int tid) {
    LAS float* tmp = (LAS float*)lds;
    LAS float* scl = (LAS float*)(lds + 1536);
    LAS float* rpk = (LAS float*)(lds + 2048);
    LAS float* rpq = (LAS float*)(lds + 4096);
    const int bs = item >> 3, h = item & 7, lane = tid & 63, wave = tid >> 6; const size_t row = (size_t)MPR + bs;
    const bf16* Zq = (const bf16*)(karg_ws() + WS_Z + 2 * ZB);
    if (tid < 384) { const int which = tid >> 7, d = tid & 127; const int c3 = which * 1024 + h * 128 + d;
        const float raw = bf2f(Zq[(size_t)which * (ZB / 2) + row * D + h * 128 + d]);
        const float* cs = INP(7) + (size_t)bs * 3 * 3072 + c3; const float* w = INP(22) + c3;
        tmp[tid] = silu_f(cs[0] * w[0] + cs[3072] * w[3072] + cs[2 * 3072] * w[2 * 3072] + raw * w[3 * 3072]); }
    __syncthreads();
    if (wave < 3) { float s;
        if (wave == 0) s = tmp[lane] * tmp[lane] + tmp[lane + 64] * tmp[lane + 64];
        else if (wave == 1) s = tmp[128 + lane] * tmp[128 + lane] + tmp[192 + lane] * tmp[192 + lane];
        else s = tmp[lane] * tmp[128 + lane] + tmp[64 + lane] * tmp[192 + lane];
        s = wave_sum(s);
        if (lane == 0) scl[wave] = wave == 0 ? rsq_f(s + EPS) * 0.08838834764831845f : (wave == 1 ? rsq_f(s + EPS) : s); }
    __syncthreads();
    const float sq = scl[0], sk = scl[1], kq = scl[2] * sq * sk;
    const int v = tid & 127, kg = tid >> 7;
    const float* S0 = INP(6) + ((size_t)(bs * NH + h) * 128 + kg * 32) * 128 + v;
    float S[32];
#pragma unroll
    for (int j = 0; j < 32; ++j) S[j] = S0[(size_t)j * 128];
    float pk = 0.f, pq = 0.f;
#pragma unroll
    for (int j = 0; j < 32; ++j) { pk += S[j] * tmp[128 + kg * 32 + j]; pq += S[j] * tmp[kg * 32 + j]; }
    rpk[kg * 128 + v] = pk * sk; rpq[kg * 128 + v] = pq * sq;
    __syncthreads();
    pk = (rpk[v] + rpk[128 + v]) + (rpk[256 + v] + rpk[384 + v]); pq = (rpq[v] + rpq[128 + v]) + (rpq[256 + v] + rpq[384 + v]);
    const float* ABL = (const float*)(karg_ws() + WS_ABL);
    const float al = ABL[row * 16 + h], bl = ABL[row * 16 + 8 + h];
    const float dc = __expf(-__expf(INP(23)[h]) * softplus_f(al + INP(24)[h])), be = sigmoid_f(bl);
    const float delta = be * (tmp[256 + v] - dc * pk);
    if (MODE == 0) {
        const float o = dc * pq + kq * delta; const float so = wave_sum(o * o);
        if (lane == 0 && wave < 2) scl[4 + wave] = so;
        __syncthreads();
        if (kg == 0) { bf16* zp = (bf16*)(karg_ws() + WS_Z + 5 * ZB) + row * D + h * 128 + v;
            *zp = (bf16)f2bf(o * rsq_f((scl[4] + scl[5]) * (1.f / 128.f) + EPS) * INP(25)[v] * bf2f(*zp)); } }
    else { float* So = karg_out() + O_SS + ((size_t)(bs * NH + h) * 128 + kg * 32) * 128 + v;
#pragma unroll
        for (int j = 0; j < 32; ++j) So[(size_t)j * 128] = dc * S[j] + (tmp[128 + kg * 32 + j] * sk) * delta; }
    __syncthreads();
}

#define XB_TMO      128
#define XB_XCNT(j)  (256  + 64 * (j))
#define XB_XSUB(j)  (1280 + 64 * (j))
#define XB_XGEN(j)  (2304 + 64 * (j))
#define XB_TOP      3328
#define XB_TOPGEN   3392
#define XCD_BAR_WORDS 3456
#define XB_SPIN_CAP (1u << 22)
__device__ __forceinline__ unsigned xb_ld(unsigned* p)              { return __hip_atomic_load(p, __ATOMIC_RELAXED, __HIP_MEMORY_SCOPE_AGENT); }
__device__ __forceinline__ unsigned xb_add(unsigned* p, unsigned v) { return __hip_atomic_fetch_add(p, v, __ATOMIC_RELAXED, __HIP_MEMORY_SCOPE_AGENT); }
__device__ __forceinline__ unsigned xb_xcc_id() { return (unsigned)__builtin_amdgcn_s_getreg((3 << 11) | 20) & 0xFu; }
#define XB_SPIN(cond, bar) do { unsigned _sp = 0; while (cond) { __builtin_amdgcn_s_sleep(1); \
    if ((++_sp & 255u) == 0u) { if (xb_ld(&(bar)[XB_TMO])) break; if (_sp > XB_SPIN_CAP) { atomicAdd(&(bar)[XB_TMO], 1u); break; } } } } while (0)
struct XcdBarrier { unsigned* bar; unsigned x; volatile LAS unsigned* st; };
__device__ __forceinline__ XcdBarrier xcd_barrier_post(unsigned* bar, volatile LAS unsigned* st, bool leader) {
    XcdBarrier b; b.bar = bar; b.x = xb_xcc_id(); b.st = st;
    if (leader) (void)xb_add(&bar[XB_XCNT(b.x)], 1u);
    return b;
}
__device__ __forceinline__ void xcd_barrier_complete(unsigned* bar, unsigned x, unsigned& nloc, unsigned& nx) {
    const unsigned G = gridDim.x * gridDim.y * gridDim.z;
    unsigned sum, cnt, mine, sp = 0u;
    for (;;) {
        sum = 0u; cnt = 0u; mine = 0u;
#pragma unroll
        for (unsigned j = 0; j < 16; ++j) { const unsigned c = xb_ld(&bar[XB_XCNT(j)]); sum += c; cnt += (c > 0u) ? 1u : 0u; mine = (j == x) ? c : mine; }
        if (sum == G) break;
        __builtin_amdgcn_s_sleep(1);
        if ((++sp & 255u) == 0u) { if (xb_ld(&bar[XB_TMO])) break; if (sp > XB_SPIN_CAP) { atomicAdd(&bar[XB_TMO], 1u); break; } }
    }
    nloc = mine > 0u ? mine : 1u; nx = cnt > 0u ? cnt : 1u;
}
__device__ __forceinline__ void xcd_barrier(const XcdBarrier& b, bool leader) {
    asm volatile("s_waitcnt vmcnt(0)" ::: "memory");
    __syncthreads();
    if (leader) {
        unsigned* bar = b.bar;
        __builtin_amdgcn_s_waitcnt(0);
        unsigned nloc = b.st[0], nx = b.st[1];
        if (nloc == 0u) { xcd_barrier_complete(bar, b.x, nloc, nx); b.st[0] = nloc; b.st[1] = nx; }
        const unsigned old = xb_add(&bar[XB_XSUB(b.x)], 1u);
        const unsigned gen = old / nloc;
        if (old + 1u == (gen + 1u) * nloc) {
            __builtin_amdgcn_fence(__ATOMIC_RELEASE, "agent");
            asm volatile("s_waitcnt vmcnt(0)" ::: "memory");
            const unsigned og = xb_add(&bar[XB_TOP], 1u);
            const unsigned tg = og / nx;
            if (og + 1u == (tg + 1u) * nx) xb_add(&bar[XB_TOPGEN], 1u);
            else XB_SPIN(xb_ld(&bar[XB_TOPGEN]) == tg, bar);
            __builtin_amdgcn_fence(__ATOMIC_ACQUIRE, "agent");
            xb_add(&bar[XB_XGEN(b.x)], 1u);
            asm volatile("s_waitcnt vmcnt(0)" ::: "memory");
        } else {
            XB_SPIN(xb_ld(&bar[XB_XGEN(b.x)]) == gen, bar);
            __builtin_amdgcn_fence(__ATOMIC_ACQUIRE, "agent");
            asm volatile("s_waitcnt vmcnt(0)" ::: "memory");
        }
    }
    __syncthreads();
}

__global__ void __launch_bounds__(NTHR, 2) fwd_megakernel(Params P) {
    extern __shared__ __attribute__((aligned(16))) unsigned char lds_raw[];
    LAS unsigned char* lds = (LAS unsigned char*)lds_raw;
    cg::grid_group grid = cg::this_grid();
    const int wave = __builtin_amdgcn_readfirstlane((int)threadIdx.x >> 6);
#define lane opq(lane_now())
#define tid opq((wave << 6) | lane_now())
    const int G = gridDim.x, wg = blockIdx.x;
    const int gw = wg * NWAVES + wave, NGW = G * NWAVES;
    unsigned char* ws = karg_ws();
    float* ADA = (float*)(ws + WS_ADA);
    bf16* H = (bf16*)(ws + WS_H);
    bf16* Z = (bf16*)(ws + WS_Z);
    bf16* ACT = (bf16*)(ws + WS_ACT);
    bf16* MG = (bf16*)(karg_out() + O_SS);
    volatile LAS unsigned* MISC = (volatile LAS unsigned*)(lds + LDS_BYTES - 64);
    if (tid < 16) MISC[tid] = 0u;
    __syncthreads();
    const XcdBarrier xbar = xcd_barrier_post((unsigned*)ws, MISC, wave == 0 && lane_now() == 0);
#define GBAR() xcd_barrier(xbar, wave == 0 && lane_now() == 0)

    if constexpr ((PHM >> 0) & 1) {
    prologue<0>(P, lds, gw, NGW, wave, lane);
    }
    GBAR();
    if constexpr ((PHM >> 1) & 1) {
    { pg8::Gemm g{(const bf16*)(ws + WS_CB), (const bf16*)(ws + WS_WADA), nullptr, nullptr, D}; pg8::StaticOrder S; S.init(256, NADA, G, wg);
      EpiAda E{ADA, INP(9)}; pg8::gemm_phase(lds, g, S, E, wave);
      if (wg >= 36) prologue<1>(P, lds, (wg - 36) * NWAVES + wave, (G - 36) * NWAVES, wave, lane); }
    }
    GBAR();
    if constexpr ((PHM >> 2) & 1) {
    norm_mod_pass<0>(P, INP(10), 0, gw, NGW, lane);
    { const int gt = wg * NTHR + tid;
      if (gt < 2 * NB * 3 * (D / 8)) { const int m = gt / (NB * 3 * (D / 8)), r = gt % (NB * 3 * (D / 8)), c8 = r & 127, j = (r >> 7) % 3, bb = (r >> 7) / 3;
          *(u32x4*)((bf16*)((unsigned char*)karg_out() + (m ? OSB_HV : OSB_HK)) + ((size_t)(bb * 32) * 3 + j) * D + c8 * 8) = (u32x4){0u, 0u, 0u, 0u}; } }
    }
    GBAR();
    if constexpr ((PHM >> 3) & 1) {
    { pg8::Gemm g{H, (const bf16*)(ws + WS_WUP1), nullptr, nullptr, D}; pg8::StaticOrder S; S.init(MPAD, 2 * FF, G, wg);
      EpiSwiglu E{ACT}; pg8::gemm_phase(lds, g, S, E, wave); }
    }
    GBAR();
    if constexpr ((PHM >> 4) & 1) {
    { pg8::Gemm g{ACT, (const bf16*)(ws + WS_WDN1), nullptr, nullptr, FF}; pg8::StaticOrder S; S.init(MPR, D, G, wg);
      EpiResidNorm<0> E{karg_out(), INP(0), ADA + 2 * D, 0.5f, INP(13), ADA + 3 * D, H, (float*)(ws + WS_PART), (unsigned*)(ws + WS_CNT), (LAS float*)(lds + 131072)}; pg8::gemm_phase(lds, g, S, E, wave);
      float* X = karg_out(); const float* xs = INP(1); const float* gate = ADA + 2 * D;
      mini_gemm(lds, ACT, (const bf16*)(ws + WS_WDN1), nullptr, nullptr, FF, wg, G, tid, [=](int row, int col, f32x4 v, f32x4) {
          const f32x4 xv = *(const f32x4*)(xs + (size_t)(row - MPR) * D + col), gv = *(const f32x4*)(gate + (size_t)cond_of_row(row) * NADA + col);
          *(f32x4*)(X + (size_t)row * D + col) = xv + (gv * 0.5f) * v; }); }
    }
    GBAR();
    if constexpr ((PHM >> 5) & 1) {
    sample_norm_rows<0>(INP(13), 3, gw, lane);
    }
    GBAR();
    if constexpr ((PHM >> 6) & 1) {
    { pg8::Gemm g{H, (const bf16*)(ws + WS_WIN), nullptr, nullptr, D}; pg8::StaticOrder S; S.init(MPAD, NIN, G, wg);
      EpiIn E{Z, MG, (float*)(ws + WS_ABL), karg_out()}; pg8::gemm_phase(lds, g, S, E, wave); }
    }
    GBAR();
    if constexpr ((PHM >> 7) & 1) {
        { const int bh0 = (wg * NWAVES) >> 5, h0 = bh0 & 7; LAS float* w = (LAS float*)lds; const float* cwq = INP(22);
          for (int i = tid; i < 1536; i += NTHR) { const int which = i >> 9, j = (i >> 7) & 3, d = i & 127; w[i] = cwq[(size_t)j * 3072 + which * 1024 + h0 * 128 + d]; }
          __syncthreads();
          delta_prep_wave(P, lds, gw, wave, lane);
          __syncthreads(); }
        for (int task = wg; task < 256; task += G) rglru_task(P, lds, task >> 5, (task >> 2) & 7, task & 3, tid, 0, RG_SPLIT);
    }
    GBAR();
    if constexpr ((PHM >> 7) & 1) {
        if (wg < 64) delta_rec_task(P, lds, wg >> 3, wg & 7, tid);
        else {
            for (int task = wg - 64; task < 256; task += G - 64) rglru_task(P, lds, task >> 5, (task >> 2) & 7, task & 3, tid, RG_SPLIT, 16);
            if (wg < 96) rglru_task(P, lds, -1, (wg - 64) >> 2, (wg - 64) & 3, tid, 0, 1);
            if (wg >= 128) for (int item = wg - 128; item < NS * NH; item += G - 128) delta_sample_item<0>(P, lds, item, tid);
        }
    }
    GBAR();
    if constexpr ((PHM >> 9) & 1) {
    { pg8::Gemm g{Z + 1 * (ZB / 2), (const bf16*)(ws + WS_WBR), Z + 5 * (ZB / 2), (const bf16*)(ws + WS_WBR) + (size_t)D * D, D};
      pg8::PairOrder S; S.base.init(MPR, D, G, wg);
      EpiBranch E{MG, MG + ZB / 2, Z}; pg8::gemm_phase(lds, g, S, E, wave);
      const bf16* mga = MG; const bf16* mgb = MG + ZB / 2; bf16* Gm = Z;
      mini_gemm(lds, g.A0, g.B0, g.A1, g.B1, D, wg, G, tid, [=](int row, int col, f32x4 ya, f32x4 yb) {
          const size_t o = (size_t)row * D + col; const u32x2 a = *(const u32x2*)(mga + o), b = *(const u32x2*)(mgb + o);
          u32x2 w; w.x = pk2(bflo(a.x) * ya[0] + bflo(b.x) * yb[0], bfhi(a.x) * ya[1] + bfhi(b.x) * yb[1]);
          w.y = pk2(bflo(a.y) * ya[2] + bflo(b.y) * yb[2], bfhi(a.y) * ya[3] + bfhi(b.y) * yb[3]);
          *(u32x2*)(Gm + o) = w; }); }
    }
    GBAR();
    if constexpr ((PHM >> 10) & 1) {
    { pg8::Gemm g{Z, (const bf16*)(ws + WS_WOUT), nullptr, nullptr, D}; pg8::StaticOrder S; S.init(MPR, D, G, wg);
      EpiResidNorm<0> E{karg_out(), nullptr, ADA + 5 * D, 1.0f, INP(28), ADA + 6 * D, H, (float*)(ws + WS_PART) + 65536, (unsigned*)(ws + WS_CNT) + 64, (LAS float*)(lds + 131072)}; pg8::gemm_phase(lds, g, S, E, wave);
      float* X = karg_out(); const float* gate = ADA + 5 * D;
      mini_gemm(lds, Z, (const bf16*)(ws + WS_WOUT), nullptr, nullptr, D, wg, G, tid, [=](int row, int col, f32x4 v, f32x4) {
          float* xp = X + (size_t)row * D + col; const f32x4 gv = *(const f32x4*)(gate + (size_t)cond_of_row(row) * NADA + col);
          *(f32x4*)xp = *(const f32x4*)xp + gv * v; }); }
    }
    GBAR();
    if constexpr ((PHM >> 11) & 1) {
    sample_norm_rows<0>(INP(28), 6, gw, lane);
    {
        for (int item = (G == 256 ? SS_TAIL : 0) + wg; item < NS * NH; item += G) delta_sample_item<1>(P, lds, item, tid);
        const int gt = wg * NTHR + tid, NGT = G * NTHR;
        for (int i = gt; i < NS * 3 * 3072; i += NGT) { const int bs = i / 9216, j = (i / 3072) % 3, c3 = i % 3072;
            karg_out()[O_CQS + i] = j < 2 ? INP(7)[(size_t)bs * 9216 + (j + 1) * 3072 + c3] : bf2f(Z[(size_t)(2 + (c3 >> 10)) * (ZB / 2) + ((size_t)MPR + bs) * D + (c3 & 1023)]); }
    }
    }
    GBAR();
    if constexpr ((PHM >> 12) & 1) {
    { pg8::Gemm g{H, (const bf16*)(ws + WS_WUP2), nullptr, nullptr, D}; pg8::StaticOrder S; S.init(MPAD, 2 * FF, G, wg);
      EpiSwiglu E{ACT}; pg8::gemm_phase(lds, g, S, E, wave);
      if (G == 256 && wg >= 150) for (int item = wg - 150; item < SS_TAIL; item += 106) delta_sample_item<1>(P, lds, item, tid); }
    }
    GBAR();
    if constexpr ((PHM >> 13) & 1) {
    { pg8::Gemm g{ACT, (const bf16*)(ws + WS_WDN2), nullptr, nullptr, FF}; pg8::StaticOrder S; S.init(MPR, D, G, wg);
      EpiResidNorm<1> E{karg_out(), nullptr, ADA + 8 * D, 0.5f, INP(31), nullptr, nullptr, (float*)(ws + WS_PART) + 131072, (unsigned*)(ws + WS_CNT) + 128, (LAS float*)(lds + 131072)}; pg8::gemm_phase(lds, g, S, E, wave);
      float* X = karg_out(); const float* gate = ADA + 8 * D;
      mini_gemm(lds, ACT, (const bf16*)(ws + WS_WDN2), nullptr, nullptr, FF, wg, G, tid, [=](int row, int col, f32x4 v, f32x4) {
          float* xp = X + (size_t)row * D + col; const f32x4 gv = *(const f32x4*)(gate + (size_t)cond_of_row(row) * NADA + col);
          *(f32x4*)xp = *(const f32x4*)xp + (gv * 0.5f) * v; }); }
    }
    GBAR();
    if constexpr ((PHM >> 14) & 1) {
    sample_norm_rows<1>(INP(31), 0, gw, lane);
    }
}

extern "C" void kernel_launch(void* const* d_in, const int* in_sizes, int n_in, void* d_out, int out_size, void* d_ws, size_t ws_size, hipStream_t stream) {
    static int grid = 0;
    if (grid == 0) {
        if (n_in != 32 || (size_t)out_size != O_END || ws_size < WS_END) { fprintf(stderr, "kernel_launch: unexpected shapes: n_in %d out %d ws %zu (need %zu)\n", n_in, out_size, ws_size, (size_t)WS_END); grid = -1; return; }
        int dev = 0, cus = 0, per_cu = 0;
        hipGetDevice(&dev); hipDeviceGetAttribute(&cus, hipDeviceAttributeMultiprocessorCount, dev);
        if (hipFuncSetAttribute((const void*)fwd_megakernel, hipFuncAttributeMaxDynamicSharedMemorySize, LDS_BYTES) != hipSuccess) { fprintf(stderr, "kernel_launch: hipFuncSetAttribute failed\n"); grid = -1; return; }
        if (hipOccupancyMaxActiveBlocksPerMultiprocessor(&per_cu, (const void*)fwd_megakernel, NTHR, LDS_BYTES) != hipSuccess || per_cu < 1) { fprintf(stderr, "kernel_launch: occupancy query says %d\n", per_cu); per_cu = 1; }
        (void)hipGetLastError();
        grid = cus * 1;
        if (grid > 256) grid = 256;
    }
    if (grid < 0) return;
    if (hipMemsetAsync(d_ws, 0, 16384, stream) != hipSuccess) { fprintf(stderr, "kernel_launch: memset failed\n"); return; }
    Params p{};
    for (int i = 0; i < 32; ++i) p.in[i] = (const float*)d_in[i];
    p.out = (float*)d_out; p.ws = (unsigned char*)d_ws;
    void* args[] = {&p};
    hipError_t e = hipLaunchCooperativeKernel((const void*)fwd_megakernel, dim3(grid), dim3(NTHR), args, LDS_BYTES, stream);
    if (e != hipSuccess) fprintf(stderr, "kernel_launch: cooperative launch failed: %s (grid %d)\n", hipGetErrorString(e), grid);
}
```

```cpp
#include <hip/hip_runtime.h>
#include <hip/hip_cooperative_groups.h>
#include <cstdio>
#include <cstdint>
namespace cg = cooperative_groups;

#define LAS __attribute__((address_space(3)))
typedef unsigned short bf16;
typedef short bf16x8 __attribute__((ext_vector_type(8)));
typedef float f32x4 __attribute__((ext_vector_type(4)));
typedef float f32x16 __attribute__((ext_vector_type(16)));
typedef unsigned u32x4 __attribute__((ext_vector_type(4)));
typedef unsigned u32x2 __attribute__((ext_vector_type(2)));

constexpr int D = 1024, SEQ = 2048, NB = 8, MPR = NB * SEQ, NS = 128, M = MPR + NS, MPAD = 16640;
constexpr int FF = 2816, NADA = 9216, NCOND = NB + NS, NIN = 8448, NH = 8;
constexpr float EPS = 1e-6f;
constexpr int NWAVES = 8, NTHR = 512;

constexpr size_t MiB = 1u << 20;
constexpr size_t ZB = (size_t)M * D * 2;
constexpr size_t WS_WUP2 = 1 * MiB;
constexpr size_t WS_WDN2 = 12 * MiB;
constexpr size_t WS_WIN = WS_WDN2 + (size_t)D * FF * 2;
constexpr size_t WS_WBR = 34 * MiB;
constexpr size_t WS_WOUT = 38 * MiB;
constexpr size_t WS_WRG = 40 * MiB;
constexpr size_t WS_CB = WS_WRG + 512 * 1024;
constexpr size_t WS_ADA = 41 * MiB;
constexpr size_t WS_ABL = 46 * MiB;
constexpr size_t WS_H = 48 * MiB;
constexpr size_t WS_Z = WS_H + ZB;
constexpr size_t WS_ACT = WS_Z;
constexpr size_t WS_WUP1 = WS_Z + 96 * MiB;
constexpr size_t WS_WDN1 = WS_Z + 107 * MiB;
constexpr size_t WS_WADA = WS_Z + 113 * MiB;
constexpr size_t WS_END = WS_Z + 6 * ZB + 1 * MiB;
static_assert(WS_WIN + (size_t)NIN * D * 2 <= WS_WBR, "ws map");
static_assert((size_t)M * 16 * 4 <= 2 * MiB, "ws map");
static_assert((size_t)MPAD * FF * 2 <= 96 * MiB, "ws map");
static_assert(WS_WADA + (size_t)NADA * D * 2 <= WS_Z + 6 * ZB, "ws map");

constexpr size_t O_Y = 0, O_HP = (size_t)M * D, O_CRP = O_HP + NB * D, O_SP = O_CRP + NB * 3 * D, O_CQP = O_SP + (size_t)NB * NH * 128 * 128,
                 O_HS = O_CQP + NB * 3 * 3072, O_CRS = O_HS + NS * D, O_SS = O_CRS + NS * 3 * D, O_CQS = O_SS + (size_t)NS * NH * 128 * 128,
                 O_END = O_CQS + (size_t)NS * 3 * 3072;
static_assert(2 * ZB <= (O_END - O_SS) * 4, "scratch in d_out");
constexpr size_t OSB = O_SS * 4 + 2 * ZB, OSB_HK = OSB, OSB_HV = OSB + 3 * MiB / 2, OSB_NK = OSB + 3 * MiB, OSB_NQ = OSB + 7 * MiB / 2;
static_assert(OSB + 4 * MiB <= O_END * 4, "d_out scratch");

__device__ __forceinline__ unsigned pk2(float lo, float hi);
__device__ __forceinline__ unsigned f2bf(float f) { return pk2(f, f) & 0xffffu; }
typedef float f32x2_t __attribute__((ext_vector_type(2))); typedef __bf16 bf16x2_t __attribute__((ext_vector_type(2)));
__device__ __forceinline__ unsigned pk2(float lo, float hi) { f32x2_t v = {lo, hi}; bf16x2_t b = __builtin_convertvector(v, bf16x2_t); return __builtin_bit_cast(unsigned, b); }
__device__ __forceinline__ float bf2f(unsigned short b) { return __builtin_bit_cast(float, (unsigned)b << 16); }
__device__ __forceinline__ float bflo(unsigned u) { return __builtin_bit_cast(float, u << 16); }
__device__ __forceinline__ float bfhi(unsigned u) { return __builtin_bit_cast(float, u & 0xffff0000u); }
__device__ __forceinline__ float rcp_f(float x) { return __builtin_amdgcn_rcpf(x); }
__device__ __forceinline__ float rsq_f(float x) { return __builtin_amdgcn_rsqf(x); }
__device__ __forceinline__ float sigmoid_f(float x) { return rcp_f(1.f + __expf(-x)); }
__device__ __forceinline__ float neg_expm1_f(float x) {
    const float p = -x * (1.f + x * (0.5f + x * (0.16666667f + x * (0.041666668f + x * (0.0083333338f + x * 0.0013888889f)))));
    return x > -0.3f ? p : 1.f - __expf(x);
}
__device__ __forceinline__ float silu_f(float x) { return x * sigmoid_f(x); }
__device__ __forceinline__ float gelu_tanh_f(float x) { return x * sigmoid_f(1.5957691216057308f * (x + 0.044715f * x * x * x)); }
__device__ __forceinline__ float softplus_f(float x) { return x > 20.f ? x : log1pf(__expf(x)); }
template <int CTRL> __device__ __forceinline__ float dpp_f(float x) {
    return __builtin_bit_cast(float, __builtin_amdgcn_update_dpp(0, __builtin_bit_cast(int, x), CTRL, 0xF, 0xF, true));
}
__device__ __forceinline__ float red8(float x) { x += dpp_f<0xB1>(x); x += dpp_f<0x4E>(x); x += dpp_f<0x141>(x); return x; }
__device__ __forceinline__ float red16(float x) { x = red8(x); x += dpp_f<0x140>(x); return x; }
__device__ __forceinline__ float wave_sum(float v) { v = red16(v);
    return ((__builtin_bit_cast(float, __builtin_amdgcn_readlane(__builtin_bit_cast(int, v), 0)) + __builtin_bit_cast(float, __builtin_amdgcn_readlane(__builtin_bit_cast(int, v), 16))) +
            (__builtin_bit_cast(float, __builtin_amdgcn_readlane(__builtin_bit_cast(int, v), 32)) + __builtin_bit_cast(float, __builtin_amdgcn_readlane(__builtin_bit_cast(int, v), 48)))); }
__device__ __forceinline__ int lane_now();
__device__ __forceinline__ int opq(int x);
__device__ __forceinline__ float shfl_xor_l(float v, int o) { const int idx = (opq(lane_now()) ^ o) << 2; return __builtin_bit_cast(float, __builtin_amdgcn_ds_bpermute(idx, __builtin_bit_cast(int, v))); }
__device__ __forceinline__ void unpack8(const u32x4 u, float* x) { x[0] = bflo(u.x); x[1] = bfhi(u.x); x[2] = bflo(u.y); x[3] = bfhi(u.y); x[4] = bflo(u.z); x[5] = bfhi(u.z); x[6] = bflo(u.w); x[7] = bfhi(u.w); }
__device__ __forceinline__ bf16x8 pack8(float a0, float a1, float a2, float a3, float a4, float a5, float a6, float a7) {
    u32x4 w; w.x = pk2(a0, a1); w.y = pk2(a2, a3); w.z = pk2(a4, a5); w.w = pk2(a6, a7); return __builtin_bit_cast(bf16x8, w);
}
#define LDS_WAIT() asm volatile("s_waitcnt lgkmcnt(0)" ::: "memory")
__device__ __forceinline__ int lane_now() { return (int)__builtin_amdgcn_mbcnt_hi(~0u, __builtin_amdgcn_mbcnt_lo(~0u, 0u)); }
__device__ __forceinline__ int opq(int x) { asm volatile("" : "+v"(x)); return x; }

namespace pg8 {
constexpr int BM = 256, BK = 64, HALF = 128, HTB = HALF * BK * 2, NXCD = 8, WGM = 4;
__host__ __device__ __forceinline__ int lds_byte(int r, int c) { const int st = (r >> 4) * 2 + (c >> 5), rr = r & 15, cc = c & 31, ob = rr * 64 + cc * 2; return st * 1024 + (ob ^ (((ob >> 9) & 1) << 5)); }
__host__ __device__ __forceinline__ void stage_rc(int b, int& R, int& C) { const int st = b / 1024, sb = b % 1024, swz = sb ^ (((sb >> 9) & 1) << 5); R = (st >> 1) * 16 + swz / 64; C = (st & 1) * 32 + (swz % 64) / 2; }
__host__ __device__ __forceinline__ int perm32(int rho) { const int n = rho >> 4, i = rho & 15; return 8 * (i >> 2) + 4 * n + (i & 3); }

struct Unit { int pm, pn, sub; };
struct Gemm { const bf16* A0; const bf16* B0; const bf16* A1; const bf16* B1; int K; };

struct StaticOrder {
    int nM, nN, nwg, G, c;
    __device__ void init(int Mp, int N, int G_, int c_) { nM = Mp / BM; nN = N / BM; nwg = nM * nN; G = G_; c = c_; }
    __device__ bool next(int i, Unit& u) const {
        const long L = (long)i * G + c; if (L >= nwg) return false;
        int wgid = (int)L; { const int q = nwg / NXCD, r = nwg % NXCD, xcd = wgid % NXCD, off = wgid / NXCD; wgid = (xcd < r ? xcd * (q + 1) : r * (q + 1) + (xcd - r) * q) + off; }
        const int nig = WGM * nN, gid = wgid / nig, fm = gid * WGM, gsz = (nM - fm) < WGM ? (nM - fm) : WGM;
        u.pm = fm + ((wgid % nig) % gsz); u.pn = (wgid % nig) / gsz; u.sub = 0; return true;
    }
};
struct PairOrder {
    StaticOrder base;
    __device__ bool next(int i, Unit& u) const { const bool ok = base.next(i >> 1, u); u.sub = i & 1; return ok; }
};

template <class Epi, class Sched>
__device__ __forceinline__ void gemm_phase(LAS unsigned char* lds, const Gemm g, const Sched& S, const Epi& E, int wid) {
    const int lane = opq(lane_now()), tid = (wid << 6) | lane, wr = wid >> 2, wc = wid & 3, fr = lane & 15, fq = lane >> 4;
    const int K = g.K, nt = K / BK;
    unsigned voffA[2], voffB[2];
#pragma unroll
    for (int i = 0; i < 2; ++i) { int R, C; stage_rc(tid * 16 + i * 8192, R, C); const int Rb = (R & ~31) + perm32(R & 31);
        voffA[i] = (unsigned)(R * K + C) * 2u; voffB[i] = (unsigned)(Rb * K + C) * 2u; }
    const size_t kstep = (size_t)(BK * 2);
    const size_t hstep = (size_t)HALF * K * 2;
    const size_t tstep = 2 * hstep;
    const unsigned ldsw = (unsigned)wid * 1024u;
    const int aoff = lds_byte(wr * 64 + fr, fq * 8), boff = lds_byte(wc * 32 + fr, fq * 8);
#define PG8_SA(b, h) (((b) * 2 + (h)) * HTB)
#define PG8_SB(b, h) ((4 + (b) * 2 + (h)) * HTB)
#define PG8_STAGE(bufoff, gbase, voff) do { _Pragma("unroll") for (int _i = 0; _i < 2; ++_i) \
        __builtin_amdgcn_global_load_lds((const unsigned*)((const char*)(gbase) + (voff)[_i]), (LAS unsigned*)(lds + (bufoff) + ldsw + _i * 8192), 16, 0, 0); } while (0)
#define PG8_LDA(dst, b, h) do { _Pragma("unroll") for (int m = 0; m < 4; ++m) _Pragma("unroll") for (int k = 0; k < 2; ++k) dst[m][k] = *(const LAS bf16x8*)(lds + PG8_SA(b, h) + aoff + m * 2048 + k * 1024); } while (0)
#define PG8_LDB(dst, b, h) do { _Pragma("unroll") for (int n = 0; n < 2; ++n) _Pragma("unroll") for (int k = 0; k < 2; ++k) dst[n][k] = *(const LAS bf16x8*)(lds + PG8_SB(b, h) + boff + n * 2048 + k * 1024); } while (0)
#define PG8_MMA(ai, bj, At, Bt) do { __builtin_amdgcn_s_setprio(1); _Pragma("unroll") for (int m = 0; m < 4; ++m) _Pragma("unroll") for (int n = 0; n < 2; ++n) _Pragma("unroll") for (int k = 0; k < 2; ++k) \
        acc[ai][bj][m][n] = __builtin_amdgcn_mfma_f32_16x16x32_bf16(Bt[n][k], At[m][k], acc[ai][bj][m][n], 0, 0, 0); __builtin_amdgcn_s_setprio(0); } while (0)
#define PG8_WAIT_V(n) asm volatile("s_waitcnt vmcnt(" #n ")" ::: "memory")
#define PG8_WAIT_L(n) asm volatile("s_waitcnt lgkmcnt(" #n ")" ::: "memory")
#define PG8_BAR __builtin_amdgcn_s_barrier()
#define PG8_SCHED __builtin_amdgcn_sched_barrier(0)
#define PG8_ZERO() do { _Pragma("unroll") for (int a = 0; a < 2; ++a) _Pragma("unroll") for (int b = 0; b < 2; ++b) _Pragma("unroll") for (int m = 0; m < 4; ++m) _Pragma("unroll") for (int n = 0; n < 2; ++n) acc[a][b][m][n] = (f32x4){0.f, 0.f, 0.f, 0.f}; } while (0)
    Unit cur, nxt; int ui = 0;
    if (!S.next(0, cur)) return;
    f32x4 acc[2][2][4][2];
    PG8_ZERO();
    bf16x8 At[4][2], B0[2][2], B1[2][2];
    const char* cA = (const char*)(cur.sub ? g.A1 : g.A0) + (size_t)cur.pm * tstep; const char* cB = (const char*)(cur.sub ? g.B1 : g.B0) + (size_t)cur.pn * tstep;
    PG8_STAGE(PG8_SB(0, 0), cB, voffB); PG8_STAGE(PG8_SB(0, 1), cB + hstep, voffB); PG8_STAGE(PG8_SA(0, 0), cA, voffA); PG8_STAGE(PG8_SA(0, 1), cA + hstep, voffA);
    if (wr == 1) PG8_BAR;
    PG8_WAIT_V(2); PG8_BAR;
    PG8_STAGE(PG8_SB(1, 0), cB + kstep, voffB); PG8_STAGE(PG8_SA(1, 0), cA + kstep, voffA); PG8_STAGE(PG8_SB(1, 1), cB + hstep + kstep, voffB);
    PG8_WAIT_V(6); PG8_BAR;
    for (;;) {
        const bool has_next = S.next(ui + 1, nxt);
        const char* nA = has_next ? (const char*)(nxt.sub ? g.A1 : g.A0) + (size_t)nxt.pm * tstep : cA; const char* nB = has_next ? (const char*)(nxt.sub ? g.B1 : g.B0) + (size_t)nxt.pn * tstep : cB;
        for (int t = 0; t < nt; t += 2) {
            const bool last = (t == nt - 2);
            const char* a1 = cA + (size_t)(t + 1) * kstep;
            const char* a2 = last ? nA : cA + (size_t)(t + 2) * kstep; const char* b2 = last ? nB : cB + (size_t)(t + 2) * kstep;
            const char* a3 = a2 + kstep; const char* b3 = b2 + kstep;
            PG8_LDB(B0, 0, 0); PG8_LDB(B1, 0, 1); PG8_SCHED; PG8_LDA(At, 0, 0); PG8_STAGE(PG8_SA(1, 1), a1 + hstep, voffA);
            PG8_WAIT_V(8); PG8_WAIT_L(0); PG8_BAR; PG8_MMA(0, 0, At, B0); PG8_MMA(0, 1, At, B1); PG8_BAR; PG8_SCHED;
            PG8_LDA(At, 0, 1); PG8_STAGE(PG8_SB(0, 0), b2, voffB); PG8_STAGE(PG8_SB(0, 1), b2 + hstep, voffB); PG8_STAGE(PG8_SA(0, 0), a2, voffA);
            PG8_WAIT_V(8); PG8_WAIT_L(0); PG8_BAR; PG8_MMA(1, 0, At, B0); PG8_MMA(1, 1, At, B1); PG8_BAR; PG8_SCHED;
            PG8_LDB(B0, 1, 0); PG8_LDB(B1, 1, 1); PG8_SCHED; PG8_LDA(At, 1, 0); PG8_STAGE(PG8_SA(0, 1), a2 + hstep, voffA);
            PG8_WAIT_V(8); PG8_WAIT_L(0); PG8_BAR; PG8_MMA(0, 0, At, B0); PG8_MMA(0, 1, At, B1); PG8_BAR; PG8_SCHED;
            PG8_LDA(At, 1, 1); PG8_STAGE(PG8_SB(1, 0), b3, voffB); PG8_STAGE(PG8_SB(1, 1), b3 + hstep, voffB); PG8_STAGE(PG8_SA(1, 0), a3, voffA);
            PG8_WAIT_V(8); PG8_WAIT_L(0); PG8_BAR; PG8_MMA(1, 0, At, B0); PG8_MMA(1, 1, At, B1); PG8_BAR; PG8_SCHED;
        }
        if (wr == 0) PG8_BAR;
        bool keep = false;
        if constexpr (Epi::KEEP) { if (cur.sub == 0) { E.mid(acc, cur, wr, wc, fr, fq); keep = true; } else E(acc, cur, wr, wc, fr, fq); }
        else E(acc, cur, wr, wc, fr, fq);
        if (!has_next) break;
        if (!keep) PG8_ZERO();
        cur = nxt; cA = nA; cB = nB; ++ui;
        if (wr == 1) PG8_BAR;
    }
    PG8_WAIT_V(0);
    PG8_BAR;
#undef PG8_SA
#undef PG8_SB
#undef PG8_STAGE
#undef PG8_LDA
#undef PG8_LDB
#undef PG8_MMA
#undef PG8_WAIT_V
#undef PG8_WAIT_L
#undef PG8_BAR
#undef PG8_SCHED
#undef PG8_ZERO
}
}

typedef f32x4 AccT[2][2][4][2];
__device__ __forceinline__ int cond_of_row(int row) { return row < MPR ? (row >> 11) : (NB + row - MPR); }

struct EpiAda {
    static constexpr bool KEEP = false;
    float* ada; const float* bias;
    __device__ __forceinline__ void operator()(const AccT& acc, const pg8::Unit& u, int wr, int wc, int fr, int fq) const {
#pragma unroll
        for (int ai = 0; ai < 2; ++ai)
#pragma unroll
            for (int m = 0; m < 4; ++m) { const int row = u.pm * 256 + ai * 128 + wr * 64 + m * 16 + fr; if (row >= NCOND) continue;
#pragma unroll
                for (int bj = 0; bj < 2; ++bj)
#pragma unroll
                    for (int n = 0; n < 2; ++n) { const int col = u.pn * 256 + bj * 128 + wc * 32 + 8 * fq + 4 * n;
                        *(f32x4*)(ada + (size_t)row * NADA + col) = acc[ai][bj][m][n] + *(const f32x4*)(bias + col); } }
    }
};
struct EpiSwiglu {
    static constexpr bool KEEP = false;
    bf16* act;
    __device__ __forceinline__ void operator()(const AccT& acc, const pg8::Unit& u, int wr, int wc, int fr, int fq) const {
#pragma unroll
        for (int ai = 0; ai < 2; ++ai)
#pragma unroll
            for (int m = 0; m < 4; ++m) { const int row = u.pm * 256 + ai * 128 + wr * 64 + m * 16 + fr; if (row >= M) continue;
                const f32x4 g0 = acc[ai][0][m][0], g1 = acc[ai][0][m][1], v0 = acc[ai][1][m][0], v1 = acc[ai][1][m][1];
                u32x4 w; w.x = pk2(silu_f(g0[0]) * v0[0], silu_f(g0[1]) * v0[1]); w.y = pk2(silu_f(g0[2]) * v0[2], silu_f(g0[3]) * v0[3]);
                w.z = pk2(silu_f(g1[0]) * v1[0], silu_f(g1[1]) * v1[1]); w.w = pk2(silu_f(g1[2]) * v1[2], silu_f(g1[3]) * v1[3]);
                *(u32x4*)(act + (size_t)row * FF + u.pn * 128 + wc * 32 + 8 * fq) = w; }
    }
};
struct EpiResid {
    static constexpr bool KEEP = false;
    float* X; const float* xp; const float* xs; const float* gate; float coef;
    __device__ __forceinline__ void operator()(const AccT& acc, const pg8::Unit& u, int wr, int wc, int fr, int fq) const {
#pragma unroll
        for (int ai = 0; ai < 2; ++ai)
#pragma unroll
            for (int m = 0; m < 4; ++m) { const int row = u.pm * 256 + ai * 128 + wr * 64 + m * 16 + fr; if (row >= M) continue;
                const float* xin = xp ? (row < MPR ? xp + (size_t)row * D : xs + (size_t)(row - MPR) * D) : X + (size_t)row * D;
                const float* gt = gate + (size_t)cond_of_row(row) * NADA;
#pragma unroll
                for (int bj = 0; bj < 2; ++bj)
#pragma unroll
                    for (int n = 0; n < 2; ++n) { const int col = u.pn * 256 + bj * 128 + wc * 32 + 8 * fq + 4 * n;
                        const f32x4 xv = *(const f32x4*)(xin + col), gv = *(const f32x4*)(gt + col);
                        *(f32x4*)(X + (size_t)row * D + col) = xv + (gv * coef) * acc[ai][bj][m][n]; } }
    }
};
constexpr size_t WS_CNT = 14336, WS_PART = 65536;
template <int MODE> struct EpiResidNorm {
    static constexpr bool KEEP = false;
    float* X; const float* xp; const float* gate; float coef; const float* gvec; const float* shift; bf16* Hout; float* part; unsigned* cnt; LAS float* sred;
    __device__ __forceinline__ void operator()(AccT& acc, const pg8::Unit& u, int wr, int wc, int fr_, int fq_) const {
        const int fr = opq(fr_), fq = opq(fq_);
        const int tid = wr * 256 + wc * 64 + fq * 16 + fr, bidx = u.pm >> 3;
        const float* gt = gate + (size_t)bidx * NADA;
        float ss[2][4]; int zoff = 0;
#pragma unroll
        for (int ai = 0; ai < 2; ++ai)
#pragma unroll
            for (int m = 0; m < 4; ++m) { const int row = u.pm * 256 + ai * 128 + wr * 64 + m * 16 + fr + zoff;
                const float* xin = xp ? xp + (size_t)row * D : X + (size_t)row * D; float sacc = 0.f;
#pragma unroll
                for (int bj = 0; bj < 2; ++bj)
#pragma unroll
                    for (int n = 0; n < 2; ++n) { const int col = u.pn * 256 + bj * 128 + wc * 32 + 8 * fq + 4 * n;
                        const f32x4 xv = *(const f32x4*)(xin + col), gv = *(const f32x4*)(gt + col);
                        const f32x4 xn = xv + (gv * coef) * acc[ai][bj][m][n]; acc[ai][bj][m][n] = xn;
                        if (MODE == 0) *(f32x4*)(X + (size_t)row * D + col) = xn;
                        sacc += (xn[0] * xn[0] + xn[1] * xn[1]) + (xn[2] * xn[2] + xn[3] * xn[3]); }
                asm volatile("" : "+v"(zoff) : "v"(sacc));
                sacc += shfl_xor_l(sacc, 16); sacc += shfl_xor_l(sacc, 32);
                ss[ai][m] = sacc; __builtin_amdgcn_sched_barrier(0); }
        if (fq == 0) {
#pragma unroll
            for (int ai = 0; ai < 2; ++ai)
#pragma unroll
                for (int m = 0; m < 4; ++m) sred[wc * 256 + ai * 128 + wr * 64 + m * 16 + fr] = ss[ai][m]; }
        __syncthreads();
        if (tid < 256) __hip_atomic_store((unsigned*)part + ((size_t)u.pm * 4 + u.pn) * 256 + tid, __builtin_bit_cast(unsigned, (sred[tid] + sred[256 + tid]) + (sred[512 + tid] + sred[768 + tid])), __ATOMIC_RELAXED, __HIP_MEMORY_SCOPE_AGENT);
        asm volatile("s_waitcnt vmcnt(0)" ::: "memory");
        __syncthreads();
        if (tid == 0) { __hip_atomic_fetch_add(cnt + u.pm, 1u, __ATOMIC_RELAXED, __HIP_MEMORY_SCOPE_AGENT);
            unsigned sp = 0; while (__hip_atomic_load(cnt + u.pm, __ATOMIC_RELAXED, __HIP_MEMORY_SCOPE_AGENT) < 4u && ++sp < (1u << 24)) __builtin_amdgcn_s_sleep(1); }
        __syncthreads();
        if (tid < 256) { unsigned* pp = (unsigned*)part + (size_t)u.pm * 4 * 256 + tid;
            const float p0 = __builtin_bit_cast(float, __hip_atomic_load(pp, __ATOMIC_RELAXED, __HIP_MEMORY_SCOPE_AGENT)), p1 = __builtin_bit_cast(float, __hip_atomic_load(pp + 256, __ATOMIC_RELAXED, __HIP_MEMORY_SCOPE_AGENT));
            const float p2 = __builtin_bit_cast(float, __hip_atomic_load(pp + 512, __ATOMIC_RELAXED, __HIP_MEMORY_SCOPE_AGENT)), p3 = __builtin_bit_cast(float, __hip_atomic_load(pp + 768, __ATOMIC_RELAXED, __HIP_MEMORY_SCOPE_AGENT));
            sred[1024 + tid] = rsq_f(((p0 + p1) + (p2 + p3)) * (1.f / D) + EPS); }
        __syncthreads();
        const float* sh = MODE == 0 ? shift + (size_t)bidx * NADA : nullptr;
#pragma unroll
        for (int bj = 0; bj < 2; ++bj) { const int col = u.pn * 256 + bj * 128 + wc * 32 + 8 * fq;
            const f32x4 g0 = *(const f32x4*)(gvec + col), g1 = *(const f32x4*)(gvec + col + 4);
            f32x4 a0 = g0, a1 = g1, b0 = {0.f, 0.f, 0.f, 0.f}, b1 = b0;
            if (MODE == 0) { a0 = g0 * (*(const f32x4*)(sh + D + col) + 1.f); a1 = g1 * (*(const f32x4*)(sh + D + col + 4) + 1.f); b0 = *(const f32x4*)(sh + col); b1 = *(const f32x4*)(sh + col + 4); }
#pragma unroll
            for (int ai = 0; ai < 2; ++ai)
#pragma unroll
                for (int m = 0; m < 4; ++m) { const int rl = ai * 128 + wr * 64 + m * 16 + fr; const size_t row = (size_t)u.pm * 256 + rl; const float rstd = sred[1024 + rl];
                    const f32x4 y0 = acc[ai][bj][m][0] * rstd * a0 + b0, y1 = acc[ai][bj][m][1] * rstd * a1 + b1;
                    if (MODE == 0) *(bf16x8*)(Hout + row * D + col) = pack8(y0[0], y0[1], y0[2], y0[3], y1[0], y1[1], y1[2], y1[3]);
                    else { *(f32x4*)(X + row * D + col) = y0; *(f32x4*)(X + row * D + col + 4) = y1; }
                    __builtin_amdgcn_sched_barrier(0); }
        }
        __syncthreads();
    }
};
struct EpiIn {
    static constexpr bool KEEP = false;
    bf16* z; bf16* mg; float* abl; float* out;
    __device__ __forceinline__ void operator()(const AccT& acc, const pg8::Unit& u, int wr, int wc, int fr, int fq) const {
        const int bi = u.pn >> 2;
        if (bi == 8) {
            if (wc == 0 && fq < 2) {
#pragma unroll
                for (int ai = 0; ai < 2; ++ai)
#pragma unroll
                    for (int m = 0; m < 4; ++m) { const int row = u.pm * 256 + ai * 128 + wr * 64 + m * 16 + fr; if (row >= M) continue;
                        *(f32x4*)(abl + (size_t)row * 16 + 8 * fq) = acc[ai][0][m][0]; *(f32x4*)(abl + (size_t)row * 16 + 8 * fq + 4) = acc[ai][0][m][1]; }
            }
            return;
        }
        bf16* base = bi < 6 ? z + (size_t)bi * (ZB / 2) : mg + (size_t)(bi - 6) * (ZB / 2);
        const int act = (bi == 1) ? 1 : (bi == 5) ? 2 : (bi >= 6) ? 3 : 0;
        const int colt = (u.pn & 3) * 256 + wc * 32 + 8 * fq;
#pragma unroll
        for (int ai = 0; ai < 2; ++ai)
#pragma unroll
            for (int m = 0; m < 4; ++m) { const int row = u.pm * 256 + ai * 128 + wr * 64 + m * 16 + fr; if (row >= M) continue;
#pragma unroll
                for (int bj = 0; bj < 2; ++bj) { f32x4 v0 = acc[ai][bj][m][0], v1 = acc[ai][bj][m][1];
                    if (act == 1) {
#pragma unroll
                        for (int j = 0; j < 4; ++j) { v0[j] = gelu_tanh_f(v0[j]); v1[j] = gelu_tanh_f(v1[j]); } }
                    else if (act == 2) {
#pragma unroll
                        for (int j = 0; j < 4; ++j) { v0[j] = silu_f(v0[j]); v1[j] = silu_f(v1[j]); } }
                    else if (act == 3) {
#pragma unroll
                        for (int j = 0; j < 4; ++j) { v0[j] = sigmoid_f(v0[j]); v1[j] = sigmoid_f(v1[j]); } }
                    u32x4 w; w.x = pk2(v0[0], v0[1]); w.y = pk2(v0[2], v0[3]); w.z = pk2(v1[0], v1[1]); w.w = pk2(v1[2], v1[3]);
                    *(u32x4*)(base + (size_t)row * D + colt + bj * 128) = w;
                    if (act == 0 && row < MPR) { const int rs = row & (SEQ - 1), r64 = row & 63, bb = row >> 11, col = colt + bj * 128;
                        if (bi >= 3 && r64 >= 61 && rs < SEQ - 3)
                            *(u32x4*)((bf16*)((unsigned char*)out + (bi == 3 ? OSB_HK : OSB_HV)) + ((size_t)(bb * 32 + (rs >> 6) + 1) * 3 + (r64 - 61)) * D + col) = w;
                        if (rs >= SEQ - 3) { float* dst = bi == 0 ? out + O_CRP + ((size_t)bb * 3 + (rs - (SEQ - 3))) * D + col : out + O_CQP + ((size_t)bb * 3 + (rs - (SEQ - 3))) * 3072 + (bi - 2) * 1024 + col;
                            *(f32x4*)dst = v0; *(f32x4*)(dst + 4) = v1; } }
                } }
    }
};
struct EpiBranch {
    static constexpr bool KEEP = true;
    const bf16* mga; const bf16* mgb; bf16* G;
    __device__ __forceinline__ void mid(AccT& acc, const pg8::Unit& u, int wr, int wc, int fr, int fq) const {
#pragma unroll
        for (int ai = 0; ai < 2; ++ai)
#pragma unroll
            for (int m = 0; m < 4; ++m) { int row = u.pm * 256 + ai * 128 + wr * 64 + m * 16 + fr; if (row >= M) row = M - 1;
#pragma unroll
                for (int bj = 0; bj < 2; ++bj) { const size_t o = (size_t)row * D + u.pn * 256 + bj * 128 + wc * 32 + 8 * fq;
                    const u32x4 a = *(const u32x4*)(mga + o), b = *(const u32x4*)(mgb + o);
                    f32x4 r0, r1;
                    r0[0] = bflo(a.x) * rcp_f(bflo(b.x)); r0[1] = bfhi(a.x) * rcp_f(bfhi(b.x)); r0[2] = bflo(a.y) * rcp_f(bflo(b.y)); r0[3] = bfhi(a.y) * rcp_f(bfhi(b.y));
                    r1[0] = bflo(a.z) * rcp_f(bflo(b.z)); r1[1] = bfhi(a.z) * rcp_f(bfhi(b.z)); r1[2] = bflo(a.w) * rcp_f(bflo(b.w)); r1[3] = bfhi(a.w) * rcp_f(bfhi(b.w));
                    acc[ai][bj][m][0] = acc[ai][bj][m][0] * r0; acc[ai][bj][m][1] = acc[ai][bj][m][1] * r1; } }
    }
    __device__ __forceinline__ void operator()(const AccT& acc, const pg8::Unit& u, int wr, int wc, int fr, int fq) const {
#pragma unroll
        for (int ai = 0; ai < 2; ++ai)
#pragma unroll
            for (int m = 0; m < 4; ++m) { const int row = u.pm * 256 + ai * 128 + wr * 64 + m * 16 + fr; if (row >= M) continue;
#pragma unroll
                for (int bj = 0; bj < 2; ++bj) { const size_t o = (size_t)row * D + u.pn * 256 + bj * 128 + wc * 32 + 8 * fq;
                    const u32x4 b = *(const u32x4*)(mgb + o);
                    const f32x4 v0 = acc[ai][bj][m][0], v1 = acc[ai][bj][m][1];
                    u32x4 w; w.x = pk2(v0[0] * bflo(b.x), v0[1] * bfhi(b.x)); w.y = pk2(v0[2] * bflo(b.y), v0[3] * bfhi(b.y));
                    w.z = pk2(v1[0] * bflo(b.z), v1[1] * bfhi(b.z)); w.w = pk2(v1[2] * bflo(b.w), v1[3] * bfhi(b.w));
                    *(u32x4*)(G + o) = w; } }
    }
};

__device__ __forceinline__ f32x4 mini_partial(const bf16* A, const bf16* Bt, int K, int row0, int col0, int ks, int lane) {
    const int kq = K >> 2;
    const bf16* ap = A + (size_t)(MPR + row0 + (lane & 15)) * K + ks * kq + (lane >> 4) * 8;
    const bf16* bp = Bt + (size_t)(col0 + (lane & 15)) * K + ks * kq + (lane >> 4) * 8;
    f32x4 acc = {0.f, 0.f, 0.f, 0.f};
#pragma unroll 1
    for (int k0 = 0; k0 < kq; k0 += 256) {
        bf16x8 a[8], b[8];
#pragma unroll
        for (int i = 0; i < 8; ++i) if (k0 + 32 * i < kq) { a[i] = *(const bf16x8*)(ap + k0 + 32 * i); b[i] = *(const bf16x8*)(bp + k0 + 32 * i); }
#pragma unroll
        for (int i = 0; i < 8; ++i) if (k0 + 32 * i < kq) acc = __builtin_amdgcn_mfma_f32_16x16x32_bf16(b[i], a[i], acc, 0, 0, 0);
    }
    return acc;
}
template <class F>
__device__ __forceinline__ void mini_gemm(LAS unsigned char* lds, const bf16* A0, const bf16* B0, const bf16* A1, const bf16* B1, int K, int wg, int G, int tid_, const F& epi) {
    const int tid = opq(tid_), lane = tid & 63, wave = tid >> 6, ks = wave & 3;
    LAS f32x4* red = (LAS f32x4*)lds;
    for (int t0 = wg * 2; t0 < 512; t0 += G * 2) {
        const int tile = t0 + (wave >> 2), row0 = (tile >> 6) * 16, col0 = (tile & 63) * 16;
        f32x4 p0 = mini_partial(A0, B0, K, row0, col0, ks, lane), p1 = {0.f, 0.f, 0.f, 0.f};
        if (A1) p1 = mini_partial(A1, B1, K, row0, col0, ks, lane);
        red[(wave * 2) * 64 + lane] = p0; red[(wave * 2 + 1) * 64 + lane] = p1;
        __syncthreads();
        if (ks == 0) {
#pragma unroll
            for (int w = 1; w < 4; ++w) { p0 = p0 + red[((wave + w) * 2) * 64 + lane]; p1 = p1 + red[((wave + w) * 2 + 1) * 64 + lane]; }
            epi(MPR + row0 + (lane & 15), col0 + 4 * (lane >> 4), p0, p1);
        }
        __syncthreads();
    }
}

struct Params { const float* in[32]; float* out; unsigned char* ws; };
constexpr int LDS_BYTES = 147456;
#ifndef PHM
#define PHM 0xFFFF
#endif
#ifndef P7M
#define P7M 0xF
#endif

struct Ctx {
    const float* const* in; float* out; unsigned char* ws; LAS unsigned char* lds;
    int tid, lane, wave, wg, G;
};
#define KAS __attribute__((address_space(4)))
typedef const float* cfptr_t; typedef float* fptr_t; typedef unsigned char* ucptr_t;
__device__ __forceinline__ const float* karg_in(int k) { return *(volatile KAS cfptr_t*)((const KAS char*)__builtin_amdgcn_kernarg_segment_ptr() + 8 * k); }
__device__ __forceinline__ float* karg_out() { return *(volatile KAS fptr_t*)((const KAS char*)__builtin_amdgcn_kernarg_segment_ptr() + 256); }
__device__ __forceinline__ unsigned char* karg_ws() { return *(volatile KAS ucptr_t*)((const KAS char*)__builtin_amdgcn_kernarg_segment_ptr() + 264); }
#define INP(k) karg_in(k)

template <int MODE>
__device__ __forceinline__ void sample_norm_rows(const float* gvec, int ish, int gw, int lane) {
    if (gw >= NS) return;
    const int row = MPR + gw; float* X = karg_out() + (size_t)row * D;
    f32x4 v[4]; float s = 0.f;
#pragma unroll
    for (int j = 0; j < 4; ++j) { v[j] = *(const f32x4*)(X + 4 * (lane + 64 * j)); s += (v[j][0] * v[j][0] + v[j][1] * v[j][1]) + (v[j][2] * v[j][2] + v[j][3] * v[j][3]); }
    const float rstd = rsq_f(wave_sum(s) * (1.f / D) + EPS);
    const float* sh = (const float*)(karg_ws() + WS_ADA) + (size_t)cond_of_row(row) * NADA + ish * D;
#pragma unroll
    for (int j = 0; j < 4; ++j) { const int col = 4 * (lane + 64 * j); const f32x4 g = *(const f32x4*)(gvec + col);
        if (MODE == 0) { const f32x4 y = (v[j] * rstd * g) * (*(const f32x4*)(sh + D + col) + 1.f) + *(const f32x4*)(sh + col);
            u32x2 o; o.x = pk2(y[0], y[1]); o.y = pk2(y[2], y[3]); *(u32x2*)((bf16*)(karg_ws() + WS_H) + (size_t)row * D + col) = o; }
        else *(f32x4*)(X + col) = v[j] * rstd * g; }
}
__device__ __forceinline__ void transpose_item(const float* W, int ldw, int k0, int n0, int nvalid, bf16* WT, int ldt, int drow0, LAS float* scr, int lane) {
    const int cc = lane & 31;
#pragma unroll 8
    for (int i = 0; i < 32; ++i) { const int kk = 2 * i + (lane >> 5); scr[kk * 33 + cc] = (cc < nvalid) ? W[(size_t)(k0 + kk) * ldw + n0 + cc] : 0.f; }
    LDS_WAIT(); asm volatile("" ::: "memory");
    const int c = lane & 7;
#pragma unroll
    for (int j = 0; j < 4; ++j) { const int n = (lane >> 3) + 8 * j; const LAS float* s = scr + (8 * c) * 33 + n;
        u32x4 o; o.x = pk2(s[0 * 33], s[1 * 33]); o.y = pk2(s[2 * 33], s[3 * 33]); o.z = pk2(s[4 * 33], s[5 * 33]); o.w = pk2(s[6 * 33], s[7 * 33]);
        if (n < nvalid) *(u32x4*)(WT + (size_t)(drow0 + n) * ldt + k0 + 8 * c) = o; }
    LDS_WAIT(); asm volatile("" ::: "memory");
}

template <int PART>
__device__ __forceinline__ void prologue(const Params& P, LAS unsigned char* lds, int gw, int NGW, int wave, int lane) {
    LAS float* scr = (LAS float*)(lds + wave * 16384);
    unsigned char* ws = karg_ws();
    constexpr int I_UP = 16 * 176, I_DN = 44 * 32, I_IN = 16 * 257, I_BR = 2 * 16 * 32, I_OUT = 16 * 32, I_ADA = 16 * 288, I_RG = 128;
    constexpr int NITEMS = 2 * I_UP + 2 * I_DN + I_IN + I_BR + I_OUT + I_ADA + I_RG;
    constexpr int I_FIRST = 2 * I_UP + 2 * I_DN + I_IN + I_BR + I_OUT;
    for (int it = gw; it < NITEMS; it += NGW) {
        int r = it;
        if (PART == 0) { if (r >= I_ADA) break; r += I_FIRST; } else { if (r >= NITEMS - I_ADA) break; if (r >= I_FIRST) r += I_ADA; }
        if (r < 2 * I_UP) { const int which = r / I_UP; r -= which * I_UP; const int kb = r / 176, nb = r % 176, n0 = nb * 32; const int half = n0 >= FF ? 1 : 0, np = n0 - half * FF;
            transpose_item(INP(which ? 29 : 11), 2 * FF, kb * 64, n0, 32, (bf16*)(ws + (which ? WS_WUP2 : WS_WUP1)), D, (np >> 7) * 256 + half * 128 + (np & 127), scr, lane); continue; }
        r -= 2 * I_UP;
        if (r < 2 * I_DN) { const int which = r / I_DN; r -= which * I_DN; const int kb = r / 32, nb = r % 32;
            transpose_item(INP(which ? 30 : 12), D, kb * 64, nb * 32, 32, (bf16*)(ws + (which ? WS_WDN2 : WS_WDN1)), FF, nb * 32, scr, lane); continue; }
        r -= 2 * I_DN;
        if (r < I_IN) { const int kb = r / 257, nb = r % 257; int n0, nv, dr;
            if (nb < 160) { n0 = nb * 32; nv = 32; dr = n0; } else if (nb == 160) { n0 = 5120; nv = 16; dr = 8192; } else { n0 = 5136 + (nb - 161) * 32; nv = 32; dr = 5120 + (nb - 161) * 32; }
            transpose_item(INP(14), 8208, kb * 64, n0, nv, (bf16*)(ws + WS_WIN), D, dr, scr, lane); continue; }
        r -= I_IN;
        if (r < I_BR) { const int which = r / 512; r -= which * 512; const int kb = r / 32, nb = r % 32;
            transpose_item(INP(26) + (size_t)which * D * D, D, kb * 64, nb * 32, 32, (bf16*)(ws + WS_WBR), D, which * D + nb * 32, scr, lane); continue; }
        r -= I_BR;
        if (r < I_OUT) { const int kb = r / 32, nb = r % 32; transpose_item(INP(27), D, kb * 64, nb * 32, 32, (bf16*)(ws + WS_WOUT), D, nb * 32, scr, lane); continue; }
        r -= I_OUT;
        if (r < I_ADA) { const int kb = r / 288, nb = r % 288; transpose_item(INP(8), NADA, kb * 64, nb * 32, 32, (bf16*)(ws + WS_WADA), D, nb * 32, scr, lane); continue; }
        r -= I_ADA;
        { const int gx = r >> 6, n = (r >> 3) & 7, kb = (r >> 2) & 1, nb = r & 3;
          transpose_item(INP(gx ? 19 : 17) + (size_t)n * 128 * 128, 128, kb * 64, nb * 32, 32, (bf16*)(ws + WS_WRG), 128, n * 256 + gx * 128 + nb * 32, scr, lane); }
    }
    bf16* cb = (bf16*)(ws + WS_CB);
    if (PART == 0) for (int row = gw; row < 256; row += NGW) {
        const float* src = row < NB ? INP(2) + (size_t)row * D : (row < NCOND ? INP(3) + (size_t)(row - NB) * D : nullptr);
#pragma unroll
        for (int j = 0; j < 4; ++j) { const int col = 4 * (lane + 64 * j); f32x4 v = src ? *(const f32x4*)(src + col) : (f32x4){0.f, 0.f, 0.f, 0.f};
            u32x2 o; o.x = pk2(v[0], v[1]); o.y = pk2(v[2], v[3]); *(u32x2*)(cb + (size_t)row * D + col) = o; }
    }
}

template <int MODE>
__device__ __forceinline__ void norm_mod_pass(const Params& P, const float* gvec, int ish, int gw, int NGW, int lane) {
    const float* ada = (const float*)(karg_ws() + WS_ADA); bf16* H = (bf16*)(karg_ws() + WS_H);
    const float* xp = INP(0); const float* xs = INP(1); const float* X = karg_out();
    for (int row0 = 2 * gw; row0 < M; row0 += 2 * NGW) {
        f32x4 v[2][4]; float s[2] = {0.f, 0.f};
#pragma unroll
        for (int u = 0; u < 2; ++u) { const int row = row0 + u;
            const float* xr = MODE == 0 ? (row < MPR ? xp + (size_t)row * D : xs + (size_t)(row - MPR) * D) : X + (size_t)row * D;
#pragma unroll
            for (int j = 0; j < 4; ++j) v[u][j] = *(const f32x4*)(xr + 4 * (lane + 64 * j)); }
#pragma unroll
        for (int u = 0; u < 2; ++u)
#pragma unroll
            for (int j = 0; j < 4; ++j) s[u] += (v[u][j][0] * v[u][j][0] + v[u][j][1] * v[u][j][1]) + (v[u][j][2] * v[u][j][2] + v[u][j][3] * v[u][j][3]);
        s[0] = wave_sum(s[0]); s[1] = wave_sum(s[1]);
#pragma unroll
        for (int u = 0; u < 2; ++u) { const int row = row0 + u; const float rstd = rsq_f(s[u] * (1.f / D) + EPS);
            const float* sh = ada + (size_t)cond_of_row(row) * NADA + ish * D; const float* sc = sh + D;
#pragma unroll
            for (int j = 0; j < 4; ++j) { const int col = 4 * (lane + 64 * j); const f32x4 g = *(const f32x4*)(gvec + col), a = *(const f32x4*)(sc + col), bb = *(const f32x4*)(sh + col);
                const f32x4 y = (v[u][j] * rstd * g) * (a + 1.f) + bb; u32x2 o; o.x = pk2(y[0], y[1]); o.y = pk2(y[2], y[3]); *(u32x2*)(H + (size_t)row * D + col) = o; } }
    }
}
__device__ __forceinline__ void final_norm_pass(const Params& P, int gw, int NGW, int lane) {
    const float* gvec = INP(31); float* X = karg_out();
    for (int row0 = 2 * gw; row0 < M; row0 += 2 * NGW) {
        f32x4 v[2][4]; float s[2] = {0.f, 0.f};
#pragma unroll
        for (int u = 0; u < 2; ++u)
#pragma unroll
            for (int j = 0; j < 4; ++j) v[u][j] = *(const f32x4*)(X + (size_t)(row0 + u) * D + 4 * (lane + 64 * j));
#pragma unroll
        for (int u = 0; u < 2; ++u)
#pragma unroll
            for (int j = 0; j < 4; ++j) s[u] += (v[u][j][0] * v[u][j][0] + v[u][j][1] * v[u][j][1]) + (v[u][j][2] * v[u][j][2] + v[u][j][3] * v[u][j][3]);
        s[0] = wave_sum(s[0]); s[1] = wave_sum(s[1]);
#pragma unroll
        for (int u = 0; u < 2; ++u) { const float rstd = rsq_f(s[u] * (1.f / D) + EPS);
#pragma unroll
            for (int j = 0; j < 4; ++j) { const int col = 4 * (lane + 64 * j); *(f32x4*)(X + (size_t)(row0 + u) * D + col) = v[u][j] * rstd * *(const f32x4*)(gvec + col); } }
    }
}
__device__ __forceinline__ void onorm_pass(const Params& P, int gw, int NGW, int lane) {
    const bf16* O = (const bf16*)(karg_ws() + WS_H); bf16* ZG = (bf16*)(karg_ws() + WS_Z + 5 * ZB); const float* dn = INP(25);
    const int dc = (lane & 7) * 16;
    for (int row0 = 2 * gw; row0 < M; row0 += 2 * NGW) {
        u32x4 a[2][2], z[2][2];
#pragma unroll
        for (int u = 0; u < 2; ++u) { const size_t o = (size_t)(row0 + u) * D + lane * 16;
            a[u][0] = *(const u32x4*)(O + o); a[u][1] = *(const u32x4*)(O + o + 8); z[u][0] = *(const u32x4*)(ZG + o); z[u][1] = *(const u32x4*)(ZG + o + 8); }
#pragma unroll
        for (int u = 0; u < 2; ++u) { const size_t o = (size_t)(row0 + u) * D + lane * 16;
            float v[16], zz[16]; unpack8(a[u][0], v); unpack8(a[u][1], v + 8); unpack8(z[u][0], zz); unpack8(z[u][1], zz + 8);
            float s = 0.f;
#pragma unroll
            for (int e = 0; e < 16; ++e) s += v[e] * v[e];
            s = red8(s);
            const float rstd = rsq_f(s * (1.f / 128.f) + EPS);
#pragma unroll
            for (int e = 0; e < 16; ++e) v[e] = v[e] * rstd * dn[dc + e] * zz[e];
            *(bf16x8*)(ZG + o) = pack8(v[0], v[1], v[2], v[3], v[4], v[5], v[6], v[7]); *(bf16x8*)(ZG + o + 8) = pack8(v[8], v[9], v[10], v[11], v[12], v[13], v[14], v[15]); }
    }
}

constexpr int SS_TAIL = 530;
constexpr int RG_SPLIT = 8;
constexpr size_t WS_HCARRY = 917504;
__device__ __forceinline__ void rglru_task(const Params& P, LAS unsigned char* lds, int b, int n, int qd, int tid, int t0, int t1) {
    const int lane = tid & 63, wave = tid >> 6;
    LAS bf16* xcA = (LAS bf16*)lds;
    LAS float* xcf = (LAS float*)(lds + 34816);
    LAS float* rb = (LAS float*)(lds + 51200);
    LAS float* ib = (LAS float*)(lds + 67584);
    LAS float* segA = (LAS float*)(lds + 83968);
    LAS float* segB = (LAS float*)(lds + 86016);
    LAS float* hc = (LAS float*)(lds + 88064);
    LAS float* cw = (LAS float*)(lds + 88192);
    LAS bf16* rawt = (LAS bf16*)(lds + 90752);
    bf16* XR = (bf16*)(karg_ws() + WS_Z); bf16* GR = (bf16*)(karg_ws() + WS_Z + ZB);
    const bf16* WRG = (const bf16*)(karg_ws() + WS_WRG);
    const int cb0 = n * 128, oc0 = cb0 + qd * 32;
    const bool prompt = b >= 0;
    for (int i = tid; i < 640; i += NTHR) cw[i] = i < 512 ? INP(15)[(size_t)(i >> 7) * D + cb0 + (i & 127)] : INP(16)[cb0 + (i - 512)];
    if (tid < 32) hc[tid] = t0 > 0 ? ((const float*)(karg_ws() + WS_HCARRY))[(size_t)b * D + oc0 + tid] : 0.f;
    const int tb = wave & 3, cbk = wave >> 2;
    bf16x8 Bf[8];
    { const bf16* wrow = WRG + (size_t)(n * 256 + cbk * 128 + qd * 32 + (lane & 31)) * 128 + (lane >> 5) * 8;
#pragma unroll
      for (int ks = 0; ks < 8; ++ks) Bf[ks] = *(const bf16x8*)(wrow + ks * 16); }
    const float gbias = INP(cbk ? 20 : 18)[oc0 + (lane & 31)];
    const int ch = tid & 31, seg = tid >> 5;
    const float sp = softplus_f(-INP(21)[oc0 + ch]);
    float hlast = 0.f;
    u32x4 pre[5];
#define RG_RAW_LOAD(tile_) do { _Pragma("unroll") for (int i = 0; i < 5; ++i) { const int q = tid + 512 * i, row = q >> 4, c16 = q & 15, tl = (tile_) * 128 - 3 + row; \
        pre[i] = (q < 131 * 16 && tl >= 0) ? *(const u32x4*)(XR + ((size_t)b * SEQ + tl) * D + cb0 + c16 * 8) : (u32x4){0u, 0u, 0u, 0u}; } } while (0)
#define RG_RAW_STORE() do { _Pragma("unroll") for (int i = 0; i < 5; ++i) { const int q = tid + 512 * i; if (q < 131 * 16) *(LAS u32x4*)(rawt + (q >> 4) * 136 + (q & 15) * 8) = pre[i]; } } while (0)
    if (prompt) { RG_RAW_LOAD(t0); RG_RAW_STORE(); }
    __syncthreads();
    const int ntiles = t1;
    for (int tile = t0; tile < ntiles; ++tile) {
        const int row0 = prompt ? b * SEQ + tile * 128 : MPR;
        if (prompt && tile + 1 < ntiles) RG_RAW_LOAD(tile + 1);
        { const int t = tid >> 2, cq = tid & 3, c0 = cq * 32;
#pragma unroll 2
          for (int q = 0; q < 4; ++q) {
              const int cc = c0 + q * 8;
              float a[8];
#pragma unroll
              for (int e = 0; e < 8; ++e) a[e] = cw[512 + cc + e];
#pragma unroll
              for (int j = 0; j < 4; ++j) {
                  if (prompt || j == 3) {
                      {
                          const u32x4 u = prompt ? *(const LAS u32x4*)(rawt + (t + j) * 136 + cc) : *(const u32x4*)(XR + (size_t)(MPR + t) * D + cb0 + cc);
                          const float x8[8] = {bflo(u.x), bfhi(u.x), bflo(u.y), bfhi(u.y), bflo(u.z), bfhi(u.z), bflo(u.w), bfhi(u.w)};
#pragma unroll
                          for (int e = 0; e < 8; ++e) a[e] += x8[e] * cw[j * 128 + cc + e];
                      }
                  } else {
                      const float* p = INP(5) + ((size_t)t * 3 + j) * D + cb0 + cc;
                      const f32x4 u0 = *(const f32x4*)p, u1 = *(const f32x4*)(p + 4);
#pragma unroll
                      for (int e = 0; e < 4; ++e) { a[e] += u0[e] * cw[j * 128 + cc + e]; a[4 + e] += u1[e] * cw[j * 128 + cc + 4 + e]; }
                  }
              }
              u32x4 w; w.x = pk2(a[0], a[1]); w.y = pk2(a[2], a[3]); w.z = pk2(a[4], a[5]); w.w = pk2(a[6], a[7]);
              *(LAS u32x4*)(xcA + t * 136 + cc) = w;
              if (cq == qd) { *(LAS f32x4*)(xcf + t * 32 + q * 8) = (f32x4){a[0], a[1], a[2], a[3]}; *(LAS f32x4*)(xcf + t * 32 + q * 8 + 4) = (f32x4){a[4], a[5], a[6], a[7]}; }
          }
        }
        __syncthreads();
        { f32x16 c;
#pragma unroll
          for (int r = 0; r < 16; ++r) c[r] = 0.f;
          const LAS bf16* ap = xcA + (tb * 32 + (lane & 31)) * 136 + (lane >> 5) * 8;
#pragma unroll
          for (int ks = 0; ks < 8; ++ks) { const bf16x8 af = *(const LAS bf16x8*)(ap + ks * 16); c = __builtin_amdgcn_mfma_f32_32x32x16_bf16(af, Bf[ks], c, 0, 0, 0); }
          LAS float* dst = cbk ? ib : rb;
#pragma unroll
          for (int r = 0; r < 16; ++r) { const int tok = tb * 32 + (r & 3) + 8 * (r >> 2) + 4 * (lane >> 5); dst[tok * 32 + (lane & 31)] = sigmoid_f(c[r] + gbias); }
        }
        __syncthreads();
        float Aacc = 1.f, h = 0.f;
#pragma unroll 4
        for (int e = 0; e < 8; ++e) { const int t = seg * 8 + e;
            const float r = rb[t * 32 + ch], ig = ib[t * 32 + ch], x = xcf[t * 32 + ch];
            const float la = -8.f * r * sp; const float a = __expf(la);
            const float x2 = 2.f * la, ser = -x2 * (1.f + x2 * (0.5f + x2 * (0.16666667f + x2 * (0.041666668f + x2 * (0.0083333338f + x2 * 0.0013888889f)))));
            float mult = __builtin_amdgcn_sqrtf(x2 > -0.3f ? ser : 1.f - a * a);
            if (prompt && tile == 0 && t == 0) mult = 1.f;
            const float bt = mult * ig * x;
            rb[t * 32 + ch] = a; ib[t * 32 + ch] = bt;
            h = a * h + bt; Aacc *= a;
        }
        float hin = 0.f;
        if (prompt) {
            segA[seg * 32 + ch] = Aacc; segB[seg * 32 + ch] = h;
            __syncthreads();
            hin = hc[ch];
            float sa[15], sb[15];
#pragma unroll
            for (int s = 0; s < 15; ++s) { sa[s] = segA[s * 32 + ch]; sb[s] = segB[s * 32 + ch]; }
#pragma unroll
            for (int s = 0; s < 15; ++s) hin = s < seg ? sa[s] * hin + sb[s] : hin;
        }
        h = hin;
        { float gr[8], h0v[8];
#pragma unroll
          for (int e = 0; e < 8; ++e) { const int t = seg * 8 + e; gr[e] = bf2f(GR[(size_t)(row0 + t) * D + oc0 + ch]); h0v[e] = prompt ? 0.f : INP(4)[(size_t)t * D + oc0 + ch]; }
#pragma unroll
          for (int e = 0; e < 8; ++e) { const int t = seg * 8 + e;
              const float a = rb[t * 32 + ch], bt = ib[t * 32 + ch];
              if (prompt) h = a * h + bt; else h = a * h0v[e] + bt;
              GR[(size_t)(row0 + t) * D + oc0 + ch] = (bf16)f2bf(h * gr[e]);
              if (!prompt) { karg_out()[O_HS + (size_t)t * D + oc0 + ch] = h;
                  const float* cs = INP(5) + (size_t)t * 3 * D + oc0 + ch; float* co = karg_out() + O_CRS + (size_t)t * 3 * D + oc0 + ch;
                  co[0] = cs[D]; co[D] = cs[2 * D]; co[2 * D] = bf2f(XR[(size_t)(MPR + t) * D + oc0 + ch]); }
          } }
        hlast = h;
        if (prompt && tile + 1 < ntiles) RG_RAW_STORE();
        __syncthreads();
        if (prompt && seg == 15) hc[ch] = hlast;
    }
    if (prompt && seg == 15) { if (t1 == 16) karg_out()[O_HP + (size_t)b * D + oc0 + ch] = hlast; else ((float*)(karg_ws() + WS_HCARRY))[(size_t)b * D + oc0 + ch] = hlast; }
    __syncthreads();
}

constexpr size_t WS_TINV = WS_WIN, WS_ATT = WS_WIN + 8 * MiB, WS_GC = WS_CB, WS_BETA = 47 * MiB + 65536;
static_assert(WS_ABL + (size_t)M * 16 * 4 <= WS_BETA && WS_BETA + 64 * 2048 * 4 <= WS_H, "ws map (beta)");
__device__ __forceinline__ int perm16(int e) { return (e & ~12) | ((e >> 1) & 4) | ((e << 1) & 8); }

__device__ __forceinline__ void conv8(const bf16* p, int tl, const LAS float* w, float* a) {
#pragma unroll
    for (int e = 0; e < 8; ++e) a[e] = 0.f;
#pragma unroll
    for (int j = 0; j < 4; ++j) {
        const bool ok = tl - 3 + j >= 0;
        const u32x4 u = *(const u32x4*)(ok ? p - (ptrdiff_t)(3 - j) * D : p);
        f32x4 w0 = *(const LAS f32x4*)(w + j * 128), w1 = *(const LAS f32x4*)(w + j * 128 + 4);
        if (!ok) { w0 = (f32x4){0.f, 0.f, 0.f, 0.f}; w1 = w0; }
        a[0] += bflo(u.x) * w0[0]; a[1] += bfhi(u.x) * w0[1]; a[2] += bflo(u.y) * w0[2]; a[3] += bfhi(u.y) * w0[3];
        a[4] += bflo(u.z) * w1[0]; a[5] += bfhi(u.z) * w1[1]; a[6] += bflo(u.w) * w1[2]; a[7] += bfhi(u.w) * w1[3];
    }
#pragma unroll
    for (int e = 0; e < 8; ++e) a[e] = silu_f(a[e]);
}

__device__ __forceinline__ void conv8h(const bf16* p, const bf16* halo, int nloc, const LAS float* w, float* a) {
#pragma unroll
    for (int e = 0; e < 8; ++e) a[e] = 0.f;
#pragma unroll
    for (int j = 0; j < 4; ++j) {
        const int r = nloc - 3 + j;
        const u32x4 u = *(const u32x4*)(r >= 0 ? p - (ptrdiff_t)(3 - j) * D : halo + (r + 3) * D);
        const f32x4 w0 = *(const LAS f32x4*)(w + j * 128), w1 = *(const LAS f32x4*)(w + j * 128 + 4);
        a[0] += bflo(u.x) * w0[0]; a[1] += bfhi(u.x) * w0[1]; a[2] += bflo(u.y) * w0[2]; a[3] += bfhi(u.y) * w0[3];
        a[4] += bflo(u.z) * w1[0]; a[5] += bfhi(u.z) * w1[1]; a[6] += bflo(u.w) * w1[2]; a[7] += bfhi(u.w) * w1[3];
    }
#pragma unroll
    for (int e = 0; e < 8; ++e) a[e] = silu_f(a[e]);
}
__device__ __forceinline__ void delta_prep_wave(const Params& P, LAS unsigned char* lds, int idx, int wave, int lane) {
    const int bh = idx >> 5, b = bh >> 3, h = bh & 7, span = idx & 31, n = lane & 31, hh = lane >> 5;
    const LAS float* wq = (const LAS float*)lds; const LAS float* wk = wq + 512; const LAS float* wv = wq + 1024;
    LAS float* Lm = (LAS float*)(lds + 6144 + wave * 10240);
    LAS float* gcs = Lm + 2 * 1152; LAS float* bts = gcs + 64;
    const bf16* Qb = (const bf16*)(karg_ws() + WS_Z + 2 * ZB); bf16* Kb = (bf16*)(karg_ws() + WS_Z + 3 * ZB); bf16* Vb = (bf16*)(karg_ws() + WS_Z + 4 * ZB);
    bf16* QT = (bf16*)(karg_ws() + WS_H);
    const bf16* HK = (const bf16*)((const unsigned char*)karg_out() + OSB_HK) + (size_t)(b * 32 + span) * 3 * D + h * 128;
    const bf16* HV = (const bf16*)((const unsigned char*)karg_out() + OSB_HV) + (size_t)(b * 32 + span) * 3 * D + h * 128;
    const float* ABL = (const float*)(karg_ws() + WS_ABL);
    bf16* TINV = (bf16*)(karg_ws() + WS_TINV); bf16* ATT = (bf16*)(karg_ws() + WS_ATT);
    { const size_t row = (size_t)b * SEQ + span * 64 + lane;
      float g = -__expf(INP(23)[h]) * softplus_f(ABL[row * 16 + h] + INP(24)[h]); const float be = sigmoid_f(ABL[row * 16 + 8 + h]);
#pragma unroll
      for (int off = 1; off < 32; off <<= 1) { const float t = __shfl_up(g, off); if (n >= off) g += t; }
      gcs[lane] = g; bts[lane] = be;
      ((float*)(karg_ws() + WS_GC))[(size_t)bh * SEQ + span * 64 + lane] = g; ((float*)(karg_ws() + WS_BETA))[(size_t)bh * SEQ + span * 64 + lane] = be; }
    LAS float* nks = bts + 64; LAS float* nqs = nks + 64;
#pragma unroll 1
    for (int it = 7; it >= 0; --it) {
        const int nloc = it * 8 + (lane >> 3), tl = span * 64 + nloc, d0 = (lane & 7) * 16; const size_t ro = ((size_t)b * SEQ + tl) * D + h * 128 + d0;
        float kv[16], qv[16], vv[16];
        conv8h(Kb + ro, HK + d0, nloc, wk + d0, kv); conv8h(Kb + ro + 8, HK + d0 + 8, nloc, wk + d0 + 8, kv + 8);
        conv8(Qb + ro, tl, wq + d0, qv); conv8(Qb + ro + 8, tl, wq + d0 + 8, qv + 8);
        conv8h(Vb + ro, HV + d0, nloc, wv + d0, vv); conv8h(Vb + ro + 8, HV + d0 + 8, nloc, wv + d0 + 8, vv + 8);
        float ssk = 0.f, ssq = 0.f;
#pragma unroll
        for (int e = 0; e < 16; ++e) { ssk += kv[e] * kv[e]; ssq += qv[e] * qv[e]; }
        ssk = red8(ssk); ssq = red8(ssq);
        if ((lane & 7) == 0) { const float nkj = rsq_f(ssk + EPS), nqj = 0.08838834764831845f * rsq_f(ssq + EPS); nks[nloc] = nkj; nqs[nloc] = nqj;
            ((float*)((unsigned char*)karg_out() + OSB_NK))[(size_t)bh * SEQ + tl] = nkj; ((float*)((unsigned char*)karg_out() + OSB_NQ))[(size_t)bh * SEQ + tl] = nqj; }
        *(bf16x8*)(Kb + ro) = pack8(kv[0], kv[1], kv[2], kv[3], kv[4], kv[5], kv[6], kv[7]); *(bf16x8*)(Kb + ro + 8) = pack8(kv[8], kv[9], kv[10], kv[11], kv[12], kv[13], kv[14], kv[15]);
        *(bf16x8*)(QT + ro) = pack8(qv[0], qv[1], qv[2], qv[3], qv[4], qv[5], qv[6], qv[7]); *(bf16x8*)(QT + ro + 8) = pack8(qv[8], qv[9], qv[10], qv[11], qv[12], qv[13], qv[14], qv[15]);
        *(bf16x8*)(Vb + ro) = pack8(vv[0], vv[1], vv[2], vv[3], vv[4], vv[5], vv[6], vv[7]); *(bf16x8*)(Vb + ro + 8) = pack8(vv[8], vv[9], vv[10], vv[11], vv[12], vv[13], vv[14], vv[15]);
    }
    asm volatile("s_waitcnt vmcnt(0)" ::: "memory"); __builtin_amdgcn_fence(__ATOMIC_ACQUIRE, "agent");
#pragma unroll 1
    for (int tile = 0; tile < 2; ++tile) {
        const int tl = span * 64 + tile * 32 + n; const size_t ro = ((size_t)b * SEQ + tl) * D + h * 128 + 8 * hh;
        f32x16 ckk, cqk;
#pragma unroll
        for (int r = 0; r < 16; ++r) { ckk[r] = 0.f; cqk[r] = 0.f; }
#pragma unroll
        for (int s8 = 0; s8 < 8; ++s8) {
            const bf16x8 kf = *(const bf16x8*)(Kb + ro + 16 * s8), qf = *(const bf16x8*)(QT + ro + 16 * s8);
            ckk = __builtin_amdgcn_mfma_f32_32x32x16_bf16(kf, kf, ckk, 0, 0, 0); cqk = __builtin_amdgcn_mfma_f32_32x32x16_bf16(qf, kf, cqk, 0, 0, 0);
        }
        const float nkj = nks[tile * 32 + n];
        const float gcj = gcs[tile * 32 + n];
        bf16* att = ATT + ((size_t)bh * 64 + span * 2 + tile) * 1024 + perm16(n);
#pragma unroll
        for (int r = 0; r < 16; ++r) { const int i = (r & 3) + 8 * (r >> 2) + 4 * hh;
            const float dm = i >= n ? __expf(gcs[tile * 32 + i] - gcj) * nkj : 0.f;
            Lm[tile * 1152 + i * 36 + n] = i > n ? bts[tile * 32 + i] * nks[tile * 32 + i] * ckk[r] * dm : 0.f;
            att[i * 32] = (bf16)f2bf(nqs[tile * 32 + i] * cqk[r] * dm); }
    }
    LDS_WAIT(); asm volatile("" ::: "memory");
    { int loff = hh * 1152;
      float x[32];
#pragma unroll
      for (int i = 0; i < 32; ++i) { float sacc = (i == n) ? 1.f : 0.f;
          const LAS float* Lb = Lm + loff;
#pragma unroll
          for (int j4 = 0; j4 < (i + 3) / 4; ++j4) { const f32x4 l = *(const LAS f32x4*)(Lb + i * 36 + 4 * j4);
#pragma unroll
              for (int jj = 0; jj < 4; ++jj) if (4 * j4 + jj < i) sacc -= l[jj] * x[4 * j4 + jj]; }
          x[i] = sacc;
          if ((i & 1) == 1) asm volatile("" : "+v"(loff) : "v"(sacc)); }
      bf16* ti = TINV + ((size_t)bh * 64 + span * 2 + hh) * 1024 + perm16(n);
#pragma unroll
      for (int i = 0; i < 32; ++i) ti[i * 32] = (bf16)f2bf(x[i]); }
    LDS_WAIT(); asm volatile("" ::: "memory");
}

constexpr int DR_KB = 0, DR_QD = 8704, DR_KDT = 17408, DR_TI = 27648, DR_AT = 30208, DR_VB = 32768, DR_EGL = 49664, DR_BUF = 49680;
struct DeltaPre { u32x4 k0, k1, q0, q1, v0, v1, tia; float gct, gl, bet, nk, nq; };
__device__ __forceinline__ void delta_pre_load(int b, int h, int c, int pt, DeltaPre& dp) {
    const int bh = b * 8 + h, tt = pt >> 3, d0 = (pt & 7) * 16; const size_t t = (size_t)bh * SEQ + c * 32 + tt;
    const size_t ro = ((size_t)b * SEQ + c * 32 + tt) * D + h * 128 + d0;
    const bf16* Kt = (const bf16*)(karg_ws() + WS_Z + 3 * ZB) + ro; const bf16* Qt = (const bf16*)(karg_ws() + WS_H) + ro; const bf16* Vt = (const bf16*)(karg_ws() + WS_Z + 4 * ZB) + ro;
    dp.k0 = *(const u32x4*)Kt; dp.k1 = *(const u32x4*)(Kt + 8); dp.q0 = *(const u32x4*)Qt; dp.q1 = *(const u32x4*)(Qt + 8); dp.v0 = *(const u32x4*)Vt; dp.v1 = *(const u32x4*)(Vt + 8);
    const float* GC = (const float*)(karg_ws() + WS_GC);
    dp.gct = GC[t]; dp.gl = GC[(size_t)bh * SEQ + c * 32 + 31]; dp.bet = ((const float*)(karg_ws() + WS_BETA))[t];
    dp.nk = ((const float*)((const unsigned char*)karg_out() + OSB_NK))[t]; dp.nq = ((const float*)((const unsigned char*)karg_out() + OSB_NQ))[t];
    dp.tia = *(const u32x4*)((const bf16*)(karg_ws() + (pt < 128 ? WS_TINV : WS_ATT)) + ((size_t)bh * 64 + c) * 1024 + (pt & 127) * 8);
}
__device__ __forceinline__ void delta_rec_stage(LAS unsigned char* buf, int pt, const DeltaPre& dp) {
    const int tt = pt >> 3, dg = pt & 7, d0 = dg * 16;
    { LAS bf16* dst = (LAS bf16*)(buf + (pt < 128 ? DR_TI : DR_AT)) + ((pt & 127) >> 2) * 40 + (pt & 3) * 8; *(LAS u32x4*)dst = dp.tia; }
    if (pt == 0) *(LAS float*)(buf + DR_EGL) = __expf(dp.gl);
    const float eg = __expf(dp.gct), ekd = __expf(dp.gl - dp.gct);
    const float fq = dp.nq * eg, fkb = dp.nk * dp.bet * eg, fkd = dp.nk * ekd, bet = dp.bet;
    float k[16], q[16], v[16];
    unpack8(dp.k0, k); unpack8(dp.k1, k + 8); unpack8(dp.q0, q); unpack8(dp.q1, q + 8); unpack8(dp.v0, v); unpack8(dp.v1, v + 8);
    LAS bf16* KB = (LAS bf16*)(buf + DR_KB) + tt * 136 + d0; LAS bf16* QD = (LAS bf16*)(buf + DR_QD) + tt * 136 + d0;
    *(LAS bf16x8*)KB = pack8(k[0] * fkb, k[1] * fkb, k[2] * fkb, k[3] * fkb, k[8] * fkb, k[9] * fkb, k[10] * fkb, k[11] * fkb);
    *(LAS bf16x8*)(KB + 8) = pack8(k[4] * fkb, k[5] * fkb, k[6] * fkb, k[7] * fkb, k[12] * fkb, k[13] * fkb, k[14] * fkb, k[15] * fkb);
    *(LAS bf16x8*)QD = pack8(q[0] * fq, q[1] * fq, q[2] * fq, q[3] * fq, q[8] * fq, q[9] * fq, q[10] * fq, q[11] * fq);
    *(LAS bf16x8*)(QD + 8) = pack8(q[4] * fq, q[5] * fq, q[6] * fq, q[7] * fq, q[12] * fq, q[13] * fq, q[14] * fq, q[15] * fq);
    LAS bf16* KDT = (LAS bf16*)(buf + DR_KDT) + d0 * 40 + perm16(tt);
#pragma unroll
    for (int e = 0; e < 16; ++e) KDT[e * 40] = (bf16)f2bf(k[e] * fkd);
    LAS float* VB = (LAS float*)(buf + DR_VB) + tt * 132 + d0;
#pragma unroll
    for (int e4 = 0; e4 < 4; ++e4) *(LAS f32x4*)(VB + 4 * e4) = (f32x4){v[4 * e4] * bet, v[4 * e4 + 1] * bet, v[4 * e4 + 2] * bet, v[4 * e4 + 3] * bet};
}

constexpr int DR_OB = 2 * DR_BUF;
static_assert(DR_OB + 2 * 32 * 132 * 4 <= LDS_BYTES - 64, "delta recurrence LDS map");
__device__ __forceinline__ void delta_out_norm(const LAS float* ob, int pt, const float* dn16, const u32x4 z0, const u32x4 z1, bf16* dst) {
    const LAS float* p = ob + (pt >> 3) * 132 + (pt & 7) * 16;
    float o[16], z[16];
#pragma unroll
    for (int e4 = 0; e4 < 4; ++e4) { const f32x4 t = *(const LAS f32x4*)(p + 4 * e4); o[4 * e4] = t[0]; o[4 * e4 + 1] = t[1]; o[4 * e4 + 2] = t[2]; o[4 * e4 + 3] = t[3]; }
    float ss = 0.f;
#pragma unroll
    for (int e = 0; e < 16; ++e) ss += o[e] * o[e];
    ss = red8(ss);
    const float rstd = rsq_f(ss * (1.f / 128.f) + EPS);
    unpack8(z0, z); unpack8(z1, z + 8);
#pragma unroll
    for (int e = 0; e < 16; ++e) o[e] = o[e] * rstd * dn16[e] * z[e];
    *(bf16x8*)dst = pack8(o[0], o[1], o[2], o[3], o[4], o[5], o[6], o[7]); *(bf16x8*)(dst + 8) = pack8(o[8], o[9], o[10], o[11], o[12], o[13], o[14], o[15]);
}
__device__ __forceinline__ void delta_rec_task(const Params& P, LAS unsigned char* lds, int b, int h, int tid) {
    const int lane = tid & 63, wave = tid >> 6, n = lane & 31, hh = lane >> 5, bh = b * 8 + h, pt = tid - 256;
    const bool producer = wave >= 4;
    constexpr int NC = SEQ / 32;
    f32x16 S[4];
#pragma unroll
    for (int kb = 0; kb < 4; ++kb)
#pragma unroll
        for (int r = 0; r < 16; ++r) S[kb][r] = 0.f;
    DeltaPre dcur, dnxt;
    if (producer) { delta_pre_load(b, h, 0, pt, dcur); delta_pre_load(b, h, 1, pt, dnxt); delta_rec_stage(lds, pt, dcur); dcur = dnxt; }
    __syncthreads();
    if (producer) {
        const int pt = opq(tid) - 256;
        float dn16[16];
#pragma unroll
        for (int e = 0; e < 16; ++e) dn16[e] = INP(25)[(pt & 7) * 16 + e];
        bf16* zgp = (bf16*)(karg_ws() + WS_Z + 5 * ZB) + ((size_t)b * SEQ + (pt >> 3)) * D + h * 128 + (pt & 7) * 16;
        u32x4 zc0 = {0u, 0u, 0u, 0u}, zc1 = zc0, zn0, zn1;
#define DR_BAR() do { asm volatile("s_waitcnt lgkmcnt(0)" ::: "memory"); __builtin_amdgcn_s_barrier(); asm volatile("" ::: "memory"); } while (0)
        for (int c = 0; c < NC; ++c) {
            if (c > 0) { dcur = dnxt; zc0 = zn0; zc1 = zn1; }
            if (c + 2 < NC) delta_pre_load(b, h, c + 2, pt, dnxt);
            zn0 = *(const u32x4*)(zgp + (size_t)c * 32 * D); zn1 = *(const u32x4*)(zgp + (size_t)c * 32 * D + 8);
            if (c + 1 < NC) delta_rec_stage(lds + ((c + 1) & 1) * DR_BUF, pt, dcur);
            if (c > 0) delta_out_norm((const LAS float*)(lds + DR_OB) + ((c - 1) & 1) * 32 * 132, pt, dn16, zc0, zc1, zgp + (size_t)(c - 1) * 32 * D);
            DR_BAR();
        }
        delta_out_norm((const LAS float*)(lds + DR_OB) + ((NC - 1) & 1) * 32 * 132, pt, dn16, zn0, zn1, zgp + (size_t)(NC - 1) * 32 * D);
    } else {
        const int lane = opq(tid) & 63, n = lane & 31, hh = lane >> 5;
        for (int c = 0; c < NC; ++c) {
            LAS unsigned char* buf = lds + (c & 1) * DR_BUF;
            const int vb = wave;
            bf16x8 SB[8];
#pragma unroll
            for (int s = 0; s < 8; ++s) { const int kb = s >> 1, o = 8 * (s & 1); SB[s] = pack8(S[kb][o], S[kb][o + 1], S[kb][o + 2], S[kb][o + 3], S[kb][o + 4], S[kb][o + 5], S[kb][o + 6], S[kb][o + 7]); }
            f32x16 X1, P1;
#pragma unroll
            for (int r = 0; r < 16; ++r) { X1[r] = 0.f; P1[r] = 0.f; }
            const LAS bf16* KB = (const LAS bf16*)(buf + DR_KB) + n * 136 + 8 * hh; const LAS bf16* QD = (const LAS bf16*)(buf + DR_QD) + n * 136 + 8 * hh;
#pragma unroll
            for (int s = 0; s < 8; ++s) { X1 = __builtin_amdgcn_mfma_f32_32x32x16_bf16(*(const LAS bf16x8*)(KB + 16 * s), SB[s], X1, 0, 0, 0);
                P1 = __builtin_amdgcn_mfma_f32_32x32x16_bf16(*(const LAS bf16x8*)(QD + 16 * s), SB[s], P1, 0, 0, 0); }
            const LAS float* VB = (const LAS float*)(buf + DR_VB) + 32 * vb + n;
            float Y[16];
#pragma unroll
            for (int r = 0; r < 16; ++r) Y[r] = VB[((r & 3) + 8 * (r >> 2) + 4 * hh) * 132] - X1[r];
            const bf16x8 YB0 = pack8(Y[0], Y[1], Y[2], Y[3], Y[4], Y[5], Y[6], Y[7]), YB1 = pack8(Y[8], Y[9], Y[10], Y[11], Y[12], Y[13], Y[14], Y[15]);
            f32x16 VN;
#pragma unroll
            for (int r = 0; r < 16; ++r) VN[r] = 0.f;
            const LAS bf16* TI = (const LAS bf16*)(buf + DR_TI) + n * 40 + 8 * hh; const LAS bf16* AT = (const LAS bf16*)(buf + DR_AT) + n * 40 + 8 * hh;
            VN = __builtin_amdgcn_mfma_f32_32x32x16_bf16(*(const LAS bf16x8*)TI, YB0, VN, 0, 0, 0);
            VN = __builtin_amdgcn_mfma_f32_32x32x16_bf16(*(const LAS bf16x8*)(TI + 16), YB1, VN, 0, 0, 0);
            const bf16x8 VB0 = pack8(VN[0], VN[1], VN[2], VN[3], VN[4], VN[5], VN[6], VN[7]), VB1 = pack8(VN[8], VN[9], VN[10], VN[11], VN[12], VN[13], VN[14], VN[15]);
            P1 = __builtin_amdgcn_mfma_f32_32x32x16_bf16(*(const LAS bf16x8*)AT, VB0, P1, 0, 0, 0);
            P1 = __builtin_amdgcn_mfma_f32_32x32x16_bf16(*(const LAS bf16x8*)(AT + 16), VB1, P1, 0, 0, 0);
            const float egl = *(const LAS float*)(buf + DR_EGL);
            const LAS bf16* KDT = (const LAS bf16*)(buf + DR_KDT) + n * 40 + 8 * hh;
#pragma unroll
            for (int kb = 0; kb < 4; ++kb) {
#pragma unroll
                for (int r = 0; r < 16; ++r) S[kb][r] *= egl;
                S[kb] = __builtin_amdgcn_mfma_f32_32x32x16_bf16(*(const LAS bf16x8*)(KDT + kb * 32 * 40), VB0, S[kb], 0, 0, 0);
                S[kb] = __builtin_amdgcn_mfma_f32_32x32x16_bf16(*(const LAS bf16x8*)(KDT + kb * 32 * 40 + 16), VB1, S[kb], 0, 0, 0); }
            LAS float* op = (LAS float*)(lds + DR_OB) + (c & 1) * 32 * 132 + 4 * hh * 132 + 32 * vb + n;
#pragma unroll
            for (int r = 0; r < 16; ++r) op[((r & 3) + 8 * (r >> 2)) * 132] = P1[r];
            DR_BAR();
        }
    }
    if (!producer) { float* So = karg_out() + O_SP + ((size_t)bh * 128 + 4 * hh) * 128 + 32 * wave + n;
#pragma unroll
        for (int kb = 0; kb < 4; ++kb)
#pragma unroll
            for (int r = 0; r < 16; ++r) So[(size_t)(32 * kb + (r & 3) + 8 * (r >> 2)) * 128] = S[kb][r]; }
    __syncthreads();
}

template <int MODE>
__device__ __forceinline__ void delta_sample_item(const Params& P, LAS unsigned char* lds, int item, int tid) {
    LAS float* tmp = (LAS float*)lds;
    LAS float* scl = (LAS float*)(lds + 1536);
    LAS float* rpk = (LAS float*)(lds + 2048);
    LAS float* rpq = (LAS float*)(lds + 4096);
    const int bs = item >> 3, h = item & 7, lane = tid & 63, wave = tid >> 6; const size_t row = (size_t)MPR + bs;
    const bf16* Zq = (const bf16*)(karg_ws() + WS_Z + 2 * ZB);
    if (tid < 384) { const int which = tid >> 7, d = tid & 127; const int c3 = which * 1024 + h * 128 + d;
        const float raw = bf2f(Zq[(size_t)which * (ZB / 2) + row * D + h * 128 + d]);
        const float* cs = INP(7) + (size_t)bs * 3 * 3072 + c3; const float* w = INP(22) + c3;
        tmp[tid] = silu_f(cs[0] * w[0] + cs[3072] * w[3072] + cs[2 * 3072] * w[2 * 3072] + raw * w[3 * 3072]); }
    __syncthreads();
    if (wave < 3) { float s;
        if (wave == 0) s = tmp[lane] * tmp[lane] + tmp[lane + 64] * tmp[lane + 64];
        else if (wave == 1) s = tmp[128 + lane] * tmp[128 + lane] + tmp[192 + lane] * tmp[192 + lane];
        else s = tmp[lane] * tmp[128 + lane] + tmp[64 + lane] * tmp[192 + lane];
        s = wave_sum(s);
        if (lane == 0) scl[wave] = wave == 0 ? rsq_f(s + EPS) * 0.08838834764831845f : (wave == 1 ? rsq_f(s + EPS) : s); }
    __syncthreads();
    const float sq = scl[0], sk = scl[1], kq = scl[2] * sq * sk;
    const int v = tid & 127, kg = tid >> 7;
    const float* S0 = INP(6) + ((size_t)(bs * NH + h) * 128 + kg * 32) * 128 + v;
    float S[32];
#pragma unroll
    for (int j = 0; j < 32; ++j) S[j] = S0[(size_t)j * 128];
    float pk = 0.f, pq = 0.f;
#pragma unroll
    for (int j = 0; j < 32; ++j) { pk += S[j] * tmp[128 + kg * 32 + j]; pq += S[j] * tmp[kg * 32 + j]; }
    rpk[kg * 128 + v] = pk * sk; rpq[kg * 128 + v] = pq * sq;
    __syncthreads();
    pk = (rpk[v] + rpk[128 + v]) + (rpk[256 + v] + rpk[384 + v]); pq = (rpq[v] + rpq[128 + v]) + (rpq[256 + v] + rpq[384 + v]);
    const float* ABL = (const float*)(karg_ws() + WS_ABL);
    const float al = ABL[row * 16 + h], bl = ABL[row * 16 + 8 + h];
    const float dc = __expf(-__expf(INP(23)[h]) * softplus_f(al + INP(24)[h])), be = sigmoid_f(bl);
    const float delta = be * (tmp[256 + v] - dc * pk);
    if (MODE == 0) {
        const float o = dc * pq + kq * delta; const float so = wave_sum(o * o);
        if (lane == 0 && wave < 2) scl[4 + wave] = so;
        __syncthreads();
        if (kg == 0) { bf16* zp = (bf16*)(karg_ws() + WS_Z + 5 * ZB) + row * D + h * 128 + v;
            *zp = (bf16)f2bf(o * rsq_f((scl[4] + scl[5]) * (1.f / 128.f) + EPS) * INP(25)[v] * bf2f(*zp)); } }
    else { float* So = karg_out() + O_SS + ((size_t)(bs * NH + h) * 128 + kg * 32) * 128 + v;
#pragma unroll
        for (int j = 0; j < 32; ++j) So[(size_t)j * 128] = dc * S[j] + (tmp[128 + kg * 32 + j] * sk) * delta; }
    __syncthreads();
}

#define XB_TMO      128
#define XB_XCNT(j)  (256  + 64 * (j))
#define XB_XSUB(j)  (1280 + 64 * (j))
#define XB_XGEN(j)  (2304 + 64 * (j))
#define XB_TOP      3328
#define XB_TOPGEN   3392
#define XCD_BAR_WORDS 3456
#define XB_SPIN_CAP (1u << 22)
__device__ __forceinline__ unsigned xb_ld(unsigned* p)              { return __hip_atomic_load(p, __ATOMIC_RELAXED, __HIP_MEMORY_SCOPE_AGENT); }
__device__ __forceinline__ unsigned xb_add(unsigned* p, unsigned v) { return __hip_atomic_fetch_add(p, v, __ATOMIC_RELAXED, __HIP_MEMORY_SCOPE_AGENT); }
__device__ __forceinline__ unsigned xb_xcc_id() { return (unsigned)__builtin_amdgcn_s_getreg((3 << 11) | 20) & 0xFu; }
#define XB_SPIN(cond, bar) do { unsigned _sp = 0; while (cond) { __builtin_amdgcn_s_sleep(1); \
    if ((++_sp & 255u) == 0u) { if (xb_ld(&(bar)[XB_TMO])) break; if (_sp > XB_SPIN_CAP) { atomicAdd(&(bar)[XB_TMO], 1u); break; } } } } while (0)
struct XcdBarrier { unsigned* bar; unsigned x; volatile LAS unsigned* st; };
__device__ __forceinline__ XcdBarrier xcd_barrier_post(unsigned* bar, volatile LAS unsigned* st, bool leader) {
    XcdBarrier b; b.bar = bar; b.x = xb_xcc_id(); b.st = st;
    if (leader) (void)xb_add(&bar[XB_XCNT(b.x)], 1u);
    return b;
}
__device__ __forceinline__ void xcd_barrier_complete(unsigned* bar, unsigned x, unsigned& nloc, unsigned& nx) {
    const unsigned G = gridDim.x * gridDim.y * gridDim.z;
    unsigned sum, cnt, mine, sp = 0u;
    for (;;) {
        sum = 0u; cnt = 0u; mine = 0u;
#pragma unroll
        for (unsigned j = 0; j < 16; ++j) { const unsigned c = xb_ld(&bar[XB_XCNT(j)]); sum += c; cnt += (c > 0u) ? 1u : 0u; mine = (j == x) ? c : mine; }
        if (sum == G) break;
        __builtin_amdgcn_s_sleep(1);
        if ((++sp & 255u) == 0u) { if (xb_ld(&bar[XB_TMO])) break; if (sp > XB_SPIN_CAP) { atomicAdd(&bar[XB_TMO], 1u); break; } }
    }
    nloc = mine > 0u ? mine : 1u; nx = cnt > 0u ? cnt : 1u;
}
__device__ __forceinline__ void xcd_barrier(const XcdBarrier& b, bool leader) {
    asm volatile("s_waitcnt vmcnt(0)" ::: "memory");
    __syncthreads();
    if (leader) {
        unsigned* bar = b.bar;
        __builtin_amdgcn_s_waitcnt(0);
        unsigned nloc = b.st[0], nx = b.st[1];
        if (nloc == 0u) { xcd_barrier_complete(bar, b.x, nloc, nx); b.st[0] = nloc; b.st[1] = nx; }
        const unsigned old = xb_add(&bar[XB_XSUB(b.x)], 1u);
        const unsigned gen = old / nloc;
        if (old + 1u == (gen + 1u) * nloc) {
            __builtin_amdgcn_fence(__ATOMIC_RELEASE, "agent");
            asm volatile("s_waitcnt vmcnt(0)" ::: "memory");
            const unsigned og = xb_add(&bar[XB_TOP], 1u);
            const unsigned tg = og / nx;
            if (og + 1u == (tg + 1u) * nx) xb_add(&bar[XB_TOPGEN], 1u);
            else XB_SPIN(xb_ld(&bar[XB_TOPGEN]) == tg, bar);
            __builtin_amdgcn_fence(__ATOMIC_ACQUIRE, "agent");
            xb_add(&bar[XB_XGEN(b.x)], 1u);
            asm volatile("s_waitcnt vmcnt(0)" ::: "memory");
        } else {
            XB_SPIN(xb_ld(&bar[XB_XGEN(b.x)]) == gen, bar);
            __builtin_amdgcn_fence(__ATOMIC_ACQUIRE, "agent");
            asm volatile("s_waitcnt vmcnt(0)" ::: "memory");
        }
    }
    __syncthreads();
}

__global__ void __launch_bounds__(NTHR, 2) fwd_megakernel(Params P) {
    extern __shared__ __attribute__((aligned(16))) unsigned char lds_raw[];
    LAS unsigned char* lds = (LAS unsigned char*)lds_raw;
    cg::grid_group grid = cg::this_grid();
    const int wave = __builtin_amdgcn_readfirstlane((int)threadIdx.x >> 6);
#define lane opq(lane_now())
#define tid opq((wave << 6) | lane_now())
    const int G = gridDim.x, wg = blockIdx.x;
    const int gw = wg * NWAVES + wave, NGW = G * NWAVES;
    unsigned char* ws = karg_ws();
    float* ADA = (float*)(ws + WS_ADA);
    bf16* H = (bf16*)(ws + WS_H);
    bf16* Z = (bf16*)(ws + WS_Z);
    bf16* ACT = (bf16*)(ws + WS_ACT);
    bf16* MG = (bf16*)(karg_out() + O_SS);
    volatile LAS unsigned* MISC = (volatile LAS unsigned*)(lds + LDS_BYTES - 64);
    if (tid < 16) MISC[tid] = 0u;
    __syncthreads();
    const XcdBarrier xbar = xcd_barrier_post((unsigned*)ws, MISC, wave == 0 && lane_now() == 0);
#define GBAR() xcd_barrier(xbar, wave == 0 && lane_now() == 0)

    if constexpr ((PHM >> 0) & 1) {
    prologue<0>(P, lds, gw, NGW, wave, lane);
    }
    GBAR();
    if constexpr ((PHM >> 1) & 1) {
    { pg8::Gemm g{(const bf16*)(ws + WS_CB), (const bf16*)(ws + WS_WADA), nullptr, nullptr, D}; pg8::StaticOrder S; S.init(256, NADA, G, wg);
      EpiAda E{ADA, INP(9)}; pg8::gemm_phase(lds, g, S, E, wave);
      if (wg >= 36) prologue<1>(P, lds, (wg - 36) * NWAVES + wave, (G - 36) * NWAVES, wave, lane); }
    }
    GBAR();
    if constexpr ((PHM >> 2) & 1) {
    norm_mod_pass<0>(P, INP(10), 0, gw, NGW, lane);
    { const int gt = wg * NTHR + tid;
      if (gt < 2 * NB * 3 * (D / 8)) { const int m = gt / (NB * 3 * (D / 8)), r = gt % (NB * 3 * (D / 8)), c8 = r & 127, j = (r >> 7) % 3, bb = (r >> 7) / 3;
          *(u32x4*)((bf16*)((unsigned char*)karg_out() + (m ? OSB_HV : OSB_HK)) + ((size_t)(bb * 32) * 3 + j) * D + c8 * 8) = (u32x4){0u, 0u, 0u, 0u}; } }
    }
    GBAR();
    if constexpr ((PHM >> 3) & 1) {
    { pg8::Gemm g{H, (const bf16*)(ws + WS_WUP1), nullptr, nullptr, D}; pg8::StaticOrder S; S.init(MPAD, 2 * FF, G, wg);
      EpiSwiglu E{ACT}; pg8::gemm_phase(lds, g, S, E, wave); }
    }
    GBAR();
    if constexpr ((PHM >> 4) & 1) {
    { pg8::Gemm g{ACT, (const bf16*)(ws + WS_WDN1), nullptr, nullptr, FF}; pg8::StaticOrder S; S.init(MPR, D, G, wg);
      EpiResidNorm<0> E{karg_out(), INP(0), ADA + 2 * D, 0.5f, INP(13), ADA + 3 * D, H, (float*)(ws + WS_PART), (unsigned*)(ws + WS_CNT), (LAS float*)(lds + 131072)}; pg8::gemm_phase(lds, g, S, E, wave);
      float* X = karg_out(); const float* xs = INP(1); const float* gate = ADA + 2 * D;
      mini_gemm(lds, ACT, (const bf16*)(ws + WS_WDN1), nullptr, nullptr, FF, wg, G, tid, [=](int row, int col, f32x4 v, f32x4) {
          const f32x4 xv = *(const f32x4*)(xs + (size_t)(row - MPR) * D + col), gv = *(const f32x4*)(gate + (size_t)cond_of_row(row) * NADA + col);
          *(f32x4*)(X + (size_t)row * D + col) = xv + (gv * 0.5f) * v; }); }
    }
    GBAR();
    if constexpr ((PHM >> 5) & 1) {
    sample_norm_rows<0>(INP(13), 3, gw, lane);
    }
    GBAR();
    if constexpr ((PHM >> 6) & 1) {
    { pg8::Gemm g{H, (const bf16*)(ws + WS_WIN), nullptr, nullptr, D}; pg8::StaticOrder S; S.init(MPAD, NIN, G, wg);
      EpiIn E{Z, MG, (float*)(ws + WS_ABL), karg_out()}; pg8::gemm_phase(lds, g, S, E, wave); }
    }
    GBAR();
    if constexpr ((PHM >> 7) & 1) {
        { const int bh0 = (wg * NWAVES) >> 5, h0 = bh0 & 7; LAS float* w = (LAS float*)lds; const float* cwq = INP(22);
          for (int i = tid; i < 1536; i += NTHR) { const int which = i >> 9, j = (i >> 7) & 3, d = i & 127; w[i] = cwq[(size_t)j * 3072 + which * 1024 + h0 * 128 + d]; }
          __syncthreads();
          delta_prep_wave(P, lds, gw, wave, lane);
          __syncthreads(); }
        if (G == 256) { const int task = (wg & 7) * 32 + (wg >> 3); rglru_task(P, lds, task >> 5, (task >> 2) & 7, task & 3, tid, 0, RG_SPLIT); }
        else for (int task = wg; task < 256; task += G) rglru_task(P, lds, task >> 5, (task >> 2) & 7, task & 3, tid, 0, RG_SPLIT);
    }
    GBAR();
    if constexpr ((PHM >> 7) & 1) {
        if (wg < 64) delta_rec_task(P, lds, wg >> 3, wg & 7, tid);
        else {
            if (G == 256) { const int slot = (wg - 64) >> 3;
                { const int task = (wg & 7) * 32 + slot; rglru_task(P, lds, task >> 5, (task >> 2) & 7, task & 3, tid, RG_SPLIT, 16); }
                if (slot < 8) { const int task = (wg & 7) * 32 + 24 + slot; rglru_task(P, lds, task >> 5, (task >> 2) & 7, task & 3, tid, RG_SPLIT, 16); } }
            else for (int task = wg - 64; task < 256; task += G - 64) rglru_task(P, lds, task >> 5, (task >> 2) & 7, task & 3, tid, RG_SPLIT, 16);
            if (wg < 96) rglru_task(P, lds, -1, (wg - 64) >> 2, (wg - 64) & 3, tid, 0, 1);
            if (wg >= 128) for (int item = wg - 128; item < NS * NH; item += G - 128) delta_sample_item<0>(P, lds, item, tid);
        }
    }
    GBAR();
    if constexpr ((PHM >> 9) & 1) {
    { pg8::Gemm g{Z + 1 * (ZB / 2), (const bf16*)(ws + WS_WBR), Z + 5 * (ZB / 2), (const bf16*)(ws + WS_WBR) + (size_t)D * D, D};
      pg8::PairOrder S; S.base.init(MPR, D, G, wg);
      EpiBranch E{MG, MG + ZB / 2, Z}; pg8::gemm_phase(lds, g, S, E, wave);
      const bf16* mga = MG; const bf16* mgb = MG + ZB / 2; bf16* Gm = Z;
      mini_gemm(lds, g.A0, g.B0, g.A1, g.B1, D, wg, G, tid, [=](int row, int col, f32x4 ya, f32x4 yb) {
          const size_t o = (size_t)row * D + col; const u32x2 a = *(const u32x2*)(mga + o), b = *(const u32x2*)(mgb + o);
          u32x2 w; w.x = pk2(bflo(a.x) * ya[0] + bflo(b.x) * yb[0], bfhi(a.x) * ya[1] + bfhi(b.x) * yb[1]);
          w.y = pk2(bflo(a.y) * ya[2] + bflo(b.y) * yb[2], bfhi(a.y) * ya[3] + bfhi(b.y) * yb[3]);
          *(u32x2*)(Gm + o) = w; }); }
    }
    GBAR();
    if constexpr ((PHM >> 10) & 1) {
    { pg8::Gemm g{Z, (const bf16*)(ws + WS_WOUT), nullptr, nullptr, D}; pg8::StaticOrder S; S.init(MPR, D, G, wg);
      EpiResidNorm<0> E{karg_out(), nullptr, ADA + 5 * D, 1.0f, INP(28), ADA + 6 * D, H, (float*)(ws + WS_PART) + 65536, (unsigned*)(ws + WS_CNT) + 64, (LAS float*)(lds + 131072)}; pg8::gemm_phase(lds, g, S, E, wave);
      float* X = karg_out(); const float* gate = ADA + 5 * D;
      mini_gemm(lds, Z, (const bf16*)(ws + WS_WOUT), nullptr, nullptr, D, wg, G, tid, [=](int row, int col, f32x4 v, f32x4) {
          float* xp = X + (size_t)row * D + col; const f32x4 gv = *(const f32x4*)(gate + (size_t)cond_of_row(row) * NADA + col);
          *(f32x4*)xp = *(const f32x4*)xp + gv * v; }); }
    }
    GBAR();
    if constexpr ((PHM >> 11) & 1) {
    sample_norm_rows<0>(INP(28), 6, gw, lane);
    {
        for (int item = (G == 256 ? SS_TAIL : 0) + wg; item < NS * NH; item += G) delta_sample_item<1>(P, lds, item, tid);
        const int gt = wg * NTHR + tid, NGT = G * NTHR;
        for (int i = gt; i < NS * 3 * 3072; i += NGT) { const int bs = i / 9216, j = (i / 3072) % 3, c3 = i % 3072;
            karg_out()[O_CQS + i] = j < 2 ? INP(7)[(size_t)bs * 9216 + (j + 1) * 3072 + c3] : bf2f(Z[(size_t)(2 + (c3 >> 10)) * (ZB / 2) + ((size_t)MPR + bs) * D + (c3 & 1023)]); }
    }
    }
    GBAR();
    if constexpr ((PHM >> 12) & 1) {
    { pg8::Gemm g{H, (const bf16*)(ws + WS_WUP2), nullptr, nullptr, D}; pg8::StaticOrder S; S.init(MPAD, 2 * FF, G, wg);
      EpiSwiglu E{ACT}; pg8::gemm_phase(lds, g, S, E, wave);
      if (G == 256 && wg >= 150) for (int item = wg - 150; item < SS_TAIL; item += 106) delta_sample_item<1>(P, lds, item, tid); }
    }
    GBAR();
    if constexpr ((PHM >> 13) & 1) {
    { pg8::Gemm g{ACT, (const bf16*)(ws + WS_WDN2), nullptr, nullptr, FF}; pg8::StaticOrder S; S.init(MPR, D, G, wg);
      EpiResidNorm<1> E{karg_out(), nullptr, ADA + 8 * D, 0.5f, INP(31), nullptr, nullptr, (float*)(ws + WS_PART) + 131072, (unsigned*)(ws + WS_CNT) + 128, (LAS float*)(lds + 131072)}; pg8::gemm_phase(lds, g, S, E, wave);
      float* X = karg_out(); const float* gate = ADA + 8 * D;
      mini_gemm(lds, ACT, (const bf16*)(ws + WS_WDN2), nullptr, nullptr, FF, wg, G, tid, [=](int row, int col, f32x4 v, f32x4) {
          float* xp = X + (size_t)row * D + col; const f32x4 gv = *(const f32x4*)(gate + (size_t)cond_of_row(row) * NADA + col);
          *(f32x4*)xp = *(const f32x4*)xp + (gv * 0.5f) * v; }); }
    }
    GBAR();
    if constexpr ((PHM >> 14) & 1) {
    sample_norm_rows<1>(INP(31), 0, gw, lane);
    }
}

extern "C" void kernel_launch(void* const* d_in, const int* in_sizes, int n_in, void* d_out, int out_size, void* d_ws, size_t ws_size, hipStream_t stream) {
    static int grid = 0;
    if (grid == 0) {
        if (n_in != 32 || (size_t)out_size != O_END || ws_size < WS_END) { fprintf(stderr, "kernel_launch: unexpected shapes: n_in %d out %d ws %zu (need %zu)\n", n_in, out_size, ws_size, (size_t)WS_END); grid = -1; return; }
        int dev = 0, cus = 0, per_cu = 0;
        hipGetDevice(&dev); hipDeviceGetAttribute(&cus, hipDeviceAttributeMultiprocessorCount, dev);
        if (hipFuncSetAttribute((const void*)fwd_megakernel, hipFuncAttributeMaxDynamicSharedMemorySize, LDS_BYTES) != hipSuccess) { fprintf(stderr, "kernel_launch: hipFuncSetAttribute failed\n"); grid = -1; return; }
        if (hipOccupancyMaxActiveBlocksPerMultiprocessor(&per_cu, (const void*)fwd_megakernel, NTHR, LDS_BYTES) != hipSuccess || per_cu < 1) { fprintf(stderr, "kernel_launch: occupancy query says %d\n", per_cu); per_cu = 1; }
        (void)hipGetLastError();
        grid = cus * 1;
        if (grid > 256) grid = 256;
    }
    if (grid < 0) return;
    if (hipMemsetAsync(d_ws, 0, 16384, stream) != hipSuccess) { fprintf(stderr, "kernel_launch: memset failed\n"); return; }
    Params p{};
    for (int i = 0; i < 32; ++i) p.in[i] = (const float*)d_in[i];
    p.out = (float*)d_out; p.ws = (unsigned char*)d_ws;
    void* args[] = {&p};
    hipError_t e = hipLaunchCooperativeKernel((const void*)fwd_megakernel, dim3(grid), dim3(NTHR), args, LDS_BYTES, stream);
    if (e != hipSuccess) fprintf(stderr, "kernel_launch: cooperative launch failed: %s (grid %d)\n", hipGetErrorString(e), grid);
}
```

```cpp
#include <hip/hip_runtime.h>
#include <hip/hip_cooperative_groups.h>
#include <cstdio>
#include <cstdint>
namespace cg = cooperative_groups;

#define LAS __attribute__((address_space(3)))
typedef unsigned short bf16;
typedef short bf16x8 __attribute__((ext_vector_type(8)));
typedef float f32x4 __attribute__((ext_vector_type(4)));
typedef float f32x16 __attribute__((ext_vector_type(16)));
typedef unsigned u32x4 __attribute__((ext_vector_type(4)));
typedef unsigned u32x2 __attribute__((ext_vector_type(2)));

constexpr int D = 1024, SEQ = 2048, NB = 8, MPR = NB * SEQ, NS = 128, M = MPR + NS, MPAD = 16640;
constexpr int FF = 2816, NADA = 9216, NCOND = NB + NS, NIN = 8448, NH = 8;
constexpr float EPS = 1e-6f;
constexpr int NWAVES = 8, NTHR = 512;

constexpr size_t MiB = 1u << 20;
constexpr size_t ZB = (size_t)M * D * 2;
constexpr size_t WS_WUP2 = 1 * MiB;
constexpr size_t WS_WDN2 = 12 * MiB;
constexpr size_t WS_WIN = WS_WDN2 + (size_t)D * FF * 2;
constexpr size_t WS_WBR = 34 * MiB;
constexpr size_t WS_WOUT = 38 * MiB;
constexpr size_t WS_WRG = 40 * MiB;
constexpr size_t WS_CB = WS_WRG + 512 * 1024;
constexpr size_t WS_ADA = 41 * MiB;
constexpr size_t WS_ABL = 46 * MiB;
constexpr size_t WS_H = 48 * MiB;
constexpr size_t WS_Z = WS_H + ZB;
constexpr size_t WS_ACT = WS_Z;
constexpr size_t WS_WUP1 = WS_Z + 96 * MiB;
constexpr size_t WS_WDN1 = WS_Z + 107 * MiB;
constexpr size_t WS_WADA = WS_Z + 113 * MiB;
constexpr size_t WS_END = WS_Z + 6 * ZB + 1 * MiB;
static_assert(WS_WIN + (size_t)NIN * D * 2 <= WS_WBR, "ws map");
static_assert((size_t)M * 16 * 4 <= 2 * MiB, "ws map");
static_assert((size_t)MPAD * FF * 2 <= 96 * MiB, "ws map");
static_assert(WS_WADA + (size_t)NADA * D * 2 <= WS_Z + 6 * ZB, "ws map");

constexpr size_t O_Y = 0, O_HP = (size_t)M * D, O_CRP = O_HP + NB * D, O_SP = O_CRP + NB * 3 * D, O_CQP = O_SP + (size_t)NB * NH * 128 * 128,
                 O_HS = O_CQP + NB * 3 * 3072, O_CRS = O_HS + NS * D, O_SS = O_CRS + NS * 3 * D, O_CQS = O_SS + (size_t)NS * NH * 128 * 128,
                 O_END = O_CQS + (size_t)NS * 3 * 3072;
static_assert(2 * ZB <= (O_END - O_SS) * 4, "scratch in d_out");
constexpr size_t OSB = O_SS * 4 + 2 * ZB, OSB_HK = OSB, OSB_HV = OSB + 3 * MiB / 2, OSB_NK = OSB + 3 * MiB, OSB_NQ = OSB + 7 * MiB / 2;
static_assert(OSB + 4 * MiB <= O_END * 4, "d_out scratch");

__device__ __forceinline__ unsigned pk2(float lo, float hi);
__device__ __forceinline__ unsigned f2bf(float f) { return pk2(f, f) & 0xffffu; }
typedef float f32x2_t __attribute__((ext_vector_type(2))); typedef __bf16 bf16x2_t __attribute__((ext_vector_type(2)));
__device__ __forceinline__ unsigned pk2(float lo, float hi) { f32x2_t v = {lo, hi}; bf16x2_t b = __builtin_convertvector(v, bf16x2_t); return __builtin_bit_cast(unsigned, b); }
__device__ __forceinline__ float bf2f(unsigned short b) { return __builtin_bit_cast(float, (unsigned)b << 16); }
__device__ __forceinline__ float bflo(unsigned u) { return __builtin_bit_cast(float, u << 16); }
__device__ __forceinline__ float bfhi(unsigned u) { return __builtin_bit_cast(float, u & 0xffff0000u); }
__device__ __forceinline__ float rcp_f(float x) { return __builtin_amdgcn_rcpf(x); }
__device__ __forceinline__ float rsq_f(float x) { return __builtin_amdgcn_rsqf(x); }
__device__ __forceinline__ float sigmoid_f(float x) { return rcp_f(1.f + __expf(-x)); }
__device__ __forceinline__ float neg_expm1_f(float x) {
    const float p = -x * (1.f + x * (0.5f + x * (0.16666667f + x * (0.041666668f + x * (0.0083333338f + x * 0.0013888889f)))));
    return x > -0.3f ? p : 1.f - __expf(x);
}
__device__ __forceinline__ float silu_f(float x) { return x * sigmoid_f(x); }
__device__ __forceinline__ float gelu_tanh_f(float x) { return x * sigmoid_f(1.5957691216057308f * (x + 0.044715f * x * x * x)); }
__device__ __forceinline__ float softplus_f(float x) { return x > 20.f ? x : log1pf(__expf(x)); }
template <int CTRL> __device__ __forceinline__ float dpp_f(float x) {
    return __builtin_bit_cast(float, __builtin_amdgcn_update_dpp(0, __builtin_bit_cast(int, x), CTRL, 0xF, 0xF, true));
}
__device__ __forceinline__ float red8(float x) { x += dpp_f<0xB1>(x); x += dpp_f<0x4E>(x); x += dpp_f<0x141>(x); return x; }
__device__ __forceinline__ float red16(float x) { x = red8(x); x += dpp_f<0x140>(x); return x; }
__device__ __forceinline__ float wave_sum(float v) { v = red16(v);
    return ((__builtin_bit_cast(float, __builtin_amdgcn_readlane(__builtin_bit_cast(int, v), 0)) + __builtin_bit_cast(float, __builtin_amdgcn_readlane(__builtin_bit_cast(int, v), 16))) +
            (__builtin_bit_cast(float, __builtin_amdgcn_readlane(__builtin_bit_cast(int, v), 32)) + __builtin_bit_cast(float, __builtin_amdgcn_readlane(__builtin_bit_cast(int, v), 48)))); }
__device__ __forceinline__ int lane_now();
__device__ __forceinline__ int opq(int x);
__device__ __forceinline__ float shfl_xor_l(float v, int o) { const int idx = (opq(lane_now()) ^ o) << 2; return __builtin_bit_cast(float, __builtin_amdgcn_ds_bpermute(idx, __builtin_bit_cast(int, v))); }
__device__ __forceinline__ void unpack8(const u32x4 u, float* x) { x[0] = bflo(u.x); x[1] = bfhi(u.x); x[2] = bflo(u.y); x[3] = bfhi(u.y); x[4] = bflo(u.z); x[5] = bfhi(u.z); x[6] = bflo(u.w); x[7] = bfhi(u.w); }
__device__ __forceinline__ bf16x8 pack8(float a0, float a1, float a2, float a3, float a4, float a5, float a6, float a7) {
    u32x4 w; w.x = pk2(a0, a1); w.y = pk2(a2, a3); w.z = pk2(a4, a5); w.w = pk2(a6, a7); return __builtin_bit_cast(bf16x8, w);
}
#define LDS_WAIT() asm volatile("s_waitcnt lgkmcnt(0)" ::: "memory")
__device__ __forceinline__ int lane_now() { return (int)__builtin_amdgcn_mbcnt_hi(~0u, __builtin_amdgcn_mbcnt_lo(~0u, 0u)); }
__device__ __forceinline__ int opq(int x) { asm volatile("" : "+v"(x)); return x; }

namespace pg8 {
constexpr int BM = 256, BK = 64, HALF = 128, HTB = HALF * BK * 2, NXCD = 8, WGM = 4;
__host__ __device__ __forceinline__ int lds_byte(int r, int c) { const int st = (r >> 4) * 2 + (c >> 5), rr = r & 15, cc = c & 31, ob = rr * 64 + cc * 2; return st * 1024 + (ob ^ (((ob >> 9) & 1) << 5)); }
__host__ __device__ __forceinline__ void stage_rc(int b, int& R, int& C) { const int st = b / 1024, sb = b % 1024, swz = sb ^ (((sb >> 9) & 1) << 5); R = (st >> 1) * 16 + swz / 64; C = (st & 1) * 32 + (swz % 64) / 2; }
__host__ __device__ __forceinline__ int perm32(int rho) { const int n = rho >> 4, i = rho & 15; return 8 * (i >> 2) + 4 * n + (i & 3); }

struct Unit { int pm, pn, sub; };
struct Gemm { const bf16* A0; const bf16* B0; const bf16* A1; const bf16* B1; int K; };

struct StaticOrder {
    int nM, nN, nwg, G, c;
    __device__ void init(int Mp, int N, int G_, int c_) { nM = Mp / BM; nN = N / BM; nwg = nM * nN; G = G_; c = c_; }
    __device__ bool next(int i, Unit& u) const {
        const long L = (long)i * G + c; if (L >= nwg) return false;
        int wgid = (int)L; { const int q = nwg / NXCD, r = nwg % NXCD, xcd = wgid % NXCD, off = wgid / NXCD; wgid = (xcd < r ? xcd * (q + 1) : r * (q + 1) + (xcd - r) * q) + off; }
        const int nig = WGM * nN, gid = wgid / nig, fm = gid * WGM, gsz = (nM - fm) < WGM ? (nM - fm) : WGM;
        u.pm = fm + ((wgid % nig) % gsz); u.pn = (wgid % nig) / gsz; u.sub = 0; return true;
    }
};
struct PairOrder {
    StaticOrder base;
    __device__ bool next(int i, Unit& u) const { const bool ok = base.next(i >> 1, u); u.sub = i & 1; return ok; }
};

template <class Epi, class Sched>
__device__ __forceinline__ void gemm_phase(LAS unsigned char* lds, const Gemm g, const Sched& S, const Epi& E, int wid) {
    const int lane = opq(lane_now()), tid = (wid << 6) | lane, wr = wid >> 2, wc = wid & 3, fr = lane & 15, fq = lane >> 4;
    const int K = g.K, nt = K / BK;
    unsigned voffA[2], voffB[2];
#pragma unroll
    for (int i = 0; i < 2; ++i) { int R, C; stage_rc(tid * 16 + i * 8192, R, C); const int Rb = (R & ~31) + perm32(R & 31);
        voffA[i] = (unsigned)(R * K + C) * 2u; voffB[i] = (unsigned)(Rb * K + C) * 2u; }
    const size_t kstep = (size_t)(BK * 2);
    const size_t hstep = (size_t)HALF * K * 2;
    const size_t tstep = 2 * hstep;
    const unsigned ldsw = (unsigned)wid * 1024u;
    const int aoff = lds_byte(wr * 64 + fr, fq * 8), boff = lds_byte(wc * 32 + fr, fq * 8);
#define PG8_SA(b, h) (((b) * 2 + (h)) * HTB)
#define PG8_SB(b, h) ((4 + (b) * 2 + (h)) * HTB)
#define PG8_STAGE(bufoff, gbase, voff) do { _Pragma("unroll") for (int _i = 0; _i < 2; ++_i) \
        __builtin_amdgcn_global_load_lds((const unsigned*)((const char*)(gbase) + (voff)[_i]), (LAS unsigned*)(lds + (bufoff) + ldsw + _i * 8192), 16, 0, 0); } while (0)
#define PG8_LDA(dst, b, h) do { _Pragma("unroll") for (int m = 0; m < 4; ++m) _Pragma("unroll") for (int k = 0; k < 2; ++k) dst[m][k] = *(const LAS bf16x8*)(lds + PG8_SA(b, h) + aoff + m * 2048 + k * 1024); } while (0)
#define PG8_LDB(dst, b, h) do { _Pragma("unroll") for (int n = 0; n < 2; ++n) _Pragma("unroll") for (int k = 0; k < 2; ++k) dst[n][k] = *(const LAS bf16x8*)(lds + PG8_SB(b, h) + boff + n * 2048 + k * 1024); } while (0)
#define PG8_MMA(ai, bj, At, Bt) do { __builtin_amdgcn_s_setprio(1); _Pragma("unroll") for (int m = 0; m < 4; ++m) _Pragma("unroll") for (int n = 0; n < 2; ++n) _Pragma("unroll") for (int k = 0; k < 2; ++k) \
        acc[ai][bj][m][n] = __builtin_amdgcn_mfma_f32_16x16x32_bf16(Bt[n][k], At[m][k], acc[ai][bj][m][n], 0, 0, 0); __builtin_amdgcn_s_setprio(0); } while (0)
#define PG8_WAIT_V(n) asm volatile("s_waitcnt vmcnt(" #n ")" ::: "memory")
#define PG8_WAIT_L(n) asm volatile("s_waitcnt lgkmcnt(" #n ")" ::: "memory")
#define PG8_BAR __builtin_amdgcn_s_barrier()
#define PG8_SCHED __builtin_amdgcn_sched_barrier(0)
#define PG8_ZERO() do { _Pragma("unroll") for (int a = 0; a < 2; ++a) _Pragma("unroll") for (int b = 0; b < 2; ++b) _Pragma("unroll") for (int m = 0; m < 4; ++m) _Pragma("unroll") for (int n = 0; n < 2; ++n) acc[a][b][m][n] = (f32x4){0.f, 0.f, 0.f, 0.f}; } while (0)
    Unit cur, nxt; int ui = 0;
    if (!S.next(0, cur)) return;
    f32x4 acc[2][2][4][2];
    PG8_ZERO();
    bf16x8 At[4][2], B0[2][2], B1[2][2];
    const char* cA = (const char*)(cur.sub ? g.A1 : g.A0) + (size_t)cur.pm * tstep; const char* cB = (const char*)(cur.sub ? g.B1 : g.B0) + (size_t)cur.pn * tstep;
    PG8_STAGE(PG8_SB(0, 0), cB, voffB); PG8_STAGE(PG8_SB(0, 1), cB + hstep, voffB); PG8_STAGE(PG8_SA(0, 0), cA, voffA); PG8_STAGE(PG8_SA(0, 1), cA + hstep, voffA);
    if (wr == 1) PG8_BAR;
    PG8_WAIT_V(2); PG8_BAR;
    PG8_STAGE(PG8_SB(1, 0), cB + kstep, voffB); PG8_STAGE(PG8_SA(1, 0), cA + kstep, voffA); PG8_STAGE(PG8_SB(1, 1), cB + hstep + kstep, voffB);
    PG8_WAIT_V(6); PG8_BAR;
    for (;;) {
        const bool has_next = S.next(ui + 1, nxt);
        const char* nA = has_next ? (const char*)(nxt.sub ? g.A1 : g.A0) + (size_t)nxt.pm * tstep : cA; const char* nB = has_next ? (const char*)(nxt.sub ? g.B1 : g.B0) + (size_t)nxt.pn * tstep : cB;
        for (int t = 0; t < nt; t += 2) {
            const bool last = (t == nt - 2);
            const char* a1 = cA + (size_t)(t + 1) * kstep;
            const char* a2 = last ? nA : cA + (size_t)(t + 2) * kstep; const char* b2 = last ? nB : cB + (size_t)(t + 2) * kstep;
            const char* a3 = a2 + kstep; const char* b3 = b2 + kstep;
            PG8_LDB(B0, 0, 0); PG8_LDB(B1, 0, 1); PG8_SCHED; PG8_LDA(At, 0, 0); PG8_STAGE(PG8_SA(1, 1), a1 + hstep, voffA);
            PG8_WAIT_V(8); PG8_WAIT_L(0); PG8_BAR; PG8_MMA(0, 0, At, B0); PG8_MMA(0, 1, At, B1); PG8_BAR; PG8_SCHED;
            PG8_LDA(At, 0, 1); PG8_STAGE(PG8_SB(0, 0), b2, voffB); PG8_STAGE(PG8_SB(0, 1), b2 + hstep, voffB); PG8_STAGE(PG8_SA(0, 0), a2, voffA);
            PG8_WAIT_V(8); PG8_WAIT_L(0); PG8_BAR; PG8_MMA(1, 0, At, B0); PG8_MMA(1, 1, At, B1); PG8_BAR; PG8_SCHED;
            PG8_LDB(B0, 1, 0); PG8_LDB(B1, 1, 1); PG8_SCHED; PG8_LDA(At, 1, 0); PG8_STAGE(PG8_SA(0, 1), a2 + hstep, voffA);
            PG8_WAIT_V(8); PG8_WAIT_L(0); PG8_BAR; PG8_MMA(0, 0, At, B0); PG8_MMA(0, 1, At, B1); PG8_BAR; PG8_SCHED;
            PG8_LDA(At, 1, 1); PG8_STAGE(PG8_SB(1, 0), b3, voffB); PG8_STAGE(PG8_SB(1, 1), b3 + hstep, voffB); PG8_STAGE(PG8_SA(1, 0), a3, voffA);
            PG8_WAIT_V(8); PG8_WAIT_L(0); PG8_BAR; PG8_MMA(1, 0, At, B0); PG8_MMA(1, 1, At, B1); PG8_BAR; PG8_SCHED;
        }
        if (wr == 0) PG8_BAR;
        bool keep = false;
        if constexpr (Epi::KEEP) { if (cur.sub == 0) { E.mid(acc, cur, wr, wc, fr, fq); keep = true; } else E(acc, cur, wr, wc, fr, fq); }
        else E(acc, cur, wr, wc, fr, fq);
        if (!has_next) break;
        if (!keep) PG8_ZERO();
        cur = nxt; cA = nA; cB = nB; ++ui;
        if (wr == 1) PG8_BAR;
    }
    PG8_WAIT_V(0);
    PG8_BAR;
#undef PG8_SA
#undef PG8_SB
#undef PG8_STAGE
#undef PG8_LDA
#undef PG8_LDB
#undef PG8_MMA
#undef PG8_WAIT_V
#undef PG8_WAIT_L
#undef PG8_BAR
#undef PG8_SCHED
#undef PG8_ZERO
}
}

typedef f32x4 AccT[2][2][4][2];
__device__ __forceinline__ int cond_of_row(int row) { return row < MPR ? (row >> 11) : (NB + row - MPR); }

struct EpiAda {
    static constexpr bool KEEP = false;
    float* ada; const float* bias;
    __device__ __forceinline__ void operator()(const AccT& acc, const pg8::Unit& u, int wr, int wc, int fr, int fq) const {
#pragma unroll
        for (int ai = 0; ai < 2; ++ai)
#pragma unroll
            for (int m = 0; m < 4; ++m) { const int row = u.pm * 256 + ai * 128 + wr * 64 + m * 16 + fr; if (row >= NCOND) continue;
#pragma unroll
                for (int bj = 0; bj < 2; ++bj)
#pragma unroll
                    for (int n = 0; n < 2; ++n) { const int col = u.pn * 256 + bj * 128 + wc * 32 + 8 * fq + 4 * n;
                        *(f32x4*)(ada + (size_t)row * NADA + col) = acc[ai][bj][m][n] + *(const f32x4*)(bias + col); } }
    }
};
struct EpiSwiglu {
    static constexpr bool KEEP = false;
    bf16* act;
    __device__ __forceinline__ void operator()(const AccT& acc, const pg8::Unit& u, int wr, int wc, int fr, int fq) const {
#pragma unroll
        for (int ai = 0; ai < 2; ++ai)
#pragma unroll
            for (int m = 0; m < 4; ++m) { const int row = u.pm * 256 + ai * 128 + wr * 64 + m * 16 + fr; if (row >= M) continue;
                const f32x4 g0 = acc[ai][0][m][0], g1 = acc[ai][0][m][1], v0 = acc[ai][1][m][0], v1 = acc[ai][1][m][1];
                u32x4 w; w.x = pk2(silu_f(g0[0]) * v0[0], silu_f(g0[1]) * v0[1]); w.y = pk2(silu_f(g0[2]) * v0[2], silu_f(g0[3]) * v0[3]);
                w.z = pk2(silu_f(g1[0]) * v1[0], silu_f(g1[1]) * v1[1]); w.w = pk2(silu_f(g1[2]) * v1[2], silu_f(g1[3]) * v1[3]);
                *(u32x4*)(act + (size_t)row * FF + u.pn * 128 + wc * 32 + 8 * fq) = w; }
    }
};
struct EpiResid {
    static constexpr bool KEEP = false;
    float* X; const float* xp; const float* xs; const float* gate; float coef;
    __device__ __forceinline__ void operator()(const AccT& acc, const pg8::Unit& u, int wr, int wc, int fr, int fq) const {
#pragma unroll
        for (int ai = 0; ai < 2; ++ai)
#pragma unroll
            for (int m = 0; m < 4; ++m) { const int row = u.pm * 256 + ai * 128 + wr * 64 + m * 16 + fr; if (row >= M) continue;
                const float* xin = xp ? (row < MPR ? xp + (size_t)row * D : xs + (size_t)(row - MPR) * D) : X + (size_t)row * D;
                const float* gt = gate + (size_t)cond_of_row(row) * NADA;
#pragma unroll
                for (int bj = 0; bj < 2; ++bj)
#pragma unroll
                    for (int n = 0; n < 2; ++n) { const int col = u.pn * 256 + bj * 128 + wc * 32 + 8 * fq + 4 * n;
                        const f32x4 xv = *(const f32x4*)(xin + col), gv = *(const f32x4*)(gt + col);
                        *(f32x4*)(X + (size_t)row * D + col) = xv + (gv * coef) * acc[ai][bj][m][n]; } }
    }
};
constexpr size_t WS_CNT = 14336, WS_PART = 65536;
template <int MODE> struct EpiResidNorm {
    static constexpr bool KEEP = false;
    float* X; const float* xp; const float* gate; float coef; const float* gvec; const float* shift; bf16* Hout; float* part; unsigned* cnt; LAS float* sred;
    __device__ __forceinline__ void operator()(AccT& acc, const pg8::Unit& u, int wr, int wc, int fr_, int fq_) const {
        const int fr = opq(fr_), fq = opq(fq_);
        const int tid = wr * 256 + wc * 64 + fq * 16 + fr, bidx = u.pm >> 3;
        const float* gt = gate + (size_t)bidx * NADA;
        float ss[2][4]; int zoff = 0;
#pragma unroll
        for (int ai = 0; ai < 2; ++ai)
#pragma unroll
            for (int m = 0; m < 4; ++m) { const int row = u.pm * 256 + ai * 128 + wr * 64 + m * 16 + fr + zoff;
                const float* xin = xp ? xp + (size_t)row * D : X + (size_t)row * D; float sacc = 0.f;
#pragma unroll
                for (int bj = 0; bj < 2; ++bj)
#pragma unroll
                    for (int n = 0; n < 2; ++n) { const int col = u.pn * 256 + bj * 128 + wc * 32 + 8 * fq + 4 * n;
                        const f32x4 xv = *(const f32x4*)(xin + col), gv = *(const f32x4*)(gt + col);
                        const f32x4 xn = xv + (gv * coef) * acc[ai][bj][m][n]; acc[ai][bj][m][n] = xn;
                        if (MODE == 0) *(f32x4*)(X + (size_t)row * D + col) = xn;
                        sacc += (xn[0] * xn[0] + xn[1] * xn[1]) + (xn[2] * xn[2] + xn[3] * xn[3]); }
                asm volatile("" : "+v"(zoff) : "v"(sacc));
                sacc += shfl_xor_l(sacc, 16); sacc += shfl_xor_l(sacc, 32);
                ss[ai][m] = sacc; __builtin_amdgcn_sched_barrier(0); }
        if (fq == 0) {
#pragma unroll
            for (int ai = 0; ai < 2; ++ai)
#pragma unroll
                for (int m = 0; m < 4; ++m) sred[wc * 256 + ai * 128 + wr * 64 + m * 16 + fr] = ss[ai][m]; }
        __syncthreads();
        if (tid < 256) __hip_atomic_store((unsigned*)part + ((size_t)u.pm * 4 + u.pn) * 256 + tid, __builtin_bit_cast(unsigned, (sred[tid] + sred[256 + tid]) + (sred[512 + tid] + sred[768 + tid])), __ATOMIC_RELAXED, __HIP_MEMORY_SCOPE_AGENT);
        asm volatile("s_waitcnt vmcnt(0)" ::: "memory");
        __syncthreads();
        if (tid == 0) { __hip_atomic_fetch_add(cnt + u.pm, 1u, __ATOMIC_RELAXED, __HIP_MEMORY_SCOPE_AGENT);
            unsigned sp = 0; while (__hip_atomic_load(cnt + u.pm, __ATOMIC_RELAXED, __HIP_MEMORY_SCOPE_AGENT) < 4u && ++sp < (1u << 24)) __builtin_amdgcn_s_sleep(1); }
        __syncthreads();
        if (tid < 256) { unsigned* pp = (unsigned*)part + (size_t)u.pm * 4 * 256 + tid;
            const float p0 = __builtin_bit_cast(float, __hip_atomic_load(pp, __ATOMIC_RELAXED, __HIP_MEMORY_SCOPE_AGENT)), p1 = __builtin_bit_cast(float, __hip_atomic_load(pp + 256, __ATOMIC_RELAXED, __HIP_MEMORY_SCOPE_AGENT));
            const float p2 = __builtin_bit_cast(float, __hip_atomic_load(pp + 512, __ATOMIC_RELAXED, __HIP_MEMORY_SCOPE_AGENT)), p3 = __builtin_bit_cast(float, __hip_atomic_load(pp + 768, __ATOMIC_RELAXED, __HIP_MEMORY_SCOPE_AGENT));
            sred[1024 + tid] = rsq_f(((p0 + p1) + (p2 + p3)) * (1.f / D) + EPS); }
        __syncthreads();
        const float* sh = MODE == 0 ? shift + (size_t)bidx * NADA : nullptr;
#pragma unroll
        for (int bj = 0; bj < 2; ++bj) { const int col = u.pn * 256 + bj * 128 + wc * 32 + 8 * fq;
            const f32x4 g0 = *(const f32x4*)(gvec + col), g1 = *(const f32x4*)(gvec + col + 4);
            f32x4 a0 = g0, a1 = g1, b0 = {0.f, 0.f, 0.f, 0.f}, b1 = b0;
            if (MODE == 0) { a0 = g0 * (*(const f32x4*)(sh + D + col) + 1.f); a1 = g1 * (*(const f32x4*)(sh + D + col + 4) + 1.f); b0 = *(const f32x4*)(sh + col); b1 = *(const f32x4*)(sh + col + 4); }
#pragma unroll
            for (int ai = 0; ai < 2; ++ai)
#pragma unroll
                for (int m = 0; m < 4; ++m) { const int rl = ai * 128 + wr * 64 + m * 16 + fr; const size_t row = (size_t)u.pm * 256 + rl; const float rstd = sred[1024 + rl];
                    const f32x4 y0 = acc[ai][bj][m][0] * rstd * a0 + b0, y1 = acc[ai][bj][m][1] * rstd * a1 + b1;
                    if (MODE == 0) *(bf16x8*)(Hout + row * D + col) = pack8(y0[0], y0[1], y0[2], y0[3], y1[0], y1[1], y1[2], y1[3]);
                    else { *(f32x4*)(X + row * D + col) = y0; *(f32x4*)(X + row * D + col + 4) = y1; }
                    __builtin_amdgcn_sched_barrier(0); }
        }
        __syncthreads();
    }
};
struct EpiIn {
    static constexpr bool KEEP = false;
    bf16* z; bf16* mg; float* abl; float* out;
    __device__ __forceinline__ void operator()(const AccT& acc, const pg8::Unit& u, int wr, int wc, int fr, int fq) const {
        const int bi = u.pn >> 2;
        if (bi == 8) {
            if (wc == 0 && fq < 2) {
#pragma unroll
                for (int ai = 0; ai < 2; ++ai)
#pragma unroll
                    for (int m = 0; m < 4; ++m) { const int row = u.pm * 256 + ai * 128 + wr * 64 + m * 16 + fr; if (row >= M) continue;
                        *(f32x4*)(abl + (size_t)row * 16 + 8 * fq) = acc[ai][0][m][0]; *(f32x4*)(abl + (size_t)row * 16 + 8 * fq + 4) = acc[ai][0][m][1]; }
            }
            return;
        }
        bf16* base = bi < 6 ? z + (size_t)bi * (ZB / 2) : mg + (size_t)(bi - 6) * (ZB / 2);
        const int act = (bi == 1) ? 1 : (bi == 5) ? 2 : (bi >= 6) ? 3 : 0;
        const int colt = (u.pn & 3) * 256 + wc * 32 + 8 * fq;
#pragma unroll
        for (int ai = 0; ai < 2; ++ai)
#pragma unroll
            for (int m = 0; m < 4; ++m) { const int row = u.pm * 256 + ai * 128 + wr * 64 + m * 16 + fr; if (row >= M) continue;
#pragma unroll
                for (int bj = 0; bj < 2; ++bj) { f32x4 v0 = acc[ai][bj][m][0], v1 = acc[ai][bj][m][1];
                    if (act == 1) {
#pragma unroll
                        for (int j = 0; j < 4; ++j) { v0[j] = gelu_tanh_f(v0[j]); v1[j] = gelu_tanh_f(v1[j]); } }
                    else if (act == 2) {
#pragma unroll
                        for (int j = 0; j < 4; ++j) { v0[j] = silu_f(v0[j]); v1[j] = silu_f(v1[j]); } }
                    else if (act == 3) {
#pragma unroll
                        for (int j = 0; j < 4; ++j) { v0[j] = sigmoid_f(v0[j]); v1[j] = sigmoid_f(v1[j]); } }
                    u32x4 w; w.x = pk2(v0[0], v0[1]); w.y = pk2(v0[2], v0[3]); w.z = pk2(v1[0], v1[1]); w.w = pk2(v1[2], v1[3]);
                    *(u32x4*)(base + (size_t)row * D + colt + bj * 128) = w;
                    if (act == 0 && row < MPR) { const int rs = row & (SEQ - 1), r64 = row & 63, bb = row >> 11, col = colt + bj * 128;
                        if (bi >= 3 && r64 >= 61 && rs < SEQ - 3)
                            *(u32x4*)((bf16*)((unsigned char*)out + (bi == 3 ? OSB_HK : OSB_HV)) + ((size_t)(bb * 32 + (rs >> 6) + 1) * 3 + (r64 - 61)) * D + col) = w;
                        if (rs >= SEQ - 3) { float* dst = bi == 0 ? out + O_CRP + ((size_t)bb * 3 + (rs - (SEQ - 3))) * D + col : out + O_CQP + ((size_t)bb * 3 + (rs - (SEQ - 3))) * 3072 + (bi - 2) * 1024 + col;
                            *(f32x4*)dst = v0; *(f32x4*)(dst + 4) = v1; } }
                } }
    }
};
struct EpiBranch {
    static constexpr bool KEEP = true;
    const bf16* mga; const bf16* mgb; bf16* G;
    __device__ __forceinline__ void mid(AccT& acc, const pg8::Unit& u, int wr, int wc, int fr, int fq) const {
#pragma unroll
        for (int ai = 0; ai < 2; ++ai)
#pragma unroll
            for (int m = 0; m < 4; ++m) { int row = u.pm * 256 + ai * 128 + wr * 64 + m * 16 + fr; if (row >= M) row = M - 1;
#pragma unroll
                for (int bj = 0; bj < 2; ++bj) { const size_t o = (size_t)row * D + u.pn * 256 + bj * 128 + wc * 32 + 8 * fq;
                    const u32x4 a = *(const u32x4*)(mga + o), b = *(const u32x4*)(mgb + o);
                    f32x4 r0, r1;
                    r0[0] = bflo(a.x) * rcp_f(bflo(b.x)); r0[1] = bfhi(a.x) * rcp_f(bfhi(b.x)); r0[2] = bflo(a.y) * rcp_f(bflo(b.y)); r0[3] = bfhi(a.y) * rcp_f(bfhi(b.y));
                    r1[0] = bflo(a.z) * rcp_f(bflo(b.z)); r1[1] = bfhi(a.z) * rcp_f(bfhi(b.z)); r1[2] = bflo(a.w) * rcp_f(bflo(b.w)); r1[3] = bfhi(a.w) * rcp_f(bfhi(b.w));
                    acc[ai][bj][m][0] = acc[ai][bj][m][0] * r0; acc[ai][bj][m][1] = acc[ai][bj][m][1] * r1; } }
    }
    __device__ __forceinline__ void operator()(const AccT& acc, const pg8::Unit& u, int wr, int wc, int fr, int fq) const {
#pragma unroll
        for (int ai = 0; ai < 2; ++ai)
#pragma unroll
            for (int m = 0; m < 4; ++m) { const int row = u.pm * 256 + ai * 128 + wr * 64 + m * 16 + fr; if (row >= M) continue;
#pragma unroll
                for (int bj = 0; bj < 2; ++bj) { const size_t o = (size_t)row * D + u.pn * 256 + bj * 128 + wc * 32 + 8 * fq;
                    const u32x4 b = *(const u32x4*)(mgb + o);
                    const f32x4 v0 = acc[ai][bj][m][0], v1 = acc[ai][bj][m][1];
                    u32x4 w; w.x = pk2(v0[0] * bflo(b.x), v0[1] * bfhi(b.x)); w.y = pk2(v0[2] * bflo(b.y), v0[3] * bfhi(b.y));
                    w.z = pk2(v1[0] * bflo(b.z), v1[1] * bfhi(b.z)); w.w = pk2(v1[2] * bflo(b.w), v1[3] * bfhi(b.w));
                    *(u32x4*)(G + o) = w; } }
    }
};

__device__ __forceinline__ f32x4 mini_partial(const bf16* A, const bf16* Bt, int K, int row0, int col0, int ks, int lane) {
    const int kq = K >> 2;
    const bf16* ap = A + (size_t)(MPR + row0 + (lane & 15)) * K + ks * kq + (lane >> 4) * 8;
    const bf16* bp = Bt + (size_t)(col0 + (lane & 15)) * K + ks * kq + (lane >> 4) * 8;
    f32x4 acc = {0.f, 0.f, 0.f, 0.f};
#pragma unroll 1
    for (int k0 = 0; k0 < kq; k0 += 256) {
        bf16x8 a[8], b[8];
#pragma unroll
        for (int i = 0; i < 8; ++i) if (k0 + 32 * i < kq) { a[i] = *(const bf16x8*)(ap + k0 + 32 * i); b[i] = *(const bf16x8*)(bp + k0 + 32 * i); }
#pragma unroll
        for (int i = 0; i < 8; ++i) if (k0 + 32 * i < kq) acc = __builtin_amdgcn_mfma_f32_16x16x32_bf16(b[i], a[i], acc, 0, 0, 0);
    }
    return acc;
}
template <class F>
__device__ __forceinline__ void mini_gemm(LAS unsigned char* lds, const bf16* A0, const bf16* B0, const bf16* A1, const bf16* B1, int K, int wg, int G, int tid_, const F& epi) {
    const int tid = opq(tid_), lane = tid & 63, wave = tid >> 6, ks = wave & 3;
    LAS f32x4* red = (LAS f32x4*)lds;
    for (int t0 = wg * 2; t0 < 512; t0 += G * 2) {
        const int tile = t0 + (wave >> 2), row0 = (tile >> 6) * 16, col0 = (tile & 63) * 16;
        f32x4 p0 = mini_partial(A0, B0, K, row0, col0, ks, lane), p1 = {0.f, 0.f, 0.f, 0.f};
        if (A1) p1 = mini_partial(A1, B1, K, row0, col0, ks, lane);
        red[(wave * 2) * 64 + lane] = p0; red[(wave * 2 + 1) * 64 + lane] = p1;
        __syncthreads();
        if (ks == 0) {
#pragma unroll
            for (int w = 1; w < 4; ++w) { p0 = p0 + red[((wave + w) * 2) * 64 + lane]; p1 = p1 + red[((wave + w) * 2 + 1) * 64 + lane]; }
            epi(MPR + row0 + (lane & 15), col0 + 4 * (lane >> 4), p0, p1);
        }
        __syncthreads();
    }
}

struct Params { const float* in[32]; float* out; unsigned char* ws; };
constexpr int LDS_BYTES = 147456;
#ifndef PHM
#define PHM 0xFFFF
#endif
#ifndef P7M
#define P7M 0xF
#endif

struct Ctx {
    const float* const* in; float* out; unsigned char* ws; LAS unsigned char* lds;
    int tid, lane, wave, wg, G;
};
#define KAS __attribute__((address_space(4)))
typedef const float* cfptr_t; typedef float* fptr_t; typedef unsigned char* ucptr_t;
__device__ __forceinline__ const float* karg_in(int k) { return *(volatile KAS cfptr_t*)((const KAS char*)__builtin_amdgcn_kernarg_segment_ptr() + 8 * k); }
__device__ __forceinline__ float* karg_out() { return *(volatile KAS fptr_t*)((const KAS char*)__builtin_amdgcn_kernarg_segment_ptr() + 256); }
__device__ __forceinline__ unsigned char* karg_ws() { return *(volatile KAS ucptr_t*)((const KAS char*)__builtin_amdgcn_kernarg_segment_ptr() + 264); }
#define INP(k) karg_in(k)

template <int MODE>
__device__ __forceinline__ void sample_norm_rows(const float* gvec, int ish, int gw, int lane) {
    if (gw >= NS) return;
    const int row = MPR + gw; float* X = karg_out() + (size_t)row * D;
    f32x4 v[4]; float s = 0.f;
#pragma unroll
    for (int j = 0; j < 4; ++j) { v[j] = *(const f32x4*)(X + 4 * (lane + 64 * j)); s += (v[j][0] * v[j][0] + v[j][1] * v[j][1]) + (v[j][2] * v[j][2] + v[j][3] * v[j][3]); }
    const float rstd = rsq_f(wave_sum(s) * (1.f / D) + EPS);
    const float* sh = (const float*)(karg_ws() + WS_ADA) + (size_t)cond_of_row(row) * NADA + ish * D;
#pragma unroll
    for (int j = 0; j < 4; ++j) { const int col = 4 * (lane + 64 * j); const f32x4 g = *(const f32x4*)(gvec + col);
        if (MODE == 0) { const f32x4 y = (v[j] * rstd * g) * (*(const f32x4*)(sh + D + col) + 1.f) + *(const f32x4*)(sh + col);
            u32x2 o; o.x = pk2(y[0], y[1]); o.y = pk2(y[2], y[3]); *(u32x2*)((bf16*)(karg_ws() + WS_H) + (size_t)row * D + col) = o; }
        else *(f32x4*)(X + col) = v[j] * rstd * g; }
}
__device__ __forceinline__ void transpose_item(const float* W, int ldw, int k0, int n0, int nvalid, bf16* WT, int ldt, int drow0, LAS float* scr, int lane) {
    const int cc = lane & 31;
#pragma unroll 8
    for (int i = 0; i < 32; ++i) { const int kk = 2 * i + (lane >> 5); scr[kk * 33 + cc] = (cc < nvalid) ? W[(size_t)(k0 + kk) * ldw + n0 + cc] : 0.f; }
    LDS_WAIT(); asm volatile("" ::: "memory");
    const int c = lane & 7;
#pragma unroll
    for (int j = 0; j < 4; ++j) { const int n = (lane >> 3) + 8 * j; const LAS float* s = scr + (8 * c) * 33 + n;
        u32x4 o; o.x = pk2(s[0 * 33], s[1 * 33]); o.y = pk2(s[2 * 33], s[3 * 33]); o.z = pk2(s[4 * 33], s[5 * 33]); o.w = pk2(s[6 * 33], s[7 * 33]);
        if (n < nvalid) *(u32x4*)(WT + (size_t)(drow0 + n) * ldt + k0 + 8 * c) = o; }
    LDS_WAIT(); asm volatile("" ::: "memory");
}

template <int PART>
__device__ __forceinline__ void prologue(const Params& P, LAS unsigned char* lds, int gw, int NGW, int wave, int lane) {
    LAS float* scr = (LAS float*)(lds + wave * 16384);
    unsigned char* ws = karg_ws();
    constexpr int I_UP = 16 * 176, I_DN = 44 * 32, I_IN = 16 * 257, I_BR = 2 * 16 * 32, I_OUT = 16 * 32, I_ADA = 16 * 288, I_RG = 128;
    constexpr int NITEMS = 2 * I_UP + 2 * I_DN + I_IN + I_BR + I_OUT + I_ADA + I_RG;
    constexpr int I_FIRST = 2 * I_UP + 2 * I_DN + I_IN + I_BR + I_OUT;
    for (int it = gw; it < NITEMS; it += NGW) {
        int r = it;
        if (PART == 0) { if (r >= I_ADA) break; r += I_FIRST; } else { if (r >= NITEMS - I_ADA) break; if (r >= I_FIRST) r += I_ADA; }
        if (r < 2 * I_UP) { const int which = r / I_UP; r -= which * I_UP; const int kb = r / 176, nb = r % 176, n0 = nb * 32; const int half = n0 >= FF ? 1 : 0, np = n0 - half * FF;
            transpose_item(INP(which ? 29 : 11), 2 * FF, kb * 64, n0, 32, (bf16*)(ws + (which ? WS_WUP2 : WS_WUP1)), D, (np >> 7) * 256 + half * 128 + (np & 127), scr, lane); continue; }
        r -= 2 * I_UP;
        if (r < 2 * I_DN) { const int which = r / I_DN; r -= which * I_DN; const int kb = r / 32, nb = r % 32;
            transpose_item(INP(which ? 30 : 12), D, kb * 64, nb * 32, 32, (bf16*)(ws + (which ? WS_WDN2 : WS_WDN1)), FF, nb * 32, scr, lane); continue; }
        r -= 2 * I_DN;
        if (r < I_IN) { const int kb = r / 257, nb = r % 257; int n0, nv, dr;
            if (nb < 160) { n0 = nb * 32; nv = 32; dr = n0; } else if (nb == 160) { n0 = 5120; nv = 16; dr = 8192; } else { n0 = 5136 + (nb - 161) * 32; nv = 32; dr = 5120 + (nb - 161) * 32; }
            transpose_item(INP(14), 8208, kb * 64, n0, nv, (bf16*)(ws + WS_WIN), D, dr, scr, lane); continue; }
        r -= I_IN;
        if (r < I_BR) { const int which = r / 512; r -= which * 512; const int kb = r / 32, nb = r % 32;
            transpose_item(INP(26) + (size_t)which * D * D, D, kb * 64, nb * 32, 32, (bf16*)(ws + WS_WBR), D, which * D + nb * 32, scr, lane); continue; }
        r -= I_BR;
        if (r < I_OUT) { const int kb = r / 32, nb = r % 32; transpose_item(INP(27), D, kb * 64, nb * 32, 32, (bf16*)(ws + WS_WOUT), D, nb * 32, scr, lane); continue; }
        r -= I_OUT;
        if (r < I_ADA) { const int kb = r / 288, nb = r % 288; transpose_item(INP(8), NADA, kb * 64, nb * 32, 32, (bf16*)(ws + WS_WADA), D, nb * 32, scr, lane); continue; }
        r -= I_ADA;
        { const int gx = r >> 6, n = (r >> 3) & 7, kb = (r >> 2) & 1, nb = r & 3;
          transpose_item(INP(gx ? 19 : 17) + (size_t)n * 128 * 128, 128, kb * 64, nb * 32, 32, (bf16*)(ws + WS_WRG), 128, n * 256 + gx * 128 + nb * 32, scr, lane); }
    }
    bf16* cb = (bf16*)(ws + WS_CB);
    if (PART == 0) for (int row = gw; row < 256; row += NGW) {
        const float* src = row < NB ? INP(2) + (size_t)row * D : (row < NCOND ? INP(3) + (size_t)(row - NB) * D : nullptr);
#pragma unroll
        for (int j = 0; j < 4; ++j) { const int col = 4 * (lane + 64 * j); f32x4 v = src ? *(const f32x4*)(src + col) : (f32x4){0.f, 0.f, 0.f, 0.f};
            u32x2 o; o.x = pk2(v[0], v[1]); o.y = pk2(v[2], v[3]); *(u32x2*)(cb + (size_t)row * D + col) = o; }
    }
}

template <int MODE>
__device__ __forceinline__ void norm_mod_pass(const Params& P, const float* gvec, int ish, int gw, int NGW, int lane) {
    const float* ada = (const float*)(karg_ws() + WS_ADA); bf16* H = (bf16*)(karg_ws() + WS_H);
    const float* xp = INP(0); const float* xs = INP(1); const float* X = karg_out();
    for (int row0 = 2 * gw; row0 < M; row0 += 2 * NGW) {
        f32x4 v[2][4]; float s[2] = {0.f, 0.f};
#pragma unroll
        for (int u = 0; u < 2; ++u) { const int row = row0 + u;
            const float* xr = MODE == 0 ? (row < MPR ? xp + (size_t)row * D : xs + (size_t)(row - MPR) * D) : X + (size_t)row * D;
#pragma unroll
            for (int j = 0; j < 4; ++j) v[u][j] = *(const f32x4*)(xr + 4 * (lane + 64 * j)); }
#pragma unroll
        for (int u = 0; u < 2; ++u)
#pragma unroll
            for (int j = 0; j < 4; ++j) s[u] += (v[u][j][0] * v[u][j][0] + v[u][j][1] * v[u][j][1]) + (v[u][j][2] * v[u][j][2] + v[u][j][3] * v[u][j][3]);
        s[0] = wave_sum(s[0]); s[1] = wave_sum(s[1]);
#pragma unroll
        for (int u = 0; u < 2; ++u) { const int row = row0 + u; const float rstd = rsq_f(s[u] * (1.f / D) + EPS);
            const float* sh = ada + (size_t)cond_of_row(row) * NADA + ish * D; const float* sc = sh + D;
#pragma unroll
            for (int j = 0; j < 4; ++j) { const int col = 4 * (lane + 64 * j); const f32x4 g = *(const f32x4*)(gvec + col), a = *(const f32x4*)(sc + col), bb = *(const f32x4*)(sh + col);
                const f32x4 y = (v[u][j] * rstd * g) * (a + 1.f) + bb; u32x2 o; o.x = pk2(y[0], y[1]); o.y = pk2(y[2], y[3]); *(u32x2*)(H + (size_t)row * D + col) = o; } }
    }
}
__device__ __forceinline__ void final_norm_pass(const Params& P, int gw, int NGW, int lane) {
    const float* gvec = INP(31); float* X = karg_out();
    for (int row0 = 2 * gw; row0 < M; row0 += 2 * NGW) {
        f32x4 v[2][4]; float s[2] = {0.f, 0.f};
#pragma unroll
        for (int u = 0; u < 2; ++u)
#pragma unroll
            for (int j = 0; j < 4; ++j) v[u][j] = *(const f32x4*)(X + (size_t)(row0 + u) * D + 4 * (lane + 64 * j));
#pragma unroll
        for (int u = 0; u < 2; ++u)
#pragma unroll
            for (int j = 0; j < 4; ++j) s[u] += (v[u][j][0] * v[u][j][0] + v[u][j][1] * v[u][j][1]) + (v[u][j][2] * v[u][j][2] + v[u][j][3] * v[u][j][3]);
        s[0] = wave_sum(s[0]); s[1] = wave_sum(s[1]);
#pragma unroll
        for (int u = 0; u < 2; ++u) { const float rstd = rsq_f(s[u] * (1.f / D) + EPS);
#pragma unroll
            for (int j = 0; j < 4; ++j) { const int col = 4 * (lane + 64 * j); *(f32x4*)(X + (size_t)(row0 + u) * D + col) = v[u][j] * rstd * *(const f32x4*)(gvec + col); } }
    }
}
__device__ __forceinline__ void onorm_pass(const Params& P, int gw, int NGW, int lane) {
    const bf16* O = (const bf16*)(karg_ws() + WS_H); bf16* ZG = (bf16*)(karg_ws() + WS_Z + 5 * ZB); const float* dn = INP(25);
    const int dc = (lane & 7) * 16;
    for (int row0 = 2 * gw; row0 < M; row0 += 2 * NGW) {
        u32x4 a[2][2], z[2][2];
#pragma unroll
        for (int u = 0; u < 2; ++u) { const size_t o = (size_t)(row0 + u) * D + lane * 16;
            a[u][0] = *(const u32x4*)(O + o); a[u][1] = *(const u32x4*)(O + o + 8); z[u][0] = *(const u32x4*)(ZG + o); z[u][1] = *(const u32x4*)(ZG + o + 8); }
#pragma unroll
        for (int u = 0; u < 2; ++u) { const size_t o = (size_t)(row0 + u) * D + lane * 16;
            float v[16], zz[16]; unpack8(a[u][0], v); unpack8(a[u][1], v + 8); unpack8(z[u][0], zz); unpack8(z[u][1], zz + 8);
            float s = 0.f;
#pragma unroll
            for (int e = 0; e < 16; ++e) s += v[e] * v[e];
            s = red8(s);
            const float rstd = rsq_f(s * (1.f / 128.f) + EPS);
#pragma unroll
            for (int e = 0; e < 16; ++e) v[e] = v[e] * rstd * dn[dc + e] * zz[e];
            *(bf16x8*)(ZG + o) = pack8(v[0], v[1], v[2], v[3], v[4], v[5], v[6], v[7]); *(bf16x8*)(ZG + o + 8) = pack8(v[8], v[9], v[10], v[11], v[12], v[13], v[14], v[15]); }
    }
}

constexpr int SS_TAIL = 530;
constexpr int RG_SPLIT = 7;
constexpr size_t WS_HCARRY = 917504;
__device__ __forceinline__ void rglru_task(const Params& P, LAS unsigned char* lds, int b, int n, int qd, int tid, int t0, int t1) {
    const int lane = tid & 63, wave = tid >> 6;
    LAS bf16* xcA = (LAS bf16*)lds;
    LAS float* xcf = (LAS float*)(lds + 34816);
    LAS float* rb = (LAS float*)(lds + 51200);
    LAS float* ib = (LAS float*)(lds + 67584);
    LAS float* segA = (LAS float*)(lds + 83968);
    LAS float* segB = (LAS float*)(lds + 86016);
    LAS float* hc = (LAS float*)(lds + 88064);
    LAS float* cw = (LAS float*)(lds + 88192);
    LAS bf16* rawt = (LAS bf16*)(lds + 90752);
    bf16* XR = (bf16*)(karg_ws() + WS_Z); bf16* GR = (bf16*)(karg_ws() + WS_Z + ZB);
    const bf16* WRG = (const bf16*)(karg_ws() + WS_WRG);
    const int cb0 = n * 128, oc0 = cb0 + qd * 32;
    const bool prompt = b >= 0;
    for (int i = tid; i < 640; i += NTHR) cw[i] = i < 512 ? INP(15)[(size_t)(i >> 7) * D + cb0 + (i & 127)] : INP(16)[cb0 + (i - 512)];
    if (tid < 32) hc[tid] = t0 > 0 ? ((const float*)(karg_ws() + WS_HCARRY))[(size_t)b * D + oc0 + tid] : 0.f;
    const int tb = wave & 3, cbk = wave >> 2;
    bf16x8 Bf[8];
    { const bf16* wrow = WRG + (size_t)(n * 256 + cbk * 128 + qd * 32 + (lane & 31)) * 128 + (lane >> 5) * 8;
#pragma unroll
      for (int ks = 0; ks < 8; ++ks) Bf[ks] = *(const bf16x8*)(wrow + ks * 16); }
    const float gbias = INP(cbk ? 20 : 18)[oc0 + (lane & 31)];
    const int ch = tid & 31, seg = tid >> 5;
    const float sp = softplus_f(-INP(21)[oc0 + ch]);
    float hlast = 0.f;
    u32x4 pre[5];
#define RG_RAW_LOAD(tile_) do { _Pragma("unroll") for (int i = 0; i < 5; ++i) { const int q = tid + 512 * i, row = q >> 4, c16 = q & 15, tl = (tile_) * 128 - 3 + row; \
        pre[i] = (q < 131 * 16 && tl >= 0) ? *(const u32x4*)(XR + ((size_t)b * SEQ + tl) * D + cb0 + c16 * 8) : (u32x4){0u, 0u, 0u, 0u}; } } while (0)
#define RG_RAW_STORE() do { _Pragma("unroll") for (int i = 0; i < 5; ++i) { const int q = tid + 512 * i; if (q < 131 * 16) *(LAS u32x4*)(rawt + (q >> 4) * 136 + (q & 15) * 8) = pre[i]; } } while (0)
    if (prompt) { RG_RAW_LOAD(t0); RG_RAW_STORE(); }
    __syncthreads();
    const int ntiles = t1;
    for (int tile = t0; tile < ntiles; ++tile) {
        const int row0 = prompt ? b * SEQ + tile * 128 : MPR;
        if (prompt && tile + 1 < ntiles) RG_RAW_LOAD(tile + 1);
        { const int t = tid >> 2, cq = tid & 3, c0 = cq * 32;
#pragma unroll 2
          for (int q = 0; q < 4; ++q) {
              const int cc = c0 + q * 8;
              float a[8];
#pragma unroll
              for (int e = 0; e < 8; ++e) a[e] = cw[512 + cc + e];
#pragma unroll
              for (int j = 0; j < 4; ++j) {
                  if (prompt || j == 3) {
                      {
                          const u32x4 u = prompt ? *(const LAS u32x4*)(rawt + (t + j) * 136 + cc) : *(const u32x4*)(XR + (size_t)(MPR + t) * D + cb0 + cc);
                          const float x8[8] = {bflo(u.x), bfhi(u.x), bflo(u.y), bfhi(u.y), bflo(u.z), bfhi(u.z), bflo(u.w), bfhi(u.w)};
#pragma unroll
                          for (int e = 0; e < 8; ++e) a[e] += x8[e] * cw[j * 128 + cc + e];
                      }
                  } else {
                      const float* p = INP(5) + ((size_t)t * 3 + j) * D + cb0 + cc;
                      const f32x4 u0 = *(const f32x4*)p, u1 = *(const f32x4*)(p + 4);
#pragma unroll
                      for (int e = 0; e < 4; ++e) { a[e] += u0[e] * cw[j * 128 + cc + e]; a[4 + e] += u1[e] * cw[j * 128 + cc + 4 + e]; }
                  }
              }
              u32x4 w; w.x = pk2(a[0], a[1]); w.y = pk2(a[2], a[3]); w.z = pk2(a[4], a[5]); w.w = pk2(a[6], a[7]);
              *(LAS u32x4*)(xcA + t * 136 + cc) = w;
              if (cq == qd) { *(LAS f32x4*)(xcf + t * 32 + q * 8) = (f32x4){a[0], a[1], a[2], a[3]}; *(LAS f32x4*)(xcf + t * 32 + q * 8 + 4) = (f32x4){a[4], a[5], a[6], a[7]}; }
          }
        }
        __syncthreads();
        { f32x16 c;
#pragma unroll
          for (int r = 0; r < 16; ++r) c[r] = 0.f;
          const LAS bf16* ap = xcA + (tb * 32 + (lane & 31)) * 136 + (lane >> 5) * 8;
#pragma unroll
          for (int ks = 0; ks < 8; ++ks) { const bf16x8 af = *(const LAS bf16x8*)(ap + ks * 16); c = __builtin_amdgcn_mfma_f32_32x32x16_bf16(af, Bf[ks], c, 0, 0, 0); }
          LAS float* dst = cbk ? ib : rb;
#pragma unroll
          for (int r = 0; r < 16; ++r) { const int tok = tb * 32 + (r & 3) + 8 * (r >> 2) + 4 * (lane >> 5); dst[tok * 32 + (lane & 31)] = sigmoid_f(c[r] + gbias); }
        }
        __syncthreads();
        float Aacc = 1.f, h = 0.f;
#pragma unroll 4
        for (int e = 0; e < 8; ++e) { const int t = seg * 8 + e;
            const float r = rb[t * 32 + ch], ig = ib[t * 32 + ch], x = xcf[t * 32 + ch];
            const float la = -8.f * r * sp; const float a = __expf(la);
            const float x2 = 2.f * la, ser = -x2 * (1.f + x2 * (0.5f + x2 * (0.16666667f + x2 * (0.041666668f + x2 * (0.0083333338f + x2 * 0.0013888889f)))));
            float mult = __builtin_amdgcn_sqrtf(x2 > -0.3f ? ser : 1.f - a * a);
            if (prompt && tile == 0 && t == 0) mult = 1.f;
            const float bt = mult * ig * x;
            rb[t * 32 + ch] = a; ib[t * 32 + ch] = bt;
            h = a * h + bt; Aacc *= a;
        }
        float hin = 0.f;
        if (prompt) {
            segA[seg * 32 + ch] = Aacc; segB[seg * 32 + ch] = h;
            __syncthreads();
            hin = hc[ch];
            float sa[15], sb[15];
#pragma unroll
            for (int s = 0; s < 15; ++s) { sa[s] = segA[s * 32 + ch]; sb[s] = segB[s * 32 + ch]; }
#pragma unroll
            for (int s = 0; s < 15; ++s) hin = s < seg ? sa[s] * hin + sb[s] : hin;
        }
        h = hin;
        { float gr[8], h0v[8];
#pragma unroll
          for (int e = 0; e < 8; ++e) { const int t = seg * 8 + e; gr[e] = bf2f(GR[(size_t)(row0 + t) * D + oc0 + ch]); h0v[e] = prompt ? 0.f : INP(4)[(size_t)t * D + oc0 + ch]; }
#pragma unroll
          for (int e = 0; e < 8; ++e) { const int t = seg * 8 + e;
              const float a = rb[t * 32 + ch], bt = ib[t * 32 + ch];
              if (prompt) h = a * h + bt; else h = a * h0v[e] + bt;
              GR[(size_t)(row0 + t) * D + oc0 + ch] = (bf16)f2bf(h * gr[e]);
              if (!prompt) { karg_out()[O_HS + (size_t)t * D + oc0 + ch] = h;
                  const float* cs = INP(5) + (size_t)t * 3 * D + oc0 + ch; float* co = karg_out() + O_CRS + (size_t)t * 3 * D + oc0 + ch;
                  co[0] = cs[D]; co[D] = cs[2 * D]; co[2 * D] = bf2f(XR[(size_t)(MPR + t) * D + oc0 + ch]); }
          } }
        hlast = h;
        if (prompt && tile + 1 < ntiles) RG_RAW_STORE();
        __syncthreads();
        if (prompt && seg == 15) hc[ch] = hlast;
    }
    if (prompt && seg == 15) { if (t1 == 16) karg_out()[O_HP + (size_t)b * D + oc0 + ch] = hlast; else ((float*)(karg_ws() + WS_HCARRY))[(size_t)b * D + oc0 + ch] = hlast; }
    __syncthreads();
}

constexpr size_t WS_TINV = WS_WIN, WS_ATT = WS_WIN + 8 * MiB, WS_GC = WS_CB, WS_BETA = 47 * MiB + 65536;
static_assert(WS_ABL + (size_t)M * 16 * 4 <= WS_BETA && WS_BETA + 64 * 2048 * 4 <= WS_H, "ws map (beta)");
__device__ __forceinline__ int perm16(int e) { return (e & ~12) | ((e >> 1) & 4) | ((e << 1) & 8); }

__device__ __forceinline__ void conv8(const bf16* p, int tl, const LAS float* w, float* a) {
#pragma unroll
    for (int e = 0; e < 8; ++e) a[e] = 0.f;
#pragma unroll
    for (int j = 0; j < 4; ++j) {
        const bool ok = tl - 3 + j >= 0;
        const u32x4 u = *(const u32x4*)(ok ? p - (ptrdiff_t)(3 - j) * D : p);
        f32x4 w0 = *(const LAS f32x4*)(w + j * 128), w1 = *(const LAS f32x4*)(w + j * 128 + 4);
        if (!ok) { w0 = (f32x4){0.f, 0.f, 0.f, 0.f}; w1 = w0; }
        a[0] += bflo(u.x) * w0[0]; a[1] += bfhi(u.x) * w0[1]; a[2] += bflo(u.y) * w0[2]; a[3] += bfhi(u.y) * w0[3];
        a[4] += bflo(u.z) * w1[0]; a[5] += bfhi(u.z) * w1[1]; a[6] += bflo(u.w) * w1[2]; a[7] += bfhi(u.w) * w1[3];
    }
#pragma unroll
    for (int e = 0; e < 8; ++e) a[e] = silu_f(a[e]);
}

__device__ __forceinline__ void conv8h(const bf16* p, const bf16* halo, int nloc, const LAS float* w, float* a) {
#pragma unroll
    for (int e = 0; e < 8; ++e) a[e] = 0.f;
#pragma unroll
    for (int j = 0; j < 4; ++j) {
        const int r = nloc - 3 + j;
        const u32x4 u = *(const u32x4*)(r >= 0 ? p - (ptrdiff_t)(3 - j) * D : halo + (r + 3) * D);
        const f32x4 w0 = *(const LAS f32x4*)(w + j * 128), w1 = *(const LAS f32x4*)(w + j * 128 + 4);
        a[0] += bflo(u.x) * w0[0]; a[1] += bfhi(u.x) * w0[1]; a[2] += bflo(u.y) * w0[2]; a[3] += bfhi(u.y) * w0[3];
        a[4] += bflo(u.z) * w1[0]; a[5] += bfhi(u.z) * w1[1]; a[6] += bflo(u.w) * w1[2]; a[7] += bfhi(u.w) * w1[3];
    }
#pragma unroll
    for (int e = 0; e < 8; ++e) a[e] = silu_f(a[e]);
}
__device__ __forceinline__ void delta_prep_wave(const Params& P, LAS unsigned char* lds, int idx, int wave, int lane) {
    const int bh = idx >> 5, b = bh >> 3, h = bh & 7, span = idx & 31, n = lane & 31, hh = lane >> 5;
    const LAS float* wq = (const LAS float*)lds; const LAS float* wk = wq + 512; const LAS float* wv = wq + 1024;
    LAS float* Lm = (LAS float*)(lds + 6144 + wave * 10240);
    LAS float* gcs = Lm + 2 * 1152; LAS float* bts = gcs + 64;
    const bf16* Qb = (const bf16*)(karg_ws() + WS_Z + 2 * ZB); bf16* Kb = (bf16*)(karg_ws() + WS_Z + 3 * ZB); bf16* Vb = (bf16*)(karg_ws() + WS_Z + 4 * ZB);
    bf16* QT = (bf16*)(karg_ws() + WS_H);
    const bf16* HK = (const bf16*)((const unsigned char*)karg_out() + OSB_HK) + (size_t)(b * 32 + span) * 3 * D + h * 128;
    const bf16* HV = (const bf16*)((const unsigned char*)karg_out() + OSB_HV) + (size_t)(b * 32 + span) * 3 * D + h * 128;
    const float* ABL = (const float*)(karg_ws() + WS_ABL);
    bf16* TINV = (bf16*)(karg_ws() + WS_TINV); bf16* ATT = (bf16*)(karg_ws() + WS_ATT);
    { const size_t row = (size_t)b * SEQ + span * 64 + lane;
      float g = -__expf(INP(23)[h]) * softplus_f(ABL[row * 16 + h] + INP(24)[h]); const float be = sigmoid_f(ABL[row * 16 + 8 + h]);
#pragma unroll
      for (int off = 1; off < 32; off <<= 1) { const float t = __shfl_up(g, off); if (n >= off) g += t; }
      gcs[lane] = g; bts[lane] = be;
      ((float*)(karg_ws() + WS_GC))[(size_t)bh * SEQ + span * 64 + lane] = g; ((float*)(karg_ws() + WS_BETA))[(size_t)bh * SEQ + span * 64 + lane] = be; }
    LAS float* nks = bts + 64; LAS float* nqs = nks + 64;
#pragma unroll 1
    for (int it = 7; it >= 0; --it) {
        const int nloc = it * 8 + (lane >> 3), tl = span * 64 + nloc, d0 = (lane & 7) * 16; const size_t ro = ((size_t)b * SEQ + tl) * D + h * 128 + d0;
        float kv[16], qv[16], vv[16];
        conv8h(Kb + ro, HK + d0, nloc, wk + d0, kv); conv8h(Kb + ro + 8, HK + d0 + 8, nloc, wk + d0 + 8, kv + 8);
        conv8(Qb + ro, tl, wq + d0, qv); conv8(Qb + ro + 8, tl, wq + d0 + 8, qv + 8);
        conv8h(Vb + ro, HV + d0, nloc, wv + d0, vv); conv8h(Vb + ro + 8, HV + d0 + 8, nloc, wv + d0 + 8, vv + 8);
        float ssk = 0.f, ssq = 0.f;
#pragma unroll
        for (int e = 0; e < 16; ++e) { ssk += kv[e] * kv[e]; ssq += qv[e] * qv[e]; }
        ssk = red8(ssk); ssq = red8(ssq);
        if ((lane & 7) == 0) { const float nkj = rsq_f(ssk + EPS), nqj = 0.08838834764831845f * rsq_f(ssq + EPS); nks[nloc] = nkj; nqs[nloc] = nqj;
            ((float*)((unsigned char*)karg_out() + OSB_NK))[(size_t)bh * SEQ + tl] = nkj; ((float*)((unsigned char*)karg_out() + OSB_NQ))[(size_t)bh * SEQ + tl] = nqj; }
        *(bf16x8*)(Kb + ro) = pack8(kv[0], kv[1], kv[2], kv[3], kv[4], kv[5], kv[6], kv[7]); *(bf16x8*)(Kb + ro + 8) = pack8(kv[8], kv[9], kv[10], kv[11], kv[12], kv[13], kv[14], kv[15]);
        *(bf16x8*)(QT + ro) = pack8(qv[0], qv[1], qv[2], qv[3], qv[4], qv[5], qv[6], qv[7]); *(bf16x8*)(QT + ro + 8) = pack8(qv[8], qv[9], qv[10], qv[11], qv[12], qv[13], qv[14], qv[15]);
        *(bf16x8*)(Vb + ro) = pack8(vv[0], vv[1], vv[2], vv[3], vv[4], vv[5], vv[6], vv[7]); *(bf16x8*)(Vb + ro + 8) = pack8(vv[8], vv[9], vv[10], vv[11], vv[12], vv[13], vv[14], vv[15]);
    }
    asm volatile("s_waitcnt vmcnt(0)" ::: "memory"); __builtin_amdgcn_fence(__ATOMIC_ACQUIRE, "agent");
#pragma unroll 1
    for (int tile = 0; tile < 2; ++tile) {
        const int tl = span * 64 + tile * 32 + n; const size_t ro = ((size_t)b * SEQ + tl) * D + h * 128 + 8 * hh;
        f32x16 ckk, cqk;
#pragma unroll
        for (int r = 0; r < 16; ++r) { ckk[r] = 0.f; cqk[r] = 0.f; }
#pragma unroll
        for (int s8 = 0; s8 < 8; ++s8) {
            const bf16x8 kf = *(const bf16x8*)(Kb + ro + 16 * s8), qf = *(const bf16x8*)(QT + ro + 16 * s8);
            ckk = __builtin_amdgcn_mfma_f32_32x32x16_bf16(kf, kf, ckk, 0, 0, 0); cqk = __builtin_amdgcn_mfma_f32_32x32x16_bf16(qf, kf, cqk, 0, 0, 0);
        }
        const float nkj = nks[tile * 32 + n];
        const float gcj = gcs[tile * 32 + n];
        bf16* att = ATT + ((size_t)bh * 64 + span * 2 + tile) * 1024 + perm16(n);
#pragma unroll
        for (int r = 0; r < 16; ++r) { const int i = (r & 3) + 8 * (r >> 2) + 4 * hh;
            const float dm = i >= n ? __expf(gcs[tile * 32 + i] - gcj) * nkj : 0.f;
            Lm[tile * 1152 + i * 36 + n] = i > n ? bts[tile * 32 + i] * nks[tile * 32 + i] * ckk[r] * dm : 0.f;
            att[i * 32] = (bf16)f2bf(nqs[tile * 32 + i] * cqk[r] * dm); }
    }
    LDS_WAIT(); asm volatile("" ::: "memory");
    { int loff = hh * 1152;
      float x[32];
#pragma unroll
      for (int i = 0; i < 32; ++i) { float sacc = (i == n) ? 1.f : 0.f;
          const LAS float* Lb = Lm + loff;
#pragma unroll
          for (int j4 = 0; j4 < (i + 3) / 4; ++j4) { const f32x4 l = *(const LAS f32x4*)(Lb + i * 36 + 4 * j4);
#pragma unroll
              for (int jj = 0; jj < 4; ++jj) if (4 * j4 + jj < i) sacc -= l[jj] * x[4 * j4 + jj]; }
          x[i] = sacc;
          if ((i & 1) == 1) asm volatile("" : "+v"(loff) : "v"(sacc)); }
      bf16* ti = TINV + ((size_t)bh * 64 + span * 2 + hh) * 1024 + perm16(n);
#pragma unroll
      for (int i = 0; i < 32; ++i) ti[i * 32] = (bf16)f2bf(x[i]); }
    LDS_WAIT(); asm volatile("" ::: "memory");
}

constexpr int DR_KB = 0, DR_QD = 8704, DR_KDT = 17408, DR_TI = 27648, DR_AT = 30208, DR_VB = 32768, DR_EGL = 49664, DR_BUF = 49680;
struct DeltaPre { u32x4 k0, k1, q0, q1, v0, v1, tia; float gct, gl, bet, nk, nq; };
__device__ __forceinline__ void delta_pre_load(int b, int h, int c, int pt, DeltaPre& dp) {
    const int bh = b * 8 + h, tt = pt >> 3, d0 = (pt & 7) * 16; const size_t t = (size_t)bh * SEQ + c * 32 + tt;
    const size_t ro = ((size_t)b * SEQ + c * 32 + tt) * D + h * 128 + d0;
    const bf16* Kt = (const bf16*)(karg_ws() + WS_Z + 3 * ZB) + ro; const bf16* Qt = (const bf16*)(karg_ws() + WS_H) + ro; const bf16* Vt = (const bf16*)(karg_ws() + WS_Z + 4 * ZB) + ro;
    dp.k0 = *(const u32x4*)Kt; dp.k1 = *(const u32x4*)(Kt + 8); dp.q0 = *(const u32x4*)Qt; dp.q1 = *(const u32x4*)(Qt + 8); dp.v0 = *(const u32x4*)Vt; dp.v1 = *(const u32x4*)(Vt + 8);
    const float* GC = (const float*)(karg_ws() + WS_GC);
    dp.gct = GC[t]; dp.gl = GC[(size_t)bh * SEQ + c * 32 + 31]; dp.bet = ((const float*)(karg_ws() + WS_BETA))[t];
    dp.nk = ((const float*)((const unsigned char*)karg_out() + OSB_NK))[t]; dp.nq = ((const float*)((const unsigned char*)karg_out() + OSB_NQ))[t];
    dp.tia = *(const u32x4*)((const bf16*)(karg_ws() + (pt < 128 ? WS_TINV : WS_ATT)) + ((size_t)bh * 64 + c) * 1024 + (pt & 127) * 8);
}
__device__ __forceinline__ void delta_rec_stage(LAS unsigned char* buf, int pt, const DeltaPre& dp) {
    const int tt = pt >> 3, dg = pt & 7, d0 = dg * 16;
    { LAS bf16* dst = (LAS bf16*)(buf + (pt < 128 ? DR_TI : DR_AT)) + ((pt & 127) >> 2) * 40 + (pt & 3) * 8; *(LAS u32x4*)dst = dp.tia; }
    if (pt == 0) *(LAS float*)(buf + DR_EGL) = __expf(dp.gl);
    const float eg = __expf(dp.gct), ekd = __expf(dp.gl - dp.gct);
    const float fq = dp.nq * eg, fkb = dp.nk * dp.bet * eg, fkd = dp.nk * ekd, bet = dp.bet;
    float k[16], q[16], v[16];
    unpack8(dp.k0, k); unpack8(dp.k1, k + 8); unpack8(dp.q0, q); unpack8(dp.q1, q + 8); unpack8(dp.v0, v); unpack8(dp.v1, v + 8);
    LAS bf16* KB = (LAS bf16*)(buf + DR_KB) + tt * 136 + d0; LAS bf16* QD = (LAS bf16*)(buf + DR_QD) + tt * 136 + d0;
    *(LAS bf16x8*)KB = pack8(k[0] * fkb, k[1] * fkb, k[2] * fkb, k[3] * fkb, k[8] * fkb, k[9] * fkb, k[10] * fkb, k[11] * fkb);
    *(LAS bf16x8*)(KB + 8) = pack8(k[4] * fkb, k[5] * fkb, k[6] * fkb, k[7] * fkb, k[12] * fkb, k[13] * fkb, k[14] * fkb, k[15] * fkb);
    *(LAS bf16x8*)QD = pack8(q[0] * fq, q[1] * fq, q[2] * fq, q[3] * fq, q[8] * fq, q[9] * fq, q[10] * fq, q[11] * fq);
    *(LAS bf16x8*)(QD + 8) = pack8(q[4] * fq, q[5] * fq, q[6] * fq, q[7] * fq, q[12] * fq, q[13] * fq, q[14] * fq, q[15] * fq);
    LAS bf16* KDT = (LAS bf16*)(buf + DR_KDT) + d0 * 40 + perm16(tt);
#pragma unroll
    for (int e = 0; e < 16; ++e) KDT[e * 40] = (bf16)f2bf(k[e] * fkd);
    LAS float* VB = (LAS float*)(buf + DR_VB) + tt * 132 + d0;
#pragma unroll
    for (int e4 = 0; e4 < 4; ++e4) *(LAS f32x4*)(VB + 4 * e4) = (f32x4){v[4 * e4] * bet, v[4 * e4 + 1] * bet, v[4 * e4 + 2] * bet, v[4 * e4 + 3] * bet};
}

constexpr int DR_OB = 2 * DR_BUF;
static_assert(DR_OB + 2 * 32 * 132 * 4 <= LDS_BYTES - 64, "delta recurrence LDS map");
__device__ __forceinline__ void delta_out_norm(const LAS float* ob, int pt, const float* dn16, const u32x4 z0, const u32x4 z1, bf16* dst) {
    const LAS float* p = ob + (pt >> 3) * 132 + (pt & 7) * 16;
    float o[16], z[16];
#pragma unroll
    for (int e4 = 0; e4 < 4; ++e4) { const f32x4 t = *(const LAS f32x4*)(p + 4 * e4); o[4 * e4] = t[0]; o[4 * e4 + 1] = t[1]; o[4 * e4 + 2] = t[2]; o[4 * e4 + 3] = t[3]; }
    float ss = 0.f;
#pragma unroll
    for (int e = 0; e < 16; ++e) ss += o[e] * o[e];
    ss = red8(ss);
    const float rstd = rsq_f(ss * (1.f / 128.f) + EPS);
    unpack8(z0, z); unpack8(z1, z + 8);
#pragma unroll
    for (int e = 0; e < 16; ++e) o[e] = o[e] * rstd * dn16[e] * z[e];
    *(bf16x8*)dst = pack8(o[0], o[1], o[2], o[3], o[4], o[5], o[6], o[7]); *(bf16x8*)(dst + 8) = pack8(o[8], o[9], o[10], o[11], o[12], o[13], o[14], o[15]);
}
__device__ __forceinline__ void delta_rec_task(const Params& P, LAS unsigned char* lds, int b, int h, int tid) {
    const int lane = tid & 63, wave = tid >> 6, n = lane & 31, hh = lane >> 5, bh = b * 8 + h, pt = tid - 256;
    const bool producer = wave >= 4;
    constexpr int NC = SEQ / 32;
    f32x16 S[4];
#pragma unroll
    for (int kb = 0; kb < 4; ++kb)
#pragma unroll
        for (int r = 0; r < 16; ++r) S[kb][r] = 0.f;
    DeltaPre dcur, dnxt;
    if (producer) { delta_pre_load(b, h, 0, pt, dcur); delta_pre_load(b, h, 1, pt, dnxt); delta_rec_stage(lds, pt, dcur); dcur = dnxt; }
    __syncthreads();
    if (producer) {
        const int pt = opq(tid) - 256;
        float dn16[16];
#pragma unroll
        for (int e = 0; e < 16; ++e) dn16[e] = INP(25)[(pt & 7) * 16 + e];
        bf16* zgp = (bf16*)(karg_ws() + WS_Z + 5 * ZB) + ((size_t)b * SEQ + (pt >> 3)) * D + h * 128 + (pt & 7) * 16;
        u32x4 zc0 = {0u, 0u, 0u, 0u}, zc1 = zc0, zn0, zn1;
#define DR_BAR() do { asm volatile("s_waitcnt lgkmcnt(0)" ::: "memory"); __builtin_amdgcn_s_barrier(); asm volatile("" ::: "memory"); } while (0)
        for (int c = 0; c < NC; ++c) {
            if (c > 0) { dcur = dnxt; zc0 = zn0; zc1 = zn1; }
            if (c + 2 < NC) delta_pre_load(b, h, c + 2, pt, dnxt);
            zn0 = *(const u32x4*)(zgp + (size_t)c * 32 * D); zn1 = *(const u32x4*)(zgp + (size_t)c * 32 * D + 8);
            if (c + 1 < NC) delta_rec_stage(lds + ((c + 1) & 1) * DR_BUF, pt, dcur);
            if (c > 0) delta_out_norm((const LAS float*)(lds + DR_OB) + ((c - 1) & 1) * 32 * 132, pt, dn16, zc0, zc1, zgp + (size_t)(c - 1) * 32 * D);
            DR_BAR();
        }
        delta_out_norm((const LAS float*)(lds + DR_OB) + ((NC - 1) & 1) * 32 * 132, pt, dn16, zn0, zn1, zgp + (size_t)(NC - 1) * 32 * D);
    } else {
        const int lane = opq(tid) & 63, n = lane & 31, hh = lane >> 5;
        for (int c = 0; c < NC; ++c) {
            LAS unsigned char* buf = lds + (c & 1) * DR_BUF;
            const int vb = wave;
            bf16x8 SB[8];
#pragma unroll
            for (int s = 0; s < 8; ++s) { const int kb = s >> 1, o = 8 * (s & 1); SB[s] = pack8(S[kb][o], S[kb][o + 1], S[kb][o + 2], S[kb][o + 3], S[kb][o + 4], S[kb][o + 5], S[kb][o + 6], S[kb][o + 7]); }
            f32x16 X1, P1;
#pragma unroll
            for (int r = 0; r < 16; ++r) { X1[r] = 0.f; P1[r] = 0.f; }
            const LAS bf16* KB = (const LAS bf16*)(buf + DR_KB) + n * 136 + 8 * hh; const LAS bf16* QD = (const LAS bf16*)(buf + DR_QD) + n * 136 + 8 * hh;
#pragma unroll
            for (int s = 0; s < 8; ++s) { X1 = __builtin_amdgcn_mfma_f32_32x32x16_bf16(*(const LAS bf16x8*)(KB + 16 * s), SB[s], X1, 0, 0, 0);
                P1 = __builtin_amdgcn_mfma_f32_32x32x16_bf16(*(const LAS bf16x8*)(QD + 16 * s), SB[s], P1, 0, 0, 0); }
            const LAS float* VB = (const LAS float*)(buf + DR_VB) + 32 * vb + n;
            float Y[16];
#pragma unroll
            for (int r = 0; r < 16; ++r) Y[r] = VB[((r & 3) + 8 * (r >> 2) + 4 * hh) * 132] - X1[r];
            const bf16x8 YB0 = pack8(Y[0], Y[1], Y[2], Y[3], Y[4], Y[5], Y[6], Y[7]), YB1 = pack8(Y[8], Y[9], Y[10], Y[11], Y[12], Y[13], Y[14], Y[15]);
            f32x16 VN;
#pragma unroll
            for (int r = 0; r < 16; ++r) VN[r] = 0.f;
            const LAS bf16* TI = (const LAS bf16*)(buf + DR_TI) + n * 40 + 8 * hh; const LAS bf16* AT = (const LAS bf16*)(buf + DR_AT) + n * 40 + 8 * hh;
            VN = __builtin_amdgcn_mfma_f32_32x32x16_bf16(*(const LAS bf16x8*)TI, YB0, VN, 0, 0, 0);
            VN = __builtin_amdgcn_mfma_f32_32x32x16_bf16(*(const LAS bf16x8*)(TI + 16), YB1, VN, 0, 0, 0);
            const bf16x8 VB0 = pack8(VN[0], VN[1], VN[2], VN[3], VN[4], VN[5], VN[6], VN[7]), VB1 = pack8(VN[8], VN[9], VN[10], VN[11], VN[12], VN[13], VN[14], VN[15]);
            P1 = __builtin_amdgcn_mfma_f32_32x32x16_bf16(*(const LAS bf16x8*)AT, VB0, P1, 0, 0, 0);
            P1 = __builtin_amdgcn_mfma_f32_32x32x16_bf16(*(const LAS bf16x8*)(AT + 16), VB1, P1, 0, 0, 0);
            const float egl = *(const LAS float*)(buf + DR_EGL);
            const LAS bf16* KDT = (const LAS bf16*)(buf + DR_KDT) + n * 40 + 8 * hh;
#pragma unroll
            for (int kb = 0; kb < 4; ++kb) {
#pragma unroll
                for (int r = 0; r < 16; ++r) S[kb][r] *= egl;
                S[kb] = __builtin_amdgcn_mfma_f32_32x32x16_bf16(*(const LAS bf16x8*)(KDT + kb * 32 * 40), VB0, S[kb], 0, 0, 0);
                S[kb] = __builtin_amdgcn_mfma_f32_32x32x16_bf16(*(const LAS bf16x8*)(KDT + kb * 32 * 40 + 16), VB1, S[kb], 0, 0, 0); }
            LAS float* op = (LAS float*)(lds + DR_OB) + (c & 1) * 32 * 132 + 4 * hh * 132 + 32 * vb + n;
#pragma unroll
            for (int r = 0; r < 16; ++r) op[((r & 3) + 8 * (r >> 2)) * 132] = P1[r];
            DR_BAR();
        }
    }
    if (!producer) { float* So = karg_out() + O_SP + ((size_t)bh * 128 + 4 * hh) * 128 + 32 * wave + n;
#pragma unroll
        for (int kb = 0; kb < 4; ++kb)
#pragma unroll
            for (int r = 0; r < 16; ++r) So[(size_t)(32 * kb + (r & 3) + 8 * (r >> 2)) * 128] = S[kb][r]; }
    __syncthreads();
}

template <int MODE>
__device__ __forceinline__ void delta_sample_item(const Params& P, LAS unsigned char* lds, int item, int tid) {
    LAS float* tmp = (LAS float*)lds;
    LAS float* scl = (LAS float*)(lds + 1536);
    LAS float* rpk = (LAS float*)(lds + 2048);
    LAS float* rpq = (LAS float*)(lds + 4096);
    const int bs = item >> 3, h = item & 7, lane = tid & 63, wave = tid >> 6; const size_t row = (size_t)MPR + bs;
    const bf16* Zq = (const bf16*)(karg_ws() + WS_Z + 2 * ZB);
    if (tid < 384) { const int which = tid >> 7, d = tid & 127; const int c3 = which * 1024 + h * 128 + d;
        const float raw = bf2f(Zq[(size_t)which * (ZB / 2) + row * D + h * 128 + d]);
        const float* cs = INP(7) + (size_t)bs * 3 * 3072 + c3; const float* w = INP(22) + c3;
        tmp[tid] = silu_f(cs[0] * w[0] + cs[3072] * w[3072] + cs[2 * 3072] * w[2 * 3072] + raw * w[3 * 3072]); }
    __syncthreads();
    if (wave < 3) { float s;
        if (wave == 0) s = tmp[lane] * tmp[lane] + tmp[lane + 64] * tmp[lane + 64];
        else if (wave == 1) s = tmp[128 + lane] * tmp[128 + lane] + tmp[192 + lane] * tmp[192 + lane];
        else s = tmp[lane] * tmp[128 + lane] + tmp[64 + lane] * tmp[192 + lane];
        s = wave_sum(s);
        if (lane == 0) scl[wave] = wave == 0 ? rsq_f(s + EPS) * 0.08838834764831845f : (wave == 1 ? rsq_f(s + EPS) : s); }
    __syncthreads();
    const float sq = scl[0], sk = scl[1], kq = scl[2] * sq * sk;
    const int v = tid & 127, kg = tid >> 7;
    const float* S0 = INP(6) + ((size_t)(bs * NH + h) * 128 + kg * 32) * 128 + v;
    float S[32];
#pragma unroll
    for (int j = 0; j < 32; ++j) S[j] = S0[(size_t)j * 128];
    float pk = 0.f, pq = 0.f;
#pragma unroll
    for (int j = 0; j < 32; ++j) { pk += S[j] * tmp[128 + kg * 32 + j]; pq += S[j] * tmp[kg * 32 + j]; }
    rpk[kg * 128 + v] = pk * sk; rpq[kg * 128 + v] = pq * sq;
    __syncthreads();
    pk = (rpk[v] + rpk[128 + v]) + (rpk[256 + v] + rpk[384 + v]); pq = (rpq[v] + rpq[128 + v]) + (rpq[256 + v] + rpq[384 + v]);
    const float* ABL = (const float*)(karg_ws() + WS_ABL);
    const float al = ABL[row * 16 + h], bl = ABL[row * 16 + 8 + h];
    const float dc = __expf(-__expf(INP(23)[h]) * softplus_f(al + INP(24)[h])), be = sigmoid_f(bl);
    const float delta = be * (tmp[256 + v] - dc * pk);
    if (MODE == 0) {
        const float o = dc * pq + kq * delta; const float so = wave_sum(o * o);
        if (lane == 0 && wave < 2) scl[4 + wave] = so;
        __syncthreads();
        if (kg == 0) { bf16* zp = (bf16*)(karg_ws() + WS_Z + 5 * ZB) + row * D + h * 128 + v;
            *zp = (bf16)f2bf(o * rsq_f((scl[4] + scl[5]) * (1.f / 128.f) + EPS) * INP(25)[v] * bf2f(*zp)); } }
    else { float* So = karg_out() + O_SS + ((size_t)(bs * NH + h) * 128 + kg * 32) * 128 + v;
#pragma unroll
        for (int j = 0; j < 32; ++j) So[(size_t)j * 128] = dc * S[j] + (tmp[128 + kg * 32 + j] * sk) * delta; }
    __syncthreads();
}

#define XB_TMO      128
#define XB_XCNT(j)  (256  + 64 * (j))
#define XB_XSUB(j)  (1280 + 64 * (j))
#define XB_XGEN(j)  (2304 + 64 * (j))
#define XB_TOP      3328
#define XB_TOPGEN   3392
#define XCD_BAR_WORDS 3456
#define XB_SPIN_CAP (1u << 22)
__device__ __forceinline__ unsigned xb_ld(unsigned* p)              { return __hip_atomic_load(p, __ATOMIC_RELAXED, __HIP_MEMORY_SCOPE_AGENT); }
__device__ __forceinline__ unsigned xb_add(unsigned* p, unsigned v) { return __hip_atomic_fetch_add(p, v, __ATOMIC_RELAXED, __HIP_MEMORY_SCOPE_AGENT); }
__device__ __forceinline__ unsigned xb_xcc_id() { return (unsigned)__builtin_amdgcn_s_getreg((3 << 11) | 20) & 0xFu; }
#define XB_SPIN(cond, bar) do { unsigned _sp = 0; while (cond) { __builtin_amdgcn_s_sleep(1); \
    if ((++_sp & 255u) == 0u) { if (xb_ld(&(bar)[XB_TMO])) break; if (_sp > XB_SPIN_CAP) { atomicAdd(&(bar)[XB_TMO], 1u); break; } } } } while (0)
struct XcdBarrier { unsigned* bar; unsigned x; volatile LAS unsigned* st; };
__device__ __forceinline__ XcdBarrier xcd_barrier_post(unsigned* bar, volatile LAS unsigned* st, bool leader) {
    XcdBarrier b; b.bar = bar; b.x = xb_xcc_id(); b.st = st;
    if (leader) (void)xb_add(&bar[XB_XCNT(b.x)], 1u);
    return b;
}
__device__ __forceinline__ void xcd_barrier_complete(unsigned* bar, unsigned x, unsigned& nloc, unsigned& nx) {
    const unsigned G = gridDim.x * gridDim.y * gridDim.z;
    unsigned sum, cnt, mine, sp = 0u;
    for (;;) {
        sum = 0u; cnt = 0u; mine = 0u;
#pragma unroll
        for (unsigned j = 0; j < 16; ++j) { const unsigned c = xb_ld(&bar[XB_XCNT(j)]); sum += c; cnt += (c > 0u) ? 1u : 0u; mine = (j == x) ? c : mine; }
        if (sum == G) break;
        __builtin_amdgcn_s_sleep(1);
        if ((++sp & 255u) == 0u) { if (xb_ld(&bar[XB_TMO])) break; if (sp > XB_SPIN_CAP) { atomicAdd(&bar[XB_TMO], 1u); break; } }
    }
    nloc = mine > 0u ? mine : 1u; nx = cnt > 0u ? cnt : 1u;
}
__device__ __forceinline__ void xcd_barrier(const XcdBarrier& b, bool leader) {
    asm volatile("s_waitcnt vmcnt(0)" ::: "memory");
    __syncthreads();
    if (leader) {
        unsigned* bar = b.bar;
        __builtin_amdgcn_s_waitcnt(0);
        unsigned nloc = b.st[0], nx = b.st[1];
        if (nloc == 0u) { xcd_barrier_complete(bar, b.x, nloc, nx); b.st[0] = nloc; b.st[1] = nx; }
        const unsigned old = xb_add(&bar[XB_XSUB(b.x)], 1u);
        const unsigned gen = old / nloc;
        if (old + 1u == (gen + 1u) * nloc) {
            __builtin_amdgcn_fence(__ATOMIC_RELEASE, "agent");
            asm volatile("s_waitcnt vmcnt(0)" ::: "memory");
            const unsigned og = xb_add(&bar[XB_TOP], 1u);
            const unsigned tg = og / nx;
            if (og + 1u == (tg + 1u) * nx) xb_add(&bar[XB_TOPGEN], 1u);
            else XB_SPIN(xb_ld(&bar[XB_TOPGEN]) == tg, bar);
            __builtin_amdgcn_fence(__ATOMIC_ACQUIRE, "agent");
            xb_add(&bar[XB_XGEN(b.x)], 1u);
            asm volatile("s_waitcnt vmcnt(0)" ::: "memory");
        } else {
            XB_SPIN(xb_ld(&bar[XB_XGEN(b.x)]) == gen, bar);
            __builtin_amdgcn_fence(__ATOMIC_ACQUIRE, "agent");
            asm volatile("s_waitcnt vmcnt(0)" ::: "memory");
        }
    }
    __syncthreads();
}

__global__ void __launch_bounds__(NTHR, 2) fwd_megakernel(Params P) {
    extern __shared__ __attribute__((aligned(16))) unsigned char lds_raw[];
    LAS unsigned char* lds = (LAS unsigned char*)lds_raw;
    cg::grid_group grid = cg::this_grid();
    const int wave = __builtin_amdgcn_readfirstlane((int)threadIdx.x >> 6);
#define lane opq(lane_now())
#define tid opq((wave << 6) | lane_now())
    const int G = gridDim.x, wg = blockIdx.x;
    const int gw = wg * NWAVES + wave, NGW = G * NWAVES;
    unsigned char* ws = karg_ws();
    float* ADA = (float*)(ws + WS_ADA);
    bf16* H = (bf16*)(ws + WS_H);
    bf16* Z = (bf16*)(ws + WS_Z);
    bf16* ACT = (bf16*)(ws + WS_ACT);
    bf16* MG = (bf16*)(karg_out() + O_SS);
    volatile LAS unsigned* MISC = (volatile LAS unsigned*)(lds + LDS_BYTES - 64);
    if (tid < 16) MISC[tid] = 0u;
    __syncthreads();
    const XcdBarrier xbar = xcd_barrier_post((unsigned*)ws, MISC, wave == 0 && lane_now() == 0);
#define GBAR() xcd_barrier(xbar, wave == 0 && lane_now() == 0)

    if constexpr ((PHM >> 0) & 1) {
    prologue<0>(P, lds, gw, NGW, wave, lane);
    }
    GBAR();
    if constexpr ((PHM >> 1) & 1) {
    { pg8::Gemm g{(const bf16*)(ws + WS_CB), (const bf16*)(ws + WS_WADA), nullptr, nullptr, D}; pg8::StaticOrder S; S.init(256, NADA, G, wg);
      EpiAda E{ADA, INP(9)}; pg8::gemm_phase(lds, g, S, E, wave);
      if (wg >= 36) prologue<1>(P, lds, (wg - 36) * NWAVES + wave, (G - 36) * NWAVES, wave, lane); }
    }
    GBAR();
    if constexpr ((PHM >> 2) & 1) {
    norm_mod_pass<0>(P, INP(10), 0, gw, NGW, lane);
    { const int gt = wg * NTHR + tid;
      if (gt < 2 * NB * 3 * (D / 8)) { const int m = gt / (NB * 3 * (D / 8)), r = gt % (NB * 3 * (D / 8)), c8 = r & 127, j = (r >> 7) % 3, bb = (r >> 7) / 3;
          *(u32x4*)((bf16*)((unsigned char*)karg_out() + (m ? OSB_HV : OSB_HK)) + ((size_t)(bb * 32) * 3 + j) * D + c8 * 8) = (u32x4){0u, 0u, 0u, 0u}; } }
    }
    GBAR();
    if constexpr ((PHM >> 3) & 1) {
    { pg8::Gemm g{H, (const bf16*)(ws + WS_WUP1), nullptr, nullptr, D}; pg8::StaticOrder S; S.init(MPAD, 2 * FF, G, wg);
      EpiSwiglu E{ACT}; pg8::gemm_phase(lds, g, S, E, wave); }
    }
    GBAR();
    if constexpr ((PHM >> 4) & 1) {
    { pg8::Gemm g{ACT, (const bf16*)(ws + WS_WDN1), nullptr, nullptr, FF}; pg8::StaticOrder S; S.init(MPR, D, G, wg);
      EpiResidNorm<0> E{karg_out(), INP(0), ADA + 2 * D, 0.5f, INP(13), ADA + 3 * D, H, (float*)(ws + WS_PART), (unsigned*)(ws + WS_CNT), (LAS float*)(lds + 131072)}; pg8::gemm_phase(lds, g, S, E, wave);
      float* X = karg_out(); const float* xs = INP(1); const float* gate = ADA + 2 * D;
      mini_gemm(lds, ACT, (const bf16*)(ws + WS_WDN1), nullptr, nullptr, FF, wg, G, tid, [=](int row, int col, f32x4 v, f32x4) {
          const f32x4 xv = *(const f32x4*)(xs + (size_t)(row - MPR) * D + col), gv = *(const f32x4*)(gate + (size_t)cond_of_row(row) * NADA + col);
          *(f32x4*)(X + (size_t)row * D + col) = xv + (gv * 0.5f) * v; }); }
    }
    GBAR();
    if constexpr ((PHM >> 5) & 1) {
    sample_norm_rows<0>(INP(13), 3, gw, lane);
    }
    GBAR();
    if constexpr ((PHM >> 6) & 1) {
    { pg8::Gemm g{H, (const bf16*)(ws + WS_WIN), nullptr, nullptr, D}; pg8::StaticOrder S; S.init(MPAD, NIN, G, wg);
      EpiIn E{Z, MG, (float*)(ws + WS_ABL), karg_out()}; pg8::gemm_phase(lds, g, S, E, wave); }
    }
    GBAR();
    if constexpr ((PHM >> 7) & 1) {
        { const int bh0 = (wg * NWAVES) >> 5, h0 = bh0 & 7; LAS float* w = (LAS float*)lds; const float* cwq = INP(22);
          for (int i = tid; i < 1536; i += NTHR) { const int which = i >> 9, j = (i >> 7) & 3, d = i & 127; w[i] = cwq[(size_t)j * 3072 + which * 1024 + h0 * 128 + d]; }
          __syncthreads();
          delta_prep_wave(P, lds, gw, wave, lane);
          __syncthreads(); }
        if (G == 256) { const int task = (wg & 7) * 32 + (wg >> 3); rglru_task(P, lds, task >> 5, (task >> 2) & 7, task & 3, tid, 0, RG_SPLIT); }
        else for (int task = wg; task < 256; task += G) rglru_task(P, lds, task >> 5, (task >> 2) & 7, task & 3, tid, 0, RG_SPLIT);
    }
    GBAR();
    if constexpr ((PHM >> 7) & 1) {
        if (wg < 64) delta_rec_task(P, lds, wg >> 3, wg & 7, tid);
        else {
            if (G == 256) { const int slot = (wg - 64) >> 3;
                { const int task = (wg & 7) * 32 + slot; rglru_task(P, lds, task >> 5, (task >> 2) & 7, task & 3, tid, RG_SPLIT, 16); }
                if (slot < 8) { const int task = (wg & 7) * 32 + 24 + slot; rglru_task(P, lds, task >> 5, (task >> 2) & 7, task & 3, tid, RG_SPLIT, 16); } }
            else for (int task = wg - 64; task < 256; task += G - 64) rglru_task(P, lds, task >> 5, (task >> 2) & 7, task & 3, tid, RG_SPLIT, 16);
            if (wg < 96) rglru_task(P, lds, -1, (wg - 64) >> 2, (wg - 64) & 3, tid, 0, 1);
            if (wg >= 128) for (int item = wg - 128; item < NS * NH; item += G - 128) delta_sample_item<0>(P, lds, item, tid);
        }
    }
    GBAR();
    if constexpr ((PHM >> 9) & 1) {
    { pg8::Gemm g{Z + 1 * (ZB / 2), (const bf16*)(ws + WS_WBR), Z + 5 * (ZB / 2), (const bf16*)(ws + WS_WBR) + (size_t)D * D, D};
      pg8::PairOrder S; S.base.init(MPR, D, G, wg);
      EpiBranch E{MG, MG + ZB / 2, Z}; pg8::gemm_phase(lds, g, S, E, wave);
      const bf16* mga = MG; const bf16* mgb = MG + ZB / 2; bf16* Gm = Z;
      mini_gemm(lds, g.A0, g.B0, g.A1, g.B1, D, wg, G, tid, [=](int row, int col, f32x4 ya, f32x4 yb) {
          const size_t o = (size_t)row * D + col; const u32x2 a = *(const u32x2*)(mga + o), b = *(const u32x2*)(mgb + o);
          u32x2 w; w.x = pk2(bflo(a.x) * ya[0] + bflo(b.x) * yb[0], bfhi(a.x) * ya[1] + bfhi(b.x) * yb[1]);
          w.y = pk2(bflo(a.y) * ya[2] + bflo(b.y) * yb[2], bfhi(a.y) * ya[3] + bfhi(b.y) * yb[3]);
          *(u32x2*)(Gm + o) = w; }); }
    }
    GBAR();
    if constexpr ((PHM >> 10) & 1) {
    { pg8::Gemm g{Z, (const bf16*)(ws + WS_WOUT), nullptr, nullptr, D}; pg8::StaticOrder S; S.init(MPR, D, G, wg);
      EpiResidNorm<0> E{karg_out(), nullptr, ADA + 5 * D, 1.0f, INP(28), ADA + 6 * D, H, (float*)(ws + WS_PART) + 65536, (unsigned*)(ws + WS_CNT) + 64, (LAS float*)(lds + 131072)}; pg8::gemm_phase(lds, g, S, E, wave);
      float* X = karg_out(); const float* gate = ADA + 5 * D;
      mini_gemm(lds, Z, (const bf16*)(ws + WS_WOUT), nullptr, nullptr, D, wg, G, tid, [=](int row, int col, f32x4 v, f32x4) {
          float* xp = X + (size_t)row * D + col; const f32x4 gv = *(const f32x4*)(gate + (size_t)cond_of_row(row) * NADA + col);
          *(f32x4*)xp = *(const f32x4*)xp + gv * v; }); }
    }
    GBAR();
    if constexpr ((PHM >> 11) & 1) {
    sample_norm_rows<0>(INP(28), 6, gw, lane);
    {
        for (int item = (G == 256 ? SS_TAIL : 0) + wg; item < NS * NH; item += G) delta_sample_item<1>(P, lds, item, tid);
        const int gt = wg * NTHR + tid, NGT = G * NTHR;
        for (int i = gt; i < NS * 3 * 3072; i += NGT) { const int bs = i / 9216, j = (i / 3072) % 3, c3 = i % 3072;
            karg_out()[O_CQS + i] = j < 2 ? INP(7)[(size_t)bs * 9216 + (j + 1) * 3072 + c3] : bf2f(Z[(size_t)(2 + (c3 >> 10)) * (ZB / 2) + ((size_t)MPR + bs) * D + (c3 & 1023)]); }
    }
    }
    GBAR();
    if constexpr ((PHM >> 12) & 1) {
    { pg8::Gemm g{H, (const bf16*)(ws + WS_WUP2), nullptr, nullptr, D}; pg8::StaticOrder S; S.init(MPAD, 2 * FF, G, wg);
      EpiSwiglu E{ACT}; pg8::gemm_phase(lds, g, S, E, wave);
      if (G == 256 && wg >= 150) for (int item = wg - 150; item < SS_TAIL; item += 106) delta_sample_item<1>(P, lds, item, tid); }
    }
    GBAR();
    if constexpr ((PHM >> 13) & 1) {
    { pg8::Gemm g{ACT, (const bf16*)(ws + WS_WDN2), nullptr, nullptr, FF}; pg8::StaticOrder S; S.init(MPR, D, G, wg);
      EpiResidNorm<1> E{karg_out(), nullptr, ADA + 8 * D, 0.5f, INP(31), nullptr, nullptr, (float*)(ws + WS_PART) + 131072, (unsigned*)(ws + WS_CNT) + 128, (LAS float*)(lds + 131072)}; pg8::gemm_phase(lds, g, S, E, wave);
      float* X = karg_out(); const float* gate = ADA + 8 * D;
      mini_gemm(lds, ACT, (const bf16*)(ws + WS_WDN2), nullptr, nullptr, FF, wg, G, tid, [=](int row, int col, f32x4 v, f32x4) {
          float* xp = X + (size_t)row * D + col; const f32x4 gv = *(const f32x4*)(gate + (size_t)cond_of_row(row) * NADA + col);
          *(f32x4*)xp = *(const f32x4*)xp + (gv * 0.5f) * v; }); }
    }
    GBAR();
    if constexpr ((PHM >> 14) & 1) {
    sample_norm_rows<1>(INP(31), 0, gw, lane);
    }
}

extern "C" void kernel_launch(void* const* d_in, const int* in_sizes, int n_in, void* d_out, int out_size, void* d_ws, size_t ws_size, hipStream_t stream) {
    static int grid = 0;
    if (grid == 0) {
        if (n_in != 32 || (size_t)out_size != O_END || ws_size < WS_END) { fprintf(stderr, "kernel_launch: unexpected shapes: n_in %d out %d ws %zu (need %zu)\n", n_in, out_size, ws_size, (size_t)WS_END); grid = -1; return; }
        int dev = 0, cus = 0, per_cu = 0;
        hipGetDevice(&dev); hipDeviceGetAttribute(&cus, hipDeviceAttributeMultiprocessorCount, dev);
        if (hipFuncSetAttribute((const void*)fwd_megakernel, hipFuncAttributeMaxDynamicSharedMemorySize, LDS_BYTES) != hipSuccess) { fprintf(stderr, "kernel_launch: hipFuncSetAttribute failed\n"); grid = -1; return; }
        if (hipOccupancyMaxActiveBlocksPerMultiprocessor(&per_cu, (const void*)fwd_megakernel, NTHR, LDS_BYTES) != hipSuccess || per_cu < 1) { fprintf(stderr, "kernel_launch: occupancy query says %d\n", per_cu); per_cu = 1; }
        (void)hipGetLastError();
        grid = cus * 1;
        if (grid > 256) grid = 256;
    }
    if (grid < 0) return;
    if (hipMemsetAsync(d_ws, 0, 16384, stream) != hipSuccess) { fprintf(stderr, "kernel_launch: memset failed\n"); return; }
    Params p{};
    for (int i = 0; i < 32; ++i) p.in[i] = (const float*)d_in[i];
    p.out = (float*)d_out; p.ws = (unsigned char*)d_ws;
    void* args[] = {&p};
    hipError_t e = hipLaunchCooperativeKernel((const void*)fwd_megakernel, dim3(grid), dim3(NTHR), args, LDS_BYTES, stream);
    if (e != hipSuccess) fprintf(stderr, "kernel_launch: cooperative launch failed: %s (grid %d)\n", hipGetErrorString(e), grid);
}
```

```cpp
#include <hip/hip_runtime.h>
#include <hip/hip_cooperative_groups.h>
#include <cstdio>
#include <cstdint>
namespace cg = cooperative_groups;

#define LAS __attribute__((address_space(3)))
typedef unsigned short bf16;
typedef short bf16x8 __attribute__((ext_vector_type(8)));
typedef float f32x4 __attribute__((ext_vector_type(4)));
typedef float f32x16 __attribute__((ext_vector_type(16)));
typedef unsigned u32x4 __attribute__((ext_vector_type(4)));
typedef unsigned u32x2 __attribute__((ext_vector_type(2)));

constexpr int D = 1024, SEQ = 2048, NB = 8, MPR = NB * SEQ, NS = 128, M = MPR + NS, MPAD = 16640;
constexpr int FF = 2816, NADA = 9216, NCOND = NB + NS, NIN = 8448, NH = 8;
constexpr float EPS = 1e-6f;
constexpr int NWAVES = 8, NTHR = 512;

constexpr size_t MiB = 1u << 20;
constexpr size_t ZB = (size_t)M * D * 2;
constexpr size_t WS_WUP2 = 1 * MiB;
constexpr size_t WS_WDN2 = 12 * MiB;
constexpr size_t WS_WIN = WS_WDN2 + (size_t)D * FF * 2;
constexpr size_t WS_WBR = 34 * MiB;
constexpr size_t WS_WOUT = 38 * MiB;
constexpr size_t WS_WRG = 40 * MiB;
constexpr size_t WS_CB = WS_WRG + 512 * 1024;
constexpr size_t WS_ADA = 41 * MiB;
constexpr size_t WS_ABL = 46 * MiB;
constexpr size_t WS_H = 48 * MiB;
constexpr size_t WS_Z = WS_H + ZB;
constexpr size_t WS_ACT = WS_Z;
constexpr size_t WS_WUP1 = WS_Z + 96 * MiB;
constexpr size_t WS_WDN1 = WS_Z + 107 * MiB;
constexpr size_t WS_WADA = WS_Z + 113 * MiB;
constexpr size_t WS_END = WS_Z + 6 * ZB + 1 * MiB;
static_assert(WS_WIN + (size_t)NIN * D * 2 <= WS_WBR, "ws map");
static_assert((size_t)M * 16 * 4 <= 2 * MiB, "ws map");
static_assert((size_t)MPAD * FF * 2 <= 96 * MiB, "ws map");
static_assert(WS_WADA + (size_t)NADA * D * 2 <= WS_Z + 6 * ZB, "ws map");

constexpr size_t O_Y = 0, O_HP = (size_t)M * D, O_CRP = O_HP + NB * D, O_SP = O_CRP + NB * 3 * D, O_CQP = O_SP + (size_t)NB * NH * 128 * 128,
                 O_HS = O_CQP + NB * 3 * 3072, O_CRS = O_HS + NS * D, O_SS = O_CRS + NS * 3 * D, O_CQS = O_SS + (size_t)NS * NH * 128 * 128,
                 O_END = O_CQS + (size_t)NS * 3 * 3072;
static_assert(2 * ZB <= (O_END - O_SS) * 4, "scratch in d_out");
constexpr size_t OSB = O_SS * 4 + 2 * ZB, OSB_HK = OSB, OSB_HV = OSB + 3 * MiB / 2, OSB_NK = OSB + 3 * MiB, OSB_NQ = OSB + 7 * MiB / 2;
static_assert(OSB + 4 * MiB <= O_END * 4, "d_out scratch");

__device__ __forceinline__ unsigned pk2(float lo, float hi);
__device__ __forceinline__ unsigned f2bf(float f) { return pk2(f, f) & 0xffffu; }
typedef float f32x2_t __attribute__((ext_vector_type(2))); typedef __bf16 bf16x2_t __attribute__((ext_vector_type(2)));
__device__ __forceinline__ unsigned pk2(float lo, float hi) { f32x2_t v = {lo, hi}; bf16x2_t b = __builtin_convertvector(v, bf16x2_t); return __builtin_bit_cast(unsigned, b); }
__device__ __forceinline__ float bf2f(unsigned short b) { return __builtin_bit_cast(float, (unsigned)b << 16); }
__device__ __forceinline__ float bflo(unsigned u) { return __builtin_bit_cast(float, u << 16); }
__device__ __forceinline__ float bfhi(unsigned u) { return __builtin_bit_cast(float, u & 0xffff0000u); }
__device__ __forceinline__ float rcp_f(float x) { return __builtin_amdgcn_rcpf(x); }
__device__ __forceinline__ float rsq_f(float x) { return __builtin_amdgcn_rsqf(x); }
__device__ __forceinline__ float sigmoid_f(float x) { return rcp_f(1.f + __expf(-x)); }
__device__ __forceinline__ float neg_expm1_f(float x) {
    const float p = -x * (1.f + x * (0.5f + x * (0.16666667f + x * (0.041666668f + x * (0.0083333338f + x * 0.0013888889f)))));
    return x > -0.3f ? p : 1.f - __expf(x);
}
__device__ __forceinline__ float silu_f(float x) { return x * sigmoid_f(x); }
__device__ __forceinline__ float gelu_tanh_f(float x) { return x * sigmoid_f(1.5957691216057308f * (x + 0.044715f * x * x * x)); }
__device__ __forceinline__ float softplus_f(float x) { return x > 20.f ? x : log1pf(__expf(x)); }
template <int CTRL> __device__ __forceinline__ float dpp_f(float x) {
    return __builtin_bit_cast(float, __builtin_amdgcn_update_dpp(0, __builtin_bit_cast(int, x), CTRL, 0xF, 0xF, true));
}
__device__ __forceinline__ float red8(float x) { x += dpp_f<0xB1>(x); x += dpp_f<0x4E>(x); x += dpp_f<0x141>(x); return x; }
__device__ __forceinline__ float red16(float x) { x = red8(x); x += dpp_f<0x140>(x); return x; }
__device__ __forceinline__ float wave_sum(float v) { v = red16(v);
    return ((__builtin_bit_cast(float, __builtin_amdgcn_readlane(__builtin_bit_cast(int, v), 0)) + __builtin_bit_cast(float, __builtin_amdgcn_readlane(__builtin_bit_cast(int, v), 16))) +
            (__builtin_bit_cast(float, __builtin_amdgcn_readlane(__builtin_bit_cast(int, v), 32)) + __builtin_bit_cast(float, __builtin_amdgcn_readlane(__builtin_bit_cast(int, v), 48)))); }
__device__ __forceinline__ int lane_now();
__device__ __forceinline__ int opq(int x);
__device__ __forceinline__ float shfl_xor_l(float v, int o) { const int idx = (opq(lane_now()) ^ o) << 2; return __builtin_bit_cast(float, __builtin_amdgcn_ds_bpermute(idx, __builtin_bit_cast(int, v))); }
__device__ __forceinline__ void unpack8(const u32x4 u, float* x) { x[0] = bflo(u.x); x[1] = bfhi(u.x); x[2] = bflo(u.y); x[3] = bfhi(u.y); x[4] = bflo(u.z); x[5] = bfhi(u.z); x[6] = bflo(u.w); x[7] = bfhi(u.w); }
__device__ __forceinline__ bf16x8 pack8(float a0, float a1, float a2, float a3, float a4, float a5, float a6, float a7) {
    u32x4 w; w.x = pk2(a0, a1); w.y = pk2(a2, a3); w.z = pk2(a4, a5); w.w = pk2(a6, a7); return __builtin_bit_cast(bf16x8, w);
}
#define LDS_WAIT() asm volatile("s_waitcnt lgkmcnt(0)" ::: "memory")
__device__ __forceinline__ int lane_now() { return (int)__builtin_amdgcn_mbcnt_hi(~0u, __builtin_amdgcn_mbcnt_lo(~0u, 0u)); }
__device__ __forceinline__ int opq(int x) { asm volatile("" : "+v"(x)); return x; }

namespace pg8 {
constexpr int BM = 256, BK = 64, HALF = 128, HTB = HALF * BK * 2, NXCD = 8, WGM = 4;
__host__ __device__ __forceinline__ int lds_byte(int r, int c) { const int st = (r >> 4) * 2 + (c >> 5), rr = r & 15, cc = c & 31, ob = rr * 64 + cc * 2; return st * 1024 + (ob ^ (((ob >> 9) & 1) << 5)); }
__host__ __device__ __forceinline__ void stage_rc(int b, int& R, int& C) { const int st = b / 1024, sb = b % 1024, swz = sb ^ (((sb >> 9) & 1) << 5); R = (st >> 1) * 16 + swz / 64; C = (st & 1) * 32 + (swz % 64) / 2; }
__host__ __device__ __forceinline__ int perm32(int rho) { const int n = rho >> 4, i = rho & 15; return 8 * (i >> 2) + 4 * n + (i & 3); }

struct Unit { int pm, pn, sub; };
struct Gemm { const bf16* A0; const bf16* B0; const bf16* A1; const bf16* B1; int K; };

struct StaticOrder {
    int nM, nN, nwg, G, c;
    __device__ void init(int Mp, int N, int G_, int c_) { nM = Mp / BM; nN = N / BM; nwg = nM * nN; G = G_; c = c_; }
    __device__ bool next(int i, Unit& u) const {
        const long L = (long)i * G + c; if (L >= nwg) return false;
        int wgid = (int)L; { const int q = nwg / NXCD, r = nwg % NXCD, xcd = wgid % NXCD, off = wgid / NXCD; wgid = (xcd < r ? xcd * (q + 1) : r * (q + 1) + (xcd - r) * q) + off; }
        const int nig = WGM * nN, gid = wgid / nig, fm = gid * WGM, gsz = (nM - fm) < WGM ? (nM - fm) : WGM;
        u.pm = fm + ((wgid % nig) % gsz); u.pn = (wgid % nig) / gsz; u.sub = 0; return true;
    }
};
struct PairOrder {
    StaticOrder base;
    __device__ bool next(int i, Unit& u) const { const bool ok = base.next(i >> 1, u); u.sub = i & 1; return ok; }
};

template <class Epi, class Sched>
__device__ __forceinline__ void gemm_phase(LAS unsigned char* lds, const Gemm g, const Sched& S, const Epi& E, int wid) {
    const int lane = opq(lane_now()), tid = (wid << 6) | lane, wr = wid >> 2, wc = wid & 3, fr = lane & 15, fq = lane >> 4;
    const int K = g.K, nt = K / BK;
    unsigned voffA[2], voffB[2];
#pragma unroll
    for (int i = 0; i < 2; ++i) { int R, C; stage_rc(tid * 16 + i * 8192, R, C); const int Rb = (R & ~31) + perm32(R & 31);
        voffA[i] = (unsigned)(R * K + C) * 2u; voffB[i] = (unsigned)(Rb * K + C) * 2u; }
    const size_t kstep = (size_t)(BK * 2);
    const size_t hstep = (size_t)HALF * K * 2;
    const size_t tstep = 2 * hstep;
    const unsigned ldsw = (unsigned)wid * 1024u;
    const int aoff = lds_byte(wr * 64 + fr, fq * 8), boff = lds_byte(wc * 32 + fr, fq * 8);
#define PG8_SA(b, h) (((b) * 2 + (h)) * HTB)
#define PG8_SB(b, h) ((4 + (b) * 2 + (h)) * HTB)
#define PG8_STAGE(bufoff, gbase, voff) do { _Pragma("unroll") for (int _i = 0; _i < 2; ++_i) \
        __builtin_amdgcn_global_load_lds((const unsigned*)((const char*)(gbase) + (voff)[_i]), (LAS unsigned*)(lds + (bufoff) + ldsw + _i * 8192), 16, 0, 0); } while (0)
#define PG8_LDA(dst, b, h) do { _Pragma("unroll") for (int m = 0; m < 4; ++m) _Pragma("unroll") for (int k = 0; k < 2; ++k) dst[m][k] = *(const LAS bf16x8*)(lds + PG8_SA(b, h) + aoff + m * 2048 + k * 1024); } while (0)
#define PG8_LDB(dst, b, h) do { _Pragma("unroll") for (int n = 0; n < 2; ++n) _Pragma("unroll") for (int k = 0; k < 2; ++k) dst[n][k] = *(const LAS bf16x8*)(lds + PG8_SB(b, h) + boff + n * 2048 + k * 1024); } while (0)
#define PG8_MMA(ai, bj, At, Bt) do { __builtin_amdgcn_s_setprio(1); _Pragma("unroll") for (int m = 0; m < 4; ++m) _Pragma("unroll") for (int n = 0; n < 2; ++n) _Pragma("unroll") for (int k = 0; k < 2; ++k) \
        acc[ai][bj][m][n] = __builtin_amdgcn_mfma_f32_16x16x32_bf16(Bt[n][k], At[m][k], acc[ai][bj][m][n], 0, 0, 0); __builtin_amdgcn_s_setprio(0); } while (0)
#define PG8_WAIT_V(n) asm volatile("s_waitcnt vmcnt(" #n ")" ::: "memory")
#define PG8_WAIT_L(n) asm volatile("s_waitcnt lgkmcnt(" #n ")" ::: "memory")
#define PG8_BAR __builtin_amdgcn_s_barrier()
#define PG8_SCHED __builtin_amdgcn_sched_barrier(0)
#define PG8_ZERO() do { _Pragma("unroll") for (int a = 0; a < 2; ++a) _Pragma("unroll") for (int b = 0; b < 2; ++b) _Pragma("unroll") for (int m = 0; m < 4; ++m) _Pragma("unroll") for (int n = 0; n < 2; ++n) acc[a][b][m][n] = (f32x4){0.f, 0.f, 0.f, 0.f}; } while (0)
    Unit cur, nxt; int ui = 0;
    if (!S.next(0, cur)) return;
    f32x4 acc[2][2][4][2];
    PG8_ZERO();
    bf16x8 At[4][2], B0[2][2], B1[2][2];
    const char* cA = (const char*)(cur.sub ? g.A1 : g.A0) + (size_t)cur.pm * tstep; const char* cB = (const char*)(cur.sub ? g.B1 : g.B0) + (size_t)cur.pn * tstep;
    PG8_STAGE(PG8_SB(0, 0), cB, voffB); PG8_STAGE(PG8_SB(0, 1), cB + hstep, voffB); PG8_STAGE(PG8_SA(0, 0), cA, voffA); PG8_STAGE(PG8_SA(0, 1), cA + hstep, voffA);
    if (wr == 1) PG8_BAR;
    PG8_WAIT_V(2); PG8_BAR;
    PG8_STAGE(PG8_SB(1, 0), cB + kstep, voffB); PG8_STAGE(PG8_SA(1, 0), cA + kstep, voffA); PG8_STAGE(PG8_SB(1, 1), cB + hstep + kstep, voffB);
    PG8_WAIT_V(6); PG8_BAR;
    for (;;) {
        const bool has_next = S.next(ui + 1, nxt);
        const char* nA = has_next ? (const char*)(nxt.sub ? g.A1 : g.A0) + (size_t)nxt.pm * tstep : cA; const char* nB = has_next ? (const char*)(nxt.sub ? g.B1 : g.B0) + (size_t)nxt.pn * tstep : cB;
        for (int t = 0; t < nt; t += 2) {
            const bool last = (t == nt - 2);
            const char* a1 = cA + (size_t)(t + 1) * kstep;
            const char* a2 = last ? nA : cA + (size_t)(t + 2) * kstep; const char* b2 = last ? nB : cB + (size_t)(t + 2) * kstep;
            const char* a3 = a2 + kstep; const char* b3 = b2 + kstep;
            PG8_LDB(B0, 0, 0); PG8_LDB(B1, 0, 1); PG8_SCHED; PG8_LDA(At, 0, 0); PG8_STAGE(PG8_SA(1, 1), a1 + hstep, voffA);
            PG8_WAIT_V(8); PG8_WAIT_L(0); PG8_BAR; PG8_MMA(0, 0, At, B0); PG8_MMA(0, 1, At, B1); PG8_BAR; PG8_SCHED;
            PG8_LDA(At, 0, 1); PG8_STAGE(PG8_SB(0, 0), b2, voffB); PG8_STAGE(PG8_SB(0, 1), b2 + hstep, voffB); PG8_STAGE(PG8_SA(0, 0), a2, voffA);
            PG8_WAIT_V(8); PG8_WAIT_L(0); PG8_BAR; PG8_MMA(1, 0, At, B0); PG8_MMA(1, 1, At, B1); PG8_BAR; PG8_SCHED;
            PG8_LDB(B0, 1, 0); PG8_LDB(B1, 1, 1); PG8_SCHED; PG8_LDA(At, 1, 0); PG8_STAGE(PG8_SA(0, 1), a2 + hstep, voffA);
            PG8_WAIT_V(8); PG8_WAIT_L(0); PG8_BAR; PG8_MMA(0, 0, At, B0); PG8_MMA(0, 1, At, B1); PG8_BAR; PG8_SCHED;
            PG8_LDA(At, 1, 1); PG8_STAGE(PG8_SB(1, 0), b3, voffB); PG8_STAGE(PG8_SB(1, 1), b3 + hstep, voffB); PG8_STAGE(PG8_SA(1, 0), a3, voffA);
            PG8_WAIT_V(8); PG8_WAIT_L(0); PG8_BAR; PG8_MMA(1, 0, At, B0); PG8_MMA(1, 1, At, B1); PG8_BAR; PG8_SCHED;
        }
        if (wr == 0) PG8_BAR;
        bool keep = false;
        if constexpr (Epi::KEEP) { if (cur.sub == 0) { E.mid(acc, cur, wr, wc, fr, fq); keep = true; } else E(acc, cur, wr, wc, fr, fq); }
        else E(acc, cur, wr, wc, fr, fq);
        if (!has_next) break;
        if (!keep) PG8_ZERO();
        cur = nxt; cA = nA; cB = nB; ++ui;
        if (wr == 1) PG8_BAR;
    }
    PG8_WAIT_V(0);
    PG8_BAR;
#undef PG8_SA
#undef PG8_SB
#undef PG8_STAGE
#undef PG8_LDA
#undef PG8_LDB
#undef PG8_MMA
#undef PG8_WAIT_V
#undef PG8_WAIT_L
#undef PG8_BAR
#undef PG8_SCHED
#undef PG8_ZERO
}
}

typedef f32x4 AccT[2][2][4][2];
__device__ __forceinline__ int cond_of_row(int row) { return row < MPR ? (row >> 11) : (NB + row - MPR); }

struct EpiAda {
    static constexpr bool KEEP = false;
    float* ada; const float* bias;
    __device__ __forceinline__ void operator()(const AccT& acc, const pg8::Unit& u, int wr, int wc, int fr, int fq) const {
#pragma unroll
        for (int ai = 0; ai < 2; ++ai)
#pragma unroll
            for (int m = 0; m < 4; ++m) { const int row = u.pm * 256 + ai * 128 + wr * 64 + m * 16 + fr; if (row >= NCOND) continue;
#pragma unroll
                for (int bj = 0; bj < 2; ++bj)
#pragma unroll
                    for (int n = 0; n < 2; ++n) { const int col = u.pn * 256 + bj * 128 + wc * 32 + 8 * fq + 4 * n;
                        *(f32x4*)(ada + (size_t)row * NADA + col) = acc[ai][bj][m][n] + *(const f32x4*)(bias + col); } }
    }
};
struct EpiSwiglu {
    static constexpr bool KEEP = false;
    bf16* act;
    __device__ __forceinline__ void operator()(const AccT& acc, const pg8::Unit& u, int wr, int wc, int fr, int fq) const {
#pragma unroll
        for (int ai = 0; ai < 2; ++ai)
#pragma unroll
            for (int m = 0; m < 4; ++m) { const int row = u.pm * 256 + ai * 128 + wr * 64 + m * 16 + fr; if (row >= M) continue;
                const f32x4 g0 = acc[ai][0][m][0], g1 = acc[ai][0][m][1], v0 = acc[ai][1][m][0], v1 = acc[ai][1][m][1];
                u32x4 w; w.x = pk2(silu_f(g0[0]) * v0[0], silu_f(g0[1]) * v0[1]); w.y = pk2(silu_f(g0[2]) * v0[2], silu_f(g0[3]) * v0[3]);
                w.z = pk2(silu_f(g1[0]) * v1[0], silu_f(g1[1]) * v1[1]); w.w = pk2(silu_f(g1[2]) * v1[2], silu_f(g1[3]) * v1[3]);
                *(u32x4*)(act + (size_t)row * FF + u.pn * 128 + wc * 32 + 8 * fq) = w; }
    }
};
struct EpiResid {
    static constexpr bool KEEP = false;
    float* X; const float* xp; const float* xs; const float* gate; float coef;
    __device__ __forceinline__ void operator()(const AccT& acc, const pg8::Unit& u, int wr, int wc, int fr, int fq) const {
#pragma unroll
        for (int ai = 0; ai < 2; ++ai)
#pragma unroll
            for (int m = 0; m < 4; ++m) { const int row = u.pm * 256 + ai * 128 + wr * 64 + m * 16 + fr; if (row >= M) continue;
                const float* xin = xp ? (row < MPR ? xp + (size_t)row * D : xs + (size_t)(row - MPR) * D) : X + (size_t)row * D;
                const float* gt = gate + (size_t)cond_of_row(row) * NADA;
#pragma unroll
                for (int bj = 0; bj < 2; ++bj)
#pragma unroll
                    for (int n = 0; n < 2; ++n) { const int col = u.pn * 256 + bj * 128 + wc * 32 + 8 * fq + 4 * n;
                        const f32x4 xv = *(const f32x4*)(xin + col), gv = *(const f32x4*)(gt + col);
                        *(f32x4*)(X + (size_t)row * D + col) = xv + (gv * coef) * acc[ai][bj][m][n]; } }
    }
};
constexpr size_t WS_CNT = 14336, WS_PART = 65536;
template <int MODE> struct EpiResidNorm {
    static constexpr bool KEEP = false;
    float* X; const float* xp; const float* gate; float coef; const float* gvec; const float* shift; bf16* Hout; float* part; unsigned* cnt; LAS float* sred;
    __device__ __forceinline__ void operator()(AccT& acc, const pg8::Unit& u, int wr, int wc, int fr_, int fq_) const {
        const int fr = opq(fr_), fq = opq(fq_);
        const int tid = wr * 256 + wc * 64 + fq * 16 + fr, bidx = u.pm >> 3;
        const float* gt = gate + (size_t)bidx * NADA;
        float ss[2][4]; int zoff = 0;
#pragma unroll
        for (int ai = 0; ai < 2; ++ai)
#pragma unroll
            for (int m = 0; m < 4; ++m) { const int row = u.pm * 256 + ai * 128 + wr * 64 + m * 16 + fr + zoff;
                const float* xin = xp ? xp + (size_t)row * D : X + (size_t)row * D; float sacc = 0.f;
#pragma unroll
                for (int bj = 0; bj < 2; ++bj)
#pragma unroll
                    for (int n = 0; n < 2; ++n) { const int col = u.pn * 256 + bj * 128 + wc * 32 + 8 * fq + 4 * n;
                        const f32x4 xv = *(const f32x4*)(xin + col), gv = *(const f32x4*)(gt + col);
                        const f32x4 xn = xv + (gv * coef) * acc[ai][bj][m][n]; acc[ai][bj][m][n] = xn;
                        if (MODE == 0) *(f32x4*)(X + (size_t)row * D + col) = xn;
                        sacc += (xn[0] * xn[0] + xn[1] * xn[1]) + (xn[2] * xn[2] + xn[3] * xn[3]); }
                asm volatile("" : "+v"(zoff) : "v"(sacc));
                sacc += shfl_xor_l(sacc, 16); sacc += shfl_xor_l(sacc, 32);
                ss[ai][m] = sacc; __builtin_amdgcn_sched_barrier(0); }
        if (fq == 0) {
#pragma unroll
            for (int ai = 0; ai < 2; ++ai)
#pragma unroll
                for (int m = 0; m < 4; ++m) sred[wc * 256 + ai * 128 + wr * 64 + m * 16 + fr] = ss[ai][m]; }
        __syncthreads();
        if (tid < 256) __hip_atomic_store((unsigned*)part + ((size_t)u.pm * 4 + u.pn) * 256 + tid, __builtin_bit_cast(unsigned, (sred[tid] + sred[256 + tid]) + (sred[512 + tid] + sred[768 + tid])), __ATOMIC_RELAXED, __HIP_MEMORY_SCOPE_AGENT);
        asm volatile("s_waitcnt vmcnt(0)" ::: "memory");
        __syncthreads();
        if (tid == 0) { __hip_atomic_fetch_add(cnt + u.pm, 1u, __ATOMIC_RELAXED, __HIP_MEMORY_SCOPE_AGENT);
            unsigned sp = 0; while (__hip_atomic_load(cnt + u.pm, __ATOMIC_RELAXED, __HIP_MEMORY_SCOPE_AGENT) < 4u && ++sp < (1u << 24)) __builtin_amdgcn_s_sleep(1); }
        __syncthreads();
        if (tid < 256) { unsigned* pp = (unsigned*)part + (size_t)u.pm * 4 * 256 + tid;
            const float p0 = __builtin_bit_cast(float, __hip_atomic_load(pp, __ATOMIC_RELAXED, __HIP_MEMORY_SCOPE_AGENT)), p1 = __builtin_bit_cast(float, __hip_atomic_load(pp + 256, __ATOMIC_RELAXED, __HIP_MEMORY_SCOPE_AGENT));
            const float p2 = __builtin_bit_cast(float, __hip_atomic_load(pp + 512, __ATOMIC_RELAXED, __HIP_MEMORY_SCOPE_AGENT)), p3 = __builtin_bit_cast(float, __hip_atomic_load(pp + 768, __ATOMIC_RELAXED, __HIP_MEMORY_SCOPE_AGENT));
            sred[1024 + tid] = rsq_f(((p0 + p1) + (p2 + p3)) * (1.f / D) + EPS); }
        __syncthreads();
        const float* sh = MODE == 0 ? shift + (size_t)bidx * NADA : nullptr;
#pragma unroll
        for (int bj = 0; bj < 2; ++bj) { const int col = u.pn * 256 + bj * 128 + wc * 32 + 8 * fq;
            const f32x4 g0 = *(const f32x4*)(gvec + col), g1 = *(const f32x4*)(gvec + col + 4);
            f32x4 a0 = g0, a1 = g1, b0 = {0.f, 0.f, 0.f, 0.f}, b1 = b0;
            if (MODE == 0) { a0 = g0 * (*(const f32x4*)(sh + D + col) + 1.f); a1 = g1 * (*(const f32x4*)(sh + D + col + 4) + 1.f); b0 = *(const f32x4*)(sh + col); b1 = *(const f32x4*)(sh + col + 4); }
#pragma unroll
            for (int ai = 0; ai < 2; ++ai)
#pragma unroll
                for (int m = 0; m < 4; ++m) { const int rl = ai * 128 + wr * 64 + m * 16 + fr; const size_t row = (size_t)u.pm * 256 + rl; const float rstd = sred[1024 + rl];
                    const f32x4 y0 = acc[ai][bj][m][0] * rstd * a0 + b0, y1 = acc[ai][bj][m][1] * rstd * a1 + b1;
                    if (MODE == 0) *(bf16x8*)(Hout + row * D + col) = pack8(y0[0], y0[1], y0[2], y0[3], y1[0], y1[1], y1[2], y1[3]);
                    else { *(f32x4*)(X + row * D + col) = y0; *(f32x4*)(X + row * D + col + 4) = y1; }
                    __builtin_amdgcn_sched_barrier(0); }
        }
        __syncthreads();
    }
};
struct EpiIn {
    static constexpr bool KEEP = false;
    bf16* z; bf16* mg; float* abl; float* out;
    __device__ __forceinline__ void operator()(const AccT& acc, const pg8::Unit& u, int wr, int wc, int fr, int fq) const {
        const int bi = u.pn >> 2;
        if (bi == 8) {
            if (wc == 0 && fq < 2) {
#pragma unroll
                for (int ai = 0; ai < 2; ++ai)
#pragma unroll
                    for (int m = 0; m < 4; ++m) { const int row = u.pm * 256 + ai * 128 + wr * 64 + m * 16 + fr; if (row >= M) continue;
                        *(f32x4*)(abl + (size_t)row * 16 + 8 * fq) = acc[ai][0][m][0]; *(f32x4*)(abl + (size_t)row * 16 + 8 * fq + 4) = acc[ai][0][m][1]; }
            }
            return;
        }
        bf16* base = bi < 6 ? z + (size_t)bi * (ZB / 2) : mg + (size_t)(bi - 6) * (ZB / 2);
        const int act = (bi == 1) ? 1 : (bi == 5) ? 2 : (bi >= 6) ? 3 : 0;
        const int colt = (u.pn & 3) * 256 + wc * 32 + 8 * fq;
#pragma unroll
        for (int ai = 0; ai < 2; ++ai)
#pragma unroll
            for (int m = 0; m < 4; ++m) { const int row = u.pm * 256 + ai * 128 + wr * 64 + m * 16 + fr; if (row >= M) continue;
#pragma unroll
                for (int bj = 0; bj < 2; ++bj) { f32x4 v0 = acc[ai][bj][m][0], v1 = acc[ai][bj][m][1];
                    if (act == 1) {
#pragma unroll
                        for (int j = 0; j < 4; ++j) { v0[j] = gelu_tanh_f(v0[j]); v1[j] = gelu_tanh_f(v1[j]); } }
                    else if (act == 2) {
#pragma unroll
                        for (int j = 0; j < 4; ++j) { v0[j] = silu_f(v0[j]); v1[j] = silu_f(v1[j]); } }
                    else if (act == 3) {
#pragma unroll
                        for (int j = 0; j < 4; ++j) { v0[j] = sigmoid_f(v0[j]); v1[j] = sigmoid_f(v1[j]); } }
                    u32x4 w; w.x = pk2(v0[0], v0[1]); w.y = pk2(v0[2], v0[3]); w.z = pk2(v1[0], v1[1]); w.w = pk2(v1[2], v1[3]);
                    *(u32x4*)(base + (size_t)row * D + colt + bj * 128) = w;
                    if (act == 0 && row < MPR) { const int rs = row & (SEQ - 1), r64 = row & 63, bb = row >> 11, col = colt + bj * 128;
                        if (bi >= 3 && r64 >= 61 && rs < SEQ - 3)
                            *(u32x4*)((bf16*)((unsigned char*)out + (bi == 3 ? OSB_HK : OSB_HV)) + ((size_t)(bb * 32 + (rs >> 6) + 1) * 3 + (r64 - 61)) * D + col) = w;
                        if (rs >= SEQ - 3) { float* dst = bi == 0 ? out + O_CRP + ((size_t)bb * 3 + (rs - (SEQ - 3))) * D + col : out + O_CQP + ((size_t)bb * 3 + (rs - (SEQ - 3))) * 3072 + (bi - 2) * 1024 + col;
                            *(f32x4*)dst = v0; *(f32x4*)(dst + 4) = v1; } }
                } }
    }
};
struct EpiBranch {
    static constexpr bool KEEP = true;
    const bf16* mga; const bf16* mgb; bf16* G;
    __device__ __forceinline__ void mid(AccT& acc, const pg8::Unit& u, int wr, int wc, int fr, int fq) const {
#pragma unroll
        for (int ai = 0; ai < 2; ++ai)
#pragma unroll
            for (int m = 0; m < 4; ++m) { int row = u.pm * 256 + ai * 128 + wr * 64 + m * 16 + fr; if (row >= M) row = M - 1;
#pragma unroll
                for (int bj = 0; bj < 2; ++bj) { const size_t o = (size_t)row * D + u.pn * 256 + bj * 128 + wc * 32 + 8 * fq;
                    const u32x4 a = *(const u32x4*)(mga + o), b = *(const u32x4*)(mgb + o);
                    f32x4 r0, r1;
                    r0[0] = bflo(a.x) * rcp_f(bflo(b.x)); r0[1] = bfhi(a.x) * rcp_f(bfhi(b.x)); r0[2] = bflo(a.y) * rcp_f(bflo(b.y)); r0[3] = bfhi(a.y) * rcp_f(bfhi(b.y));
                    r1[0] = bflo(a.z) * rcp_f(bflo(b.z)); r1[1] = bfhi(a.z) * rcp_f(bfhi(b.z)); r1[2] = bflo(a.w) * rcp_f(bflo(b.w)); r1[3] = bfhi(a.w) * rcp_f(bfhi(b.w));
                    acc[ai][bj][m][0] = acc[ai][bj][m][0] * r0; acc[ai][bj][m][1] = acc[ai][bj][m][1] * r1; } }
    }
    __device__ __forceinline__ void operator()(const AccT& acc, const pg8::Unit& u, int wr, int wc, int fr, int fq) const {
#pragma unroll
        for (int ai = 0; ai < 2; ++ai)
#pragma unroll
            for (int m = 0; m < 4; ++m) { const int row = u.pm * 256 + ai * 128 + wr * 64 + m * 16 + fr; if (row >= M) continue;
#pragma unroll
                for (int bj = 0; bj < 2; ++bj) { const size_t o = (size_t)row * D + u.pn * 256 + bj * 128 + wc * 32 + 8 * fq;
                    const u32x4 b = *(const u32x4*)(mgb + o);
                    const f32x4 v0 = acc[ai][bj][m][0], v1 = acc[ai][bj][m][1];
                    u32x4 w; w.x = pk2(v0[0] * bflo(b.x), v0[1] * bfhi(b.x)); w.y = pk2(v0[2] * bflo(b.y), v0[3] * bfhi(b.y));
                    w.z = pk2(v1[0] * bflo(b.z), v1[1] * bfhi(b.z)); w.w = pk2(v1[2] * bflo(b.w), v1[3] * bfhi(b.w));
                    *(u32x4*)(G + o) = w; } }
    }
};

__device__ __forceinline__ f32x4 mini_partial(const bf16* A, const bf16* Bt, int K, int row0, int col0, int ks, int lane) {
    const int kq = K >> 2;
    const bf16* ap = A + (size_t)(MPR + row0 + (lane & 15)) * K + ks * kq + (lane >> 4) * 8;
    const bf16* bp = Bt + (size_t)(col0 + (lane & 15)) * K + ks * kq + (lane >> 4) * 8;
    f32x4 acc = {0.f, 0.f, 0.f, 0.f};
#pragma unroll 1
    for (int k0 = 0; k0 < kq; k0 += 256) {
        bf16x8 a[8], b[8];
#pragma unroll
        for (int i = 0; i < 8; ++i) if (k0 + 32 * i < kq) { a[i] = *(const bf16x8*)(ap + k0 + 32 * i); b[i] = *(const bf16x8*)(bp + k0 + 32 * i); }
#pragma unroll
        for (int i = 0; i < 8; ++i) if (k0 + 32 * i < kq) acc = __builtin_amdgcn_mfma_f32_16x16x32_bf16(b[i], a[i], acc, 0, 0, 0);
    }
    return acc;
}
template <class F>
__device__ __forceinline__ void mini_gemm(LAS unsigned char* lds, const bf16* A0, const bf16* B0, const bf16* A1, const bf16* B1, int K, int wg, int G, int tid_, const F& epi) {
    const int tid = opq(tid_), lane = tid & 63, wave = tid >> 6, ks = wave & 3;
    LAS f32x4* red = (LAS f32x4*)lds;
    for (int t0 = wg * 2; t0 < 512; t0 += G * 2) {
        const int tile = t0 + (wave >> 2), row0 = (tile >> 6) * 16, col0 = (tile & 63) * 16;
        f32x4 p0 = mini_partial(A0, B0, K, row0, col0, ks, lane), p1 = {0.f, 0.f, 0.f, 0.f};
        if (A1) p1 = mini_partial(A1, B1, K, row0, col0, ks, lane);
        red[(wave * 2) * 64 + lane] = p0; red[(wave * 2 + 1) * 64 + lane] = p1;
        __syncthreads();
        if (ks == 0) {
#pragma unroll
            for (int w = 1; w < 4; ++w) { p0 = p0 + red[((wave + w) * 2) * 64 + lane]; p1 = p1 + red[((wave + w) * 2 + 1) * 64 + lane]; }
            epi(MPR + row0 + (lane & 15), col0 + 4 * (lane >> 4), p0, p1);
        }
        __syncthreads();
    }
}

struct Params { const float* in[32]; float* out; unsigned char* ws; };
constexpr int LDS_BYTES = 147456;
#ifndef PHM
#define PHM 0xFFFF
#endif
#ifndef P7M
#define P7M 0xF
#endif

struct Ctx {
    const float* const* in; float* out; unsigned char* ws; LAS unsigned char* lds;
    int tid, lane, wave, wg, G;
};
#define KAS __attribute__((address_space(4)))
typedef const float* cfptr_t; typedef float* fptr_t; typedef unsigned char* ucptr_t;
__device__ __forceinline__ const float* karg_in(int k) { return *(volatile KAS cfptr_t*)((const KAS char*)__builtin_amdgcn_kernarg_segment_ptr() + 8 * k); }
__device__ __forceinline__ float* karg_out() { return *(volatile KAS fptr_t*)((const KAS char*)__builtin_amdgcn_kernarg_segment_ptr() + 256); }
__device__ __forceinline__ unsigned char* karg_ws() { return *(volatile KAS ucptr_t*)((const KAS char*)__builtin_amdgcn_kernarg_segment_ptr() + 264); }
#define INP(k) karg_in(k)

template <int MODE>
__device__ __forceinline__ void sample_norm_rows(const float* gvec, int ish, int gw, int lane) {
    if (gw >= NS) return;
    const int row = MPR + gw; float* X = karg_out() + (size_t)row * D;
    f32x4 v[4]; float s = 0.f;
#pragma unroll
    for (int j = 0; j < 4; ++j) { v[j] = *(const f32x4*)(X + 4 * (lane + 64 * j)); s += (v[j][0] * v[j][0] + v[j][1] * v[j][1]) + (v[j][2] * v[j][2] + v[j][3] * v[j][3]); }
    const float rstd = rsq_f(wave_sum(s) * (1.f / D) + EPS);
    const float* sh = (const float*)(karg_ws() + WS_ADA) + (size_t)cond_of_row(row) * NADA + ish * D;
#pragma unroll
    for (int j = 0; j < 4; ++j) { const int col = 4 * (lane + 64 * j); const f32x4 g = *(const f32x4*)(gvec + col);
        if (MODE == 0) { const f32x4 y = (v[j] * rstd * g) * (*(const f32x4*)(sh + D + col) + 1.f) + *(const f32x4*)(sh + col);
            u32x2 o; o.x = pk2(y[0], y[1]); o.y = pk2(y[2], y[3]); *(u32x2*)((bf16*)(karg_ws() + WS_H) + (size_t)row * D + col) = o; }
        else *(f32x4*)(X + col) = v[j] * rstd * g; }
}
__device__ __forceinline__ void transpose_item(const float* W, int ldw, int k0, int n0, int nvalid, bf16* WT, int ldt, int drow0, LAS float* scr, int lane) {
    const int cc = lane & 31;
#pragma unroll 8
    for (int i = 0; i < 32; ++i) { const int kk = 2 * i + (lane >> 5); scr[kk * 33 + cc] = (cc < nvalid) ? W[(size_t)(k0 + kk) * ldw + n0 + cc] : 0.f; }
    LDS_WAIT(); asm volatile("" ::: "memory");
    const int c = lane & 7;
#pragma unroll
    for (int j = 0; j < 4; ++j) { const int n = (lane >> 3) + 8 * j; const LAS float* s = scr + (8 * c) * 33 + n;
        u32x4 o; o.x = pk2(s[0 * 33], s[1 * 33]); o.y = pk2(s[2 * 33], s[3 * 33]); o.z = pk2(s[4 * 33], s[5 * 33]); o.w = pk2(s[6 * 33], s[7 * 33]);
        if (n < nvalid) *(u32x4*)(WT + (size_t)(drow0 + n) * ldt + k0 + 8 * c) = o; }
    LDS_WAIT(); asm volatile("" ::: "memory");
}

template <int PART>
__device__ __forceinline__ void prologue(const Params& P, LAS unsigned char* lds, int gw, int NGW, int wave, int lane) {
    LAS float* scr = (LAS float*)(lds + wave * 16384);
    unsigned char* ws = karg_ws();
    constexpr int I_UP = 16 * 176, I_DN = 44 * 32, I_IN = 16 * 257, I_BR = 2 * 16 * 32, I_OUT = 16 * 32, I_ADA = 16 * 288, I_RG = 128;
    constexpr int NITEMS = 2 * I_UP + 2 * I_DN + I_IN + I_BR + I_OUT + I_ADA + I_RG;
    constexpr int I_FIRST = 2 * I_UP + 2 * I_DN + I_IN + I_BR + I_OUT;
    for (int it = gw; it < NITEMS; it += NGW) {
        int r = it;
        if (PART == 0) { if (r >= I_ADA) break; r += I_FIRST; } else { if (r >= NITEMS - I_ADA) break; if (r >= I_FIRST) r += I_ADA; }
        if (r < 2 * I_UP) { const int which = r / I_UP; r -= which * I_UP; const int kb = r / 176, nb = r % 176, n0 = nb * 32; const int half = n0 >= FF ? 1 : 0, np = n0 - half * FF;
            transpose_item(INP(which ? 29 : 11), 2 * FF, kb * 64, n0, 32, (bf16*)(ws + (which ? WS_WUP2 : WS_WUP1)), D, (np >> 7) * 256 + half * 128 + (np & 127), scr, lane); continue; }
        r -= 2 * I_UP;
        if (r < 2 * I_DN) { const int which = r / I_DN; r -= which * I_DN; const int kb = r / 32, nb = r % 32;
            transpose_item(INP(which ? 30 : 12), D, kb * 64, nb * 32, 32, (bf16*)(ws + (which ? WS_WDN2 : WS_WDN1)), FF, nb * 32, scr, lane); continue; }
        r -= 2 * I_DN;
        if (r < I_IN) { const int kb = r / 257, nb = r % 257; int n0, nv, dr;
            if (nb < 160) { n0 = nb * 32; nv = 32; dr = n0; } else if (nb == 160) { n0 = 5120; nv = 16; dr = 8192; } else { n0 = 5136 + (nb - 161) * 32; nv = 32; dr = 5120 + (nb - 161) * 32; }
            transpose_item(INP(14), 8208, kb * 64, n0, nv, (bf16*)(ws + WS_WIN), D, dr, scr, lane); continue; }
        r -= I_IN;
        if (r < I_BR) { const int which = r / 512; r -= which * 512; const int kb = r / 32, nb = r % 32;
            transpose_item(INP(26) + (size_t)which * D * D, D, kb * 64, nb * 32, 32, (bf16*)(ws + WS_WBR), D, which * D + nb * 32, scr, lane); continue; }
        r -= I_BR;
        if (r < I_OUT) { const int kb = r / 32, nb = r % 32; transpose_item(INP(27), D, kb * 64, nb * 32, 32, (bf16*)(ws + WS_WOUT), D, nb * 32, scr, lane); continue; }
        r -= I_OUT;
        if (r < I_ADA) { const int kb = r / 288, nb = r % 288; transpose_item(INP(8), NADA, kb * 64, nb * 32, 32, (bf16*)(ws + WS_WADA), D, nb * 32, scr, lane); continue; }
        r -= I_ADA;
        { const int gx = r >> 6, n = (r >> 3) & 7, kb = (r >> 2) & 1, nb = r & 3;
          transpose_item(INP(gx ? 19 : 17) + (size_t)n * 128 * 128, 128, kb * 64, nb * 32, 32, (bf16*)(ws + WS_WRG), 128, n * 256 + gx * 128 + nb * 32, scr, lane); }
    }
    bf16* cb = (bf16*)(ws + WS_CB);
    if (PART == 0) for (int row = gw; row < 256; row += NGW) {
        const float* src = row < NB ? INP(2) + (size_t)row * D : (row < NCOND ? INP(3) + (size_t)(row - NB) * D : nullptr);
#pragma unroll
        for (int j = 0; j < 4; ++j) { const int col = 4 * (lane + 64 * j); f32x4 v = src ? *(const f32x4*)(src + col) : (f32x4){0.f, 0.f, 0.f, 0.f};
            u32x2 o; o.x = pk2(v[0], v[1]); o.y = pk2(v[2], v[3]); *(u32x2*)(cb + (size_t)row * D + col) = o; }
    }
}

template <int MODE>
__device__ __forceinline__ void norm_mod_pass(const Params& P, const float* gvec, int ish, int gw, int NGW, int lane) {
    const float* ada = (const float*)(karg_ws() + WS_ADA); bf16* H = (bf16*)(karg_ws() + WS_H);
    const float* xp = INP(0); const float* xs = INP(1); const float* X = karg_out();
    for (int row0 = 2 * gw; row0 < M; row0 += 2 * NGW) {
        f32x4 v[2][4]; float s[2] = {0.f, 0.f};
#pragma unroll
        for (int u = 0; u < 2; ++u) { const int row = row0 + u;
            const float* xr = MODE == 0 ? (row < MPR ? xp + (size_t)row * D : xs + (size_t)(row - MPR) * D) : X + (size_t)row * D;
#pragma unroll
            for (int j = 0; j < 4; ++j) v[u][j] = *(const f32x4*)(xr + 4 * (lane + 64 * j)); }
#pragma unroll
        for (int u = 0; u < 2; ++u)
#pragma unroll
            for (int j = 0; j < 4; ++j) s[u] += (v[u][j][0] * v[u][j][0] + v[u][j][1] * v[u][j][1]) + (v[u][j][2] * v[u][j][2] + v[u][j][3] * v[u][j][3]);
        s[0] = wave_sum(s[0]); s[1] = wave_sum(s[1]);
#pragma unroll
        for (int u = 0; u < 2; ++u) { const int row = row0 + u; const float rstd = rsq_f(s[u] * (1.f / D) + EPS);
            const float* sh = ada + (size_t)cond_of_row(row) * NADA + ish * D; const float* sc = sh + D;
#pragma unroll
            for (int j = 0; j < 4; ++j) { const int col = 4 * (lane + 64 * j); const f32x4 g = *(const f32x4*)(gvec + col), a = *(const f32x4*)(sc + col), bb = *(const f32x4*)(sh + col);
                const f32x4 y = (v[u][j] * rstd * g) * (a + 1.f) + bb; u32x2 o; o.x = pk2(y[0], y[1]); o.y = pk2(y[2], y[3]); *(u32x2*)(H + (size_t)row * D + col) = o; } }
    }
}
__device__ __forceinline__ void final_norm_pass(const Params& P, int gw, int NGW, int lane) {
    const float* gvec = INP(31); float* X = karg_out();
    for (int row0 = 2 * gw; row0 < M; row0 += 2 * NGW) {
        f32x4 v[2][4]; float s[2] = {0.f, 0.f};
#pragma unroll
        for (int u = 0; u < 2; ++u)
#pragma unroll
            for (int j = 0; j < 4; ++j) v[u][j] = *(const f32x4*)(X + (size_t)(row0 + u) * D + 4 * (lane + 64 * j));
#pragma unroll
        for (int u = 0; u < 2; ++u)
#pragma unroll
            for (int j = 0; j < 4; ++j) s[u] += (v[u][j][0] * v[u][j][0] + v[u][j][1] * v[u][j][1]) + (v[u][j][2] * v[u][j][2] + v[u][j][3] * v[u][j][3]);
        s[0] = wave_sum(s[0]); s[1] = wave_sum(s[1]);
#pragma unroll
        for (int u = 0; u < 2; ++u) { const float rstd = rsq_f(s[u] * (1.f / D) + EPS);
#pragma unroll
            for (int j = 0; j < 4; ++j) { const int col = 4 * (lane + 64 * j); *(f32x4*)(X + (size_t)(row0 + u) * D + col) = v[u][j] * rstd * *(const f32x4*)(gvec + col); } }
    }
}
__device__ __forceinline__ void onorm_pass(const Params& P, int gw, int NGW, int lane) {
    const bf16* O = (const bf16*)(karg_ws() + WS_H); bf16* ZG = (bf16*)(karg_ws() + WS_Z + 5 * ZB); const float* dn = INP(25);
    const int dc = (lane & 7) * 16;
    for (int row0 = 2 * gw; row0 < M; row0 += 2 * NGW) {
        u32x4 a[2][2], z[2][2];
#pragma unroll
        for (int u = 0; u < 2; ++u) { const size_t o = (size_t)(row0 + u) * D + lane * 16;
            a[u][0] = *(const u32x4*)(O + o); a[u][1] = *(const u32x4*)(O + o + 8); z[u][0] = *(const u32x4*)(ZG + o); z[u][1] = *(const u32x4*)(ZG + o + 8); }
#pragma unroll
        for (int u = 0; u < 2; ++u) { const size_t o = (size_t)(row0 + u) * D + lane * 16;
            float v[16], zz[16]; unpack8(a[u][0], v); unpack8(a[u][1], v + 8); unpack8(z[u][0], zz); unpack8(z[u][1], zz + 8);
            float s = 0.f;
#pragma unroll
            for (int e = 0; e < 16; ++e) s += v[e] * v[e];
            s = red8(s);
            const float rstd = rsq_f(s * (1.f / 128.f) + EPS);
#pragma unroll
            for (int e = 0; e < 16; ++e) v[e] = v[e] * rstd * dn[dc + e] * zz[e];
            *(bf16x8*)(ZG + o) = pack8(v[0], v[1], v[2], v[3], v[4], v[5], v[6], v[7]); *(bf16x8*)(ZG + o + 8) = pack8(v[8], v[9], v[10], v[11], v[12], v[13], v[14], v[15]); }
    }
}

constexpr int SS_TAIL = 530;
constexpr int RG_SPLIT = 7;
constexpr size_t WS_HCARRY = 917504;
__device__ __forceinline__ void rglru_task(const Params& P, LAS unsigned char* lds, int b, int n, int qd, int tid, int t0, int t1) {
    const int lane = tid & 63, wave = tid >> 6;
    LAS bf16* xcA = (LAS bf16*)lds;
    LAS float* xcf = (LAS float*)(lds + 34816);
    LAS float* rb = (LAS float*)(lds + 51200);
    LAS float* ib = (LAS float*)(lds + 67584);
    LAS float* segA = (LAS float*)(lds + 83968);
    LAS float* segB = (LAS float*)(lds + 86016);
    LAS float* hc = (LAS float*)(lds + 88064);
    LAS float* cw = (LAS float*)(lds + 88192);
    LAS bf16* rawt = (LAS bf16*)(lds + 90752);
    bf16* XR = (bf16*)(karg_ws() + WS_Z); bf16* GR = (bf16*)(karg_ws() + WS_Z + ZB);
    const bf16* WRG = (const bf16*)(karg_ws() + WS_WRG);
    const int cb0 = n * 128, oc0 = cb0 + qd * 32;
    const bool prompt = b >= 0;
    for (int i = tid; i < 640; i += NTHR) cw[i] = i < 512 ? INP(15)[(size_t)(i >> 7) * D + cb0 + (i & 127)] : INP(16)[cb0 + (i - 512)];
    if (tid < 32) hc[tid] = t0 > 0 ? ((const float*)(karg_ws() + WS_HCARRY))[(size_t)b * D + oc0 + tid] : 0.f;
    const int tb = wave & 3, cbk = wave >> 2;
    bf16x8 Bf[8];
    { const bf16* wrow = WRG + (size_t)(n * 256 + cbk * 128 + qd * 32 + (lane & 31)) * 128 + (lane >> 5) * 8;
#pragma unroll
      for (int ks = 0; ks < 8; ++ks) Bf[ks] = *(const bf16x8*)(wrow + ks * 16); }
    const float gbias = INP(cbk ? 20 : 18)[oc0 + (lane & 31)];
    const int ch = tid & 31, seg = tid >> 5;
    const float sp = softplus_f(-INP(21)[oc0 + ch]);
    float hlast = 0.f;
    u32x4 pre[5];
#define RG_RAW_LOAD(tile_) do { _Pragma("unroll") for (int i = 0; i < 5; ++i) { const int q = tid + 512 * i, row = q >> 4, c16 = q & 15, tl = (tile_) * 128 - 3 + row; \
        pre[i] = (q < 131 * 16 && tl >= 0) ? *(const u32x4*)(XR + ((size_t)b * SEQ + tl) * D + cb0 + c16 * 8) : (u32x4){0u, 0u, 0u, 0u}; } } while (0)
#define RG_RAW_STORE() do { _Pragma("unroll") for (int i = 0; i < 5; ++i) { const int q = tid + 512 * i; if (q < 131 * 16) *(LAS u32x4*)(rawt + (q >> 4) * 136 + (q & 15) * 8) = pre[i]; } } while (0)
    if (prompt) { RG_RAW_LOAD(t0); RG_RAW_STORE(); }
    __syncthreads();
    const int ntiles = t1;
    for (int tile = t0; tile < ntiles; ++tile) {
        const int row0 = prompt ? b * SEQ + tile * 128 : MPR;
        if (prompt && tile + 1 < ntiles) RG_RAW_LOAD(tile + 1);
        { const int t = tid >> 2, cq = tid & 3, c0 = cq * 32;
#pragma unroll 2
          for (int q = 0; q < 4; ++q) {
              const int cc = c0 + q * 8;
              float a[8];
#pragma unroll
              for (int e = 0; e < 8; ++e) a[e] = cw[512 + cc + e];
#pragma unroll
              for (int j = 0; j < 4; ++j) {
                  if (prompt || j == 3) {
                      {
                          const u32x4 u = prompt ? *(const LAS u32x4*)(rawt + (t + j) * 136 + cc) : *(const u32x4*)(XR + (size_t)(MPR + t) * D + cb0 + cc);
                          const float x8[8] = {bflo(u.x), bfhi(u.x), bflo(u.y), bfhi(u.y), bflo(u.z), bfhi(u.z), bflo(u.w), bfhi(u.w)};
#pragma unroll
                          for (int e = 0; e < 8; ++e) a[e] += x8[e] * cw[j * 128 + cc + e];
                      }
                  } else {
                      const float* p = INP(5) + ((size_t)t * 3 + j) * D + cb0 + cc;
                      const f32x4 u0 = *(const f32x4*)p, u1 = *(const f32x4*)(p + 4);
#pragma unroll
                      for (int e = 0; e < 4; ++e) { a[e] += u0[e] * cw[j * 128 + cc + e]; a[4 + e] += u1[e] * cw[j * 128 + cc + 4 + e]; }
                  }
              }
              u32x4 w; w.x = pk2(a[0], a[1]); w.y = pk2(a[2], a[3]); w.z = pk2(a[4], a[5]); w.w = pk2(a[6], a[7]);
              *(LAS u32x4*)(xcA + t * 136 + cc) = w;
              if (cq == qd) { *(LAS f32x4*)(xcf + t * 32 + q * 8) = (f32x4){a[0], a[1], a[2], a[3]}; *(LAS f32x4*)(xcf + t * 32 + q * 8 + 4) = (f32x4){a[4], a[5], a[6], a[7]}; }
          }
        }
        __syncthreads();
        { f32x16 c;
#pragma unroll
          for (int r = 0; r < 16; ++r) c[r] = 0.f;
          const LAS bf16* ap = xcA + (tb * 32 + (lane & 31)) * 136 + (lane >> 5) * 8;
#pragma unroll
          for (int ks = 0; ks < 8; ++ks) { const bf16x8 af = *(const LAS bf16x8*)(ap + ks * 16); c = __builtin_amdgcn_mfma_f32_32x32x16_bf16(af, Bf[ks], c, 0, 0, 0); }
          LAS float* dst = cbk ? ib : rb;
#pragma unroll
          for (int r = 0; r < 16; ++r) { const int tok = tb * 32 + (r & 3) + 8 * (r >> 2) + 4 * (lane >> 5); dst[tok * 32 + (lane & 31)] = sigmoid_f(c[r] + gbias); }
        }
        __syncthreads();
        float Aacc = 1.f, h = 0.f;
#pragma unroll 4
        for (int e = 0; e < 8; ++e) { const int t = seg * 8 + e;
            const float r = rb[t * 32 + ch], ig = ib[t * 32 + ch], x = xcf[t * 32 + ch];
            const float la = -8.f * r * sp; const float a = __expf(la);
            const float x2 = 2.f * la, ser = -x2 * (1.f + x2 * (0.5f + x2 * (0.16666667f + x2 * (0.041666668f + x2 * (0.0083333338f + x2 * 0.0013888889f)))));
            float mult = __builtin_amdgcn_sqrtf(x2 > -0.3f ? ser : 1.f - a * a);
            if (prompt && tile == 0 && t == 0) mult = 1.f;
            const float bt = mult * ig * x;
            rb[t * 32 + ch] = a; ib[t * 32 + ch] = bt;
            h = a * h + bt; Aacc *= a;
        }
        float hin = 0.f;
        if (prompt) {
            segA[seg * 32 + ch] = Aacc; segB[seg * 32 + ch] = h;
            __syncthreads();
            hin = hc[ch];
            float sa[15], sb[15];
#pragma unroll
            for (int s = 0; s < 15; ++s) { sa[s] = segA[s * 32 + ch]; sb[s] = segB[s * 32 + ch]; }
#pragma unroll
            for (int s = 0; s < 15; ++s) hin = s < seg ? sa[s] * hin + sb[s] : hin;
        }
        h = hin;
        { float gr[8], h0v[8];
#pragma unroll
          for (int e = 0; e < 8; ++e) { const int t = seg * 8 + e; gr[e] = bf2f(GR[(size_t)(row0 + t) * D + oc0 + ch]); h0v[e] = prompt ? 0.f : INP(4)[(size_t)t * D + oc0 + ch]; }
#pragma unroll
          for (int e = 0; e < 8; ++e) { const int t = seg * 8 + e;
              const float a = rb[t * 32 + ch], bt = ib[t * 32 + ch];
              if (prompt) h = a * h + bt; else h = a * h0v[e] + bt;
              GR[(size_t)(row0 + t) * D + oc0 + ch] = (bf16)f2bf(h * gr[e]);
              if (!prompt) { karg_out()[O_HS + (size_t)t * D + oc0 + ch] = h;
                  const float* cs = INP(5) + (size_t)t * 3 * D + oc0 + ch; float* co = karg_out() + O_CRS + (size_t)t * 3 * D + oc0 + ch;
                  co[0] = cs[D]; co[D] = cs[2 * D]; co[2 * D] = bf2f(XR[(size_t)(MPR + t) * D + oc0 + ch]); }
          } }
        hlast = h;
        if (prompt && tile + 1 < ntiles) RG_RAW_STORE();
        __syncthreads();
        if (prompt && seg == 15) hc[ch] = hlast;
    }
    if (prompt && seg == 15) { if (t1 == 16) karg_out()[O_HP + (size_t)b * D + oc0 + ch] = hlast; else ((float*)(karg_ws() + WS_HCARRY))[(size_t)b * D + oc0 + ch] = hlast; }
    __syncthreads();
}

constexpr size_t WS_TINV = WS_WIN, WS_ATT = WS_WIN + 8 * MiB, WS_GC = WS_CB, WS_BETA = 47 * MiB + 65536;
static_assert(WS_ABL + (size_t)M * 16 * 4 <= WS_BETA && WS_BETA + 64 * 2048 * 4 <= WS_H, "ws map (beta)");
__device__ __forceinline__ int perm16(int e) { return (e & ~12) | ((e >> 1) & 4) | ((e << 1) & 8); }

__device__ __forceinline__ void conv8(const bf16* p, int tl, const LAS float* w, float* a) {
#pragma unroll
    for (int e = 0; e < 8; ++e) a[e] = 0.f;
#pragma unroll
    for (int j = 0; j < 4; ++j) {
        const bool ok = tl - 3 + j >= 0;
        const u32x4 u = *(const u32x4*)(ok ? p - (ptrdiff_t)(3 - j) * D : p);
        f32x4 w0 = *(const LAS f32x4*)(w + j * 128), w1 = *(const LAS f32x4*)(w + j * 128 + 4);
        if (!ok) { w0 = (f32x4){0.f, 0.f, 0.f, 0.f}; w1 = w0; }
        a[0] += bflo(u.x) * w0[0]; a[1] += bfhi(u.x) * w0[1]; a[2] += bflo(u.y) * w0[2]; a[3] += bfhi(u.y) * w0[3];
        a[4] += bflo(u.z) * w1[0]; a[5] += bfhi(u.z) * w1[1]; a[6] += bflo(u.w) * w1[2]; a[7] += bfhi(u.w) * w1[3];
    }
#pragma unroll
    for (int e = 0; e < 8; ++e) a[e] = silu_f(a[e]);
}

__device__ __forceinline__ void conv8h(const bf16* p, const bf16* halo, int nloc, const LAS float* w, float* a) {
#pragma unroll
    for (int e = 0; e < 8; ++e) a[e] = 0.f;
#pragma unroll
    for (int j = 0; j < 4; ++j) {
        const int r = nloc - 3 + j;
        const u32x4 u = *(const u32x4*)(r >= 0 ? p - (ptrdiff_t)(3 - j) * D : halo + (r + 3) * D);
        const f32x4 w0 = *(const LAS f32x4*)(w + j * 128), w1 = *(const LAS f32x4*)(w + j * 128 + 4);
        a[0] += bflo(u.x) * w0[0]; a[1] += bfhi(u.x) * w0[1]; a[2] += bflo(u.y) * w0[2]; a[3] += bfhi(u.y) * w0[3];
        a[4] += bflo(u.z) * w1[0]; a[5] += bfhi(u.z) * w1[1]; a[6] += bflo(u.w) * w1[2]; a[7] += bfhi(u.w) * w1[3];
    }
#pragma unroll
    for (int e = 0; e < 8; ++e) a[e] = silu_f(a[e]);
}
__device__ __forceinline__ void delta_prep_wave(const Params& P, LAS unsigned char* lds, int idx, int wave, int lane) {
    const int bh = idx >> 5, b = bh >> 3, h = bh & 7, span = idx & 31, n = lane & 31, hh = lane >> 5;
    const LAS float* wq = (const LAS float*)lds; const LAS float* wk = wq + 512; const LAS float* wv = wq + 1024;
    LAS float* Lm = (LAS float*)(lds + 6144 + wave * 10240);
    LAS float* gcs = Lm + 2 * 1152; LAS float* bts = gcs + 64;
    const bf16* Qb = (const bf16*)(karg_ws() + WS_Z + 2 * ZB); bf16* Kb = (bf16*)(karg_ws() + WS_Z + 3 * ZB); bf16* Vb = (bf16*)(karg_ws() + WS_Z + 4 * ZB);
    bf16* QT = (bf16*)(karg_ws() + WS_H);
    const bf16* HK = (const bf16*)((const unsigned char*)karg_out() + OSB_HK) + (size_t)(b * 32 + span) * 3 * D + h * 128;
    const bf16* HV = (const bf16*)((const unsigned char*)karg_out() + OSB_HV) + (size_t)(b * 32 + span) * 3 * D + h * 128;
    const float* ABL = (const float*)(karg_ws() + WS_ABL);
    bf16* TINV = (bf16*)(karg_ws() + WS_TINV); bf16* ATT = (bf16*)(karg_ws() + WS_ATT);
    { const size_t row = (size_t)b * SEQ + span * 64 + lane;
      float g = -__expf(INP(23)[h]) * softplus_f(ABL[row * 16 + h] + INP(24)[h]); const float be = sigmoid_f(ABL[row * 16 + 8 + h]);
#pragma unroll
      for (int off = 1; off < 32; off <<= 1) { const float t = __shfl_up(g, off); if (n >= off) g += t; }
      gcs[lane] = g; bts[lane] = be;
      ((float*)(karg_ws() + WS_GC))[(size_t)bh * SEQ + span * 64 + lane] = g; ((float*)(karg_ws() + WS_BETA))[(size_t)bh * SEQ + span * 64 + lane] = be; }
    LAS float* nks = bts + 64; LAS float* nqs = nks + 64;
#pragma unroll 1
    for (int it = 7; it >= 0; --it) {
        const int nloc = it * 8 + (lane >> 3), tl = span * 64 + nloc, d0 = (lane & 7) * 16; const size_t ro = ((size_t)b * SEQ + tl) * D + h * 128 + d0;
        float kv[16], qv[16], vv[16];
        conv8h(Kb + ro, HK + d0, nloc, wk + d0, kv); conv8h(Kb + ro + 8, HK + d0 + 8, nloc, wk + d0 + 8, kv + 8);
        conv8(Qb + ro, tl, wq + d0, qv); conv8(Qb + ro + 8, tl, wq + d0 + 8, qv + 8);
        conv8h(Vb + ro, HV + d0, nloc, wv + d0, vv); conv8h(Vb + ro + 8, HV + d0 + 8, nloc, wv + d0 + 8, vv + 8);
        float ssk = 0.f, ssq = 0.f;
#pragma unroll
        for (int e = 0; e < 16; ++e) { ssk += kv[e] * kv[e]; ssq += qv[e] * qv[e]; }
        ssk = red8(ssk); ssq = red8(ssq);
        if ((lane & 7) == 0) { const float nkj = rsq_f(ssk + EPS), nqj = 0.08838834764831845f * rsq_f(ssq + EPS); nks[nloc] = nkj; nqs[nloc] = nqj;
            ((float*)((unsigned char*)karg_out() + OSB_NK))[(size_t)bh * SEQ + tl] = nkj; ((float*)((unsigned char*)karg_out() + OSB_NQ))[(size_t)bh * SEQ + tl] = nqj; }
        *(bf16x8*)(Kb + ro) = pack8(kv[0], kv[1], kv[2], kv[3], kv[4], kv[5], kv[6], kv[7]); *(bf16x8*)(Kb + ro + 8) = pack8(kv[8], kv[9], kv[10], kv[11], kv[12], kv[13], kv[14], kv[15]);
        *(bf16x8*)(QT + ro) = pack8(qv[0], qv[1], qv[2], qv[3], qv[4], qv[5], qv[6], qv[7]); *(bf16x8*)(QT + ro + 8) = pack8(qv[8], qv[9], qv[10], qv[11], qv[12], qv[13], qv[14], qv[15]);
        *(bf16x8*)(Vb + ro) = pack8(vv[0], vv[1], vv[2], vv[3], vv[4], vv[5], vv[6], vv[7]); *(bf16x8*)(Vb + ro + 8) = pack8(vv[8], vv[9], vv[10], vv[11], vv[12], vv[13], vv[14], vv[15]);
    }
    asm volatile("s_waitcnt vmcnt(0)" ::: "memory"); __builtin_amdgcn_fence(__ATOMIC_ACQUIRE, "agent");
#pragma unroll 1
    for (int tile = 0; tile < 2; ++tile) {
        const int tl = span * 64 + tile * 32 + n; const size_t ro = ((size_t)b * SEQ + tl) * D + h * 128 + 8 * hh;
        f32x16 ckk, cqk;
#pragma unroll
        for (int r = 0; r < 16; ++r) { ckk[r] = 0.f; cqk[r] = 0.f; }
#pragma unroll
        for (int s8 = 0; s8 < 8; ++s8) {
            const bf16x8 kf = *(const bf16x8*)(Kb + ro + 16 * s8), qf = *(const bf16x8*)(QT + ro + 16 * s8);
            ckk = __builtin_amdgcn_mfma_f32_32x32x16_bf16(kf, kf, ckk, 0, 0, 0); cqk = __builtin_amdgcn_mfma_f32_32x32x16_bf16(qf, kf, cqk, 0, 0, 0);
        }
        const float nkj = nks[tile * 32 + n];
        const float gcj = gcs[tile * 32 + n];
        bf16* att = ATT + ((size_t)bh * 64 + span * 2 + tile) * 1024 + perm16(n);
#pragma unroll
        for (int r = 0; r < 16; ++r) { const int i = (r & 3) + 8 * (r >> 2) + 4 * hh;
            const float dm = i >= n ? __expf(gcs[tile * 32 + i] - gcj) * nkj : 0.f;
            Lm[tile * 1152 + i * 36 + n] = i > n ? bts[tile * 32 + i] * nks[tile * 32 + i] * ckk[r] * dm : 0.f;
            att[i * 32] = (bf16)f2bf(nqs[tile * 32 + i] * cqk[r] * dm); }
    }
    LDS_WAIT(); asm volatile("" ::: "memory");
    { int loff = hh * 1152;
      float x[32];
#pragma unroll
      for (int i = 0; i < 32; ++i) { float sacc = (i == n) ? 1.f : 0.f;
          const LAS float* Lb = Lm + loff;
#pragma unroll
          for (int j4 = 0; j4 < (i + 3) / 4; ++j4) { const f32x4 l = *(const LAS f32x4*)(Lb + i * 36 + 4 * j4);
#pragma unroll
              for (int jj = 0; jj < 4; ++jj) if (4 * j4 + jj < i) sacc -= l[jj] * x[4 * j4 + jj]; }
          x[i] = sacc;
          if ((i & 1) == 1) asm volatile("" : "+v"(loff) : "v"(sacc)); }
      bf16* ti = TINV + ((size_t)bh * 64 + span * 2 + hh) * 1024 + perm16(n);
#pragma unroll
      for (int i = 0; i < 32; ++i) ti[i * 32] = (bf16)f2bf(x[i]); }
    LDS_WAIT(); asm volatile("" ::: "memory");
}

constexpr int DR_KB = 0, DR_QD = 8704, DR_KDT = 17408, DR_TI = 27648, DR_AT = 30208, DR_VB = 32768, DR_EGL = 49664, DR_BUF = 49680;
struct DeltaPre { u32x4 k0, k1, q0, q1, v0, v1, tia; float gct, gl, bet, nk, nq; };
__device__ __forceinline__ void delta_pre_load(int b, int h, int c, int pt, DeltaPre& dp) {
    const int bh = b * 8 + h, tt = pt >> 3, d0 = (pt & 7) * 16; const size_t t = (size_t)bh * SEQ + c * 32 + tt;
    const size_t ro = ((size_t)b * SEQ + c * 32 + tt) * D + h * 128 + d0;
    const bf16* Kt = (const bf16*)(karg_ws() + WS_Z + 3 * ZB) + ro; const bf16* Qt = (const bf16*)(karg_ws() + WS_H) + ro; const bf16* Vt = (const bf16*)(karg_ws() + WS_Z + 4 * ZB) + ro;
    dp.k0 = *(const u32x4*)Kt; dp.k1 = *(const u32x4*)(Kt + 8); dp.q0 = *(const u32x4*)Qt; dp.q1 = *(const u32x4*)(Qt + 8); dp.v0 = *(const u32x4*)Vt; dp.v1 = *(const u32x4*)(Vt + 8);
    const float* GC = (const float*)(karg_ws() + WS_GC);
    dp.gct = GC[t]; dp.gl = GC[(size_t)bh * SEQ + c * 32 + 31]; dp.bet = ((const float*)(karg_ws() + WS_BETA))[t];
    dp.nk = ((const float*)((const unsigned char*)karg_out() + OSB_NK))[t]; dp.nq = ((const float*)((const unsigned char*)karg_out() + OSB_NQ))[t];
    dp.tia = *(const u32x4*)((const bf16*)(karg_ws() + (pt < 128 ? WS_TINV : WS_ATT)) + ((size_t)bh * 64 + c) * 1024 + (pt & 127) * 8);
}
__device__ __forceinline__ void delta_rec_stage(LAS unsigned char* buf, int pt, const DeltaPre& dp) {
    const int tt = pt >> 3, dg = pt & 7, d0 = dg * 16;
    { LAS bf16* dst = (LAS bf16*)(buf + (pt < 128 ? DR_TI : DR_AT)) + ((pt & 127) >> 2) * 40 + (pt & 3) * 8; *(LAS u32x4*)dst = dp.tia; }
    if (pt == 0) *(LAS float*)(buf + DR_EGL) = __expf(dp.gl);
    const float eg = __expf(dp.gct), ekd = __expf(dp.gl - dp.gct);
    const float fq = dp.nq * eg, fkb = dp.nk * dp.bet * eg, fkd = dp.nk * ekd, bet = dp.bet;
    float k[16], q[16], v[16];
    unpack8(dp.k0, k); unpack8(dp.k1, k + 8); unpack8(dp.q0, q); unpack8(dp.q1, q + 8); unpack8(dp.v0, v); unpack8(dp.v1, v + 8);
    LAS bf16* KB = (LAS bf16*)(buf + DR_KB) + tt * 136 + d0; LAS bf16* QD = (LAS bf16*)(buf + DR_QD) + tt * 136 + d0;
    *(LAS bf16x8*)KB = pack8(k[0] * fkb, k[1] * fkb, k[2] * fkb, k[3] * fkb, k[8] * fkb, k[9] * fkb, k[10] * fkb, k[11] * fkb);
    *(LAS bf16x8*)(KB + 8) = pack8(k[4] * fkb, k[5] * fkb, k[6] * fkb, k[7] * fkb, k[12] * fkb, k[13] * fkb, k[14] * fkb, k[15] * fkb);
    *(LAS bf16x8*)QD = pack8(q[0] * fq, q[1] * fq, q[2] * fq, q[3] * fq, q[8] * fq, q[9] * fq, q[10] * fq, q[11] * fq);
    *(LAS bf16x8*)(QD + 8) = pack8(q[4] * fq, q[5] * fq, q[6] * fq, q[7] * fq, q[12] * fq, q[13] * fq, q[14] * fq, q[15] * fq);
    LAS bf16* KDT = (LAS bf16*)(buf + DR_KDT) + d0 * 40 + perm16(tt);
#pragma unroll
    for (int e = 0; e < 16; ++e) KDT[e * 40] = (bf16)f2bf(k[e] * fkd);
    LAS float* VB = (LAS float*)(buf + DR_VB) + tt * 132 + d0;
#pragma unroll
    for (int e4 = 0; e4 < 4; ++e4) *(LAS f32x4*)(VB + 4 * e4) = (f32x4){v[4 * e4] * bet, v[4 * e4 + 1] * bet, v[4 * e4 + 2] * bet, v[4 * e4 + 3] * bet};
}

constexpr int DR_OB = 2 * DR_BUF;
static_assert(DR_OB + 2 * 32 * 132 * 4 <= LDS_BYTES - 64, "delta recurrence LDS map");
__device__ __forceinline__ void delta_out_norm(const LAS float* ob, int pt, const float* dn16, const u32x4 z0, const u32x4 z1, bf16* dst) {
    const LAS float* p = ob + (pt >> 3) * 132 + (pt & 7) * 16;
    float o[16], z[16];
#pragma unroll
    for (int e4 = 0; e4 < 4; ++e4) { const f32x4 t = *(const LAS f32x4*)(p + 4 * e4); o[4 * e4] = t[0]; o[4 * e4 + 1] = t[1]; o[4 * e4 + 2] = t[2]; o[4 * e4 + 3] = t[3]; }
    float ss = 0.f;
#pragma unroll
    for (int e = 0; e < 16; ++e) ss += o[e] * o[e];
    ss = red8(ss);
    const float rstd = rsq_f(ss * (1.f / 128.f) + EPS);
    unpack8(z0, z); unpack8(z1, z + 8);
#pragma unroll
    for (int e = 0; e < 16; ++e) o[e] = o[e] * rstd * dn16[e] * z[e];
    *(bf16x8*)dst = pack8(o[0], o[1], o[2], o[3], o[4], o[5], o[6], o[7]); *(bf16x8*)(dst + 8) = pack8(o[8], o[9], o[10], o[11], o[12], o[13], o[14], o[15]);
}
__device__ __forceinline__ void delta_rec_task(const Params& P, LAS unsigned char* lds, int b, int h, int tid) {
    const int lane = tid & 63, wave = tid >> 6, n = lane & 31, hh = lane >> 5, bh = b * 8 + h, pt = tid - 256;
    const bool producer = wave >= 4;
    constexpr int NC = SEQ / 32;
    f32x16 S[4];
#pragma unroll
    for (int kb = 0; kb < 4; ++kb)
#pragma unroll
        for (int r = 0; r < 16; ++r) S[kb][r] = 0.f;
    DeltaPre dcur, dnxt;
    if (producer) { delta_pre_load(b, h, 0, pt, dcur); delta_pre_load(b, h, 1, pt, dnxt); delta_rec_stage(lds, pt, dcur); dcur = dnxt; }
    __syncthreads();
    if (producer) {
        const int pt = opq(tid) - 256;
        float dn16[16];
#pragma unroll
        for (int e = 0; e < 16; ++e) dn16[e] = INP(25)[(pt & 7) * 16 + e];
        bf16* zgp = (bf16*)(karg_ws() + WS_Z + 5 * ZB) + ((size_t)b * SEQ + (pt >> 3)) * D + h * 128 + (pt & 7) * 16;
        u32x4 zc0 = {0u, 0u, 0u, 0u}, zc1 = zc0, zn0, zn1;
#define DR_BAR() do { asm volatile("s_waitcnt lgkmcnt(0)" ::: "memory"); __builtin_amdgcn_s_barrier(); asm volatile("" ::: "memory"); } while (0)
        for (int c = 0; c < NC; ++c) {
            if (c > 0) { dcur = dnxt; zc0 = zn0; zc1 = zn1; }
            if (c + 2 < NC) delta_pre_load(b, h, c + 2, pt, dnxt);
            zn0 = *(const u32x4*)(zgp + (size_t)c * 32 * D); zn1 = *(const u32x4*)(zgp + (size_t)c * 32 * D + 8);
            if (c + 1 < NC) delta_rec_stage(lds + ((c + 1) & 1) * DR_BUF, pt, dcur);
            if (c > 0) delta_out_norm((const LAS float*)(lds + DR_OB) + ((c - 1) & 1) * 32 * 132, pt, dn16, zc0, zc1, zgp + (size_t)(c - 1) * 32 * D);
            DR_BAR();
        }
        delta_out_norm((const LAS float*)(lds + DR_OB) + ((NC - 1) & 1) * 32 * 132, pt, dn16, zn0, zn1, zgp + (size_t)(NC - 1) * 32 * D);
    } else {
        const int lane = opq(tid) & 63, n = lane & 31, hh = lane >> 5;
        for (int c = 0; c < NC; ++c) {
            LAS unsigned char* buf = lds + (c & 1) * DR_BUF;
            const int vb = wave;
            bf16x8 SB[8];
#pragma unroll
            for (int s = 0; s < 8; ++s) { const int kb = s >> 1, o = 8 * (s & 1); SB[s] = pack8(S[kb][o], S[kb][o + 1], S[kb][o + 2], S[kb][o + 3], S[kb][o + 4], S[kb][o + 5], S[kb][o + 6], S[kb][o + 7]); }
            f32x16 X1, P1;
#pragma unroll
            for (int r = 0; r < 16; ++r) { X1[r] = 0.f; P1[r] = 0.f; }
            const LAS bf16* KB = (const LAS bf16*)(buf + DR_KB) + n * 136 + 8 * hh; const LAS bf16* QD = (const LAS bf16*)(buf + DR_QD) + n * 136 + 8 * hh;
#pragma unroll
            for (int s = 0; s < 8; ++s) { X1 = __builtin_amdgcn_mfma_f32_32x32x16_bf16(*(const LAS bf16x8*)(KB + 16 * s), SB[s], X1, 0, 0, 0);
                P1 = __builtin_amdgcn_mfma_f32_32x32x16_bf16(*(const LAS bf16x8*)(QD + 16 * s), SB[s], P1, 0, 0, 0); }
            const LAS float* VB = (const LAS float*)(buf + DR_VB) + 32 * vb + n;
            float Y[16];
#pragma unroll
            for (int r = 0; r < 16; ++r) Y[r] = VB[((r & 3) + 8 * (r >> 2) + 4 * hh) * 132] - X1[r];
            const bf16x8 YB0 = pack8(Y[0], Y[1], Y[2], Y[3], Y[4], Y[5], Y[6], Y[7]), YB1 = pack8(Y[8], Y[9], Y[10], Y[11], Y[12], Y[13], Y[14], Y[15]);
            f32x16 VN;
#pragma unroll
            for (int r = 0; r < 16; ++r) VN[r] = 0.f;
            const LAS bf16* TI = (const LAS bf16*)(buf + DR_TI) + n * 40 + 8 * hh; const LAS bf16* AT = (const LAS bf16*)(buf + DR_AT) + n * 40 + 8 * hh;
            VN = __builtin_amdgcn_mfma_f32_32x32x16_bf16(*(const LAS bf16x8*)TI, YB0, VN, 0, 0, 0);
            VN = __builtin_amdgcn_mfma_f32_32x32x16_bf16(*(const LAS bf16x8*)(TI + 16), YB1, VN, 0, 0, 0);
            const bf16x8 VB0 = pack8(VN[0], VN[1], VN[2], VN[3], VN[4], VN[5], VN[6], VN[7]), VB1 = pack8(VN[8], VN[9], VN[10], VN[11], VN[12], VN[13], VN[14], VN[15]);
            P1 = __builtin_amdgcn_mfma_f32_32x32x16_bf16(*(const LAS bf16x8*)AT, VB0, P1, 0, 0, 0);
            P1 = __builtin_amdgcn_mfma_f32_32x32x16_bf16(*(const LAS bf16x8*)(AT + 16), VB1, P1, 0, 0, 0);
            const float egl = *(const LAS float*)(buf + DR_EGL);
            const LAS bf16* KDT = (const LAS bf16*)(buf + DR_KDT) + n * 40 + 8 * hh;
#pragma unroll
            for (int kb = 0; kb < 4; ++kb) {
#pragma unroll
                for (int r = 0; r < 16; ++r) S[kb][r] *= egl;
                S[kb] = __builtin_amdgcn_mfma_f32_32x32x16_bf16(*(const LAS bf16x8*)(KDT + kb * 32 * 40), VB0, S[kb], 0, 0, 0);
                S[kb] = __builtin_amdgcn_mfma_f32_32x32x16_bf16(*(const LAS bf16x8*)(KDT + kb * 32 * 40 + 16), VB1, S[kb], 0, 0, 0); }
            LAS float* op = (LAS float*)(lds + DR_OB) + (c & 1) * 32 * 132 + 4 * hh * 132 + 32 * vb + n;
#pragma unroll
            for (int r = 0; r < 16; ++r) op[((r & 3) + 8 * (r >> 2)) * 132] = P1[r];
            DR_BAR();
        }
    }
    if (!producer) { float* So = karg_out() + O_SP + ((size_t)bh * 128 + 4 * hh) * 128 + 32 * wave + n;
#pragma unroll
        for (int kb = 0; kb < 4; ++kb)
#pragma unroll
            for (int r = 0; r < 16; ++r) So[(size_t)(32 * kb + (r & 3) + 8 * (r >> 2)) * 128] = S[kb][r]; }
    __syncthreads();
}

template <int MODE>
__device__ __forceinline__ void delta_sample_item(const Params& P, LAS unsigned char* lds, int item, int tid) {
    LAS float* tmp = (LAS float*)lds;
    LAS float* scl = (LAS float*)(lds + 1536);
    LAS float* rpk = (LAS float*)(lds + 2048);
    LAS float* rpq = (LAS float*)(lds + 4096);
    const int bs = item >> 3, h = item & 7, lane = tid & 63, wave = tid >> 6; const size_t row = (size_t)MPR + bs;
    const bf16* Zq = (const bf16*)(karg_ws() + WS_Z + 2 * ZB);
    if (tid < 384) { const int which = tid >> 7, d = tid & 127; const int c3 = which * 1024 + h * 128 + d;
        const float raw = bf2f(Zq[(size_t)which * (ZB / 2) + row * D + h * 128 + d]);
        const float* cs = INP(7) + (size_t)bs * 3 * 3072 + c3; const float* w = INP(22) + c3;
        tmp[tid] = silu_f(cs[0] * w[0] + cs[3072] * w[3072] + cs[2 * 3072] * w[2 * 3072] + raw * w[3 * 3072]); }
    __syncthreads();
    if (wave < 3) { float s;
        if (wave == 0) s = tmp[lane] * tmp[lane] + tmp[lane + 64] * tmp[lane + 64];
        else if (wave == 1) s = tmp[128 + lane] * tmp[128 + lane] + tmp[192 + lane] * tmp[192 + lane];
        else s = tmp[lane] * tmp[128 + lane] + tmp[64 + lane] * tmp[192 + lane];
        s = wave_sum(s);
        if (lane == 0) scl[wave] = wave == 0 ? rsq_f(s + EPS) * 0.08838834764831845f : (wave == 1 ? rsq_f(s + EPS) : s); }
    __syncthreads();
    const float sq = scl[0], sk = scl[1], kq = scl[2] * sq * sk;
    const int v = tid & 127, kg = tid >> 7;
    const float* S0 = INP(6) + ((size_t)(bs * NH + h) * 128 + kg * 32) * 128 + v;
    float S[32];
#pragma unroll
    for (int j = 0; j < 32; ++j) S[j] = MODE == 1 ? __builtin_nontemporal_load(S0 + (size_t)j * 128) : S0[(size_t)j * 128];
    float pk = 0.f, pq = 0.f;
#pragma unroll
    for (int j = 0; j < 32; ++j) { pk += S[j] * tmp[128 + kg * 32 + j]; pq += S[j] * tmp[kg * 32 + j]; }
    rpk[kg * 128 + v] = pk * sk; rpq[kg * 128 + v] = pq * sq;
    __syncthreads();
    pk = (rpk[v] + rpk[128 + v]) + (rpk[256 + v] + rpk[384 + v]); pq = (rpq[v] + rpq[128 + v]) + (rpq[256 + v] + rpq[384 + v]);
    const float* ABL = (const float*)(karg_ws() + WS_ABL);
    const float al = ABL[row * 16 + h], bl = ABL[row * 16 + 8 + h];
    const float dc = __expf(-__expf(INP(23)[h]) * softplus_f(al + INP(24)[h])), be = sigmoid_f(bl);
    const float delta = be * (tmp[256 + v] - dc * pk);
    if (MODE == 0) {
        const float o = dc * pq + kq * delta; const float so = wave_sum(o * o);
        if (lane == 0 && wave < 2) scl[4 + wave] = so;
        __syncthreads();
        if (kg == 0) { bf16* zp = (bf16*)(karg_ws() + WS_Z + 5 * ZB) + row * D + h * 128 + v;
            *zp = (bf16)f2bf(o * rsq_f((scl[4] + scl[5]) * (1.f / 128.f) + EPS) * INP(25)[v] * bf2f(*zp)); } }
    else { float* So = karg_out() + O_SS + ((size_t)(bs * NH + h) * 128 + kg * 32) * 128 + v;
#pragma unroll
        for (int j = 0; j < 32; ++j) __builtin_nontemporal_store(dc * S[j] + (tmp[128 + kg * 32 + j] * sk) * delta, So + (size_t)j * 128); }
    __syncthreads();
}

#define XB_TMO      128
#define XB_XCNT(j)  (256  + 64 * (j))
#define XB_XSUB(j)  (1280 + 64 * (j))
#define XB_XGEN(j)  (2304 + 64 * (j))
#define XB_TOP      3328
#define XB_TOPGEN   3392
#define XCD_BAR_WORDS 3456
#define XB_SPIN_CAP (1u << 22)
__device__ __forceinline__ unsigned xb_ld(unsigned* p)              { return __hip_atomic_load(p, __ATOMIC_RELAXED, __HIP_MEMORY_SCOPE_AGENT); }
__device__ __forceinline__ unsigned xb_add(unsigned* p, unsigned v) { return __hip_atomic_fetch_add(p, v, __ATOMIC_RELAXED, __HIP_MEMORY_SCOPE_AGENT); }
__device__ __forceinline__ unsigned xb_xcc_id() { return (unsigned)__builtin_amdgcn_s_getreg((3 << 11) | 20) & 0xFu; }
#define XB_SPIN(cond, bar) do { unsigned _sp = 0; while (cond) { __builtin_amdgcn_s_sleep(1); \
    if ((++_sp & 255u) == 0u) { if (xb_ld(&(bar)[XB_TMO])) break; if (_sp > XB_SPIN_CAP) { atomicAdd(&(bar)[XB_TMO], 1u); break; } } } } while (0)
struct XcdBarrier { unsigned* bar; unsigned x; volatile LAS unsigned* st; };
__device__ __forceinline__ XcdBarrier xcd_barrier_post(unsigned* bar, volatile LAS unsigned* st, bool leader) {
    XcdBarrier b; b.bar = bar; b.x = xb_xcc_id(); b.st = st;
    if (leader) (void)xb_add(&bar[XB_XCNT(b.x)], 1u);
    return b;
}
__device__ __forceinline__ void xcd_barrier_complete(unsigned* bar, unsigned x, unsigned& nloc, unsigned& nx) {
    const unsigned G = gridDim.x * gridDim.y * gridDim.z;
    unsigned sum, cnt, mine, sp = 0u;
    for (;;) {
        sum = 0u; cnt = 0u; mine = 0u;
#pragma unroll
        for (unsigned j = 0; j < 16; ++j) { const unsigned c = xb_ld(&bar[XB_XCNT(j)]); sum += c; cnt += (c > 0u) ? 1u : 0u; mine = (j == x) ? c : mine; }
        if (sum == G) break;
        __builtin_amdgcn_s_sleep(1);
        if ((++sp & 255u) == 0u) { if (xb_ld(&bar[XB_TMO])) break; if (sp > XB_SPIN_CAP) { atomicAdd(&bar[XB_TMO], 1u); break; } }
    }
    nloc = mine > 0u ? mine : 1u; nx = cnt > 0u ? cnt : 1u;
}
__device__ __forceinline__ void xcd_barrier(const XcdBarrier& b, bool leader) {
    asm volatile("s_waitcnt vmcnt(0)" ::: "memory");
    __syncthreads();
    if (leader) {
        unsigned* bar = b.bar;
        __builtin_amdgcn_s_waitcnt(0);
        unsigned nloc = b.st[0], nx = b.st[1];
        if (nloc == 0u) { xcd_barrier_complete(bar, b.x, nloc, nx); b.st[0] = nloc; b.st[1] = nx; }
        const unsigned old = xb_add(&bar[XB_XSUB(b.x)], 1u);
        const unsigned gen = old / nloc;
        if (old + 1u == (gen + 1u) * nloc) {
            __builtin_amdgcn_fence(__ATOMIC_RELEASE, "agent");
            asm volatile("s_waitcnt vmcnt(0)" ::: "memory");
            const unsigned og = xb_add(&bar[XB_TOP], 1u);
            const unsigned tg = og / nx;
            if (og + 1u == (tg + 1u) * nx) xb_add(&bar[XB_TOPGEN], 1u);
            else XB_SPIN(xb_ld(&bar[XB_TOPGEN]) == tg, bar);
            __builtin_amdgcn_fence(__ATOMIC_ACQUIRE, "agent");
            xb_add(&bar[XB_XGEN(b.x)], 1u);
            asm volatile("s_waitcnt vmcnt(0)" ::: "memory");
        } else {
            XB_SPIN(xb_ld(&bar[XB_XGEN(b.x)]) == gen, bar);
            __builtin_amdgcn_fence(__ATOMIC_ACQUIRE, "agent");
            asm volatile("s_waitcnt vmcnt(0)" ::: "memory");
        }
    }
    __syncthreads();
}

__global__ void __launch_bounds__(NTHR, 2) fwd_megakernel(Params P) {
    extern __shared__ __attribute__((aligned(16))) unsigned char lds_raw[];
    LAS unsigned char* lds = (LAS unsigned char*)lds_raw;
    cg::grid_group grid = cg::this_grid();
    const int wave = __builtin_amdgcn_readfirstlane((int)threadIdx.x >> 6);
#define lane opq(lane_now())
#define tid opq((wave << 6) | lane_now())
    const int G = gridDim.x, wg = blockIdx.x;
    const int gw = wg * NWAVES + wave, NGW = G * NWAVES;
    unsigned char* ws = karg_ws();
    float* ADA = (float*)(ws + WS_ADA);
    bf16* H = (bf16*)(ws + WS_H);
    bf16* Z = (bf16*)(ws + WS_Z);
    bf16* ACT = (bf16*)(ws + WS_ACT);
    bf16* MG = (bf16*)(karg_out() + O_SS);
    volatile LAS unsigned* MISC = (volatile LAS unsigned*)(lds + LDS_BYTES - 64);
    if (tid < 16) MISC[tid] = 0u;
    __syncthreads();
    const XcdBarrier xbar = xcd_barrier_post((unsigned*)ws, MISC, wave == 0 && lane_now() == 0);
#define GBAR() xcd_barrier(xbar, wave == 0 && lane_now() == 0)

    if constexpr ((PHM >> 0) & 1) {
    prologue<0>(P, lds, gw, NGW, wave, lane);
    }
    GBAR();
    if constexpr ((PHM >> 1) & 1) {
    { pg8::Gemm g{(const bf16*)(ws + WS_CB), (const bf16*)(ws + WS_WADA), nullptr, nullptr, D}; pg8::StaticOrder S; S.init(256, NADA, G, wg);
      EpiAda E{ADA, INP(9)}; pg8::gemm_phase(lds, g, S, E, wave);
      if (wg >= 36) prologue<1>(P, lds, (wg - 36) * NWAVES + wave, (G - 36) * NWAVES, wave, lane); }
    }
    GBAR();
    if constexpr ((PHM >> 2) & 1) {
    norm_mod_pass<0>(P, INP(10), 0, gw, NGW, lane);
    { const int gt = wg * NTHR + tid;
      if (gt < 2 * NB * 3 * (D / 8)) { const int m = gt / (NB * 3 * (D / 8)), r = gt % (NB * 3 * (D / 8)), c8 = r & 127, j = (r >> 7) % 3, bb = (r >> 7) / 3;
          *(u32x4*)((bf16*)((unsigned char*)karg_out() + (m ? OSB_HV : OSB_HK)) + ((size_t)(bb * 32) * 3 + j) * D + c8 * 8) = (u32x4){0u, 0u, 0u, 0u}; } }
    }
    GBAR();
    if constexpr ((PHM >> 3) & 1) {
    { pg8::Gemm g{H, (const bf16*)(ws + WS_WUP1), nullptr, nullptr, D}; pg8::StaticOrder S; S.init(MPAD, 2 * FF, G, wg);
      EpiSwiglu E{ACT}; pg8::gemm_phase(lds, g, S, E, wave); }
    }
    GBAR();
    if constexpr ((PHM >> 4) & 1) {
    { pg8::Gemm g{ACT, (const bf16*)(ws + WS_WDN1), nullptr, nullptr, FF}; pg8::StaticOrder S; S.init(MPR, D, G, wg);
      EpiResidNorm<0> E{karg_out(), INP(0), ADA + 2 * D, 0.5f, INP(13), ADA + 3 * D, H, (float*)(ws + WS_PART), (unsigned*)(ws + WS_CNT), (LAS float*)(lds + 131072)}; pg8::gemm_phase(lds, g, S, E, wave);
      float* X = karg_out(); const float* xs = INP(1); const float* gate = ADA + 2 * D;
      mini_gemm(lds, ACT, (const bf16*)(ws + WS_WDN1), nullptr, nullptr, FF, wg, G, tid, [=](int row, int col, f32x4 v, f32x4) {
          const f32x4 xv = *(const f32x4*)(xs + (size_t)(row - MPR) * D + col), gv = *(const f32x4*)(gate + (size_t)cond_of_row(row) * NADA + col);
          *(f32x4*)(X + (size_t)row * D + col) = xv + (gv * 0.5f) * v; }); }
    }
    GBAR();
    if constexpr ((PHM >> 5) & 1) {
    sample_norm_rows<0>(INP(13), 3, gw, lane);
    }
    GBAR();
    if constexpr ((PHM >> 6) & 1) {
    { pg8::Gemm g{H, (const bf16*)(ws + WS_WIN), nullptr, nullptr, D}; pg8::StaticOrder S; S.init(MPAD, NIN, G, wg);
      EpiIn E{Z, MG, (float*)(ws + WS_ABL), karg_out()}; pg8::gemm_phase(lds, g, S, E, wave); }
    }
    GBAR();
    if constexpr ((PHM >> 7) & 1) {
        { const int bh0 = (wg * NWAVES) >> 5, h0 = bh0 & 7; LAS float* w = (LAS float*)lds; const float* cwq = INP(22);
          for (int i = tid; i < 1536; i += NTHR) { const int which = i >> 9, j = (i >> 7) & 3, d = i & 127; w[i] = cwq[(size_t)j * 3072 + which * 1024 + h0 * 128 + d]; }
          __syncthreads();
          delta_prep_wave(P, lds, gw, wave, lane);
          __syncthreads(); }
        if (G == 256) { const int task = (wg & 7) * 32 + (wg >> 3); rglru_task(P, lds, task >> 5, (task >> 2) & 7, task & 3, tid, 0, RG_SPLIT); }
        else for (int task = wg; task < 256; task += G) rglru_task(P, lds, task >> 5, (task >> 2) & 7, task & 3, tid, 0, RG_SPLIT);
    }
    GBAR();
    if constexpr ((PHM >> 7) & 1) {
        if (wg < 64) delta_rec_task(P, lds, wg >> 3, wg & 7, tid);
        else {
            if (G == 256) { const int slot = (wg - 64) >> 3;
                { const int task = (wg & 7) * 32 + slot; rglru_task(P, lds, task >> 5, (task >> 2) & 7, task & 3, tid, RG_SPLIT, 16); }
                if (slot < 8) { const int task = (wg & 7) * 32 + 24 + slot; rglru_task(P, lds, task >> 5, (task >> 2) & 7, task & 3, tid, RG_SPLIT, 16); } }
            else for (int task = wg - 64; task < 256; task += G - 64) rglru_task(P, lds, task >> 5, (task >> 2) & 7, task & 3, tid, RG_SPLIT, 16);
            if (wg < 96) rglru_task(P, lds, -1, (wg - 64) >> 2, (wg - 64) & 3, tid, 0, 1);
            if (wg >= 128) for (int item = wg - 128; item < NS * NH; item += G - 128) delta_sample_item<0>(P, lds, item, tid);
        }
    }
    GBAR();
    if constexpr ((PHM >> 9) & 1) {
    { pg8::Gemm g{Z + 1 * (ZB / 2), (const bf16*)(ws + WS_WBR), Z + 5 * (ZB / 2), (const bf16*)(ws + WS_WBR) + (size_t)D * D, D};
      pg8::PairOrder S; S.base.init(MPR, D, G, wg);
      EpiBranch E{MG, MG + ZB / 2, Z}; pg8::gemm_phase(lds, g, S, E, wave);
      const bf16* mga = MG; const bf16* mgb = MG + ZB / 2; bf16* Gm = Z;
      mini_gemm(lds, g.A0, g.B0, g.A1, g.B1, D, wg, G, tid, [=](int row, int col, f32x4 ya, f32x4 yb) {
          const size_t o = (size_t)row * D + col; const u32x2 a = *(const u32x2*)(mga + o), b = *(const u32x2*)(mgb + o);
          u32x2 w; w.x = pk2(bflo(a.x) * ya[0] + bflo(b.x) * yb[0], bfhi(a.x) * ya[1] + bfhi(b.x) * yb[1]);
          w.y = pk2(bflo(a.y) * ya[2] + bflo(b.y) * yb[2], bfhi(a.y) * ya[3] + bfhi(b.y) * yb[3]);
          *(u32x2*)(Gm + o) = w; }); }
    }
    GBAR();
    if constexpr ((PHM >> 10) & 1) {
    { pg8::Gemm g{Z, (const bf16*)(ws + WS_WOUT), nullptr, nullptr, D}; pg8::StaticOrder S; S.init(MPR, D, G, wg);
      EpiResidNorm<0> E{karg_out(), nullptr, ADA + 5 * D, 1.0f, INP(28), ADA + 6 * D, H, (float*)(ws + WS_PART) + 65536, (unsigned*)(ws + WS_CNT) + 64, (LAS float*)(lds + 131072)}; pg8::gemm_phase(lds, g, S, E, wave);
      float* X = karg_out(); const float* gate = ADA + 5 * D;
      mini_gemm(lds, Z, (const bf16*)(ws + WS_WOUT), nullptr, nullptr, D, wg, G, tid, [=](int row, int col, f32x4 v, f32x4) {
          float* xp = X + (size_t)row * D + col; const f32x4 gv = *(const f32x4*)(gate + (size_t)cond_of_row(row) * NADA + col);
          *(f32x4*)xp = *(const f32x4*)xp + gv * v; }); }
    }
    GBAR();
    if constexpr ((PHM >> 11) & 1) {
    sample_norm_rows<0>(INP(28), 6, gw, lane);
    {
        for (int item = (G == 256 ? SS_TAIL : 0) + wg; item < NS * NH; item += G) delta_sample_item<1>(P, lds, item, tid);
        const int gt = wg * NTHR + tid, NGT = G * NTHR;
        for (int i = gt; i < NS * 3 * 3072; i += NGT) { const int bs = i / 9216, j = (i / 3072) % 3, c3 = i % 3072;
            karg_out()[O_CQS + i] = j < 2 ? INP(7)[(size_t)bs * 9216 + (j + 1) * 3072 + c3] : bf2f(Z[(size_t)(2 + (c3 >> 10)) * (ZB / 2) + ((size_t)MPR + bs) * D + (c3 & 1023)]); }
    }
    }
    GBAR();
    if constexpr ((PHM >> 12) & 1) {
    { pg8::Gemm g{H, (const bf16*)(ws + WS_WUP2), nullptr, nullptr, D}; pg8::StaticOrder S; S.init(MPAD, 2 * FF, G, wg);
      EpiSwiglu E{ACT}; pg8::gemm_phase(lds, g, S, E, wave);
      if (G == 256 && wg >= 150) for (int item = wg - 150; item < SS_TAIL; item += 106) delta_sample_item<1>(P, lds, item, tid); }
    }
    GBAR();
    if constexpr ((PHM >> 13) & 1) {
    { pg8::Gemm g{ACT, (const bf16*)(ws + WS_WDN2), nullptr, nullptr, FF}; pg8::StaticOrder S; S.init(MPR, D, G, wg);
      EpiResidNorm<1> E{karg_out(), nullptr, ADA + 8 * D, 0.5f, INP(31), nullptr, nullptr, (float*)(ws + WS_PART) + 131072, (unsigned*)(ws + WS_CNT) + 128, (LAS float*)(lds + 131072)}; pg8::gemm_phase(lds, g, S, E, wave);
      float* X = karg_out(); const float* gate = ADA + 8 * D;
      mini_gemm(lds, ACT, (const bf16*)(ws + WS_WDN2), nullptr, nullptr, FF, wg, G, tid, [=](int row, int col, f32x4 v, f32x4) {
          float* xp = X + (size_t)row * D + col; const f32x4 gv = *(const f32x4*)(gate + (size_t)cond_of_row(row) * NADA + col);
          *(f32x4*)xp = *(const f32x4*)xp + (gv * 0.5f) * v; }); }
    }
    GBAR();
    if constexpr ((PHM >> 14) & 1) {
    sample_norm_rows<1>(INP(31), 0, gw, lane);
    }
}

extern "C" void kernel_launch(void* const* d_in, const int* in_sizes, int n_in, void* d_out, int out_size, void* d_ws, size_t ws_size, hipStream_t stream) {
    static int grid = 0;
    if (grid == 0) {
        if (n_in != 32 || (size_t)out_size != O_END || ws_size < WS_END) { fprintf(stderr, "kernel_launch: unexpected shapes: n_in %d out %d ws %zu (need %zu)\n", n_in, out_size, ws_size, (size_t)WS_END); grid = -1; return; }
        int dev = 0, cus = 0, per_cu = 0;
        hipGetDevice(&dev); hipDeviceGetAttribute(&cus, hipDeviceAttributeMultiprocessorCount, dev);
        if (hipFuncSetAttribute((const void*)fwd_megakernel, hipFuncAttributeMaxDynamicSharedMemorySize, LDS_BYTES) != hipSuccess) { fprintf(stderr, "kernel_launch: hipFuncSetAttribute failed\n"); grid = -1; return; }
        if (hipOccupancyMaxActiveBlocksPerMultiprocessor(&per_cu, (const void*)fwd_megakernel, NTHR, LDS_BYTES) != hipSuccess || per_cu < 1) { fprintf(stderr, "kernel_launch: occupancy query says %d\n", per_cu); per_cu = 1; }
        (void)hipGetLastError();
        grid = cus * 1;
        if (grid > 256) grid = 256;
    }
    if (grid < 0) return;
    if (hipMemsetAsync(d_ws, 0, 16384, stream) != hipSuccess) { fprintf(stderr, "kernel_launch: memset failed\n"); return; }
    Params p{};
    for (int i = 0; i < 32; ++i) p.in[i] = (const float*)d_in[i];
    p.out = (float*)d_out; p.ws = (unsigned char*)d_ws;
    void* args[] = {&p};
    hipError_t e = hipLaunchCooperativeKernel((const void*)fwd_megakernel, dim3(grid), dim3(NTHR), args, LDS_BYTES, stream);
    if (e != hipSuccess) fprintf(stderr, "kernel_launch: cooperative launch failed: %s (grid %d)\n", hipGetErrorString(e), grid);
}
```

```cpp
#include <hip/hip_runtime.h>
#include <hip/hip_cooperative_groups.h>
#include <cstdio>
#include <cstdint>
namespace cg = cooperative_groups;

#define LAS __attribute__((address_space(3)))
typedef unsigned short bf16;
typedef short bf16x8 __attribute__((ext_vector_type(8)));
typedef float f32x4 __attribute__((ext_vector_type(4)));
typedef float f32x16 __attribute__((ext_vector_type(16)));
typedef unsigned u32x4 __attribute__((ext_vector_type(4)));
typedef unsigned u32x2 __attribute__((ext_vector_type(2)));

constexpr int D = 1024, SEQ = 2048, NB = 8, MPR = NB * SEQ, NS = 128, M = MPR + NS, MPAD = 16640;
constexpr int FF = 2816, NADA = 9216, NCOND = NB + NS, NIN = 8448, NH = 8;
constexpr float EPS = 1e-6f;
constexpr int NWAVES = 8, NTHR = 512;

constexpr size_t MiB = 1u << 20;
constexpr size_t ZB = (size_t)M * D * 2;
constexpr size_t WS_WUP2 = 1 * MiB;
constexpr size_t WS_WDN2 = 12 * MiB;
constexpr size_t WS_WIN = WS_WDN2 + (size_t)D * FF * 2;
constexpr size_t WS_WBR = 34 * MiB;
constexpr size_t WS_WOUT = 38 * MiB;
constexpr size_t WS_WRG = 40 * MiB;
constexpr size_t WS_CB = WS_WRG + 512 * 1024;
constexpr size_t WS_ADA = 41 * MiB;
constexpr size_t WS_ABL = 46 * MiB;
constexpr size_t WS_H = 48 * MiB;
constexpr size_t WS_Z = WS_H + ZB;
constexpr size_t WS_ACT = WS_Z;
constexpr size_t WS_WUP1 = WS_Z + 96 * MiB;
constexpr size_t WS_WDN1 = WS_Z + 107 * MiB;
constexpr size_t WS_WADA = WS_Z + 113 * MiB;
constexpr size_t WS_END = WS_Z + 6 * ZB + 1 * MiB;
static_assert(WS_WIN + (size_t)NIN * D * 2 <= WS_WBR, "ws map");
static_assert((size_t)M * 16 * 4 <= 2 * MiB, "ws map");
static_assert((size_t)MPAD * FF * 2 <= 96 * MiB, "ws map");
static_assert(WS_WADA + (size_t)NADA * D * 2 <= WS_Z + 6 * ZB, "ws map");

constexpr size_t O_Y = 0, O_HP = (size_t)M * D, O_CRP = O_HP + NB * D, O_SP = O_CRP + NB * 3 * D, O_CQP = O_SP + (size_t)NB * NH * 128 * 128,
                 O_HS = O_CQP + NB * 3 * 3072, O_CRS = O_HS + NS * D, O_SS = O_CRS + NS * 3 * D, O_CQS = O_SS + (size_t)NS * NH * 128 * 128,
                 O_END = O_CQS + (size_t)NS * 3 * 3072;
static_assert(2 * ZB <= (O_END - O_SS) * 4, "scratch in d_out");
constexpr size_t OSB = O_SS * 4 + 2 * ZB, OSB_HK = OSB, OSB_HV = OSB + 3 * MiB / 2, OSB_NK = OSB + 3 * MiB, OSB_NQ = OSB + 7 * MiB / 2;
static_assert(OSB + 4 * MiB <= O_END * 4, "d_out scratch");

__device__ __forceinline__ unsigned pk2(float lo, float hi);
__device__ __forceinline__ unsigned f2bf(float f) { return pk2(f, f) & 0xffffu; }
typedef float f32x2_t __attribute__((ext_vector_type(2))); typedef __bf16 bf16x2_t __attribute__((ext_vector_type(2)));
__device__ __forceinline__ unsigned pk2(float lo, float hi) { f32x2_t v = {lo, hi}; bf16x2_t b = __builtin_convertvector(v, bf16x2_t); return __builtin_bit_cast(unsigned, b); }
__device__ __forceinline__ float bf2f(unsigned short b) { return __builtin_bit_cast(float, (unsigned)b << 16); }
__device__ __forceinline__ float bflo(unsigned u) { return __builtin_bit_cast(float, u << 16); }
__device__ __forceinline__ float bfhi(unsigned u) { return __builtin_bit_cast(float, u & 0xffff0000u); }
__device__ __forceinline__ float rcp_f(float x) { return __builtin_amdgcn_rcpf(x); }
__device__ __forceinline__ float rsq_f(float x) { return __builtin_amdgcn_rsqf(x); }
__device__ __forceinline__ float sigmoid_f(float x) { return rcp_f(1.f + __expf(-x)); }
__device__ __forceinline__ float neg_expm1_f(float x) {
    const float p = -x * (1.f + x * (0.5f + x * (0.16666667f + x * (0.041666668f + x * (0.0083333338f + x * 0.0013888889f)))));
    return x > -0.3f ? p : 1.f - __expf(x);
}
__device__ __forceinline__ float silu_f(float x) { return x * sigmoid_f(x); }
__device__ __forceinline__ float gelu_tanh_f(float x) { return x * sigmoid_f(1.5957691216057308f * (x + 0.044715f * x * x * x)); }
__device__ __forceinline__ float softplus_f(float x) { return x > 20.f ? x : log1pf(__expf(x)); }
template <int CTRL> __device__ __forceinline__ float dpp_f(float x) {
    return __builtin_bit_cast(float, __builtin_amdgcn_update_dpp(0, __builtin_bit_cast(int, x), CTRL, 0xF, 0xF, true));
}
__device__ __forceinline__ float red8(float x) { x += dpp_f<0xB1>(x); x += dpp_f<0x4E>(x); x += dpp_f<0x141>(x); return x; }
__device__ __forceinline__ float red16(float x) { x = red8(x); x += dpp_f<0x140>(x); return x; }
__device__ __forceinline__ float wave_sum(float v) { v = red16(v);
    return ((__builtin_bit_cast(float, __builtin_amdgcn_readlane(__builtin_bit_cast(int, v), 0)) + __builtin_bit_cast(float, __builtin_amdgcn_readlane(__builtin_bit_cast(int, v), 16))) +
            (__builtin_bit_cast(float, __builtin_amdgcn_readlane(__builtin_bit_cast(int, v), 32)) + __builtin_bit_cast(float, __builtin_amdgcn_readlane(__builtin_bit_cast(int, v), 48)))); }
__device__ __forceinline__ int lane_now();
__device__ __forceinline__ int opq(int x);
__device__ __forceinline__ float shfl_xor_l(float v, int o) { const int idx = (opq(lane_now()) ^ o) << 2; return __builtin_bit_cast(float, __builtin_amdgcn_ds_bpermute(idx, __builtin_bit_cast(int, v))); }
__device__ __forceinline__ void unpack8(const u32x4 u, float* x) { x[0] = bflo(u.x); x[1] = bfhi(u.x); x[2] = bflo(u.y); x[3] = bfhi(u.y); x[4] = bflo(u.z); x[5] = bfhi(u.z); x[6] = bflo(u.w); x[7] = bfhi(u.w); }
__device__ __forceinline__ bf16x8 pack8(float a0, float a1, float a2, float a3, float a4, float a5, float a6, float a7) {
    u32x4 w; w.x = pk2(a0, a1); w.y = pk2(a2, a3); w.z = pk2(a4, a5); w.w = pk2(a6, a7); return __builtin_bit_cast(bf16x8, w);
}
#define LDS_WAIT() asm volatile("s_waitcnt lgkmcnt(0)" ::: "memory")
__device__ __forceinline__ int lane_now() { return (int)__builtin_amdgcn_mbcnt_hi(~0u, __builtin_amdgcn_mbcnt_lo(~0u, 0u)); }
__device__ __forceinline__ int opq(int x) { asm volatile("" : "+v"(x)); return x; }

namespace pg8 {
constexpr int BM = 256, BK = 64, HALF = 128, HTB = HALF * BK * 2, NXCD = 8, WGM = 4;
__host__ __device__ __forceinline__ int lds_byte(int r, int c) { const int st = (r >> 4) * 2 + (c >> 5), rr = r & 15, cc = c & 31, ob = rr * 64 + cc * 2; return st * 1024 + (ob ^ (((ob >> 9) & 1) << 5)); }
__host__ __device__ __forceinline__ void stage_rc(int b, int& R, int& C) { const int st = b / 1024, sb = b % 1024, swz = sb ^ (((sb >> 9) & 1) << 5); R = (st >> 1) * 16 + swz / 64; C = (st & 1) * 32 + (swz % 64) / 2; }
__host__ __device__ __forceinline__ int perm32(int rho) { const int n = rho >> 4, i = rho & 15; return 8 * (i >> 2) + 4 * n + (i & 3); }

struct Unit { int pm, pn, sub; };
struct Gemm { const bf16* A0; const bf16* B0; const bf16* A1; const bf16* B1; int K; };

struct StaticOrder {
    int nM, nN, nwg, G, c;
    __device__ void init(int Mp, int N, int G_, int c_) { nM = Mp / BM; nN = N / BM; nwg = nM * nN; G = G_; c = c_; }
    __device__ bool next(int i, Unit& u) const {
        const long L = (long)i * G + c; if (L >= nwg) return false;
        int wgid = (int)L; { const int q = nwg / NXCD, r = nwg % NXCD, xcd = wgid % NXCD, off = wgid / NXCD; wgid = (xcd < r ? xcd * (q + 1) : r * (q + 1) + (xcd - r) * q) + off; }
        const int nig = WGM * nN, gid = wgid / nig, fm = gid * WGM, gsz = (nM - fm) < WGM ? (nM - fm) : WGM;
        u.pm = fm + ((wgid % nig) % gsz); u.pn = (wgid % nig) / gsz; u.sub = 0; return true;
    }
};
struct PairOrder {
    StaticOrder base;
    __device__ bool next(int i, Unit& u) const { const bool ok = base.next(i >> 1, u); u.sub = i & 1; return ok; }
};

template <class Epi, class Sched>
__device__ __forceinline__ void gemm_phase(LAS unsigned char* lds, const Gemm g, const Sched& S, const Epi& E, int wid) {
    const int lane = opq(lane_now()), tid = (wid << 6) | lane, wr = wid >> 2, wc = wid & 3, fr = lane & 15, fq = lane >> 4;
    const int K = g.K, nt = K / BK;
    unsigned voffA[2], voffB[2];
#pragma unroll
    for (int i = 0; i < 2; ++i) { int R, C; stage_rc(tid * 16 + i * 8192, R, C); const int Rb = (R & ~31) + perm32(R & 31);
        voffA[i] = (unsigned)(R * K + C) * 2u; voffB[i] = (unsigned)(Rb * K + C) * 2u; }
    const size_t kstep = (size_t)(BK * 2);
    const size_t hstep = (size_t)HALF * K * 2;
    const size_t tstep = 2 * hstep;
    const unsigned ldsw = (unsigned)wid * 1024u;
    const int aoff = lds_byte(wr * 64 + fr, fq * 8), boff = lds_byte(wc * 32 + fr, fq * 8);
#define PG8_SA(b, h) (((b) * 2 + (h)) * HTB)
#define PG8_SB(b, h) ((4 + (b) * 2 + (h)) * HTB)
#define PG8_STAGE(bufoff, gbase, voff) do { _Pragma("unroll") for (int _i = 0; _i < 2; ++_i) \
        __builtin_amdgcn_global_load_lds((const unsigned*)((const char*)(gbase) + (voff)[_i]), (LAS unsigned*)(lds + (bufoff) + ldsw + _i * 8192), 16, 0, 0); } while (0)
#define PG8_LDA(dst, b, h) do { _Pragma("unroll") for (int m = 0; m < 4; ++m) _Pragma("unroll") for (int k = 0; k < 2; ++k) dst[m][k] = *(const LAS bf16x8*)(lds + PG8_SA(b, h) + aoff + m * 2048 + k * 1024); } while (0)
#define PG8_LDB(dst, b, h) do { _Pragma("unroll") for (int n = 0; n < 2; ++n) _Pragma("unroll") for (int k = 0; k < 2; ++k) dst[n][k] = *(const LAS bf16x8*)(lds + PG8_SB(b, h) + boff + n * 2048 + k * 1024); } while (0)
#define PG8_MMA(ai, bj, At, Bt) do { __builtin_amdgcn_s_setprio(1); _Pragma("unroll") for (int m = 0; m < 4; ++m) _Pragma("unroll") for (int n = 0; n < 2; ++n) _Pragma("unroll") for (int k = 0; k < 2; ++k) \
        acc[ai][bj][m][n] = __builtin_amdgcn_mfma_f32_16x16x32_bf16(Bt[n][k], At[m][k], acc[ai][bj][m][n], 0, 0, 0); __builtin_amdgcn_s_setprio(0); } while (0)
#define PG8_WAIT_V(n) asm volatile("s_waitcnt vmcnt(" #n ")" ::: "memory")
#define PG8_WAIT_L(n) asm volatile("s_waitcnt lgkmcnt(" #n ")" ::: "memory")
#define PG8_BAR __builtin_amdgcn_s_barrier()
#define PG8_SCHED __builtin_amdgcn_sched_barrier(0)
#define PG8_ZERO() do { _Pragma("unroll") for (int a = 0; a < 2; ++a) _Pragma("unroll") for (int b = 0; b < 2; ++b) _Pragma("unroll") for (int m = 0; m < 4; ++m) _Pragma("unroll") for (int n = 0; n < 2; ++n) acc[a][b][m][n] = (f32x4){0.f, 0.f, 0.f, 0.f}; } while (0)
    Unit cur, nxt; int ui = 0;
    if (!S.next(0, cur)) return;
    f32x4 acc[2][2][4][2];
    PG8_ZERO();
    bf16x8 At[4][2], B0[2][2], B1[2][2];
    const char* cA = (const char*)(cur.sub ? g.A1 : g.A0) + (size_t)cur.pm * tstep; const char* cB = (const char*)(cur.sub ? g.B1 : g.B0) + (size_t)cur.pn * tstep;
    PG8_STAGE(PG8_SB(0, 0), cB, voffB); PG8_STAGE(PG8_SB(0, 1), cB + hstep, voffB); PG8_STAGE(PG8_SA(0, 0), cA, voffA); PG8_STAGE(PG8_SA(0, 1), cA + hstep, voffA);
    if (wr == 1) PG8_BAR;
    PG8_WAIT_V(2); PG8_BAR;
    PG8_STAGE(PG8_SB(1, 0), cB + kstep, voffB); PG8_STAGE(PG8_SA(1, 0), cA + kstep, voffA); PG8_STAGE(PG8_SB(1, 1), cB + hstep + kstep, voffB);
    PG8_WAIT_V(6); PG8_BAR;
    for (;;) {
        const bool has_next = S.next(ui + 1, nxt);
        const char* nA = has_next ? (const char*)(nxt.sub ? g.A1 : g.A0) + (size_t)nxt.pm * tstep : cA; const char* nB = has_next ? (const char*)(nxt.sub ? g.B1 : g.B0) + (size_t)nxt.pn * tstep : cB;
        for (int t = 0; t < nt; t += 2) {
            const bool last = (t == nt - 2);
            const char* a1 = cA + (size_t)(t + 1) * kstep;
            const char* a2 = last ? nA : cA + (size_t)(t + 2) * kstep; const char* b2 = last ? nB : cB + (size_t)(t + 2) * kstep;
            const char* a3 = a2 + kstep; const char* b3 = b2 + kstep;
            PG8_LDB(B0, 0, 0); PG8_LDB(B1, 0, 1); PG8_SCHED; PG8_LDA(At, 0, 0); PG8_STAGE(PG8_SA(1, 1), a1 + hstep, voffA);
            PG8_WAIT_V(8); PG8_WAIT_L(0); PG8_BAR; PG8_MMA(0, 0, At, B0); PG8_MMA(0, 1, At, B1); PG8_BAR; PG8_SCHED;
            PG8_LDA(At, 0, 1); PG8_STAGE(PG8_SB(0, 0), b2, voffB); PG8_STAGE(PG8_SB(0, 1), b2 + hstep, voffB); PG8_STAGE(PG8_SA(0, 0), a2, voffA);
            PG8_WAIT_V(8); PG8_WAIT_L(0); PG8_BAR; PG8_MMA(1, 0, At, B0); PG8_MMA(1, 1, At, B1); PG8_BAR; PG8_SCHED;
            PG8_LDB(B0, 1, 0); PG8_LDB(B1, 1, 1); PG8_SCHED; PG8_LDA(At, 1, 0); PG8_STAGE(PG8_SA(0, 1), a2 + hstep, voffA);
            PG8_WAIT_V(8); PG8_WAIT_L(0); PG8_BAR; PG8_MMA(0, 0, At, B0); PG8_MMA(0, 1, At, B1); PG8_BAR; PG8_SCHED;
            PG8_LDA(At, 1, 1); PG8_STAGE(PG8_SB(1, 0), b3, voffB); PG8_STAGE(PG8_SB(1, 1), b3 + hstep, voffB); PG8_STAGE(PG8_SA(1, 0), a3, voffA);
            PG8_WAIT_V(8); PG8_WAIT_L(0); PG8_BAR; PG8_MMA(1, 0, At, B0); PG8_MMA(1, 1, At, B1); PG8_BAR; PG8_SCHED;
        }
        if (wr == 0) PG8_BAR;
        bool keep = false;
        if constexpr (Epi::KEEP) { if (cur.sub == 0) { E.mid(acc, cur, wr, wc, fr, fq); keep = true; } else E(acc, cur, wr, wc, fr, fq); }
        else E(acc, cur, wr, wc, fr, fq);
        if (!has_next) break;
        if (!keep) PG8_ZERO();
        cur = nxt; cA = nA; cB = nB; ++ui;
        if (wr == 1) PG8_BAR;
    }
    PG8_WAIT_V(0);
    PG8_BAR;
#undef PG8_SA
#undef PG8_SB
#undef PG8_STAGE
#undef PG8_LDA
#undef PG8_LDB
#undef PG8_MMA
#undef PG8_WAIT_V
#undef PG8_WAIT_L
#undef PG8_BAR
#undef PG8_SCHED
#undef PG8_ZERO
}
}

typedef f32x4 AccT[2][2][4][2];
__device__ __forceinline__ int cond_of_row(int row) { return row < MPR ? (row >> 11) : (NB + row - MPR); }

struct EpiAda {
    static constexpr bool KEEP = false;
    float* ada; const float* bias;
    __device__ __forceinline__ void operator()(const AccT& acc, const pg8::Unit& u, int wr, int wc, int fr, int fq) const {
#pragma unroll
        for (int ai = 0; ai < 2; ++ai)
#pragma unroll
            for (int m = 0; m < 4; ++m) { const int row = u.pm * 256 + ai * 128 + wr * 64 + m * 16 + fr; if (row >= NCOND) continue;
#pragma unroll
                for (int bj = 0; bj < 2; ++bj)
#pragma unroll
                    for (int n = 0; n < 2; ++n) { const int col = u.pn * 256 + bj * 128 + wc * 32 + 8 * fq + 4 * n;
                        *(f32x4*)(ada + (size_t)row * NADA + col) = acc[ai][bj][m][n] + *(const f32x4*)(bias + col); } }
    }
};
struct EpiSwiglu {
    static constexpr bool KEEP = false;
    bf16* act;
    __device__ __forceinline__ void operator()(const AccT& acc, const pg8::Unit& u, int wr, int wc, int fr, int fq) const {
#pragma unroll
        for (int ai = 0; ai < 2; ++ai)
#pragma unroll
            for (int m = 0; m < 4; ++m) { const int row = u.pm * 256 + ai * 128 + wr * 64 + m * 16 + fr; if (row >= M) continue;
                const f32x4 g0 = acc[ai][0][m][0], g1 = acc[ai][0][m][1], v0 = acc[ai][1][m][0], v1 = acc[ai][1][m][1];
                u32x4 w; w.x = pk2(silu_f(g0[0]) * v0[0], silu_f(g0[1]) * v0[1]); w.y = pk2(silu_f(g0[2]) * v0[2], silu_f(g0[3]) * v0[3]);
                w.z = pk2(silu_f(g1[0]) * v1[0], silu_f(g1[1]) * v1[1]); w.w = pk2(silu_f(g1[2]) * v1[2], silu_f(g1[3]) * v1[3]);
                *(u32x4*)(act + (size_t)row * FF + u.pn * 128 + wc * 32 + 8 * fq) = w; }
    }
};
struct EpiResid {
    static constexpr bool KEEP = false;
    float* X; const float* xp; const float* xs; const float* gate; float coef;
    __device__ __forceinline__ void operator()(const AccT& acc, const pg8::Unit& u, int wr, int wc, int fr, int fq) const {
#pragma unroll
        for (int ai = 0; ai < 2; ++ai)
#pragma unroll
            for (int m = 0; m < 4; ++m) { const int row = u.pm * 256 + ai * 128 + wr * 64 + m * 16 + fr; if (row >= M) continue;
                const float* xin = xp ? (row < MPR ? xp + (size_t)row * D : xs + (size_t)(row - MPR) * D) : X + (size_t)row * D;
                const float* gt = gate + (size_t)cond_of_row(row) * NADA;
#pragma unroll
                for (int bj = 0; bj < 2; ++bj)
#pragma unroll
                    for (int n = 0; n < 2; ++n) { const int col = u.pn * 256 + bj * 128 + wc * 32 + 8 * fq + 4 * n;
                        const f32x4 xv = *(const f32x4*)(xin + col), gv = *(const f32x4*)(gt + col);
                        *(f32x4*)(X + (size_t)row * D + col) = xv + (gv * coef) * acc[ai][bj][m][n]; } }
    }
};
constexpr size_t WS_CNT = 14336, WS_PART = 65536;
template <int MODE> struct EpiResidNorm {
    static constexpr bool KEEP = false;
    float* X; const float* xp; const float* gate; float coef; const float* gvec; const float* shift; bf16* Hout; float* part; unsigned* cnt; LAS float* sred;
    __device__ __forceinline__ void operator()(AccT& acc, const pg8::Unit& u, int wr, int wc, int fr_, int fq_) const {
        const int fr = opq(fr_), fq = opq(fq_);
        const int tid = wr * 256 + wc * 64 + fq * 16 + fr, bidx = u.pm >> 3;
        const float* gt = gate + (size_t)bidx * NADA;
        float ss[2][4]; int zoff = 0;
#pragma unroll
        for (int ai = 0; ai < 2; ++ai)
#pragma unroll
            for (int m = 0; m < 4; ++m) { const int row = u.pm * 256 + ai * 128 + wr * 64 + m * 16 + fr + zoff;
                const float* xin = xp ? xp + (size_t)row * D : X + (size_t)row * D; float sacc = 0.f;
#pragma unroll
                for (int bj = 0; bj < 2; ++bj)
#pragma unroll
                    for (int n = 0; n < 2; ++n) { const int col = u.pn * 256 + bj * 128 + wc * 32 + 8 * fq + 4 * n;
                        const f32x4 xv = *(const f32x4*)(xin + col), gv = *(const f32x4*)(gt + col);
                        const f32x4 xn = xv + (gv * coef) * acc[ai][bj][m][n]; acc[ai][bj][m][n] = xn;
                        if (MODE == 0) *(f32x4*)(X + (size_t)row * D + col) = xn;
                        sacc += (xn[0] * xn[0] + xn[1] * xn[1]) + (xn[2] * xn[2] + xn[3] * xn[3]); }
                asm volatile("" : "+v"(zoff) : "v"(sacc));
                sacc += shfl_xor_l(sacc, 16); sacc += shfl_xor_l(sacc, 32);
                ss[ai][m] = sacc; __builtin_amdgcn_sched_barrier(0); }
        if (fq == 0) {
#pragma unroll
            for (int ai = 0; ai < 2; ++ai)
#pragma unroll
                for (int m = 0; m < 4; ++m) sred[wc * 256 + ai * 128 + wr * 64 + m * 16 + fr] = ss[ai][m]; }
        __syncthreads();
        if (tid < 256) __hip_atomic_store((unsigned*)part + ((size_t)u.pm * 4 + u.pn) * 256 + tid, __builtin_bit_cast(unsigned, (sred[tid] + sred[256 + tid]) + (sred[512 + tid] + sred[768 + tid])), __ATOMIC_RELAXED, __HIP_MEMORY_SCOPE_AGENT);
        asm volatile("s_waitcnt vmcnt(0)" ::: "memory");
        __syncthreads();
        if (tid == 0) { __hip_atomic_fetch_add(cnt + u.pm, 1u, __ATOMIC_RELAXED, __HIP_MEMORY_SCOPE_AGENT);
            unsigned sp = 0; while (__hip_atomic_load(cnt + u.pm, __ATOMIC_RELAXED, __HIP_MEMORY_SCOPE_AGENT) < 4u && ++sp < (1u << 24)) __builtin_amdgcn_s_sleep(1); }
        __syncthreads();
        if (tid < 256) { unsigned* pp = (unsigned*)part + (size_t)u.pm * 4 * 256 + tid;
            const float p0 = __builtin_bit_cast(float, __hip_atomic_load(pp, __ATOMIC_RELAXED, __HIP_MEMORY_SCOPE_AGENT)), p1 = __builtin_bit_cast(float, __hip_atomic_load(pp + 256, __ATOMIC_RELAXED, __HIP_MEMORY_SCOPE_AGENT));
            const float p2 = __builtin_bit_cast(float, __hip_atomic_load(pp + 512, __ATOMIC_RELAXED, __HIP_MEMORY_SCOPE_AGENT)), p3 = __builtin_bit_cast(float, __hip_atomic_load(pp + 768, __ATOMIC_RELAXED, __HIP_MEMORY_SCOPE_AGENT));
            sred[1024 + tid] = rsq_f(((p0 + p1) + (p2 + p3)) * (1.f / D) + EPS); }
        __syncthreads();
        const float* sh = MODE == 0 ? shift + (size_t)bidx * NADA : nullptr;
#pragma unroll
        for (int bj = 0; bj < 2; ++bj) { const int col = u.pn * 256 + bj * 128 + wc * 32 + 8 * fq;
            const f32x4 g0 = *(const f32x4*)(gvec + col), g1 = *(const f32x4*)(gvec + col + 4);
            f32x4 a0 = g0, a1 = g1, b0 = {0.f, 0.f, 0.f, 0.f}, b1 = b0;
            if (MODE == 0) { a0 = g0 * (*(const f32x4*)(sh + D + col) + 1.f); a1 = g1 * (*(const f32x4*)(sh + D + col + 4) + 1.f); b0 = *(const f32x4*)(sh + col); b1 = *(const f32x4*)(sh + col + 4); }
#pragma unroll
            for (int ai = 0; ai < 2; ++ai)
#pragma unroll
                for (int m = 0; m < 4; ++m) { const int rl = ai * 128 + wr * 64 + m * 16 + fr; const size_t row = (size_t)u.pm * 256 + rl; const float rstd = sred[1024 + rl];
                    const f32x4 y0 = acc[ai][bj][m][0] * rstd * a0 + b0, y1 = acc[ai][bj][m][1] * rstd * a1 + b1;
                    if (MODE == 0) *(bf16x8*)(Hout + row * D + col) = pack8(y0[0], y0[1], y0[2], y0[3], y1[0], y1[1], y1[2], y1[3]);
                    else { *(f32x4*)(X + row * D + col) = y0; *(f32x4*)(X + row * D + col + 4) = y1; }
                    __builtin_amdgcn_sched_barrier(0); }
        }
        __syncthreads();
    }
};
struct EpiIn {
    static constexpr bool KEEP = false;
    bf16* z; bf16* mg; float* abl; float* out;
    __device__ __forceinline__ void operator()(const AccT& acc, const pg8::Unit& u, int wr, int wc, int fr, int fq) const {
        const int bi = u.pn >> 2;
        if (bi == 8) {
            if (wc == 0 && fq < 2) {
#pragma unroll
                for (int ai = 0; ai < 2; ++ai)
#pragma unroll
                    for (int m = 0; m < 4; ++m) { const int row = u.pm * 256 + ai * 128 + wr * 64 + m * 16 + fr; if (row >= M) continue;
                        *(f32x4*)(abl + (size_t)row * 16 + 8 * fq) = acc[ai][0][m][0]; *(f32x4*)(abl + (size_t)row * 16 + 8 * fq + 4) = acc[ai][0][m][1]; }
            }
            return;
        }
        bf16* base = bi < 6 ? z + (size_t)bi * (ZB / 2) : mg + (size_t)(bi - 6) * (ZB / 2);
        const int act = (bi == 1) ? 1 : (bi == 5) ? 2 : (bi >= 6) ? 3 : 0;
        const int colt = (u.pn & 3) * 256 + wc * 32 + 8 * fq;
#pragma unroll
        for (int ai = 0; ai < 2; ++ai)
#pragma unroll
            for (int m = 0; m < 4; ++m) { const int row = u.pm * 256 + ai * 128 + wr * 64 + m * 16 + fr; if (row >= M) continue;
#pragma unroll
                for (int bj = 0; bj < 2; ++bj) { f32x4 v0 = acc[ai][bj][m][0], v1 = acc[ai][bj][m][1];
                    if (act == 1) {
#pragma unroll
                        for (int j = 0; j < 4; ++j) { v0[j] = gelu_tanh_f(v0[j]); v1[j] = gelu_tanh_f(v1[j]); } }
                    else if (act == 2) {
#pragma unroll
                        for (int j = 0; j < 4; ++j) { v0[j] = silu_f(v0[j]); v1[j] = silu_f(v1[j]); } }
                    else if (act == 3) {
#pragma unroll
                        for (int j = 0; j < 4; ++j) { v0[j] = sigmoid_f(v0[j]); v1[j] = sigmoid_f(v1[j]); } }
                    u32x4 w; w.x = pk2(v0[0], v0[1]); w.y = pk2(v0[2], v0[3]); w.z = pk2(v1[0], v1[1]); w.w = pk2(v1[2], v1[3]);
                    if (bi >= 6) __builtin_nontemporal_store(w, (u32x4*)(base + (size_t)row * D + colt + bj * 128));
                    else *(u32x4*)(base + (size_t)row * D + colt + bj * 128) = w;
                    if (act == 0 && row < MPR) { const int rs = row & (SEQ - 1), r64 = row & 63, bb = row >> 11, col = colt + bj * 128;
                        if (bi >= 3 && r64 >= 61 && rs < SEQ - 3)
                            *(u32x4*)((bf16*)((unsigned char*)out + (bi == 3 ? OSB_HK : OSB_HV)) + ((size_t)(bb * 32 + (rs >> 6) + 1) * 3 + (r64 - 61)) * D + col) = w;
                        if (rs >= SEQ - 3) { float* dst = bi == 0 ? out + O_CRP + ((size_t)bb * 3 + (rs - (SEQ - 3))) * D + col : out + O_CQP + ((size_t)bb * 3 + (rs - (SEQ - 3))) * 3072 + (bi - 2) * 1024 + col;
                            *(f32x4*)dst = v0; *(f32x4*)(dst + 4) = v1; } }
                } }
    }
};
struct EpiBranch {
    static constexpr bool KEEP = true;
    const bf16* mga; const bf16* mgb; bf16* G;
    __device__ __forceinline__ void mid(AccT& acc, const pg8::Unit& u, int wr, int wc, int fr, int fq) const {
#pragma unroll
        for (int ai = 0; ai < 2; ++ai)
#pragma unroll
            for (int m = 0; m < 4; ++m) { int row = u.pm * 256 + ai * 128 + wr * 64 + m * 16 + fr; if (row >= M) row = M - 1;
#pragma unroll
                for (int bj = 0; bj < 2; ++bj) { const size_t o = (size_t)row * D + u.pn * 256 + bj * 128 + wc * 32 + 8 * fq;
                    const u32x4 a = *(const u32x4*)(mga + o), b = *(const u32x4*)(mgb + o);
                    f32x4 r0, r1;
                    r0[0] = bflo(a.x) * rcp_f(bflo(b.x)); r0[1] = bfhi(a.x) * rcp_f(bfhi(b.x)); r0[2] = bflo(a.y) * rcp_f(bflo(b.y)); r0[3] = bfhi(a.y) * rcp_f(bfhi(b.y));
                    r1[0] = bflo(a.z) * rcp_f(bflo(b.z)); r1[1] = bfhi(a.z) * rcp_f(bfhi(b.z)); r1[2] = bflo(a.w) * rcp_f(bflo(b.w)); r1[3] = bfhi(a.w) * rcp_f(bfhi(b.w));
                    acc[ai][bj][m][0] = acc[ai][bj][m][0] * r0; acc[ai][bj][m][1] = acc[ai][bj][m][1] * r1; } }
    }
    __device__ __forceinline__ void operator()(const AccT& acc, const pg8::Unit& u, int wr, int wc, int fr, int fq) const {
#pragma unroll
        for (int ai = 0; ai < 2; ++ai)
#pragma unroll
            for (int m = 0; m < 4; ++m) { const int row = u.pm * 256 + ai * 128 + wr * 64 + m * 16 + fr; if (row >= M) continue;
#pragma unroll
                for (int bj = 0; bj < 2; ++bj) { const size_t o = (size_t)row * D + u.pn * 256 + bj * 128 + wc * 32 + 8 * fq;
                    const u32x4 b = *(const u32x4*)(mgb + o);
                    const f32x4 v0 = acc[ai][bj][m][0], v1 = acc[ai][bj][m][1];
                    u32x4 w; w.x = pk2(v0[0] * bflo(b.x), v0[1] * bfhi(b.x)); w.y = pk2(v0[2] * bflo(b.y), v0[3] * bfhi(b.y));
                    w.z = pk2(v1[0] * bflo(b.z), v1[1] * bfhi(b.z)); w.w = pk2(v1[2] * bflo(b.w), v1[3] * bfhi(b.w));
                    *(u32x4*)(G + o) = w; } }
    }
};

__device__ __forceinline__ f32x4 mini_partial(const bf16* A, const bf16* Bt, int K, int row0, int col0, int ks, int lane) {
    const int kq = K >> 2;
    const bf16* ap = A + (size_t)(MPR + row0 + (lane & 15)) * K + ks * kq + (lane >> 4) * 8;
    const bf16* bp = Bt + (size_t)(col0 + (lane & 15)) * K + ks * kq + (lane >> 4) * 8;
    f32x4 acc = {0.f, 0.f, 0.f, 0.f};
#pragma unroll 1
    for (int k0 = 0; k0 < kq; k0 += 256) {
        bf16x8 a[8], b[8];
#pragma unroll
        for (int i = 0; i < 8; ++i) if (k0 + 32 * i < kq) { a[i] = *(const bf16x8*)(ap + k0 + 32 * i); b[i] = *(const bf16x8*)(bp + k0 + 32 * i); }
#pragma unroll
        for (int i = 0; i < 8; ++i) if (k0 + 32 * i < kq) acc = __builtin_amdgcn_mfma_f32_16x16x32_bf16(b[i], a[i], acc, 0, 0, 0);
    }
    return acc;
}
template <class F>
__device__ __forceinline__ void mini_gemm(LAS unsigned char* lds, const bf16* A0, const bf16* B0, const bf16* A1, const bf16* B1, int K, int wg, int G, int tid_, const F& epi) {
    const int tid = opq(tid_), lane = tid & 63, wave = tid >> 6, ks = wave & 3;
    LAS f32x4* red = (LAS f32x4*)lds;
    for (int t0 = wg * 2; t0 < 512; t0 += G * 2) {
        const int tile = t0 + (wave >> 2), row0 = (tile >> 6) * 16, col0 = (tile & 63) * 16;
        f32x4 p0 = mini_partial(A0, B0, K, row0, col0, ks, lane), p1 = {0.f, 0.f, 0.f, 0.f};
        if (A1) p1 = mini_partial(A1, B1, K, row0, col0, ks, lane);
        red[(wave * 2) * 64 + lane] = p0; red[(wave * 2 + 1) * 64 + lane] = p1;
        __syncthreads();
        if (ks == 0) {
#pragma unroll
            for (int w = 1; w < 4; ++w) { p0 = p0 + red[((wave + w) * 2) * 64 + lane]; p1 = p1 + red[((wave + w) * 2 + 1) * 64 + lane]; }
            epi(MPR + row0 + (lane & 15), col0 + 4 * (lane >> 4), p0, p1);
        }
        __syncthreads();
    }
}

struct Params { const float* in[32]; float* out; unsigned char* ws; };
constexpr int LDS_BYTES = 147456;
#ifndef PHM
#define PHM 0xFFFF
#endif
#ifndef P7M
#define P7M 0xF
#endif

struct Ctx {
    const float* const* in; float* out; unsigned char* ws; LAS unsigned char* lds;
    int tid, lane, wave, wg, G;
};
#define KAS __attribute__((address_space(4)))
typedef const float* cfptr_t; typedef float* fptr_t; typedef unsigned char* ucptr_t;
__device__ __forceinline__ const float* karg_in(int k) { return *(volatile KAS cfptr_t*)((const KAS char*)__builtin_amdgcn_kernarg_segment_ptr() + 8 * k); }
__device__ __forceinline__ float* karg_out() { return *(volatile KAS fptr_t*)((const KAS char*)__builtin_amdgcn_kernarg_segment_ptr() + 256); }
__device__ __forceinline__ unsigned char* karg_ws() { return *(volatile KAS ucptr_t*)((const KAS char*)__builtin_amdgcn_kernarg_segment_ptr() + 264); }
#define INP(k) karg_in(k)

template <int MODE>
__device__ __forceinline__ void sample_norm_rows(const float* gvec, int ish, int gw, int lane) {
    if (gw >= NS) return;
    const int row = MPR + gw; float* X = karg_out() + (size_t)row * D;
    f32x4 v[4]; float s = 0.f;
#pragma unroll
    for (int j = 0; j < 4; ++j) { v[j] = *(const f32x4*)(X + 4 * (lane + 64 * j)); s += (v[j][0] * v[j][0] + v[j][1] * v[j][1]) + (v[j][2] * v[j][2] + v[j][3] * v[j][3]); }
    const float rstd = rsq_f(wave_sum(s) * (1.f / D) + EPS);
    const float* sh = (const float*)(karg_ws() + WS_ADA) + (size_t)cond_of_row(row) * NADA + ish * D;
#pragma unroll
    for (int j = 0; j < 4; ++j) { const int col = 4 * (lane + 64 * j); const f32x4 g = *(const f32x4*)(gvec + col);
        if (MODE == 0) { const f32x4 y = (v[j] * rstd * g) * (*(const f32x4*)(sh + D + col) + 1.f) + *(const f32x4*)(sh + col);
            u32x2 o; o.x = pk2(y[0], y[1]); o.y = pk2(y[2], y[3]); *(u32x2*)((bf16*)(karg_ws() + WS_H) + (size_t)row * D + col) = o; }
        else *(f32x4*)(X + col) = v[j] * rstd * g; }
}
__device__ __forceinline__ void transpose_item(const float* W, int ldw, int k0, int n0, int nvalid, bf16* WT, int ldt, int drow0, LAS float* scr, int lane) {
    const int cc = lane & 31;
#pragma unroll 8
    for (int i = 0; i < 32; ++i) { const int kk = 2 * i + (lane >> 5); scr[kk * 33 + cc] = (cc < nvalid) ? W[(size_t)(k0 + kk) * ldw + n0 + cc] : 0.f; }
    LDS_WAIT(); asm volatile("" ::: "memory");
    const int c = lane & 7;
#pragma unroll
    for (int j = 0; j < 4; ++j) { const int n = (lane >> 3) + 8 * j; const LAS float* s = scr + (8 * c) * 33 + n;
        u32x4 o; o.x = pk2(s[0 * 33], s[1 * 33]); o.y = pk2(s[2 * 33], s[3 * 33]); o.z = pk2(s[4 * 33], s[5 * 33]); o.w = pk2(s[6 * 33], s[7 * 33]);
        if (n < nvalid) *(u32x4*)(WT + (size_t)(drow0 + n) * ldt + k0 + 8 * c) = o; }
    LDS_WAIT(); asm volatile("" ::: "memory");
}

template <int PART>
__device__ __forceinline__ void prologue(const Params& P, LAS unsigned char* lds, int gw, int NGW, int wave, int lane) {
    LAS float* scr = (LAS float*)(lds + wave * 16384);
    unsigned char* ws = karg_ws();
    constexpr int I_UP = 16 * 176, I_DN = 44 * 32, I_IN = 16 * 257, I_BR = 2 * 16 * 32, I_OUT = 16 * 32, I_ADA = 16 * 288, I_RG = 128;
    constexpr int NITEMS = 2 * I_UP + 2 * I_DN + I_IN + I_BR + I_OUT + I_ADA + I_RG;
    constexpr int I_FIRST = 2 * I_UP + 2 * I_DN + I_IN + I_BR + I_OUT;
    for (int it = gw; it < NITEMS; it += NGW) {
        int r = it;
        if (PART == 0) { if (r >= I_ADA) break; r += I_FIRST; } else { if (r >= NITEMS - I_ADA) break; if (r >= I_FIRST) r += I_ADA; }
        if (r < 2 * I_UP) { const int which = r / I_UP; r -= which * I_UP; const int kb = r / 176, nb = r % 176, n0 = nb * 32; const int half = n0 >= FF ? 1 : 0, np = n0 - half * FF;
            transpose_item(INP(which ? 29 : 11), 2 * FF, kb * 64, n0, 32, (bf16*)(ws + (which ? WS_WUP2 : WS_WUP1)), D, (np >> 7) * 256 + half * 128 + (np & 127), scr, lane); continue; }
        r -= 2 * I_UP;
        if (r < 2 * I_DN) { const int which = r / I_DN; r -= which * I_DN; const int kb = r / 32, nb = r % 32;
            transpose_item(INP(which ? 30 : 12), D, kb * 64, nb * 32, 32, (bf16*)(ws + (which ? WS_WDN2 : WS_WDN1)), FF, nb * 32, scr, lane); continue; }
        r -= 2 * I_DN;
        if (r < I_IN) { const int kb = r / 257, nb = r % 257; int n0, nv, dr;
            if (nb < 160) { n0 = nb * 32; nv = 32; dr = n0; } else if (nb == 160) { n0 = 5120; nv = 16; dr = 8192; } else { n0 = 5136 + (nb - 161) * 32; nv = 32; dr = 5120 + (nb - 161) * 32; }
            transpose_item(INP(14), 8208, kb * 64, n0, nv, (bf16*)(ws + WS_WIN), D, dr, scr, lane); continue; }
        r -= I_IN;
        if (r < I_BR) { const int which = r / 512; r -= which * 512; const int kb = r / 32, nb = r % 32;
            transpose_item(INP(26) + (size_t)which * D * D, D, kb * 64, nb * 32, 32, (bf16*)(ws + WS_WBR), D, which * D + nb * 32, scr, lane); continue; }
        r -= I_BR;
        if (r < I_OUT) { const int kb = r / 32, nb = r % 32; transpose_item(INP(27), D, kb * 64, nb * 32, 32, (bf16*)(ws + WS_WOUT), D, nb * 32, scr, lane); continue; }
        r -= I_OUT;
        if (r < I_ADA) { const int kb = r / 288, nb = r % 288; transpose_item(INP(8), NADA, kb * 64, nb * 32, 32, (bf16*)(ws + WS_WADA), D, nb * 32, scr, lane); continue; }
        r -= I_ADA;
        { const int gx = r >> 6, n = (r >> 3) & 7, kb = (r >> 2) & 1, nb = r & 3;
          transpose_item(INP(gx ? 19 : 17) + (size_t)n * 128 * 128, 128, kb * 64, nb * 32, 32, (bf16*)(ws + WS_WRG), 128, n * 256 + gx * 128 + nb * 32, scr, lane); }
    }
    bf16* cb = (bf16*)(ws + WS_CB);
    if (PART == 0) for (int row = gw; row < 256; row += NGW) {
        const float* src = row < NB ? INP(2) + (size_t)row * D : (row < NCOND ? INP(3) + (size_t)(row - NB) * D : nullptr);
#pragma unroll
        for (int j = 0; j < 4; ++j) { const int col = 4 * (lane + 64 * j); f32x4 v = src ? *(const f32x4*)(src + col) : (f32x4){0.f, 0.f, 0.f, 0.f};
            u32x2 o; o.x = pk2(v[0], v[1]); o.y = pk2(v[2], v[3]); *(u32x2*)(cb + (size_t)row * D + col) = o; }
    }
}

template <int MODE>
__device__ __forceinline__ void norm_mod_pass(const Params& P, const float* gvec, int ish, int gw, int NGW, int lane) {
    const float* ada = (const float*)(karg_ws() + WS_ADA); bf16* H = (bf16*)(karg_ws() + WS_H);
    const float* xp = INP(0); const float* xs = INP(1); const float* X = karg_out();
    for (int row0 = 2 * gw; row0 < M; row0 += 2 * NGW) {
        f32x4 v[2][4]; float s[2] = {0.f, 0.f};
#pragma unroll
        for (int u = 0; u < 2; ++u) { const int row = row0 + u;
            const float* xr = MODE == 0 ? (row < MPR ? xp + (size_t)row * D : xs + (size_t)(row - MPR) * D) : X + (size_t)row * D;
#pragma unroll
            for (int j = 0; j < 4; ++j) v[u][j] = *(const f32x4*)(xr + 4 * (lane + 64 * j)); }
#pragma unroll
        for (int u = 0; u < 2; ++u)
#pragma unroll
            for (int j = 0; j < 4; ++j) s[u] += (v[u][j][0] * v[u][j][0] + v[u][j][1] * v[u][j][1]) + (v[u][j][2] * v[u][j][2] + v[u][j][3] * v[u][j][3]);
        s[0] = wave_sum(s[0]); s[1] = wave_sum(s[1]);
#pragma unroll
        for (int u = 0; u < 2; ++u) { const int row = row0 + u; const float rstd = rsq_f(s[u] * (1.f / D) + EPS);
            const float* sh = ada + (size_t)cond_of_row(row) * NADA + ish * D; const float* sc = sh + D;
#pragma unroll
            for (int j = 0; j < 4; ++j) { const int col = 4 * (lane + 64 * j); const f32x4 g = *(const f32x4*)(gvec + col), a = *(const f32x4*)(sc + col), bb = *(const f32x4*)(sh + col);
                const f32x4 y = (v[u][j] * rstd * g) * (a + 1.f) + bb; u32x2 o; o.x = pk2(y[0], y[1]); o.y = pk2(y[2], y[3]); *(u32x2*)(H + (size_t)row * D + col) = o; } }
    }
}
__device__ __forceinline__ void final_norm_pass(const Params& P, int gw, int NGW, int lane) {
    const float* gvec = INP(31); float* X = karg_out();
    for (int row0 = 2 * gw; row0 < M; row0 += 2 * NGW) {
        f32x4 v[2][4]; float s[2] = {0.f, 0.f};
#pragma unroll
        for (int u = 0; u < 2; ++u)
#pragma unroll
            for (int j = 0; j < 4; ++j) v[u][j] = *(const f32x4*)(X + (size_t)(row0 + u) * D + 4 * (lane + 64 * j));
#pragma unroll
        for (int u = 0; u < 2; ++u)
#pragma unroll
            for (int j = 0; j < 4; ++j) s[u] += (v[u][j][0] * v[u][j][0] + v[u][j][1] * v[u][j][1]) + (v[u][j][2] * v[u][j][2] + v[u][j][3] * v[u][j][3]);
        s[0] = wave_sum(s[0]); s[1] = wave_sum(s[1]);
#pragma unroll
        for (int u = 0; u < 2; ++u) { const float rstd = rsq_f(s[u] * (1.f / D) + EPS);
#pragma unroll
            for (int j = 0; j < 4; ++j) { const int col = 4 * (lane + 64 * j); *(f32x4*)(X + (size_t)(row0 + u) * D + col) = v[u][j] * rstd * *(const f32x4*)(gvec + col); } }
    }
}
__device__ __forceinline__ void onorm_pass(const Params& P, int gw, int NGW, int lane) {
    const bf16* O = (const bf16*)(karg_ws() + WS_H); bf16* ZG = (bf16*)(karg_ws() + WS_Z + 5 * ZB); const float* dn = INP(25);
    const int dc = (lane & 7) * 16;
    for (int row0 = 2 * gw; row0 < M; row0 += 2 * NGW) {
        u32x4 a[2][2], z[2][2];
#pragma unroll
        for (int u = 0; u < 2; ++u) { const size_t o = (size_t)(row0 + u) * D + lane * 16;
            a[u][0] = *(const u32x4*)(O + o); a[u][1] = *(const u32x4*)(O + o + 8); z[u][0] = *(const u32x4*)(ZG + o); z[u][1] = *(const u32x4*)(ZG + o + 8); }
#pragma unroll
        for (int u = 0; u < 2; ++u) { const size_t o = (size_t)(row0 + u) * D + lane * 16;
            float v[16], zz[16]; unpack8(a[u][0], v); unpack8(a[u][1], v + 8); unpack8(z[u][0], zz); unpack8(z[u][1], zz + 8);
            float s = 0.f;
#pragma unroll
            for (int e = 0; e < 16; ++e) s += v[e] * v[e];
            s = red8(s);
            const float rstd = rsq_f(s * (1.f / 128.f) + EPS);
#pragma unroll
            for (int e = 0; e < 16; ++e) v[e] = v[e] * rstd * dn[dc + e] * zz[e];
            *(bf16x8*)(ZG + o) = pack8(v[0], v[1], v[2], v[3], v[4], v[5], v[6], v[7]); *(bf16x8*)(ZG + o + 8) = pack8(v[8], v[9], v[10], v[11], v[12], v[13], v[14], v[15]); }
    }
}

constexpr int SS_TAIL = 530;
constexpr int RG_SPLIT = 7;
constexpr size_t WS_HCARRY = 917504;
__device__ __forceinline__ void rglru_task(const Params& P, LAS unsigned char* lds, int b, int n, int qd, int tid, int t0, int t1) {
    const int lane = tid & 63, wave = tid >> 6;
    LAS bf16* xcA = (LAS bf16*)lds;
    LAS float* xcf = (LAS float*)(lds + 34816);
    LAS float* rb = (LAS float*)(lds + 51200);
    LAS float* ib = (LAS float*)(lds + 67584);
    LAS float* segA = (LAS float*)(lds + 83968);
    LAS float* segB = (LAS float*)(lds + 86016);
    LAS float* hc = (LAS float*)(lds + 88064);
    LAS float* cw = (LAS float*)(lds + 88192);
    LAS bf16* rawt = (LAS bf16*)(lds + 90752);
    bf16* XR = (bf16*)(karg_ws() + WS_Z); bf16* GR = (bf16*)(karg_ws() + WS_Z + ZB);
    const bf16* WRG = (const bf16*)(karg_ws() + WS_WRG);
    const int cb0 = n * 128, oc0 = cb0 + qd * 32;
    const bool prompt = b >= 0;
    for (int i = tid; i < 640; i += NTHR) cw[i] = i < 512 ? INP(15)[(size_t)(i >> 7) * D + cb0 + (i & 127)] : INP(16)[cb0 + (i - 512)];
    if (tid < 32) hc[tid] = t0 > 0 ? ((const float*)(karg_ws() + WS_HCARRY))[(size_t)b * D + oc0 + tid] : 0.f;
    const int tb = wave & 3, cbk = wave >> 2;
    bf16x8 Bf[8];
    { const bf16* wrow = WRG + (size_t)(n * 256 + cbk * 128 + qd * 32 + (lane & 31)) * 128 + (lane >> 5) * 8;
#pragma unroll
      for (int ks = 0; ks < 8; ++ks) Bf[ks] = *(const bf16x8*)(wrow + ks * 16); }
    const float gbias = INP(cbk ? 20 : 18)[oc0 + (lane & 31)];
    const int ch = tid & 31, seg = tid >> 5;
    const float sp = softplus_f(-INP(21)[oc0 + ch]);
    float hlast = 0.f;
    u32x4 pre[5];
#define RG_RAW_LOAD(tile_) do { _Pragma("unroll") for (int i = 0; i < 5; ++i) { const int q = tid + 512 * i, row = q >> 4, c16 = q & 15, tl = (tile_) * 128 - 3 + row; \
        pre[i] = (q < 131 * 16 && tl >= 0) ? *(const u32x4*)(XR + ((size_t)b * SEQ + tl) * D + cb0 + c16 * 8) : (u32x4){0u, 0u, 0u, 0u}; } } while (0)
#define RG_RAW_STORE() do { _Pragma("unroll") for (int i = 0; i < 5; ++i) { const int q = tid + 512 * i; if (q < 131 * 16) *(LAS u32x4*)(rawt + (q >> 4) * 136 + (q & 15) * 8) = pre[i]; } } while (0)
    if (prompt) { RG_RAW_LOAD(t0); RG_RAW_STORE(); }
    __syncthreads();
    const int ntiles = t1;
    for (int tile = t0; tile < ntiles; ++tile) {
        const int row0 = prompt ? b * SEQ + tile * 128 : MPR;
        if (prompt && tile + 1 < ntiles) RG_RAW_LOAD(tile + 1);
        { const int t = tid >> 2, cq = tid & 3, c0 = cq * 32;
#pragma unroll 2
          for (int q = 0; q < 4; ++q) {
              const int cc = c0 + q * 8;
              float a[8];
#pragma unroll
              for (int e = 0; e < 8; ++e) a[e] = cw[512 + cc + e];
#pragma unroll
              for (int j = 0; j < 4; ++j) {
                  if (prompt || j == 3) {
                      {
                          const u32x4 u = prompt ? *(const LAS u32x4*)(rawt + (t + j) * 136 + cc) : *(const u32x4*)(XR + (size_t)(MPR + t) * D + cb0 + cc);
                          const float x8[8] = {bflo(u.x), bfhi(u.x), bflo(u.y), bfhi(u.y), bflo(u.z), bfhi(u.z), bflo(u.w), bfhi(u.w)};
#pragma unroll
                          for (int e = 0; e < 8; ++e) a[e] += x8[e] * cw[j * 128 + cc + e];
                      }
                  } else {
                      const float* p = INP(5) + ((size_t)t * 3 + j) * D + cb0 + cc;
                      const f32x4 u0 = *(const f32x4*)p, u1 = *(const f32x4*)(p + 4);
#pragma unroll
                      for (int e = 0; e < 4; ++e) { a[e] += u0[e] * cw[j * 128 + cc + e]; a[4 + e] += u1[e] * cw[j * 128 + cc + 4 + e]; }
                  }
              }
              u32x4 w; w.x = pk2(a[0], a[1]); w.y = pk2(a[2], a[3]); w.z = pk2(a[4], a[5]); w.w = pk2(a[6], a[7]);
              *(LAS u32x4*)(xcA + t * 136 + cc) = w;
              if (cq == qd) { *(LAS f32x4*)(xcf + t * 32 + q * 8) = (f32x4){a[0], a[1], a[2], a[3]}; *(LAS f32x4*)(xcf + t * 32 + q * 8 + 4) = (f32x4){a[4], a[5], a[6], a[7]}; }
          }
        }
        __syncthreads();
        { f32x16 c;
#pragma unroll
          for (int r = 0; r < 16; ++r) c[r] = 0.f;
          const LAS bf16* ap = xcA + (tb * 32 + (lane & 31)) * 136 + (lane >> 5) * 8;
#pragma unroll
          for (int ks = 0; ks < 8; ++ks) { const bf16x8 af = *(const LAS bf16x8*)(ap + ks * 16); c = __builtin_amdgcn_mfma_f32_32x32x16_bf16(af, Bf[ks], c, 0, 0, 0); }
          LAS float* dst = cbk ? ib : rb;
#pragma unroll
          for (int r = 0; r < 16; ++r) { const int tok = tb * 32 + (r & 3) + 8 * (r >> 2) + 4 * (lane >> 5); dst[tok * 32 + (lane & 31)] = sigmoid_f(c[r] + gbias); }
        }
        __syncthreads();
        float Aacc = 1.f, h = 0.f;
#pragma unroll 4
        for (int e = 0; e < 8; ++e) { const int t = seg * 8 + e;
            const float r = rb[t * 32 + ch], ig = ib[t * 32 + ch], x = xcf[t * 32 + ch];
            const float la = -8.f * r * sp; const float a = __expf(la);
            const float x2 = 2.f * la, ser = -x2 * (1.f + x2 * (0.5f + x2 * (0.16666667f + x2 * (0.041666668f + x2 * (0.0083333338f + x2 * 0.0013888889f)))));
            float mult = __builtin_amdgcn_sqrtf(x2 > -0.3f ? ser : 1.f - a * a);
            if (prompt && tile == 0 && t == 0) mult = 1.f;
            const float bt = mult * ig * x;
            rb[t * 32 + ch] = a; ib[t * 32 + ch] = bt;
            h = a * h + bt; Aacc *= a;
        }
        float hin = 0.f;
        if (prompt) {
            segA[seg * 32 + ch] = Aacc; segB[seg * 32 + ch] = h;
            __syncthreads();
            hin = hc[ch];
            float sa[15], sb[15];
#pragma unroll
            for (int s = 0; s < 15; ++s) { sa[s] = segA[s * 32 + ch]; sb[s] = segB[s * 32 + ch]; }
#pragma unroll
            for (int s = 0; s < 15; ++s) hin = s < seg ? sa[s] * hin + sb[s] : hin;
        }
        h = hin;
        { float gr[8], h0v[8];
#pragma unroll
          for (int e = 0; e < 8; ++e) { const int t = seg * 8 + e; gr[e] = bf2f(GR[(size_t)(row0 + t) * D + oc0 + ch]); h0v[e] = prompt ? 0.f : INP(4)[(size_t)t * D + oc0 + ch]; }
#pragma unroll
          for (int e = 0; e < 8; ++e) { const int t = seg * 8 + e;
              const float a = rb[t * 32 + ch], bt = ib[t * 32 + ch];
              if (prompt) h = a * h + bt; else h = a * h0v[e] + bt;
              GR[(size_t)(row0 + t) * D + oc0 + ch] = (bf16)f2bf(h * gr[e]);
              if (!prompt) { karg_out()[O_HS + (size_t)t * D + oc0 + ch] = h;
                  const float* cs = INP(5) + (size_t)t * 3 * D + oc0 + ch; float* co = karg_out() + O_CRS + (size_t)t * 3 * D + oc0 + ch;
                  co[0] = cs[D]; co[D] = cs[2 * D]; co[2 * D] = bf2f(XR[(size_t)(MPR + t) * D + oc0 + ch]); }
          } }
        hlast = h;
        if (prompt && tile + 1 < ntiles) RG_RAW_STORE();
        __syncthreads();
        if (prompt && seg == 15) hc[ch] = hlast;
    }
    if (prompt && seg == 15) { if (t1 == 16) karg_out()[O_HP + (size_t)b * D + oc0 + ch] = hlast; else ((float*)(karg_ws() + WS_HCARRY))[(size_t)b * D + oc0 + ch] = hlast; }
    __syncthreads();
}

constexpr size_t WS_TINV = WS_WIN, WS_ATT = WS_WIN + 8 * MiB, WS_GC = WS_CB, WS_BETA = 47 * MiB + 65536;
static_assert(WS_ABL + (size_t)M * 16 * 4 <= WS_BETA && WS_BETA + 64 * 2048 * 4 <= WS_H, "ws map (beta)");
__device__ __forceinline__ int perm16(int e) { return (e & ~12) | ((e >> 1) & 4) | ((e << 1) & 8); }

__device__ __forceinline__ void conv8(const bf16* p, int tl, const LAS float* w, float* a) {
#pragma unroll
    for (int e = 0; e < 8; ++e) a[e] = 0.f;
#pragma unroll
    for (int j = 0; j < 4; ++j) {
        const bool ok = tl - 3 + j >= 0;
        const u32x4 u = *(const u32x4*)(ok ? p - (ptrdiff_t)(3 - j) * D : p);
        f32x4 w0 = *(const LAS f32x4*)(w + j * 128), w1 = *(const LAS f32x4*)(w + j * 128 + 4);
        if (!ok) { w0 = (f32x4){0.f, 0.f, 0.f, 0.f}; w1 = w0; }
        a[0] += bflo(u.x) * w0[0]; a[1] += bfhi(u.x) * w0[1]; a[2] += bflo(u.y) * w0[2]; a[3] += bfhi(u.y) * w0[3];
        a[4] += bflo(u.z) * w1[0]; a[5] += bfhi(u.z) * w1[1]; a[6] += bflo(u.w) * w1[2]; a[7] += bfhi(u.w) * w1[3];
    }
#pragma unroll
    for (int e = 0; e < 8; ++e) a[e] = silu_f(a[e]);
}

__device__ __forceinline__ void conv8h(const bf16* p, const bf16* halo, int nloc, const LAS float* w, float* a) {
#pragma unroll
    for (int e = 0; e < 8; ++e) a[e] = 0.f;
#pragma unroll
    for (int j = 0; j < 4; ++j) {
        const int r = nloc - 3 + j;
        const u32x4 u = *(const u32x4*)(r >= 0 ? p - (ptrdiff_t)(3 - j) * D : halo + (r + 3) * D);
        const f32x4 w0 = *(const LAS f32x4*)(w + j * 128), w1 = *(const LAS f32x4*)(w + j * 128 + 4);
        a[0] += bflo(u.x) * w0[0]; a[1] += bfhi(u.x) * w0[1]; a[2] += bflo(u.y) * w0[2]; a[3] += bfhi(u.y) * w0[3];
        a[4] += bflo(u.z) * w1[0]; a[5] += bfhi(u.z) * w1[1]; a[6] += bflo(u.w) * w1[2]; a[7] += bfhi(u.w) * w1[3];
    }
#pragma unroll
    for (int e = 0; e < 8; ++e) a[e] = silu_f(a[e]);
}
__device__ __forceinline__ void delta_prep_wave(const Params& P, LAS unsigned char* lds, int idx, int wave, int lane) {
    const int bh = idx >> 5, b = bh >> 3, h = bh & 7, span = idx & 31, n = lane & 31, hh = lane >> 5;
    const LAS float* wq = (const LAS float*)lds; const LAS float* wk = wq + 512; const LAS float* wv = wq + 1024;
    LAS float* Lm = (LAS float*)(lds + 6144 + wave * 10240);
    LAS float* gcs = Lm + 2 * 1152; LAS float* bts = gcs + 64;
    const bf16* Qb = (const bf16*)(karg_ws() + WS_Z + 2 * ZB); bf16* Kb = (bf16*)(karg_ws() + WS_Z + 3 * ZB); bf16* Vb = (bf16*)(karg_ws() + WS_Z + 4 * ZB);
    bf16* QT = (bf16*)(karg_ws() + WS_H);
    const bf16* HK = (const bf16*)((const unsigned char*)karg_out() + OSB_HK) + (size_t)(b * 32 + span) * 3 * D + h * 128;
    const bf16* HV = (const bf16*)((const unsigned char*)karg_out() + OSB_HV) + (size_t)(b * 32 + span) * 3 * D + h * 128;
    const float* ABL = (const float*)(karg_ws() + WS_ABL);
    bf16* TINV = (bf16*)(karg_ws() + WS_TINV); bf16* ATT = (bf16*)(karg_ws() + WS_ATT);
    { const size_t row = (size_t)b * SEQ + span * 64 + lane;
      float g = -__expf(INP(23)[h]) * softplus_f(ABL[row * 16 + h] + INP(24)[h]); const float be = sigmoid_f(ABL[row * 16 + 8 + h]);
#pragma unroll
      for (int off = 1; off < 32; off <<= 1) { const float t = __shfl_up(g, off); if (n >= off) g += t; }
      gcs[lane] = g; bts[lane] = be;
      ((float*)(karg_ws() + WS_GC))[(size_t)bh * SEQ + span * 64 + lane] = g; ((float*)(karg_ws() + WS_BETA))[(size_t)bh * SEQ + span * 64 + lane] = be; }
    LAS float* nks = bts + 64; LAS float* nqs = nks + 64;
#pragma unroll 1
    for (int it = 7; it >= 0; --it) {
        const int nloc = it * 8 + (lane >> 3), tl = span * 64 + nloc, d0 = (lane & 7) * 16; const size_t ro = ((size_t)b * SEQ + tl) * D + h * 128 + d0;
        float kv[16], qv[16], vv[16];
        conv8h(Kb + ro, HK + d0, nloc, wk + d0, kv); conv8h(Kb + ro + 8, HK + d0 + 8, nloc, wk + d0 + 8, kv + 8);
        conv8(Qb + ro, tl, wq + d0, qv); conv8(Qb + ro + 8, tl, wq + d0 + 8, qv + 8);
        conv8h(Vb + ro, HV + d0, nloc, wv + d0, vv); conv8h(Vb + ro + 8, HV + d0 + 8, nloc, wv + d0 + 8, vv + 8);
        float ssk = 0.f, ssq = 0.f;
#pragma unroll
        for (int e = 0; e < 16; ++e) { ssk += kv[e] * kv[e]; ssq += qv[e] * qv[e]; }
        ssk = red8(ssk); ssq = red8(ssq);
        if ((lane & 7) == 0) { const float nkj = rsq_f(ssk + EPS), nqj = 0.08838834764831845f * rsq_f(ssq + EPS); nks[nloc] = nkj; nqs[nloc] = nqj;
            ((float*)((unsigned char*)karg_out() + OSB_NK))[(size_t)bh * SEQ + tl] = nkj; ((float*)((unsigned char*)karg_out() + OSB_NQ))[(size_t)bh * SEQ + tl] = nqj; }
        *(bf16x8*)(Kb + ro) = pack8(kv[0], kv[1], kv[2], kv[3], kv[4], kv[5], kv[6], kv[7]); *(bf16x8*)(Kb + ro + 8) = pack8(kv[8], kv[9], kv[10], kv[11], kv[12], kv[13], kv[14], kv[15]);
        *(bf16x8*)(QT + ro) = pack8(qv[0], qv[1], qv[2], qv[3], qv[4], qv[5], qv[6], qv[7]); *(bf16x8*)(QT + ro + 8) = pack8(qv[8], qv[9], qv[10], qv[11], qv[12], qv[13], qv[14], qv[15]);
        *(bf16x8*)(Vb + ro) = pack8(vv[0], vv[1], vv[2], vv[3], vv[4], vv[5], vv[6], vv[7]); *(bf16x8*)(Vb + ro + 8) = pack8(vv[8], vv[9], vv[10], vv[11], vv[12], vv[13], vv[14], vv[15]);
    }
    asm volatile("s_waitcnt vmcnt(0)" ::: "memory"); __builtin_amdgcn_fence(__ATOMIC_ACQUIRE, "agent");
#pragma unroll 1
    for (int tile = 0; tile < 2; ++tile) {
        const int tl = span * 64 + tile * 32 + n; const size_t ro = ((size_t)b * SEQ + tl) * D + h * 128 + 8 * hh;
        f32x16 ckk, cqk;
#pragma unroll
        for (int r = 0; r < 16; ++r) { ckk[r] = 0.f; cqk[r] = 0.f; }
#pragma unroll
        for (int s8 = 0; s8 < 8; ++s8) {
            const bf16x8 kf = *(const bf16x8*)(Kb + ro + 16 * s8), qf = *(const bf16x8*)(QT + ro + 16 * s8);
            ckk = __builtin_amdgcn_mfma_f32_32x32x16_bf16(kf, kf, ckk, 0, 0, 0); cqk = __builtin_amdgcn_mfma_f32_32x32x16_bf16(qf, kf, cqk, 0, 0, 0);
        }
        const float nkj = nks[tile * 32 + n];
        const float gcj = gcs[tile * 32 + n];
        bf16* att = ATT + ((size_t)bh * 64 + span * 2 + tile) * 1024 + perm16(n);
#pragma unroll
        for (int r = 0; r < 16; ++r) { const int i = (r & 3) + 8 * (r >> 2) + 4 * hh;
            const float dm = i >= n ? __expf(gcs[tile * 32 + i] - gcj) * nkj : 0.f;
            Lm[tile * 1152 + i * 36 + n] = i > n ? bts[tile * 32 + i] * nks[tile * 32 + i] * ckk[r] * dm : 0.f;
            att[i * 32] = (bf16)f2bf(nqs[tile * 32 + i] * cqk[r] * dm); }
    }
    LDS_WAIT(); asm volatile("" ::: "memory");
    { int loff = hh * 1152;
      float x[32];
#pragma unroll
      for (int i = 0; i < 32; ++i) { float sacc = (i == n) ? 1.f : 0.f;
          const LAS float* Lb = Lm + loff;
#pragma unroll
          for (int j4 = 0; j4 < (i + 3) / 4; ++j4) { const f32x4 l = *(const LAS f32x4*)(Lb + i * 36 + 4 * j4);
#pragma unroll
              for (int jj = 0; jj < 4; ++jj) if (4 * j4 + jj < i) sacc -= l[jj] * x[4 * j4 + jj]; }
          x[i] = sacc;
          if ((i & 1) == 1) asm volatile("" : "+v"(loff) : "v"(sacc)); }
      bf16* ti = TINV + ((size_t)bh * 64 + span * 2 + hh) * 1024 + perm16(n);
#pragma unroll
      for (int i = 0; i < 32; ++i) ti[i * 32] = (bf16)f2bf(x[i]); }
    LDS_WAIT(); asm volatile("" ::: "memory");
}

constexpr int DR_KB = 0, DR_QD = 8704, DR_KDT = 17408, DR_TI = 27648, DR_AT = 30208, DR_VB = 32768, DR_EGL = 49664, DR_BUF = 49680;
struct DeltaPre { u32x4 k0, k1, q0, q1, v0, v1, tia; float gct, gl, bet, nk, nq; };
__device__ __forceinline__ void delta_pre_load(int b, int h, int c, int pt, DeltaPre& dp) {
    const int bh = b * 8 + h, tt = pt >> 3, d0 = (pt & 7) * 16; const size_t t = (size_t)bh * SEQ + c * 32 + tt;
    const size_t ro = ((size_t)b * SEQ + c * 32 + tt) * D + h * 128 + d0;
    const bf16* Kt = (const bf16*)(karg_ws() + WS_Z + 3 * ZB) + ro; const bf16* Qt = (const bf16*)(karg_ws() + WS_H) + ro; const bf16* Vt = (const bf16*)(karg_ws() + WS_Z + 4 * ZB) + ro;
    dp.k0 = *(const u32x4*)Kt; dp.k1 = *(const u32x4*)(Kt + 8); dp.q0 = *(const u32x4*)Qt; dp.q1 = *(const u32x4*)(Qt + 8); dp.v0 = *(const u32x4*)Vt; dp.v1 = *(const u32x4*)(Vt + 8);
    const float* GC = (const float*)(karg_ws() + WS_GC);
    dp.gct = GC[t]; dp.gl = GC[(size_t)bh * SEQ + c * 32 + 31]; dp.bet = ((const float*)(karg_ws() + WS_BETA))[t];
    dp.nk = ((const float*)((const unsigned char*)karg_out() + OSB_NK))[t]; dp.nq = ((const float*)((const unsigned char*)karg_out() + OSB_NQ))[t];
    dp.tia = *(const u32x4*)((const bf16*)(karg_ws() + (pt < 128 ? WS_TINV : WS_ATT)) + ((size_t)bh * 64 + c) * 1024 + (pt & 127) * 8);
}
__device__ __forceinline__ void delta_rec_stage(LAS unsigned char* buf, int pt, const DeltaPre& dp) {
    const int tt = pt >> 3, dg = pt & 7, d0 = dg * 16;
    { LAS bf16* dst = (LAS bf16*)(buf + (pt < 128 ? DR_TI : DR_AT)) + ((pt & 127) >> 2) * 40 + (pt & 3) * 8; *(LAS u32x4*)dst = dp.tia; }
    if (pt == 0) *(LAS float*)(buf + DR_EGL) = __expf(dp.gl);
    const float eg = __expf(dp.gct), ekd = __expf(dp.gl - dp.gct);
    const float fq = dp.nq * eg, fkb = dp.nk * dp.bet * eg, fkd = dp.nk * ekd, bet = dp.bet;
    float k[16], q[16], v[16];
    unpack8(dp.k0, k); unpack8(dp.k1, k + 8); unpack8(dp.q0, q); unpack8(dp.q1, q + 8); unpack8(dp.v0, v); unpack8(dp.v1, v + 8);
    LAS bf16* KB = (LAS bf16*)(buf + DR_KB) + tt * 136 + d0; LAS bf16* QD = (LAS bf16*)(buf + DR_QD) + tt * 136 + d0;
    *(LAS bf16x8*)KB = pack8(k[0] * fkb, k[1] * fkb, k[2] * fkb, k[3] * fkb, k[8] * fkb, k[9] * fkb, k[10] * fkb, k[11] * fkb);
    *(LAS bf16x8*)(KB + 8) = pack8(k[4] * fkb, k[5] * fkb, k[6] * fkb, k[7] * fkb, k[12] * fkb, k[13] * fkb, k[14] * fkb, k[15] * fkb);
    *(LAS bf16x8*)QD = pack8(q[0] * fq, q[1] * fq, q[2] * fq, q[3] * fq, q[8] * fq, q[9] * fq, q[10] * fq, q[11] * fq);
    *(LAS bf16x8*)(QD + 8) = pack8(q[4] * fq, q[5] * fq, q[6] * fq, q[7] * fq, q[12] * fq, q[13] * fq, q[14] * fq, q[15] * fq);
    LAS bf16* KDT = (LAS bf16*)(buf + DR_KDT) + d0 * 40 + perm16(tt);
#pragma unroll
    for (int e = 0; e < 16; ++e) KDT[e * 40] = (bf16)f2bf(k[e] * fkd);
    LAS float* VB = (LAS float*)(buf + DR_VB) + tt * 132 + d0;
#pragma unroll
    for (int e4 = 0; e4 < 4; ++e4) *(LAS f32x4*)(VB + 4 * e4) = (f32x4){v[4 * e4] * bet, v[4 * e4 + 1] * bet, v[4 * e4 + 2] * bet, v[4 * e4 + 3] * bet};
}

constexpr int DR_OB = 2 * DR_BUF;
static_assert(DR_OB + 2 * 32 * 132 * 4 <= LDS_BYTES - 64, "delta recurrence LDS map");
__device__ __forceinline__ void delta_out_norm(const LAS float* ob, int pt, const float* dn16, const u32x4 z0, const u32x4 z1, bf16* dst) {
    const LAS float* p = ob + (pt >> 3) * 132 + (pt & 7) * 16;
    float o[16], z[16];
#pragma unroll
    for (int e4 = 0; e4 < 4; ++e4) { const f32x4 t = *(const LAS f32x4*)(p + 4 * e4); o[4 * e4] = t[0]; o[4 * e4 + 1] = t[1]; o[4 * e4 + 2] = t[2]; o[4 * e4 + 3] = t[3]; }
    float ss = 0.f;
#pragma unroll
    for (int e = 0; e < 16; ++e) ss += o[e] * o[e];
    ss = red8(ss);
    const float rstd = rsq_f(ss * (1.f / 128.f) + EPS);
    unpack8(z0, z); unpack8(z1, z + 8);
#pragma unroll
    for (int e = 0; e < 16; ++e) o[e] = o[e] * rstd * dn16[e] * z[e];
    *(bf16x8*)dst = pack8(o[0], o[1], o[2], o[3], o[4], o[5], o[6], o[7]); *(bf16x8*)(dst + 8) = pack8(o[8], o[9], o[10], o[11], o[12], o[13], o[14], o[15]);
}
__device__ __forceinline__ void delta_rec_task(const Params& P, LAS unsigned char* lds, int b, int h, int tid) {
    const int lane = tid & 63, wave = tid >> 6, n = lane & 31, hh = lane >> 5, bh = b * 8 + h, pt = tid - 256;
    const bool producer = wave >= 4;
    constexpr int NC = SEQ / 32;
    f32x16 S[4];
#pragma unroll
    for (int kb = 0; kb < 4; ++kb)
#pragma unroll
        for (int r = 0; r < 16; ++r) S[kb][r] = 0.f;
    DeltaPre dcur, dnxt;
    if (producer) { delta_pre_load(b, h, 0, pt, dcur); delta_pre_load(b, h, 1, pt, dnxt); delta_rec_stage(lds, pt, dcur); dcur = dnxt; }
    __syncthreads();
    if (producer) {
        const int pt = opq(tid) - 256;
        float dn16[16];
#pragma unroll
        for (int e = 0; e < 16; ++e) dn16[e] = INP(25)[(pt & 7) * 16 + e];
        bf16* zgp = (bf16*)(karg_ws() + WS_Z + 5 * ZB) + ((size_t)b * SEQ + (pt >> 3)) * D + h * 128 + (pt & 7) * 16;
        u32x4 zc0 = {0u, 0u, 0u, 0u}, zc1 = zc0, zn0, zn1;
#define DR_BAR() do { asm volatile("s_waitcnt lgkmcnt(0)" ::: "memory"); __builtin_amdgcn_s_barrier(); asm volatile("" ::: "memory"); } while (0)
        for (int c = 0; c < NC; ++c) {
            if (c > 0) { dcur = dnxt; zc0 = zn0; zc1 = zn1; }
            if (c + 2 < NC) delta_pre_load(b, h, c + 2, pt, dnxt);
            zn0 = *(const u32x4*)(zgp + (size_t)c * 32 * D); zn1 = *(const u32x4*)(zgp + (size_t)c * 32 * D + 8);
            if (c + 1 < NC) delta_rec_stage(lds + ((c + 1) & 1) * DR_BUF, pt, dcur);
            if (c > 0) delta_out_norm((const LAS float*)(lds + DR_OB) + ((c - 1) & 1) * 32 * 132, pt, dn16, zc0, zc1, zgp + (size_t)(c - 1) * 32 * D);
            DR_BAR();
        }
        delta_out_norm((const LAS float*)(lds + DR_OB) + ((NC - 1) & 1) * 32 * 132, pt, dn16, zn0, zn1, zgp + (size_t)(NC - 1) * 32 * D);
    } else {
        const int lane = opq(tid) & 63, n = lane & 31, hh = lane >> 5;
        for (int c = 0; c < NC; ++c) {
            LAS unsigned char* buf = lds + (c & 1) * DR_BUF;
            const int vb = wave;
            bf16x8 SB[8];
#pragma unroll
            for (int s = 0; s < 8; ++s) { const int kb = s >> 1, o = 8 * (s & 1); SB[s] = pack8(S[kb][o], S[kb][o + 1], S[kb][o + 2], S[kb][o + 3], S[kb][o + 4], S[kb][o + 5], S[kb][o + 6], S[kb][o + 7]); }
            f32x16 X1, P1;
#pragma unroll
            for (int r = 0; r < 16; ++r) { X1[r] = 0.f; P1[r] = 0.f; }
            const LAS bf16* KB = (const LAS bf16*)(buf + DR_KB) + n * 136 + 8 * hh; const LAS bf16* QD = (const LAS bf16*)(buf + DR_QD) + n * 136 + 8 * hh;
#pragma unroll
            for (int s = 0; s < 8; ++s) { X1 = __builtin_amdgcn_mfma_f32_32x32x16_bf16(*(const LAS bf16x8*)(KB + 16 * s), SB[s], X1, 0, 0, 0);
                P1 = __builtin_amdgcn_mfma_f32_32x32x16_bf16(*(const LAS bf16x8*)(QD + 16 * s), SB[s], P1, 0, 0, 0); }
            const LAS float* VB = (const LAS float*)(buf + DR_VB) + 32 * vb + n;
            float Y[16];
#pragma unroll
            for (int r = 0; r < 16; ++r) Y[r] = VB[((r & 3) + 8 * (r >> 2) + 4 * hh) * 132] - X1[r];
            const bf16x8 YB0 = pack8(Y[0], Y[1], Y[2], Y[3], Y[4], Y[5], Y[6], Y[7]), YB1 = pack8(Y[8], Y[9], Y[10], Y[11], Y[12], Y[13], Y[14], Y[15]);
            f32x16 VN;
#pragma unroll
            for (int r = 0; r < 16; ++r) VN[r] = 0.f;
            const LAS bf16* TI = (const LAS bf16*)(buf + DR_TI) + n * 40 + 8 * hh; const LAS bf16* AT = (const LAS bf16*)(buf + DR_AT) + n * 40 + 8 * hh;
            VN = __builtin_amdgcn_mfma_f32_32x32x16_bf16(*(const LAS bf16x8*)TI, YB0, VN, 0, 0, 0);
            VN = __builtin_amdgcn_mfma_f32_32x32x16_bf16(*(const LAS bf16x8*)(TI + 16), YB1, VN, 0, 0, 0);
            const bf16x8 VB0 = pack8(VN[0], VN[1], VN[2], VN[3], VN[4], VN[5], VN[6], VN[7]), VB1 = pack8(VN[8], VN[9], VN[10], VN[11], VN[12], VN[13], VN[14], VN[15]);
            P1 = __builtin_amdgcn_mfma_f32_32x32x16_bf16(*(const LAS bf16x8*)AT, VB0, P1, 0, 0, 0);
            P1 = __builtin_amdgcn_mfma_f32_32x32x16_bf16(*(const LAS bf16x8*)(AT + 16), VB1, P1, 0, 0, 0);
            const float egl = *(const LAS float*)(buf + DR_EGL);
            const LAS bf16* KDT = (const LAS bf16*)(buf + DR_KDT) + n * 40 + 8 * hh;
#pragma unroll
            for (int kb = 0; kb < 4; ++kb) {
#pragma unroll
                for (int r = 0; r < 16; ++r) S[kb][r] *= egl;
                S[kb] = __builtin_amdgcn_mfma_f32_32x32x16_bf16(*(const LAS bf16x8*)(KDT + kb * 32 * 40), VB0, S[kb], 0, 0, 0);
                S[kb] = __builtin_amdgcn_mfma_f32_32x32x16_bf16(*(const LAS bf16x8*)(KDT + kb * 32 * 40 + 16), VB1, S[kb], 0, 0, 0); }
            LAS float* op = (LAS float*)(lds + DR_OB) + (c & 1) * 32 * 132 + 4 * hh * 132 + 32 * vb + n;
#pragma unroll
            for (int r = 0; r < 16; ++r) op[((r & 3) + 8 * (r >> 2)) * 132] = P1[r];
            DR_BAR();
        }
    }
    if (!producer) { float* So = karg_out() + O_SP + ((size_t)bh * 128 + 4 * hh) * 128 + 32 * wave + n;
#pragma unroll
        for (int kb = 0; kb < 4; ++kb)
#pragma unroll
            for (int r = 0; r < 16; ++r) So[(size_t)(32 * kb + (r & 3) + 8 * (r >> 2)) * 128] = S[kb][r]; }
    __syncthreads();
}

template <int MODE>
__device__ __forceinline__ void delta_sample_item(const Params& P, LAS unsigned char* lds, int item, int tid) {
    LAS float* tmp = (LAS float*)lds;
    LAS float* scl = (LAS float*)(lds + 1536);
    LAS float* rpk = (LAS float*)(lds + 2048);
    LAS float* rpq = (LAS float*)(lds + 4096);
    const int bs = item >> 3, h = item & 7, lane = tid & 63, wave = tid >> 6; const size_t row = (size_t)MPR + bs;
    const bf16* Zq = (const bf16*)(karg_ws() + WS_Z + 2 * ZB);
    if (tid < 384) { const int which = tid >> 7, d = tid & 127; const int c3 = which * 1024 + h * 128 + d;
        const float raw = bf2f(Zq[(size_t)which * (ZB / 2) + row * D + h * 128 + d]);
        const float* cs = INP(7) + (size_t)bs * 3 * 3072 + c3; const float* w = INP(22) + c3;
        tmp[tid] = silu_f(cs[0] * w[0] + cs[3072] * w[3072] + cs[2 * 3072] * w[2 * 3072] + raw * w[3 * 3072]); }
    __syncthreads();
    if (wave < 3) { float s;
        if (wave == 0) s = tmp[lane] * tmp[lane] + tmp[lane + 64] * tmp[lane + 64];
        else if (wave == 1) s = tmp[128 + lane] * tmp[128 + lane] + tmp[192 + lane] * tmp[192 + lane];
        else s = tmp[lane] * tmp[128 + lane] + tmp[64 + lane] * tmp[192 + lane];
        s = wave_sum(s);
        if (lane == 0) scl[wave] = wave == 0 ? rsq_f(s + EPS) * 0.08838834764831845f : (wave == 1 ? rsq_f(s + EPS) : s); }
    __syncthreads();
    const float sq = scl[0], sk = scl[1], kq = scl[2] * sq * sk;
    const int v = tid & 127, kg = tid >> 7;
    const float* S0 = INP(6) + ((size_t)(bs * NH + h) * 128 + kg * 32) * 128 + v;
    float S[32];
#pragma unroll
    for (int j = 0; j < 32; ++j) S[j] = MODE == 1 ? __builtin_nontemporal_load(S0 + (size_t)j * 128) : S0[(size_t)j * 128];
    float pk = 0.f, pq = 0.f;
#pragma unroll
    for (int j = 0; j < 32; ++j) { pk += S[j] * tmp[128 + kg * 32 + j]; pq += S[j] * tmp[kg * 32 + j]; }
    rpk[kg * 128 + v] = pk * sk; rpq[kg * 128 + v] = pq * sq;
    __syncthreads();
    pk = (rpk[v] + rpk[128 + v]) + (rpk[256 + v] + rpk[384 + v]); pq = (rpq[v] + rpq[128 + v]) + (rpq[256 + v] + rpq[384 + v]);
    const float* ABL = (const float*)(karg_ws() + WS_ABL);
    const float al = ABL[row * 16 + h], bl = ABL[row * 16 + 8 + h];
    const float dc = __expf(-__expf(INP(23)[h]) * softplus_f(al + INP(24)[h])), be = sigmoid_f(bl);
    const float delta = be * (tmp[256 + v] - dc * pk);
    if (MODE == 0) {
        const float o = dc * pq + kq * delta; const float so = wave_sum(o * o);
        if (lane == 0 && wave < 2) scl[4 + wave] = so;
        __syncthreads();
        if (kg == 0) { bf16* zp = (bf16*)(karg_ws() + WS_Z + 5 * ZB) + row * D + h * 128 + v;
            *zp = (bf16)f2bf(o * rsq_f((scl[4] + scl[5]) * (1.f / 128.f) + EPS) * INP(25)[v] * bf2f(*zp)); } }
    else { float* So = karg_out() + O_SS + ((size_t)(bs * NH + h) * 128 + kg * 32) * 128 + v;
#pragma unroll
        for (int j = 0; j < 32; ++j) __builtin_nontemporal_store(dc * S[j] + (tmp[128 + kg * 32 + j] * sk) * delta, So + (size_t)j * 128); }
    __syncthreads();
}

#define XB_TMO      128
#define XB_XCNT(j)  (256  + 64 * (j))
#define XB_XSUB(j)  (1280 + 64 * (j))
#define XB_XGEN(j)  (2304 + 64 * (j))
#define XB_TOP      3328
#define XB_TOPGEN   3392
#define XCD_BAR_WORDS 3456
#define XB_SPIN_CAP (1u << 22)
__device__ __forceinline__ unsigned xb_ld(unsigned* p)              { return __hip_atomic_load(p, __ATOMIC_RELAXED, __HIP_MEMORY_SCOPE_AGENT); }
__device__ __forceinline__ unsigned xb_add(unsigned* p, unsigned v) { return __hip_atomic_fetch_add(p, v, __ATOMIC_RELAXED, __HIP_MEMORY_SCOPE_AGENT); }
__device__ __forceinline__ unsigned xb_xcc_id() { return (unsigned)__builtin_amdgcn_s_getreg((3 << 11) | 20) & 0xFu; }
#define XB_SPIN(cond, bar) do { unsigned _sp = 0; while (cond) { __builtin_amdgcn_s_sleep(1); \
    if ((++_sp & 255u) == 0u) { if (xb_ld(&(bar)[XB_TMO])) break; if (_sp > XB_SPIN_CAP) { atomicAdd(&(bar)[XB_TMO], 1u); break; } } } } while (0)
struct XcdBarrier { unsigned* bar; unsigned x; volatile LAS unsigned* st; };
__device__ __forceinline__ XcdBarrier xcd_barrier_post(unsigned* bar, volatile LAS unsigned* st, bool leader) {
    XcdBarrier b; b.bar = bar; b.x = xb_xcc_id(); b.st = st;
    if (leader) (void)xb_add(&bar[XB_XCNT(b.x)], 1u);
    return b;
}
__device__ __forceinline__ void xcd_barrier_complete(unsigned* bar, unsigned x, unsigned& nloc, unsigned& nx) {
    const unsigned G = gridDim.x * gridDim.y * gridDim.z;
    unsigned sum, cnt, mine, sp = 0u;
    for (;;) {
        sum = 0u; cnt = 0u; mine = 0u;
#pragma unroll
        for (unsigned j = 0; j < 16; ++j) { const unsigned c = xb_ld(&bar[XB_XCNT(j)]); sum += c; cnt += (c > 0u) ? 1u : 0u; mine = (j == x) ? c : mine; }
        if (sum == G) break;
        __builtin_amdgcn_s_sleep(1);
        if ((++sp & 255u) == 0u) { if (xb_ld(&bar[XB_TMO])) break; if (sp > XB_SPIN_CAP) { atomicAdd(&bar[XB_TMO], 1u); break; } }
    }
    nloc = mine > 0u ? mine : 1u; nx = cnt > 0u ? cnt : 1u;
}
__device__ __forceinline__ void xcd_barrier(const XcdBarrier& b, bool leader) {
    asm volatile("s_waitcnt vmcnt(0)" ::: "memory");
    __syncthreads();
    if (leader) {
        unsigned* bar = b.bar;
        __builtin_amdgcn_s_waitcnt(0);
        unsigned nloc = b.st[0], nx = b.st[1];
        if (nloc == 0u) { xcd_barrier_complete(bar, b.x, nloc, nx); b.st[0] = nloc; b.st[1] = nx; }
        const unsigned old = xb_add(&bar[XB_XSUB(b.x)], 1u);
        const unsigned gen = old / nloc;
        if (old + 1u == (gen + 1u) * nloc) {
            __builtin_amdgcn_fence(__ATOMIC_RELEASE, "agent");
            asm volatile("s_waitcnt vmcnt(0)" ::: "memory");
            const unsigned og = xb_add(&bar[XB_TOP], 1u);
            const unsigned tg = og / nx;
            if (og + 1u == (tg + 1u) * nx) xb_add(&bar[XB_TOPGEN], 1u);
            else XB_SPIN(xb_ld(&bar[XB_TOPGEN]) == tg, bar);
            __builtin_amdgcn_fence(__ATOMIC_ACQUIRE, "agent");
            xb_add(&bar[XB_XGEN(b.x)], 1u);
            asm volatile("s_waitcnt vmcnt(0)" ::: "memory");
        } else {
            XB_SPIN(xb_ld(&bar[XB_XGEN(b.x)]) == gen, bar);
            __builtin_amdgcn_fence(__ATOMIC_ACQUIRE, "agent");
            asm volatile("s_waitcnt vmcnt(0)" ::: "memory");
        }
    }
    __syncthreads();
}

__global__ void __launch_bounds__(NTHR, 2) fwd_megakernel(Params P) {
    extern __shared__ __attribute__((aligned(16))) unsigned char lds_raw[];
    LAS unsigned char* lds = (LAS unsigned char*)lds_raw;
    cg::grid_group grid = cg::this_grid();
    const int wave = __builtin_amdgcn_readfirstlane((int)threadIdx.x >> 6);
#define lane opq(lane_now())
#define tid opq((wave << 6) | lane_now())
    const int G = gridDim.x, wg = blockIdx.x;
    const int gw = wg * NWAVES + wave, NGW = G * NWAVES;
    unsigned char* ws = karg_ws();
    float* ADA = (float*)(ws + WS_ADA);
    bf16* H = (bf16*)(ws + WS_H);
    bf16* Z = (bf16*)(ws + WS_Z);
    bf16* ACT = (bf16*)(ws + WS_ACT);
    bf16* MG = (bf16*)(karg_out() + O_SS);
    volatile LAS unsigned* MISC = (volatile LAS unsigned*)(lds + LDS_BYTES - 64);
    if (tid < 16) MISC[tid] = 0u;
    __syncthreads();
    const XcdBarrier xbar = xcd_barrier_post((unsigned*)ws, MISC, wave == 0 && lane_now() == 0);
#define GBAR() xcd_barrier(xbar, wave == 0 && lane_now() == 0)

    if constexpr ((PHM >> 0) & 1) {
    prologue<0>(P, lds, gw, NGW, wave, lane);
    }
    GBAR();
    if constexpr ((PHM >> 1) & 1) {
    { pg8::Gemm g{(const bf16*)(ws + WS_CB), (const bf16*)(ws + WS_WADA), nullptr, nullptr, D}; pg8::StaticOrder S; S.init(256, NADA, G, wg);
      EpiAda E{ADA, INP(9)}; pg8::gemm_phase(lds, g, S, E, wave);
      if (wg >= 36) prologue<1>(P, lds, (wg - 36) * NWAVES + wave, (G - 36) * NWAVES, wave, lane); }
    }
    GBAR();
    if constexpr ((PHM >> 2) & 1) {
    norm_mod_pass<0>(P, INP(10), 0, gw, NGW, lane);
    { const int gt = wg * NTHR + tid;
      if (gt < 2 * NB * 3 * (D / 8)) { const int m = gt / (NB * 3 * (D / 8)), r = gt % (NB * 3 * (D / 8)), c8 = r & 127, j = (r >> 7) % 3, bb = (r >> 7) / 3;
          *(u32x4*)((bf16*)((unsigned char*)karg_out() + (m ? OSB_HV : OSB_HK)) + ((size_t)(bb * 32) * 3 + j) * D + c8 * 8) = (u32x4){0u, 0u, 0u, 0u}; } }
    }
    GBAR();
    if constexpr ((PHM >> 3) & 1) {
    { pg8::Gemm g{H, (const bf16*)(ws + WS_WUP1), nullptr, nullptr, D}; pg8::StaticOrder S; S.init(MPAD, 2 * FF, G, wg);
      EpiSwiglu E{ACT}; pg8::gemm_phase(lds, g, S, E, wave); }
    }
    GBAR();
    if constexpr ((PHM >> 4) & 1) {
    { pg8::Gemm g{ACT, (const bf16*)(ws + WS_WDN1), nullptr, nullptr, FF}; pg8::StaticOrder S; S.init(MPR, D, G, wg);
      EpiResidNorm<0> E{karg_out(), INP(0), ADA + 2 * D, 0.5f, INP(13), ADA + 3 * D, H, (float*)(ws + WS_PART), (unsigned*)(ws + WS_CNT), (LAS float*)(lds + 131072)}; pg8::gemm_phase(lds, g, S, E, wave);
      float* X = karg_out(); const float* xs = INP(1); const float* gate = ADA + 2 * D;
      mini_gemm(lds, ACT, (const bf16*)(ws + WS_WDN1), nullptr, nullptr, FF, wg, G, tid, [=](int row, int col, f32x4 v, f32x4) {
          const f32x4 xv = *(const f32x4*)(xs + (size_t)(row - MPR) * D + col), gv = *(const f32x4*)(gate + (size_t)cond_of_row(row) * NADA + col);
          *(f32x4*)(X + (size_t)row * D + col) = xv + (gv * 0.5f) * v; }); }
    }
    GBAR();
    if constexpr ((PHM >> 5) & 1) {
    sample_norm_rows<0>(INP(13), 3, gw, lane);
    }
    GBAR();
    if constexpr ((PHM >> 6) & 1) {
    { pg8::Gemm g{H, (const bf16*)(ws + WS_WIN), nullptr, nullptr, D}; pg8::StaticOrder S; S.init(MPAD, NIN, G, wg);
      EpiIn E{Z, MG, (float*)(ws + WS_ABL), karg_out()}; pg8::gemm_phase(lds, g, S, E, wave); }
    }
    GBAR();
    if constexpr ((PHM >> 7) & 1) {
        { const int bh0 = (wg * NWAVES) >> 5, h0 = bh0 & 7; LAS float* w = (LAS float*)lds; const float* cwq = INP(22);
          for (int i = tid; i < 1536; i += NTHR) { const int which = i >> 9, j = (i >> 7) & 3, d = i & 127; w[i] = cwq[(size_t)j * 3072 + which * 1024 + h0 * 128 + d]; }
          __syncthreads();
          delta_prep_wave(P, lds, gw, wave, lane);
          __syncthreads(); }
        if (G == 256) { const int task = (wg & 7) * 32 + (wg >> 3); rglru_task(P, lds, task >> 5, (task >> 2) & 7, task & 3, tid, 0, RG_SPLIT); }
        else for (int task = wg; task < 256; task += G) rglru_task(P, lds, task >> 5, (task >> 2) & 7, task & 3, tid, 0, RG_SPLIT);
    }
    GBAR();
    if constexpr ((PHM >> 7) & 1) {
        if (wg < 64) delta_rec_task(P, lds, wg >> 3, wg & 7, tid);
        else {
            if (G == 256) { const int slot = (wg - 64) >> 3;
                { const int task = (wg & 7) * 32 + slot; rglru_task(P, lds, task >> 5, (task >> 2) & 7, task & 3, tid, RG_SPLIT, 16); }
                if (slot < 8) { const int task = (wg & 7) * 32 + 24 + slot; rglru_task(P, lds, task >> 5, (task >> 2) & 7, task & 3, tid, RG_SPLIT, 16); } }
            else for (int task = wg - 64; task < 256; task += G - 64) rglru_task(P, lds, task >> 5, (task >> 2) & 7, task & 3, tid, RG_SPLIT, 16);
            if (wg < 96) rglru_task(P, lds, -1, (wg - 64) >> 2, (wg - 64) & 3, tid, 0, 1);
            if (wg >= 128) for (int item = wg - 128; item < NS * NH; item += G - 128) delta_sample_item<0>(P, lds, item, tid);
        }
    }
    GBAR();
    if constexpr ((PHM >> 9) & 1) {
    { pg8::Gemm g{Z + 1 * (ZB / 2), (const bf16*)(ws + WS_WBR), Z + 5 * (ZB / 2), (const bf16*)(ws + WS_WBR) + (size_t)D * D, D};
      pg8::PairOrder S; S.base.init(MPR, D, G, wg);
      EpiBranch E{MG, MG + ZB / 2, Z}; pg8::gemm_phase(lds, g, S, E, wave);
      const bf16* mga = MG; const bf16* mgb = MG + ZB / 2; bf16* Gm = Z;
      mini_gemm(lds, g.A0, g.B0, g.A1, g.B1, D, wg, G, tid, [=](int row, int col, f32x4 ya, f32x4 yb) {
          const size_t o = (size_t)row * D + col; const u32x2 a = *(const u32x2*)(mga + o), b = *(const u32x2*)(mgb + o);
          u32x2 w; w.x = pk2(bflo(a.x) * ya[0] + bflo(b.x) * yb[0], bfhi(a.x) * ya[1] + bfhi(b.x) * yb[1]);
          w.y = pk2(bflo(a.y) * ya[2] + bflo(b.y) * yb[2], bfhi(a.y) * ya[3] + bfhi(b.y) * yb[3]);
          *(u32x2*)(Gm + o) = w; }); }
    }
    GBAR();
    if constexpr ((PHM >> 10) & 1) {
    { pg8::Gemm g{Z, (const bf16*)(ws + WS_WOUT), nullptr, nullptr, D}; pg8::StaticOrder S; S.init(MPR, D, G, wg);
      EpiResidNorm<0> E{karg_out(), nullptr, ADA + 5 * D, 1.0f, INP(28), ADA + 6 * D, H, (float*)(ws + WS_PART) + 65536, (unsigned*)(ws + WS_CNT) + 64, (LAS float*)(lds + 131072)}; pg8::gemm_phase(lds, g, S, E, wave);
      float* X = karg_out(); const float* gate = ADA + 5 * D;
      mini_gemm(lds, Z, (const bf16*)(ws + WS_WOUT), nullptr, nullptr, D, wg, G, tid, [=](int row, int col, f32x4 v, f32x4) {
          float* xp = X + (size_t)row * D + col; const f32x4 gv = *(const f32x4*)(gate + (size_t)cond_of_row(row) * NADA + col);
          *(f32x4*)xp = *(const f32x4*)xp + gv * v; }); }
    }
    GBAR();
    if constexpr ((PHM >> 11) & 1) {
    sample_norm_rows<0>(INP(28), 6, gw, lane);
    {
        for (int item = (G == 256 ? SS_TAIL : 0) + wg; item < NS * NH; item += G) delta_sample_item<1>(P, lds, item, tid);
        const int gt = wg * NTHR + tid, NGT = G * NTHR;
        for (int i = gt; i < NS * 3 * 3072; i += NGT) { const int bs = i / 9216, j = (i / 3072) % 3, c3 = i % 3072;
            karg_out()[O_CQS + i] = j < 2 ? INP(7)[(size_t)bs * 9216 + (j + 1) * 3072 + c3] : bf2f(Z[(size_t)(2 + (c3 >> 10)) * (ZB / 2) + ((size_t)MPR + bs) * D + (c3 & 1023)]); }
    }
    }
    GBAR();
    if constexpr ((PHM >> 12) & 1) {
    { pg8::Gemm g{H, (const bf16*)(ws + WS_WUP2), nullptr, nullptr, D}; pg8::StaticOrder S; S.init(MPAD, 2 * FF, G, wg);
      EpiSwiglu E{ACT}; pg8::gemm_phase(lds, g, S, E, wave);
      if (G == 256 && wg >= 150) for (int item = wg - 150; item < SS_TAIL; item += 106) delta_sample_item<1>(P, lds, item, tid); }
    }
    GBAR();
    if constexpr ((PHM >> 13) & 1) {
    { pg8::Gemm g{ACT, (const bf16*)(ws + WS_WDN2), nullptr, nullptr, FF}; pg8::StaticOrder S; S.init(MPR, D, G, wg);
      EpiResidNorm<1> E{karg_out(), nullptr, ADA + 8 * D, 0.5f, INP(31), nullptr, nullptr, (float*)(ws + WS_PART) + 131072, (unsigned*)(ws + WS_CNT) + 128, (LAS float*)(lds + 131072)}; pg8::gemm_phase(lds, g, S, E, wave);
      float* X = karg_out(); const float* gate = ADA + 8 * D;
      mini_gemm(lds, ACT, (const bf16*)(ws + WS_WDN2), nullptr, nullptr, FF, wg, G, tid, [=](int row, int col, f32x4 v, f32x4) {
          float* xp = X + (size_t)row * D + col; const f32x4 gv = *(const f32x4*)(gate + (size_t)cond_of_row(row) * NADA + col);
          *(f32x4*)xp = *(const f32x4*)xp + (gv * 0.5f) * v; }); }
    }
    GBAR();
    if constexpr ((PHM >> 14) & 1) {
    sample_norm_rows<1>(INP(31), 0, gw, lane);
    }
}

extern "C" void kernel_launch(void* const* d_in, const int* in_sizes, int n_in, void* d_out, int out_size, void* d_ws, size_t ws_size, hipStream_t stream) {
    static int grid = 0;
    if (grid == 0) {
        if (n_in != 32 || (size_t)out_size != O_END || ws_size < WS_END) { fprintf(stderr, "kernel_launch: unexpected shapes: n_in %d out %d ws %zu (need %zu)\n", n_in, out_size, ws_size, (size_t)WS_END); grid = -1; return; }
        int dev = 0, cus = 0, per_cu = 0;
        hipGetDevice(&dev); hipDeviceGetAttribute(&cus, hipDeviceAttributeMultiprocessorCount, dev);
        if (hipFuncSetAttribute((const void*)fwd_megakernel, hipFuncAttributeMaxDynamicSharedMemorySize, LDS_BYTES) != hipSuccess) { fprintf(stderr, "kernel_launch: hipFuncSetAttribute failed\n"); grid = -1; return; }
        if (hipOccupancyMaxActiveBlocksPerMultiprocessor(&per_cu, (const void*)fwd_megakernel, NTHR, LDS_BYTES) != hipSuccess || per_cu < 1) { fprintf(stderr, "kernel_launch: occupancy query says %d\n", per_cu); per_cu = 1; }
        (void)hipGetLastError();
        grid = cus * 1;
        if (grid > 256) grid = 256;
    }
    if (grid < 0) return;
    if (hipMemsetAsync(d_ws, 0, 16384, stream) != hipSuccess) { fprintf(stderr, "kernel_launch: memset failed\n"); return; }
    Params p{};
    for (int i = 0; i < 32; ++i) p.in[i] = (const float*)d_in[i];
    p.out = (float*)d_out; p.ws = (unsigned char*)d_ws;
    void* args[] = {&p};
    hipError_t e = hipLaunchCooperativeKernel((const void*)fwd_megakernel, dim3(grid), dim3(NTHR), args, LDS_BYTES, stream);
    if (e != hipSuccess) fprintf(stderr, "kernel_launch: cooperative launch failed: %s (grid %d)\n", hipGetErrorString(e), grid);
}
```

```cpp
#include <hip/hip_runtime.h>
#include <hip/hip_cooperative_groups.h>
#include <cstdio>
#include <cstdint>
namespace cg = cooperative_groups;

#define LAS __attribute__((address_space(3)))
typedef unsigned short bf16;
typedef short bf16x8 __attribute__((ext_vector_type(8)));
typedef float f32x4 __attribute__((ext_vector_type(4)));
typedef float f32x16 __attribute__((ext_vector_type(16)));
typedef unsigned u32x4 __attribute__((ext_vector_type(4)));
typedef unsigned u32x2 __attribute__((ext_vector_type(2)));

constexpr int D = 1024, SEQ = 2048, NB = 8, MPR = NB * SEQ, NS = 128, M = MPR + NS, MPAD = 16640;
constexpr int FF = 2816, NADA = 9216, NCOND = NB + NS, NIN = 8448, NH = 8;
constexpr float EPS = 1e-6f;
constexpr int NWAVES = 8, NTHR = 512;

constexpr size_t MiB = 1u << 20;
constexpr size_t ZB = (size_t)M * D * 2;
constexpr size_t WS_WUP2 = 1 * MiB;
constexpr size_t WS_WDN2 = 12 * MiB;
constexpr size_t WS_WIN = WS_WDN2 + (size_t)D * FF * 2;
constexpr size_t WS_WBR = 34 * MiB;
constexpr size_t WS_WOUT = 38 * MiB;
constexpr size_t WS_WRG = 40 * MiB;
constexpr size_t WS_CB = WS_WRG + 512 * 1024;
constexpr size_t WS_ADA = 41 * MiB;
constexpr size_t WS_ABL = 46 * MiB;
constexpr size_t WS_H = 48 * MiB;
constexpr size_t WS_Z = WS_H + ZB;
constexpr size_t WS_ACT = WS_Z;
constexpr size_t WS_WUP1 = WS_Z + 96 * MiB;
constexpr size_t WS_WDN1 = WS_Z + 107 * MiB;
constexpr size_t WS_WADA = WS_Z + 113 * MiB;
constexpr size_t WS_END = WS_Z + 6 * ZB + 1 * MiB;
static_assert(WS_WIN + (size_t)NIN * D * 2 <= WS_WBR, "ws map");
static_assert((size_t)M * 16 * 4 <= 2 * MiB, "ws map");
static_assert((size_t)MPAD * FF * 2 <= 96 * MiB, "ws map");
static_assert(WS_WADA + (size_t)NADA * D * 2 <= WS_Z + 6 * ZB, "ws map");

constexpr size_t O_Y = 0, O_HP = (size_t)M * D, O_CRP = O_HP + NB * D, O_SP = O_CRP + NB * 3 * D, O_CQP = O_SP + (size_t)NB * NH * 128 * 128,
                 O_HS = O_CQP + NB * 3 * 3072, O_CRS = O_HS + NS * D, O_SS = O_CRS + NS * 3 * D, O_CQS = O_SS + (size_t)NS * NH * 128 * 128,
                 O_END = O_CQS + (size_t)NS * 3 * 3072;
static_assert(2 * ZB <= (O_END - O_SS) * 4, "scratch in d_out");
constexpr size_t OSB = O_SS * 4 + 2 * ZB, OSB_HK = OSB, OSB_HV = OSB + 3 * MiB / 2, OSB_NK = OSB + 3 * MiB, OSB_NQ = OSB + 7 * MiB / 2;
static_assert(OSB + 4 * MiB <= O_END * 4, "d_out scratch");

__device__ __forceinline__ unsigned pk2(float lo, float hi);
__device__ __forceinline__ unsigned f2bf(float f) { return pk2(f, f) & 0xffffu; }
typedef float f32x2_t __attribute__((ext_vector_type(2))); typedef __bf16 bf16x2_t __attribute__((ext_vector_type(2)));
__device__ __forceinline__ unsigned pk2(float lo, float hi) { f32x2_t v = {lo, hi}; bf16x2_t b = __builtin_convertvector(v, bf16x2_t); return __builtin_bit_cast(unsigned, b); }
__device__ __forceinline__ float bf2f(unsigned short b) { return __builtin_bit_cast(float, (unsigned)b << 16); }
__device__ __forceinline__ float bflo(unsigned u) { return __builtin_bit_cast(float, u << 16); }
__device__ __forceinline__ float bfhi(unsigned u) { return __builtin_bit_cast(float, u & 0xffff0000u); }
__device__ __forceinline__ float rcp_f(float x) { return __builtin_amdgcn_rcpf(x); }
__device__ __forceinline__ float rsq_f(float x) { return __builtin_amdgcn_rsqf(x); }
__device__ __forceinline__ float sigmoid_f(float x) { return rcp_f(1.f + __expf(-x)); }
__device__ __forceinline__ float neg_expm1_f(float x) {
    const float p = -x * (1.f + x * (0.5f + x * (0.16666667f + x * (0.041666668f + x * (0.0083333338f + x * 0.0013888889f)))));
    return x > -0.3f ? p : 1.f - __expf(x);
}
__device__ __forceinline__ float silu_f(float x) { return x * sigmoid_f(x); }
__device__ __forceinline__ float gelu_tanh_f(float x) { return x * sigmoid_f(1.5957691216057308f * (x + 0.044715f * x * x * x)); }
__device__ __forceinline__ float softplus_f(float x) { return x > 20.f ? x : log1pf(__expf(x)); }
template <int CTRL> __device__ __forceinline__ float dpp_f(float x) {
    return __builtin_bit_cast(float, __builtin_amdgcn_update_dpp(0, __builtin_bit_cast(int, x), CTRL, 0xF, 0xF, true));
}
__device__ __forceinline__ float red8(float x) { x += dpp_f<0xB1>(x); x += dpp_f<0x4E>(x); x += dpp_f<0x141>(x); return x; }
__device__ __forceinline__ float red16(float x) { x = red8(x); x += dpp_f<0x140>(x); return x; }
__device__ __forceinline__ float wave_sum(float v) { v = red16(v);
    return ((__builtin_bit_cast(float, __builtin_amdgcn_readlane(__builtin_bit_cast(int, v), 0)) + __builtin_bit_cast(float, __builtin_amdgcn_readlane(__builtin_bit_cast(int, v), 16))) +
            (__builtin_bit_cast(float, __builtin_amdgcn_readlane(__builtin_bit_cast(int, v), 32)) + __builtin_bit_cast(float, __builtin_amdgcn_readlane(__builtin_bit_cast(int, v), 48)))); }
__device__ __forceinline__ int lane_now();
__device__ __forceinline__ int opq(int x);
__device__ __forceinline__ float shfl_xor_l(float v, int o) { const int idx = (opq(lane_now()) ^ o) << 2; return __builtin_bit_cast(float, __builtin_amdgcn_ds_bpermute(idx, __builtin_bit_cast(int, v))); }
__device__ __forceinline__ void unpack8(const u32x4 u, float* x) { x[0] = bflo(u.x); x[1] = bfhi(u.x); x[2] = bflo(u.y); x[3] = bfhi(u.y); x[4] = bflo(u.z); x[5] = bfhi(u.z); x[6] = bflo(u.w); x[7] = bfhi(u.w); }
__device__ __forceinline__ bf16x8 pack8(float a0, float a1, float a2, float a3, float a4, float a5, float a6, float a7) {
    u32x4 w; w.x = pk2(a0, a1); w.y = pk2(a2, a3); w.z = pk2(a4, a5); w.w = pk2(a6, a7); return __builtin_bit_cast(bf16x8, w);
}
#define LDS_WAIT() asm volatile("s_waitcnt lgkmcnt(0)" ::: "memory")
__device__ __forceinline__ int lane_now() { return (int)__builtin_amdgcn_mbcnt_hi(~0u, __builtin_amdgcn_mbcnt_lo(~0u, 0u)); }
__device__ __forceinline__ int opq(int x) { asm volatile("" : "+v"(x)); return x; }

namespace pg8 {
constexpr int BM = 256, BK = 64, HALF = 128, HTB = HALF * BK * 2, NXCD = 8, WGM = 4;
__host__ __device__ __forceinline__ int lds_byte(int r, int c) { const int st = (r >> 4) * 2 + (c >> 5), rr = r & 15, cc = c & 31, ob = rr * 64 + cc * 2; return st * 1024 + (ob ^ (((ob >> 9) & 1) << 5)); }
__host__ __device__ __forceinline__ void stage_rc(int b, int& R, int& C) { const int st = b / 1024, sb = b % 1024, swz = sb ^ (((sb >> 9) & 1) << 5); R = (st >> 1) * 16 + swz / 64; C = (st & 1) * 32 + (swz % 64) / 2; }
__host__ __device__ __forceinline__ int perm32(int rho) { const int n = rho >> 4, i = rho & 15; return 8 * (i >> 2) + 4 * n + (i & 3); }

struct Unit { int pm, pn, sub; };
struct Gemm { const bf16* A0; const bf16* B0; const bf16* A1; const bf16* B1; int K; };

struct StaticOrder {
    int nM, nN, nwg, G, c;
    __device__ void init(int Mp, int N, int G_, int c_) { nM = Mp / BM; nN = N / BM; nwg = nM * nN; G = G_; c = c_; }
    __device__ bool next(int i, Unit& u) const {
        const long L = (long)i * G + c; if (L >= nwg) return false;
        int wgid = (int)L; { const int q = nwg / NXCD, r = nwg % NXCD, xcd = wgid % NXCD, off = wgid / NXCD; wgid = (xcd < r ? xcd * (q + 1) : r * (q + 1) + (xcd - r) * q) + off; }
        const int nig = WGM * nN, gid = wgid / nig, fm = gid * WGM, gsz = (nM - fm) < WGM ? (nM - fm) : WGM;
        u.pm = fm + ((wgid % nig) % gsz); u.pn = (wgid % nig) / gsz; u.sub = 0; return true;
    }
};
struct PairOrder {
    StaticOrder base;
    __device__ bool next(int i, Unit& u) const { const bool ok = base.next(i >> 1, u); u.sub = i & 1; return ok; }
};

template <class Epi, class Sched>
__device__ __forceinline__ void gemm_phase(LAS unsigned char* lds, const Gemm g, const Sched& S, const Epi& E, int wid) {
    const int lane = opq(lane_now()), tid = (wid << 6) | lane, wr = wid >> 2, wc = wid & 3, fr = lane & 15, fq = lane >> 4;
    const int K = g.K, nt = K / BK;
    unsigned voffA[2], voffB[2];
#pragma unroll
    for (int i = 0; i < 2; ++i) { int R, C; stage_rc(tid * 16 + i * 8192, R, C); const int Rb = (R & ~31) + perm32(R & 31);
        voffA[i] = (unsigned)(R * K + C) * 2u; voffB[i] = (unsigned)(Rb * K + C) * 2u; }
    const size_t kstep = (size_t)(BK * 2);
    const size_t hstep = (size_t)HALF * K * 2;
    const size_t tstep = 2 * hstep;
    const unsigned ldsw = (unsigned)wid * 1024u;
    const int aoff = lds_byte(wr * 64 + fr, fq * 8), boff = lds_byte(wc * 32 + fr, fq * 8);
#define PG8_SA(b, h) (((b) * 2 + (h)) * HTB)
#define PG8_SB(b, h) ((4 + (b) * 2 + (h)) * HTB)
#define PG8_STAGE(bufoff, gbase, voff) do { _Pragma("unroll") for (int _i = 0; _i < 2; ++_i) \
        __builtin_amdgcn_global_load_lds((const unsigned*)((const char*)(gbase) + (voff)[_i]), (LAS unsigned*)(lds + (bufoff) + ldsw + _i * 8192), 16, 0, 0); } while (0)
#define PG8_LDA(dst, b, h) do { _Pragma("unroll") for (int m = 0; m < 4; ++m) _Pragma("unroll") for (int k = 0; k < 2; ++k) dst[m][k] = *(const LAS bf16x8*)(lds + PG8_SA(b, h) + aoff + m * 2048 + k * 1024); } while (0)
#define PG8_LDB(dst, b, h) do { _Pragma("unroll") for (int n = 0; n < 2; ++n) _Pragma("unroll") for (int k = 0; k < 2; ++k) dst[n][k] = *(const LAS bf16x8*)(lds + PG8_SB(b, h) + boff + n * 2048 + k * 1024); } while (0)
#define PG8_MMA(ai, bj, At, Bt) do { __builtin_amdgcn_s_setprio(1); _Pragma("unroll") for (int m = 0; m < 4; ++m) _Pragma("unroll") for (int n = 0; n < 2; ++n) _Pragma("unroll") for (int k = 0; k < 2; ++k) \
        acc[ai][bj][m][n] = __builtin_amdgcn_mfma_f32_16x16x32_bf16(Bt[n][k], At[m][k], acc[ai][bj][m][n], 0, 0, 0); __builtin_amdgcn_s_setprio(0); } while (0)
#define PG8_WAIT_V(n) asm volatile("s_waitcnt vmcnt(" #n ")" ::: "memory")
#define PG8_WAIT_L(n) asm volatile("s_waitcnt lgkmcnt(" #n ")" ::: "memory")
#define PG8_BAR __builtin_amdgcn_s_barrier()
#define PG8_SCHED __builtin_amdgcn_sched_barrier(0)
#define PG8_ZERO() do { _Pragma("unroll") for (int a = 0; a < 2; ++a) _Pragma("unroll") for (int b = 0; b < 2; ++b) _Pragma("unroll") for (int m = 0; m < 4; ++m) _Pragma("unroll") for (int n = 0; n < 2; ++n) acc[a][b][m][n] = (f32x4){0.f, 0.f, 0.f, 0.f}; } while (0)
    Unit cur, nxt; int ui = 0;
    if (!S.next(0, cur)) return;
    f32x4 acc[2][2][4][2];
    PG8_ZERO();
    bf16x8 At[4][2], B0[2][2], B1[2][2];
    const char* cA = (const char*)(cur.sub ? g.A1 : g.A0) + (size_t)cur.pm * tstep; const char* cB = (const char*)(cur.sub ? g.B1 : g.B0) + (size_t)cur.pn * tstep;
    PG8_STAGE(PG8_SB(0, 0), cB, voffB); PG8_STAGE(PG8_SB(0, 1), cB + hstep, voffB); PG8_STAGE(PG8_SA(0, 0), cA, voffA); PG8_STAGE(PG8_SA(0, 1), cA + hstep, voffA);
    if (wr == 1) PG8_BAR;
    PG8_WAIT_V(2); PG8_BAR;
    PG8_STAGE(PG8_SB(1, 0), cB + kstep, voffB); PG8_STAGE(PG8_SA(1, 0), cA + kstep, voffA); PG8_STAGE(PG8_SB(1, 1), cB + hstep + kstep, voffB);
    PG8_WAIT_V(6); PG8_BAR;
    for (;;) {
        const bool has_next = S.next(ui + 1, nxt);
        const char* nA = has_next ? (const char*)(nxt.sub ? g.A1 : g.A0) + (size_t)nxt.pm * tstep : cA; const char* nB = has_next ? (const char*)(nxt.sub ? g.B1 : g.B0) + (size_t)nxt.pn * tstep : cB;
        for (int t = 0; t < nt; t += 2) {
            const bool last = (t == nt - 2);
            const char* a1 = cA + (size_t)(t + 1) * kstep;
            const char* a2 = last ? nA : cA + (size_t)(t + 2) * kstep; const char* b2 = last ? nB : cB + (size_t)(t + 2) * kstep;
            const char* a3 = a2 + kstep; const char* b3 = b2 + kstep;
            PG8_LDB(B0, 0, 0); PG8_LDB(B1, 0, 1); PG8_SCHED; PG8_LDA(At, 0, 0); PG8_STAGE(PG8_SA(1, 1), a1 + hstep, voffA);
            PG8_WAIT_V(8); PG8_WAIT_L(0); PG8_BAR; PG8_MMA(0, 0, At, B0); PG8_MMA(0, 1, At, B1); PG8_BAR; PG8_SCHED;
            PG8_LDA(At, 0, 1); PG8_STAGE(PG8_SB(0, 0), b2, voffB); PG8_STAGE(PG8_SB(0, 1), b2 + hstep, voffB); PG8_STAGE(PG8_SA(0, 0), a2, voffA);
            PG8_WAIT_V(8); PG8_WAIT_L(0); PG8_BAR; PG8_MMA(1, 0, At, B0); PG8_MMA(1, 1, At, B1); PG8_BAR; PG8_SCHED;
            PG8_LDB(B0, 1, 0); PG8_LDB(B1, 1, 1); PG8_SCHED; PG8_LDA(At, 1, 0); PG8_STAGE(PG8_SA(0, 1), a2 + hstep, voffA);
            PG8_WAIT_V(8); PG8_WAIT_L(0); PG8_BAR; PG8_MMA(0, 0, At, B0); PG8_MMA(0, 1, At, B1); PG8_BAR; PG8_SCHED;
            PG8_LDA(At, 1, 1); PG8_STAGE(PG8_SB(1, 0), b3, voffB); PG8_STAGE(PG8_SB(1, 1), b3 + hstep, voffB); PG8_STAGE(PG8_SA(1, 0), a3, voffA);
            PG8_WAIT_V(8); PG8_WAIT_L(0); PG8_BAR; PG8_MMA(1, 0, At, B0); PG8_MMA(1, 1, At, B1); PG8_BAR; PG8_SCHED;
        }
        if (wr == 0) PG8_BAR;
        bool keep = false;
        if constexpr (Epi::KEEP) { if (cur.sub == 0) { E.mid(acc, cur, wr, wc, fr, fq); keep = true; } else E(acc, cur, wr, wc, fr, fq); }
        else E(acc, cur, wr, wc, fr, fq);
        if (!has_next) break;
        if (!keep) PG8_ZERO();
        cur = nxt; cA = nA; cB = nB; ++ui;
        if (wr == 1) PG8_BAR;
    }
    PG8_WAIT_V(0);
    PG8_BAR;
#undef PG8_SA
#undef PG8_SB
#undef PG8_STAGE
#undef PG8_LDA
#undef PG8_LDB
#undef PG8_MMA
#undef PG8_WAIT_V
#undef PG8_WAIT_L
#undef PG8_BAR
#undef PG8_SCHED
#undef PG8_ZERO
}
}

typedef f32x4 AccT[2][2][4][2];
__device__ __forceinline__ int cond_of_row(int row) { return row < MPR ? (row >> 11) : (NB + row - MPR); }

struct EpiAda {
    static constexpr bool KEEP = false;
    float* ada; const float* bias;
    __device__ __forceinline__ void operator()(const AccT& acc, const pg8::Unit& u, int wr, int wc, int fr, int fq) const {
#pragma unroll
        for (int ai = 0; ai < 2; ++ai)
#pragma unroll
            for (int m = 0; m < 4; ++m) { const int row = u.pm * 256 + ai * 128 + wr * 64 + m * 16 + fr; if (row >= NCOND) continue;
#pragma unroll
                for (int bj = 0; bj < 2; ++bj)
#pragma unroll
                    for (int n = 0; n < 2; ++n) { const int col = u.pn * 256 + bj * 128 + wc * 32 + 8 * fq + 4 * n;
                        *(f32x4*)(ada + (size_t)row * NADA + col) = acc[ai][bj][m][n] + *(const f32x4*)(bias + col); } }
    }
};
struct EpiSwiglu {
    static constexpr bool KEEP = false;
    bf16* act;
    __device__ __forceinline__ void operator()(const AccT& acc, const pg8::Unit& u, int wr, int wc, int fr, int fq) const {
#pragma unroll
        for (int ai = 0; ai < 2; ++ai)
#pragma unroll
            for (int m = 0; m < 4; ++m) { const int row = u.pm * 256 + ai * 128 + wr * 64 + m * 16 + fr; if (row >= M) continue;
                const f32x4 g0 = acc[ai][0][m][0], g1 = acc[ai][0][m][1], v0 = acc[ai][1][m][0], v1 = acc[ai][1][m][1];
                u32x4 w; w.x = pk2(silu_f(g0[0]) * v0[0], silu_f(g0[1]) * v0[1]); w.y = pk2(silu_f(g0[2]) * v0[2], silu_f(g0[3]) * v0[3]);
                w.z = pk2(silu_f(g1[0]) * v1[0], silu_f(g1[1]) * v1[1]); w.w = pk2(silu_f(g1[2]) * v1[2], silu_f(g1[3]) * v1[3]);
                *(u32x4*)(act + (size_t)row * FF + u.pn * 128 + wc * 32 + 8 * fq) = w; }
    }
};
struct EpiResid {
    static constexpr bool KEEP = false;
    float* X; const float* xp; const float* xs; const float* gate; float coef;
    __device__ __forceinline__ void operator()(const AccT& acc, const pg8::Unit& u, int wr, int wc, int fr, int fq) const {
#pragma unroll
        for (int ai = 0; ai < 2; ++ai)
#pragma unroll
            for (int m = 0; m < 4; ++m) { const int row = u.pm * 256 + ai * 128 + wr * 64 + m * 16 + fr; if (row >= M) continue;
                const float* xin = xp ? (row < MPR ? xp + (size_t)row * D : xs + (size_t)(row - MPR) * D) : X + (size_t)row * D;
                const float* gt = gate + (size_t)cond_of_row(row) * NADA;
#pragma unroll
                for (int bj = 0; bj < 2; ++bj)
#pragma unroll
                    for (int n = 0; n < 2; ++n) { const int col = u.pn * 256 + bj * 128 + wc * 32 + 8 * fq + 4 * n;
                        const f32x4 xv = *(const f32x4*)(xin + col), gv = *(const f32x4*)(gt + col);
                        *(f32x4*)(X + (size_t)row * D + col) = xv + (gv * coef) * acc[ai][bj][m][n]; } }
    }
};
constexpr size_t WS_CNT = 14336, WS_PART = 65536;
template <int MODE> struct EpiResidNorm {
    static constexpr bool KEEP = false;
    float* X; const float* xp; const float* gate; float coef; const float* gvec; const float* shift; bf16* Hout; float* part; unsigned* cnt; LAS float* sred;
    __device__ __forceinline__ void operator()(AccT& acc, const pg8::Unit& u, int wr, int wc, int fr_, int fq_) const {
        const int fr = opq(fr_), fq = opq(fq_);
        const int tid = wr * 256 + wc * 64 + fq * 16 + fr, bidx = u.pm >> 3;
        const float* gt = gate + (size_t)bidx * NADA;
        float ss[2][4]; int zoff = 0;
#pragma unroll
        for (int ai = 0; ai < 2; ++ai)
#pragma unroll
            for (int m = 0; m < 4; ++m) { const int row = u.pm * 256 + ai * 128 + wr * 64 + m * 16 + fr + zoff;
                const float* xin = xp ? xp + (size_t)row * D : X + (size_t)row * D; float sacc = 0.f;
#pragma unroll
                for (int bj = 0; bj < 2; ++bj)
#pragma unroll
                    for (int n = 0; n < 2; ++n) { const int col = u.pn * 256 + bj * 128 + wc * 32 + 8 * fq + 4 * n;
                        const f32x4 xv = *(const f32x4*)(xin + col), gv = *(const f32x4*)(gt + col);
                        const f32x4 xn = xv + (gv * coef) * acc[ai][bj][m][n]; acc[ai][bj][m][n] = xn;
                        if (MODE == 0) *(f32x4*)(X + (size_t)row * D + col) = xn;
                        sacc += (xn[0] * xn[0] + xn[1] * xn[1]) + (xn[2] * xn[2] + xn[3] * xn[3]); }
                asm volatile("" : "+v"(zoff) : "v"(sacc));
                sacc += shfl_xor_l(sacc, 16); sacc += shfl_xor_l(sacc, 32);
                ss[ai][m] = sacc; __builtin_amdgcn_sched_barrier(0); }
        if (fq == 0) {
#pragma unroll
            for (int ai = 0; ai < 2; ++ai)
#pragma unroll
                for (int m = 0; m < 4; ++m) sred[wc * 256 + ai * 128 + wr * 64 + m * 16 + fr] = ss[ai][m]; }
        __syncthreads();
        if (tid < 256) __hip_atomic_store((unsigned*)part + ((size_t)u.pm * 4 + u.pn) * 256 + tid, __builtin_bit_cast(unsigned, (sred[tid] + sred[256 + tid]) + (sred[512 + tid] + sred[768 + tid])), __ATOMIC_RELAXED, __HIP_MEMORY_SCOPE_AGENT);
        asm volatile("s_waitcnt vmcnt(0)" ::: "memory");
        __syncthreads();
        if (tid == 0) { __hip_atomic_fetch_add(cnt + u.pm, 1u, __ATOMIC_RELAXED, __HIP_MEMORY_SCOPE_AGENT);
            unsigned sp = 0; while (__hip_atomic_load(cnt + u.pm, __ATOMIC_RELAXED, __HIP_MEMORY_SCOPE_AGENT) < 4u && ++sp < (1u << 24)) __builtin_amdgcn_s_sleep(1); }
        __syncthreads();
        if (tid < 256) { unsigned* pp = (unsigned*)part + (size_t)u.pm * 4 * 256 + tid;
            const float p0 = __builtin_bit_cast(float, __hip_atomic_load(pp, __ATOMIC_RELAXED, __HIP_MEMORY_SCOPE_AGENT)), p1 = __builtin_bit_cast(float, __hip_atomic_load(pp + 256, __ATOMIC_RELAXED, __HIP_MEMORY_SCOPE_AGENT));
            const float p2 = __builtin_bit_cast(float, __hip_atomic_load(pp + 512, __ATOMIC_RELAXED, __HIP_MEMORY_SCOPE_AGENT)), p3 = __builtin_bit_cast(float, __hip_atomic_load(pp + 768, __ATOMIC_RELAXED, __HIP_MEMORY_SCOPE_AGENT));
            sred[1024 + tid] = rsq_f(((p0 + p1) + (p2 + p3)) * (1.f / D) + EPS); }
        __syncthreads();
        const float* sh = MODE == 0 ? shift + (size_t)bidx * NADA : nullptr;
#pragma unroll
        for (int bj = 0; bj < 2; ++bj) { const int col = u.pn * 256 + bj * 128 + wc * 32 + 8 * fq;
            const f32x4 g0 = *(const f32x4*)(gvec + col), g1 = *(const f32x4*)(gvec + col + 4);
            f32x4 a0 = g0, a1 = g1, b0 = {0.f, 0.f, 0.f, 0.f}, b1 = b0;
            if (MODE == 0) { a0 = g0 * (*(const f32x4*)(sh + D + col) + 1.f); a1 = g1 * (*(const f32x4*)(sh + D + col + 4) + 1.f); b0 = *(const f32x4*)(sh + col); b1 = *(const f32x4*)(sh + col + 4); }
#pragma unroll
            for (int ai = 0; ai < 2; ++ai)
#pragma unroll
                for (int m = 0; m < 4; ++m) { const int rl = ai * 128 + wr * 64 + m * 16 + fr; const size_t row = (size_t)u.pm * 256 + rl; const float rstd = sred[1024 + rl];
                    const f32x4 y0 = acc[ai][bj][m][0] * rstd * a0 + b0, y1 = acc[ai][bj][m][1] * rstd * a1 + b1;
                    if (MODE == 0) *(bf16x8*)(Hout + row * D + col) = pack8(y0[0], y0[1], y0[2], y0[3], y1[0], y1[1], y1[2], y1[3]);
                    else { *(f32x4*)(X + row * D + col) = y0; *(f32x4*)(X + row * D + col + 4) = y1; }
                    __builtin_amdgcn_sched_barrier(0); }
        }
        __syncthreads();
    }
};
struct EpiIn {
    static constexpr bool KEEP = false;
    bf16* z; bf16* mg; float* abl; float* out;
    __device__ __forceinline__ void operator()(const AccT& acc, const pg8::Unit& u, int wr, int wc, int fr, int fq) const {
        const int bi = u.pn >> 2;
        if (bi == 8) {
            if (wc == 0 && fq < 2) {
#pragma unroll
                for (int ai = 0; ai < 2; ++ai)
#pragma unroll
                    for (int m = 0; m < 4; ++m) { const int row = u.pm * 256 + ai * 128 + wr * 64 + m * 16 + fr; if (row >= M) continue;
                        *(f32x4*)(abl + (size_t)row * 16 + 8 * fq) = acc[ai][0][m][0]; *(f32x4*)(abl + (size_t)row * 16 + 8 * fq + 4) = acc[ai][0][m][1]; }
            }
            return;
        }
        bf16* base = bi < 6 ? z + (size_t)bi * (ZB / 2) : mg + (size_t)(bi - 6) * (ZB / 2);
        const int act = (bi == 1) ? 1 : (bi == 5) ? 2 : (bi >= 6) ? 3 : 0;
        const int colt = (u.pn & 3) * 256 + wc * 32 + 8 * fq;
#pragma unroll
        for (int ai = 0; ai < 2; ++ai)
#pragma unroll
            for (int m = 0; m < 4; ++m) { const int row = u.pm * 256 + ai * 128 + wr * 64 + m * 16 + fr; if (row >= M) continue;
#pragma unroll
                for (int bj = 0; bj < 2; ++bj) { f32x4 v0 = acc[ai][bj][m][0], v1 = acc[ai][bj][m][1];
                    if (act == 1) {
#pragma unroll
                        for (int j = 0; j < 4; ++j) { v0[j] = gelu_tanh_f(v0[j]); v1[j] = gelu_tanh_f(v1[j]); } }
                    else if (act == 2) {
#pragma unroll
                        for (int j = 0; j < 4; ++j) { v0[j] = silu_f(v0[j]); v1[j] = silu_f(v1[j]); } }
                    else if (act == 3) {
#pragma unroll
                        for (int j = 0; j < 4; ++j) { v0[j] = sigmoid_f(v0[j]); v1[j] = sigmoid_f(v1[j]); } }
                    u32x4 w; w.x = pk2(v0[0], v0[1]); w.y = pk2(v0[2], v0[3]); w.z = pk2(v1[0], v1[1]); w.w = pk2(v1[2], v1[3]);
                    if (bi >= 6) __builtin_nontemporal_store(w, (u32x4*)(base + (size_t)row * D + colt + bj * 128));
                    else *(u32x4*)(base + (size_t)row * D + colt + bj * 128) = w;
                    if (act == 0 && row < MPR) { const int rs = row & (SEQ - 1), r64 = row & 63, bb = row >> 11, col = colt + bj * 128;
                        if (bi >= 3 && r64 >= 61 && rs < SEQ - 3)
                            *(u32x4*)((bf16*)((unsigned char*)out + (bi == 3 ? OSB_HK : OSB_HV)) + ((size_t)(bb * 32 + (rs >> 6) + 1) * 3 + (r64 - 61)) * D + col) = w;
                        if (rs >= SEQ - 3) { float* dst = bi == 0 ? out + O_CRP + ((size_t)bb * 3 + (rs - (SEQ - 3))) * D + col : out + O_CQP + ((size_t)bb * 3 + (rs - (SEQ - 3))) * 3072 + (bi - 2) * 1024 + col;
                            *(f32x4*)dst = v0; *(f32x4*)(dst + 4) = v1; } }
                } }
    }
};
struct EpiBranch {
    static constexpr bool KEEP = true;
    const bf16* mga; const bf16* mgb; bf16* G;
    __device__ __forceinline__ void mid(AccT& acc, const pg8::Unit& u, int wr, int wc, int fr, int fq) const {
#pragma unroll
        for (int ai = 0; ai < 2; ++ai)
#pragma unroll
            for (int m = 0; m < 4; ++m) { int row = u.pm * 256 + ai * 128 + wr * 64 + m * 16 + fr; if (row >= M) row = M - 1;
#pragma unroll
                for (int bj = 0; bj < 2; ++bj) { const size_t o = (size_t)row * D + u.pn * 256 + bj * 128 + wc * 32 + 8 * fq;
                    const u32x4 a = *(const u32x4*)(mga + o), b = *(const u32x4*)(mgb + o);
                    f32x4 r0, r1;
                    r0[0] = bflo(a.x) * rcp_f(bflo(b.x)); r0[1] = bfhi(a.x) * rcp_f(bfhi(b.x)); r0[2] = bflo(a.y) * rcp_f(bflo(b.y)); r0[3] = bfhi(a.y) * rcp_f(bfhi(b.y));
                    r1[0] = bflo(a.z) * rcp_f(bflo(b.z)); r1[1] = bfhi(a.z) * rcp_f(bfhi(b.z)); r1[2] = bflo(a.w) * rcp_f(bflo(b.w)); r1[3] = bfhi(a.w) * rcp_f(bfhi(b.w));
                    acc[ai][bj][m][0] = acc[ai][bj][m][0] * r0; acc[ai][bj][m][1] = acc[ai][bj][m][1] * r1; } }
    }
    __device__ __forceinline__ void operator()(const AccT& acc, const pg8::Unit& u, int wr, int wc, int fr, int fq) const {
#pragma unroll
        for (int ai = 0; ai < 2; ++ai)
#pragma unroll
            for (int m = 0; m < 4; ++m) { const int row = u.pm * 256 + ai * 128 + wr * 64 + m * 16 + fr; if (row >= M) continue;
#pragma unroll
                for (int bj = 0; bj < 2; ++bj) { const size_t o = (size_t)row * D + u.pn * 256 + bj * 128 + wc * 32 + 8 * fq;
                    const u32x4 b = *(const u32x4*)(mgb + o);
                    const f32x4 v0 = acc[ai][bj][m][0], v1 = acc[ai][bj][m][1];
                    u32x4 w; w.x = pk2(v0[0] * bflo(b.x), v0[1] * bfhi(b.x)); w.y = pk2(v0[2] * bflo(b.y), v0[3] * bfhi(b.y));
                    w.z = pk2(v1[0] * bflo(b.z), v1[1] * bfhi(b.z)); w.w = pk2(v1[2] * bflo(b.w), v1[3] * bfhi(b.w));
                    *(u32x4*)(G + o) = w; } }
    }
};

__device__ __forceinline__ f32x4 mini_partial(const bf16* A, const bf16* Bt, int K, int row0, int col0, int ks, int lane) {
    const int kq = K >> 2;
    const bf16* ap = A + (size_t)(MPR + row0 + (lane & 15)) * K + ks * kq + (lane >> 4) * 8;
    const bf16* bp = Bt + (size_t)(col0 + (lane & 15)) * K + ks * kq + (lane >> 4) * 8;
    f32x4 acc = {0.f, 0.f, 0.f, 0.f};
#pragma unroll 1
    for (int k0 = 0; k0 < kq; k0 += 256) {
        bf16x8 a[8], b[8];
#pragma unroll
        for (int i = 0; i < 8; ++i) if (k0 + 32 * i < kq) { a[i] = *(const bf16x8*)(ap + k0 + 32 * i); b[i] = *(const bf16x8*)(bp + k0 + 32 * i); }
#pragma unroll
        for (int i = 0; i < 8; ++i) if (k0 + 32 * i < kq) acc = __builtin_amdgcn_mfma_f32_16x16x32_bf16(b[i], a[i], acc, 0, 0, 0);
    }
    return acc;
}
template <class F>
__device__ __forceinline__ void mini_gemm(LAS unsigned char* lds, const bf16* A0, const bf16* B0, const bf16* A1, const bf16* B1, int K, int wg, int G, int tid_, const F& epi) {
    const int tid = opq(tid_), lane = tid & 63, wave = tid >> 6, ks = wave & 3;
    LAS f32x4* red = (LAS f32x4*)lds;
    for (int t0 = wg * 2; t0 < 512; t0 += G * 2) {
        const int tile = t0 + (wave >> 2), row0 = (tile >> 6) * 16, col0 = (tile & 63) * 16;
        f32x4 p0 = mini_partial(A0, B0, K, row0, col0, ks, lane), p1 = {0.f, 0.f, 0.f, 0.f};
        if (A1) p1 = mini_partial(A1, B1, K, row0, col0, ks, lane);
        red[(wave * 2) * 64 + lane] = p0; red[(wave * 2 + 1) * 64 + lane] = p1;
        __syncthreads();
        if (ks == 0) {
#pragma unroll
            for (int w = 1; w < 4; ++w) { p0 = p0 + red[((wave + w) * 2) * 64 + lane]; p1 = p1 + red[((wave + w) * 2 + 1) * 64 + lane]; }
            epi(MPR + row0 + (lane & 15), col0 + 4 * (lane >> 4), p0, p1);
        }
        __syncthreads();
    }
}

struct Params { const float* in[32]; float* out; unsigned char* ws; };
constexpr int LDS_BYTES = 147456;
#ifndef PHM
#define PHM 0xFFFF
#endif
#ifndef P7M
#define P7M 0xF
#endif

struct Ctx {
    const float* const* in; float* out; unsigned char* ws; LAS unsigned char* lds;
    int tid, lane, wave, wg, G;
};
#define KAS __attribute__((address_space(4)))
typedef const float* cfptr_t; typedef float* fptr_t; typedef unsigned char* ucptr_t;
__device__ __forceinline__ const float* karg_in(int k) { return *(volatile KAS cfptr_t*)((const KAS char*)__builtin_amdgcn_kernarg_segment_ptr() + 8 * k); }
__device__ __forceinline__ float* karg_out() { return *(volatile KAS fptr_t*)((const KAS char*)__builtin_amdgcn_kernarg_segment_ptr() + 256); }
__device__ __forceinline__ unsigned char* karg_ws() { return *(volatile KAS ucptr_t*)((const KAS char*)__builtin_amdgcn_kernarg_segment_ptr() + 264); }
#define INP(k) karg_in(k)

template <int MODE>
__device__ __forceinline__ void sample_norm_rows(const float* gvec, int ish, int gw, int lane) {
    if (gw >= NS) return;
    const int row = MPR + gw; float* X = karg_out() + (size_t)row * D;
    f32x4 v[4]; float s = 0.f;
#pragma unroll
    for (int j = 0; j < 4; ++j) { v[j] = *(const f32x4*)(X + 4 * (lane + 64 * j)); s += (v[j][0] * v[j][0] + v[j][1] * v[j][1]) + (v[j][2] * v[j][2] + v[j][3] * v[j][3]); }
    const float rstd = rsq_f(wave_sum(s) * (1.f / D) + EPS);
    const float* sh = (const float*)(karg_ws() + WS_ADA) + (size_t)cond_of_row(row) * NADA + ish * D;
#pragma unroll
    for (int j = 0; j < 4; ++j) { const int col = 4 * (lane + 64 * j); const f32x4 g = *(const f32x4*)(gvec + col);
        if (MODE == 0) { const f32x4 y = (v[j] * rstd * g) * (*(const f32x4*)(sh + D + col) + 1.f) + *(const f32x4*)(sh + col);
            u32x2 o; o.x = pk2(y[0], y[1]); o.y = pk2(y[2], y[3]); *(u32x2*)((bf16*)(karg_ws() + WS_H) + (size_t)row * D + col) = o; }
        else *(f32x4*)(X + col) = v[j] * rstd * g; }
}
__device__ __forceinline__ void transpose_item(const float* W, int ldw, int k0, int n0, int nvalid, bf16* WT, int ldt, int drow0, LAS float* scr, int lane) {
    const int cc = lane & 31;
#pragma unroll 8
    for (int i = 0; i < 32; ++i) { const int kk = 2 * i + (lane >> 5); scr[kk * 33 + cc] = (cc < nvalid) ? __builtin_nontemporal_load(W + (size_t)(k0 + kk) * ldw + n0 + cc) : 0.f; }
    LDS_WAIT(); asm volatile("" ::: "memory");
    const int c = lane & 7;
#pragma unroll
    for (int j = 0; j < 4; ++j) { const int n = (lane >> 3) + 8 * j; const LAS float* s = scr + (8 * c) * 33 + n;
        u32x4 o; o.x = pk2(s[0 * 33], s[1 * 33]); o.y = pk2(s[2 * 33], s[3 * 33]); o.z = pk2(s[4 * 33], s[5 * 33]); o.w = pk2(s[6 * 33], s[7 * 33]);
        if (n < nvalid) *(u32x4*)(WT + (size_t)(drow0 + n) * ldt + k0 + 8 * c) = o; }
    LDS_WAIT(); asm volatile("" ::: "memory");
}

template <int PART>
__device__ __forceinline__ void prologue(const Params& P, LAS unsigned char* lds, int gw, int NGW, int wave, int lane) {
    LAS float* scr = (LAS float*)(lds + wave * 16384);
    unsigned char* ws = karg_ws();
    constexpr int I_UP = 16 * 176, I_DN = 44 * 32, I_IN = 16 * 257, I_BR = 2 * 16 * 32, I_OUT = 16 * 32, I_ADA = 16 * 288, I_RG = 128;
    constexpr int NITEMS = 2 * I_UP + 2 * I_DN + I_IN + I_BR + I_OUT + I_ADA + I_RG;
    constexpr int I_FIRST = 2 * I_UP + 2 * I_DN + I_IN + I_BR + I_OUT;
    for (int it = gw; it < NITEMS; it += NGW) {
        int r = it;
        if (PART == 0) { if (r >= I_ADA) break; r += I_FIRST; } else { if (r >= NITEMS - I_ADA) break; if (r >= I_FIRST) r += I_ADA; }
        if (r < 2 * I_UP) { const int which = r / I_UP; r -= which * I_UP; const int kb = r / 176, nb = r % 176, n0 = nb * 32; const int half = n0 >= FF ? 1 : 0, np = n0 - half * FF;
            transpose_item(INP(which ? 29 : 11), 2 * FF, kb * 64, n0, 32, (bf16*)(ws + (which ? WS_WUP2 : WS_WUP1)), D, (np >> 7) * 256 + half * 128 + (np & 127), scr, lane); continue; }
        r -= 2 * I_UP;
        if (r < 2 * I_DN) { const int which = r / I_DN; r -= which * I_DN; const int kb = r / 32, nb = r % 32;
            transpose_item(INP(which ? 30 : 12), D, kb * 64, nb * 32, 32, (bf16*)(ws + (which ? WS_WDN2 : WS_WDN1)), FF, nb * 32, scr, lane); continue; }
        r -= 2 * I_DN;
        if (r < I_IN) { const int kb = r / 257, nb = r % 257; int n0, nv, dr;
            if (nb < 160) { n0 = nb * 32; nv = 32; dr = n0; } else if (nb == 160) { n0 = 5120; nv = 16; dr = 8192; } else { n0 = 5136 + (nb - 161) * 32; nv = 32; dr = 5120 + (nb - 161) * 32; }
            transpose_item(INP(14), 8208, kb * 64, n0, nv, (bf16*)(ws + WS_WIN), D, dr, scr, lane); continue; }
        r -= I_IN;
        if (r < I_BR) { const int which = r / 512; r -= which * 512; const int kb = r / 32, nb = r % 32;
            transpose_item(INP(26) + (size_t)which * D * D, D, kb * 64, nb * 32, 32, (bf16*)(ws + WS_WBR), D, which * D + nb * 32, scr, lane); continue; }
        r -= I_BR;
        if (r < I_OUT) { const int kb = r / 32, nb = r % 32; transpose_item(INP(27), D, kb * 64, nb * 32, 32, (bf16*)(ws + WS_WOUT), D, nb * 32, scr, lane); continue; }
        r -= I_OUT;
        if (r < I_ADA) { const int kb = r / 288, nb = r % 288; transpose_item(INP(8), NADA, kb * 64, nb * 32, 32, (bf16*)(ws + WS_WADA), D, nb * 32, scr, lane); continue; }
        r -= I_ADA;
        { const int gx = r >> 6, n = (r >> 3) & 7, kb = (r >> 2) & 1, nb = r & 3;
          transpose_item(INP(gx ? 19 : 17) + (size_t)n * 128 * 128, 128, kb * 64, nb * 32, 32, (bf16*)(ws + WS_WRG), 128, n * 256 + gx * 128 + nb * 32, scr, lane); }
    }
    bf16* cb = (bf16*)(ws + WS_CB);
    if (PART == 0) for (int row = gw; row < 256; row += NGW) {
        const float* src = row < NB ? INP(2) + (size_t)row * D : (row < NCOND ? INP(3) + (size_t)(row - NB) * D : nullptr);
#pragma unroll
        for (int j = 0; j < 4; ++j) { const int col = 4 * (lane + 64 * j); f32x4 v = src ? *(const f32x4*)(src + col) : (f32x4){0.f, 0.f, 0.f, 0.f};
            u32x2 o; o.x = pk2(v[0], v[1]); o.y = pk2(v[2], v[3]); *(u32x2*)(cb + (size_t)row * D + col) = o; }
    }
}

template <int MODE>
__device__ __forceinline__ void norm_mod_pass(const Params& P, const float* gvec, int ish, int gw, int NGW, int lane) {
    const float* ada = (const float*)(karg_ws() + WS_ADA); bf16* H = (bf16*)(karg_ws() + WS_H);
    const float* xp = INP(0); const float* xs = INP(1); const float* X = karg_out();
    for (int row0 = 2 * gw; row0 < M; row0 += 2 * NGW) {
        f32x4 v[2][4]; float s[2] = {0.f, 0.f};
#pragma unroll
        for (int u = 0; u < 2; ++u) { const int row = row0 + u;
            const float* xr = MODE == 0 ? (row < MPR ? xp + (size_t)row * D : xs + (size_t)(row - MPR) * D) : X + (size_t)row * D;
#pragma unroll
            for (int j = 0; j < 4; ++j) v[u][j] = *(const f32x4*)(xr + 4 * (lane + 64 * j)); }
#pragma unroll
        for (int u = 0; u < 2; ++u)
#pragma unroll
            for (int j = 0; j < 4; ++j) s[u] += (v[u][j][0] * v[u][j][0] + v[u][j][1] * v[u][j][1]) + (v[u][j][2] * v[u][j][2] + v[u][j][3] * v[u][j][3]);
        s[0] = wave_sum(s[0]); s[1] = wave_sum(s[1]);
#pragma unroll
        for (int u = 0; u < 2; ++u) { const int row = row0 + u; const float rstd = rsq_f(s[u] * (1.f / D) + EPS);
            const float* sh = ada + (size_t)cond_of_row(row) * NADA + ish * D; const float* sc = sh + D;
#pragma unroll
            for (int j = 0; j < 4; ++j) { const int col = 4 * (lane + 64 * j); const f32x4 g = *(const f32x4*)(gvec + col), a = *(const f32x4*)(sc + col), bb = *(const f32x4*)(sh + col);
                const f32x4 y = (v[u][j] * rstd * g) * (a + 1.f) + bb; u32x2 o; o.x = pk2(y[0], y[1]); o.y = pk2(y[2], y[3]); *(u32x2*)(H + (size_t)row * D + col) = o; } }
    }
}
__device__ __forceinline__ void final_norm_pass(const Params& P, int gw, int NGW, int lane) {
    const float* gvec = INP(31); float* X = karg_out();
    for (int row0 = 2 * gw; row0 < M; row0 += 2 * NGW) {
        f32x4 v[2][4]; float s[2] = {0.f, 0.f};
#pragma unroll
        for (int u = 0; u < 2; ++u)
#pragma unroll
            for (int j = 0; j < 4; ++j) v[u][j] = *(const f32x4*)(X + (size_t)(row0 + u) * D + 4 * (lane + 64 * j));
#pragma unroll
        for (int u = 0; u < 2; ++u)
#pragma unroll
            for (int j = 0; j < 4; ++j) s[u] += (v[u][j][0] * v[u][j][0] + v[u][j][1] * v[u][j][1]) + (v[u][j][2] * v[u][j][2] + v[u][j][3] * v[u][j][3]);
        s[0] = wave_sum(s[0]); s[1] = wave_sum(s[1]);
#pragma unroll
        for (int u = 0; u < 2; ++u) { const float rstd = rsq_f(s[u] * (1.f / D) + EPS);
#pragma unroll
            for (int j = 0; j < 4; ++j) { const int col = 4 * (lane + 64 * j); *(f32x4*)(X + (size_t)(row0 + u) * D + col) = v[u][j] * rstd * *(const f32x4*)(gvec + col); } }
    }
}
__device__ __forceinline__ void onorm_pass(const Params& P, int gw, int NGW, int lane) {
    const bf16* O = (const bf16*)(karg_ws() + WS_H); bf16* ZG = (bf16*)(karg_ws() + WS_Z + 5 * ZB); const float* dn = INP(25);
    const int dc = (lane & 7) * 16;
    for (int row0 = 2 * gw; row0 < M; row0 += 2 * NGW) {
        u32x4 a[2][2], z[2][2];
#pragma unroll
        for (int u = 0; u < 2; ++u) { const size_t o = (size_t)(row0 + u) * D + lane * 16;
            a[u][0] = *(const u32x4*)(O + o); a[u][1] = *(const u32x4*)(O + o + 8); z[u][0] = *(const u32x4*)(ZG + o); z[u][1] = *(const u32x4*)(ZG + o + 8); }
#pragma unroll
        for (int u = 0; u < 2; ++u) { const size_t o = (size_t)(row0 + u) * D + lane * 16;
            float v[16], zz[16]; unpack8(a[u][0], v); unpack8(a[u][1], v + 8); unpack8(z[u][0], zz); unpack8(z[u][1], zz + 8);
            float s = 0.f;
#pragma unroll
            for (int e = 0; e < 16; ++e) s += v[e] * v[e];
            s = red8(s);
            const float rstd = rsq_f(s * (1.f / 128.f) + EPS);
#pragma unroll
            for (int e = 0; e < 16; ++e) v[e] = v[e] * rstd * dn[dc + e] * zz[e];
            *(bf16x8*)(ZG + o) = pack8(v[0], v[1], v[2], v[3], v[4], v[5], v[6], v[7]); *(bf16x8*)(ZG + o + 8) = pack8(v[8], v[9], v[10], v[11], v[12], v[13], v[14], v[15]); }
    }
}

constexpr int SS_TAIL = 530;
constexpr int RG_SPLIT = 7;
constexpr size_t WS_HCARRY = 917504;
__device__ __forceinline__ void rglru_task(const Params& P, LAS unsigned char* lds, int b, int n, int qd, int tid, int t0, int t1) {
    const int lane = tid & 63, wave = tid >> 6;
    LAS bf16* xcA = (LAS bf16*)lds;
    LAS float* xcf = (LAS float*)(lds + 34816);
    LAS float* rb = (LAS float*)(lds + 51200);
    LAS float* ib = (LAS float*)(lds + 67584);
    LAS float* segA = (LAS float*)(lds + 83968);
    LAS float* segB = (LAS float*)(lds + 86016);
    LAS float* hc = (LAS float*)(lds + 88064);
    LAS float* cw = (LAS float*)(lds + 88192);
    LAS bf16* rawt = (LAS bf16*)(lds + 90752);
    bf16* XR = (bf16*)(karg_ws() + WS_Z); bf16* GR = (bf16*)(karg_ws() + WS_Z + ZB);
    const bf16* WRG = (const bf16*)(karg_ws() + WS_WRG);
    const int cb0 = n * 128, oc0 = cb0 + qd * 32;
    const bool prompt = b >= 0;
    for (int i = tid; i < 640; i += NTHR) cw[i] = i < 512 ? INP(15)[(size_t)(i >> 7) * D + cb0 + (i & 127)] : INP(16)[cb0 + (i - 512)];
    if (tid < 32) hc[tid] = t0 > 0 ? ((const float*)(karg_ws() + WS_HCARRY))[(size_t)b * D + oc0 + tid] : 0.f;
    const int tb = wave & 3, cbk = wave >> 2;
    bf16x8 Bf[8];
    { const bf16* wrow = WRG + (size_t)(n * 256 + cbk * 128 + qd * 32 + (lane & 31)) * 128 + (lane >> 5) * 8;
#pragma unroll
      for (int ks = 0; ks < 8; ++ks) Bf[ks] = *(const bf16x8*)(wrow + ks * 16); }
    const float gbias = INP(cbk ? 20 : 18)[oc0 + (lane & 31)];
    const int ch = tid & 31, seg = tid >> 5;
    const float sp = softplus_f(-INP(21)[oc0 + ch]);
    float hlast = 0.f;
    u32x4 pre[5];
#define RG_RAW_LOAD(tile_) do { _Pragma("unroll") for (int i = 0; i < 5; ++i) { const int q = tid + 512 * i, row = q >> 4, c16 = q & 15, tl = (tile_) * 128 - 3 + row; \
        pre[i] = (q < 131 * 16 && tl >= 0) ? *(const u32x4*)(XR + ((size_t)b * SEQ + tl) * D + cb0 + c16 * 8) : (u32x4){0u, 0u, 0u, 0u}; } } while (0)
#define RG_RAW_STORE() do { _Pragma("unroll") for (int i = 0; i < 5; ++i) { const int q = tid + 512 * i; if (q < 131 * 16) *(LAS u32x4*)(rawt + (q >> 4) * 136 + (q & 15) * 8) = pre[i]; } } while (0)
    if (prompt) { RG_RAW_LOAD(t0); RG_RAW_STORE(); }
    __syncthreads();
    const int ntiles = t1;
    for (int tile = t0; tile < ntiles; ++tile) {
        const int row0 = prompt ? b * SEQ + tile * 128 : MPR;
        if (prompt && tile + 1 < ntiles) RG_RAW_LOAD(tile + 1);
        { const int t = tid >> 2, cq = tid & 3, c0 = cq * 32;
#pragma unroll 2
          for (int q = 0; q < 4; ++q) {
              const int cc = c0 + q * 8;
              float a[8];
#pragma unroll
              for (int e = 0; e < 8; ++e) a[e] = cw[512 + cc + e];
#pragma unroll
              for (int j = 0; j < 4; ++j) {
                  if (prompt || j == 3) {
                      {
                          const u32x4 u = prompt ? *(const LAS u32x4*)(rawt + (t + j) * 136 + cc) : *(const u32x4*)(XR + (size_t)(MPR + t) * D + cb0 + cc);
                          const float x8[8] = {bflo(u.x), bfhi(u.x), bflo(u.y), bfhi(u.y), bflo(u.z), bfhi(u.z), bflo(u.w), bfhi(u.w)};
#pragma unroll
                          for (int e = 0; e < 8; ++e) a[e] += x8[e] * cw[j * 128 + cc + e];
                      }
                  } else {
                      const float* p = INP(5) + ((size_t)t * 3 + j) * D + cb0 + cc;
                      const f32x4 u0 = *(const f32x4*)p, u1 = *(const f32x4*)(p + 4);
#pragma unroll
                      for (int e = 0; e < 4; ++e) { a[e] += u0[e] * cw[j * 128 + cc + e]; a[4 + e] += u1[e] * cw[j * 128 + cc + 4 + e]; }
                  }
              }
              u32x4 w; w.x = pk2(a[0], a[1]); w.y = pk2(a[2], a[3]); w.z = pk2(a[4], a[5]); w.w = pk2(a[6], a[7]);
              *(LAS u32x4*)(xcA + t * 136 + cc) = w;
              if (cq == qd) { *(LAS f32x4*)(xcf + t * 32 + q * 8) = (f32x4){a[0], a[1], a[2], a[3]}; *(LAS f32x4*)(xcf + t * 32 + q * 8 + 4) = (f32x4){a[4], a[5], a[6], a[7]}; }
          }
        }
        __syncthreads();
        { f32x16 c;
#pragma unroll
          for (int r = 0; r < 16; ++r) c[r] = 0.f;
          const LAS bf16* ap = xcA + (tb * 32 + (lane & 31)) * 136 + (lane >> 5) * 8;
#pragma unroll
          for (int ks = 0; ks < 8; ++ks) { const bf16x8 af = *(const LAS bf16x8*)(ap + ks * 16); c = __builtin_amdgcn_mfma_f32_32x32x16_bf16(af, Bf[ks], c, 0, 0, 0); }
          LAS float* dst = cbk ? ib : rb;
#pragma unroll
          for (int r = 0; r < 16; ++r) { const int tok = tb * 32 + (r & 3) + 8 * (r >> 2) + 4 * (lane >> 5); dst[tok * 32 + (lane & 31)] = sigmoid_f(c[r] + gbias); }
        }
        __syncthreads();
        float Aacc = 1.f, h = 0.f;
#pragma unroll 4
        for (int e = 0; e < 8; ++e) { const int t = seg * 8 + e;
            const float r = rb[t * 32 + ch], ig = ib[t * 32 + ch], x = xcf[t * 32 + ch];
            const float la = -8.f * r * sp; const float a = __expf(la);
            const float x2 = 2.f * la, ser = -x2 * (1.f + x2 * (0.5f + x2 * (0.16666667f + x2 * (0.041666668f + x2 * (0.0083333338f + x2 * 0.0013888889f)))));
            float mult = __builtin_amdgcn_sqrtf(x2 > -0.3f ? ser : 1.f - a * a);
            if (prompt && tile == 0 && t == 0) mult = 1.f;
            const float bt = mult * ig * x;
            rb[t * 32 + ch] = a; ib[t * 32 + ch] = bt;
            h = a * h + bt; Aacc *= a;
        }
        float hin = 0.f;
        if (prompt) {
            segA[seg * 32 + ch] = Aacc; segB[seg * 32 + ch] = h;
            __syncthreads();
            hin = hc[ch];
            float sa[15], sb[15];
#pragma unroll
            for (int s = 0; s < 15; ++s) { sa[s] = segA[s * 32 + ch]; sb[s] = segB[s * 32 + ch]; }
#pragma unroll
            for (int s = 0; s < 15; ++s) hin = s < seg ? sa[s] * hin + sb[s] : hin;
        }
        h = hin;
        { float gr[8], h0v[8];
#pragma unroll
          for (int e = 0; e < 8; ++e) { const int t = seg * 8 + e; gr[e] = bf2f(GR[(size_t)(row0 + t) * D + oc0 + ch]); h0v[e] = prompt ? 0.f : INP(4)[(size_t)t * D + oc0 + ch]; }
#pragma unroll
          for (int e = 0; e < 8; ++e) { const int t = seg * 8 + e;
              const float a = rb[t * 32 + ch], bt = ib[t * 32 + ch];
              if (prompt) h = a * h + bt; else h = a * h0v[e] + bt;
              GR[(size_t)(row0 + t) * D + oc0 + ch] = (bf16)f2bf(h * gr[e]);
              if (!prompt) { karg_out()[O_HS + (size_t)t * D + oc0 + ch] = h;
                  const float* cs = INP(5) + (size_t)t * 3 * D + oc0 + ch; float* co = karg_out() + O_CRS + (size_t)t * 3 * D + oc0 + ch;
                  co[0] = cs[D]; co[D] = cs[2 * D]; co[2 * D] = bf2f(XR[(size_t)(MPR + t) * D + oc0 + ch]); }
          } }
        hlast = h;
        if (prompt && tile + 1 < ntiles) RG_RAW_STORE();
        __syncthreads();
        if (prompt && seg == 15) hc[ch] = hlast;
    }
    if (prompt && seg == 15) { if (t1 == 16) karg_out()[O_HP + (size_t)b * D + oc0 + ch] = hlast; else ((float*)(karg_ws() + WS_HCARRY))[(size_t)b * D + oc0 + ch] = hlast; }
    __syncthreads();
}

constexpr size_t WS_TINV = WS_WIN, WS_ATT = WS_WIN + 8 * MiB, WS_GC = WS_CB, WS_BETA = 47 * MiB + 65536;
static_assert(WS_ABL + (size_t)M * 16 * 4 <= WS_BETA && WS_BETA + 64 * 2048 * 4 <= WS_H, "ws map (beta)");
__device__ __forceinline__ int perm16(int e) { return (e & ~12) | ((e >> 1) & 4) | ((e << 1) & 8); }

__device__ __forceinline__ void conv8(const bf16* p, int tl, const LAS float* w, float* a) {
#pragma unroll
    for (int e = 0; e < 8; ++e) a[e] = 0.f;
#pragma unroll
    for (int j = 0; j < 4; ++j) {
        const bool ok = tl - 3 + j >= 0;
        const u32x4 u = *(const u32x4*)(ok ? p - (ptrdiff_t)(3 - j) * D : p);
        f32x4 w0 = *(const LAS f32x4*)(w + j * 128), w1 = *(const LAS f32x4*)(w + j * 128 + 4);
        if (!ok) { w0 = (f32x4){0.f, 0.f, 0.f, 0.f}; w1 = w0; }
        a[0] += bflo(u.x) * w0[0]; a[1] += bfhi(u.x) * w0[1]; a[2] += bflo(u.y) * w0[2]; a[3] += bfhi(u.y) * w0[3];
        a[4] += bflo(u.z) * w1[0]; a[5] += bfhi(u.z) * w1[1]; a[6] += bflo(u.w) * w1[2]; a[7] += bfhi(u.w) * w1[3];
    }
#pragma unroll
    for (int e = 0; e < 8; ++e) a[e] = silu_f(a[e]);
}

__device__ __forceinline__ void conv8h(const bf16* p, const bf16* halo, int nloc, const LAS float* w, float* a) {
#pragma unroll
    for (int e = 0; e < 8; ++e) a[e] = 0.f;
#pragma unroll
    for (int j = 0; j < 4; ++j) {
        const int r = nloc - 3 + j;
        const u32x4 u = *(const u32x4*)(r >= 0 ? p - (ptrdiff_t)(3 - j) * D : halo + (r + 3) * D);
        const f32x4 w0 = *(const LAS f32x4*)(w + j * 128), w1 = *(const LAS f32x4*)(w + j * 128 + 4);
        a[0] += bflo(u.x) * w0[0]; a[1] += bfhi(u.x) * w0[1]; a[2] += bflo(u.y) * w0[2]; a[3] += bfhi(u.y) * w0[3];
        a[4] += bflo(u.z) * w1[0]; a[5] += bfhi(u.z) * w1[1]; a[6] += bflo(u.w) * w1[2]; a[7] += bfhi(u.w) * w1[3];
    }
#pragma unroll
    for (int e = 0; e < 8; ++e) a[e] = silu_f(a[e]);
}
__device__ __forceinline__ void delta_prep_wave(const Params& P, LAS unsigned char* lds, int idx, int wave, int lane) {
    const int bh = idx >> 5, b = bh >> 3, h = bh & 7, span = idx & 31, n = lane & 31, hh = lane >> 5;
    const LAS float* wq = (const LAS float*)lds; const LAS float* wk = wq + 512; const LAS float* wv = wq + 1024;
    LAS float* Lm = (LAS float*)(lds + 6144 + wave * 10240);
    LAS float* gcs = Lm + 2 * 1152; LAS float* bts = gcs + 64;
    const bf16* Qb = (const bf16*)(karg_ws() + WS_Z + 2 * ZB); bf16* Kb = (bf16*)(karg_ws() + WS_Z + 3 * ZB); bf16* Vb = (bf16*)(karg_ws() + WS_Z + 4 * ZB);
    bf16* QT = (bf16*)(karg_ws() + WS_H);
    const bf16* HK = (const bf16*)((const unsigned char*)karg_out() + OSB_HK) + (size_t)(b * 32 + span) * 3 * D + h * 128;
    const bf16* HV = (const bf16*)((const unsigned char*)karg_out() + OSB_HV) + (size_t)(b * 32 + span) * 3 * D + h * 128;
    const float* ABL = (const float*)(karg_ws() + WS_ABL);
    bf16* TINV = (bf16*)(karg_ws() + WS_TINV); bf16* ATT = (bf16*)(karg_ws() + WS_ATT);
    { const size_t row = (size_t)b * SEQ + span * 64 + lane;
      float g = -__expf(INP(23)[h]) * softplus_f(ABL[row * 16 + h] + INP(24)[h]); const float be = sigmoid_f(ABL[row * 16 + 8 + h]);
#pragma unroll
      for (int off = 1; off < 32; off <<= 1) { const float t = __shfl_up(g, off); if (n >= off) g += t; }
      gcs[lane] = g; bts[lane] = be;
      ((float*)(karg_ws() + WS_GC))[(size_t)bh * SEQ + span * 64 + lane] = g; ((float*)(karg_ws() + WS_BETA))[(size_t)bh * SEQ + span * 64 + lane] = be; }
    LAS float* nks = bts + 64; LAS float* nqs = nks + 64;
#pragma unroll 1
    for (int it = 7; it >= 0; --it) {
        const int nloc = it * 8 + (lane >> 3), tl = span * 64 + nloc, d0 = (lane & 7) * 16; const size_t ro = ((size_t)b * SEQ + tl) * D + h * 128 + d0;
        float kv[16], qv[16], vv[16];
        conv8h(Kb + ro, HK + d0, nloc, wk + d0, kv); conv8h(Kb + ro + 8, HK + d0 + 8, nloc, wk + d0 + 8, kv + 8);
        conv8(Qb + ro, tl, wq + d0, qv); conv8(Qb + ro + 8, tl, wq + d0 + 8, qv + 8);
        conv8h(Vb + ro, HV + d0, nloc, wv + d0, vv); conv8h(Vb + ro + 8, HV + d0 + 8, nloc, wv + d0 + 8, vv + 8);
        float ssk = 0.f, ssq = 0.f;
#pragma unroll
        for (int e = 0; e < 16; ++e) { ssk += kv[e] * kv[e]; ssq += qv[e] * qv[e]; }
        ssk = red8(ssk); ssq = red8(ssq);
        if ((lane & 7) == 0) { const float nkj = rsq_f(ssk + EPS), nqj = 0.08838834764831845f * rsq_f(ssq + EPS); nks[nloc] = nkj; nqs[nloc] = nqj;
            ((float*)((unsigned char*)karg_out() + OSB_NK))[(size_t)bh * SEQ + tl] = nkj; ((float*)((unsigned char*)karg_out() + OSB_NQ))[(size_t)bh * SEQ + tl] = nqj; }
        *(bf16x8*)(Kb + ro) = pack8(kv[0], kv[1], kv[2], kv[3], kv[4], kv[5], kv[6], kv[7]); *(bf16x8*)(Kb + ro + 8) = pack8(kv[8], kv[9], kv[10], kv[11], kv[12], kv[13], kv[14], kv[15]);
        *(bf16x8*)(QT + ro) = pack8(qv[0], qv[1], qv[2], qv[3], qv[4], qv[5], qv[6], qv[7]); *(bf16x8*)(QT + ro + 8) = pack8(qv[8], qv[9], qv[10], qv[11], qv[12], qv[13], qv[14], qv[15]);
        *(bf16x8*)(Vb + ro) = pack8(vv[0], vv[1], vv[2], vv[3], vv[4], vv[5], vv[6], vv[7]); *(bf16x8*)(Vb + ro + 8) = pack8(vv[8], vv[9], vv[10], vv[11], vv[12], vv[13], vv[14], vv[15]);
    }
    asm volatile("s_waitcnt vmcnt(0)" ::: "memory"); __builtin_amdgcn_fence(__ATOMIC_ACQUIRE, "agent");
#pragma unroll 1
    for (int tile = 0; tile < 2; ++tile) {
        const int tl = span * 64 + tile * 32 + n; const size_t ro = ((size_t)b * SEQ + tl) * D + h * 128 + 8 * hh;
        f32x16 ckk, cqk;
#pragma unroll
        for (int r = 0; r < 16; ++r) { ckk[r] = 0.f; cqk[r] = 0.f; }
#pragma unroll
        for (int s8 = 0; s8 < 8; ++s8) {
            const bf16x8 kf = *(const bf16x8*)(Kb + ro + 16 * s8), qf = *(const bf16x8*)(QT + ro + 16 * s8);
            ckk = __builtin_amdgcn_mfma_f32_32x32x16_bf16(kf, kf, ckk, 0, 0, 0); cqk = __builtin_amdgcn_mfma_f32_32x32x16_bf16(qf, kf, cqk, 0, 0, 0);
        }
        const float nkj = nks[tile * 32 + n];
        const float gcj = gcs[tile * 32 + n];
        bf16* att = ATT + ((size_t)bh * 64 + span * 2 + tile) * 1024 + perm16(n);
#pragma unroll
        for (int r = 0; r < 16; ++r) { const int i = (r & 3) + 8 * (r >> 2) + 4 * hh;
            const float dm = i >= n ? __expf(gcs[tile * 32 + i] - gcj) * nkj : 0.f;
            Lm[tile * 1152 + i * 36 + n] = i > n ? bts[tile * 32 + i] * nks[tile * 32 + i] * ckk[r] * dm : 0.f;
            att[i * 32] = (bf16)f2bf(nqs[tile * 32 + i] * cqk[r] * dm); }
    }
    LDS_WAIT(); asm volatile("" ::: "memory");
    { int loff = hh * 1152;
      float x[32];
#pragma unroll
      for (int i = 0; i < 32; ++i) { float sacc = (i == n) ? 1.f : 0.f;
          const LAS float* Lb = Lm + loff;
#pragma unroll
          for (int j4 = 0; j4 < (i + 3) / 4; ++j4) { const f32x4 l = *(const LAS f32x4*)(Lb + i * 36 + 4 * j4);
#pragma unroll
              for (int jj = 0; jj < 4; ++jj) if (4 * j4 + jj < i) sacc -= l[jj] * x[4 * j4 + jj]; }
          x[i] = sacc;
          if ((i & 1) == 1) asm volatile("" : "+v"(loff) : "v"(sacc)); }
      bf16* ti = TINV + ((size_t)bh * 64 + span * 2 + hh) * 1024 + perm16(n);
#pragma unroll
      for (int i = 0; i < 32; ++i) ti[i * 32] = (bf16)f2bf(x[i]); }
    LDS_WAIT(); asm volatile("" ::: "memory");
}

constexpr int DR_KB = 0, DR_QD = 8704, DR_KDT = 17408, DR_TI = 27648, DR_AT = 30208, DR_VB = 32768, DR_EGL = 49664, DR_BUF = 49680;
struct DeltaPre { u32x4 k0, k1, q0, q1, v0, v1, tia; float gct, gl, bet, nk, nq; };
__device__ __forceinline__ void delta_pre_load(int b, int h, int c, int pt, DeltaPre& dp) {
    const int bh = b * 8 + h, tt = pt >> 3, d0 = (pt & 7) * 16; const size_t t = (size_t)bh * SEQ + c * 32 + tt;
    const size_t ro = ((size_t)b * SEQ + c * 32 + tt) * D + h * 128 + d0;
    const bf16* Kt = (const bf16*)(karg_ws() + WS_Z + 3 * ZB) + ro; const bf16* Qt = (const bf16*)(karg_ws() + WS_H) + ro; const bf16* Vt = (const bf16*)(karg_ws() + WS_Z + 4 * ZB) + ro;
    dp.k0 = *(const u32x4*)Kt; dp.k1 = *(const u32x4*)(Kt + 8); dp.q0 = *(const u32x4*)Qt; dp.q1 = *(const u32x4*)(Qt + 8); dp.v0 = *(const u32x4*)Vt; dp.v1 = *(const u32x4*)(Vt + 8);
    const float* GC = (const float*)(karg_ws() + WS_GC);
    dp.gct = GC[t]; dp.gl = GC[(size_t)bh * SEQ + c * 32 + 31]; dp.bet = ((const float*)(karg_ws() + WS_BETA))[t];
    dp.nk = ((const float*)((const unsigned char*)karg_out() + OSB_NK))[t]; dp.nq = ((const float*)((const unsigned char*)karg_out() + OSB_NQ))[t];
    dp.tia = *(const u32x4*)((const bf16*)(karg_ws() + (pt < 128 ? WS_TINV : WS_ATT)) + ((size_t)bh * 64 + c) * 1024 + (pt & 127) * 8);
}
__device__ __forceinline__ void delta_rec_stage(LAS unsigned char* buf, int pt, const DeltaPre& dp) {
    const int tt = pt >> 3, dg = pt & 7, d0 = dg * 16;
    { LAS bf16* dst = (LAS bf16*)(buf + (pt < 128 ? DR_TI : DR_AT)) + ((pt & 127) >> 2) * 40 + (pt & 3) * 8; *(LAS u32x4*)dst = dp.tia; }
    if (pt == 0) *(LAS float*)(buf + DR_EGL) = __expf(dp.gl);
    const float eg = __expf(dp.gct), ekd = __expf(dp.gl - dp.gct);
    const float fq = dp.nq * eg, fkb = dp.nk * dp.bet * eg, fkd = dp.nk * ekd, bet = dp.bet;
    float k[16], q[16], v[16];
    unpack8(dp.k0, k); unpack8(dp.k1, k + 8); unpack8(dp.q0, q); unpack8(dp.q1, q + 8); unpack8(dp.v0, v); unpack8(dp.v1, v + 8);
    LAS bf16* KB = (LAS bf16*)(buf + DR_KB) + tt * 136 + d0; LAS bf16* QD = (LAS bf16*)(buf + DR_QD) + tt * 136 + d0;
    *(LAS bf16x8*)KB = pack8(k[0] * fkb, k[1] * fkb, k[2] * fkb, k[3] * fkb, k[8] * fkb, k[9] * fkb, k[10] * fkb, k[11] * fkb);
    *(LAS bf16x8*)(KB + 8) = pack8(k[4] * fkb, k[5] * fkb, k[6] * fkb, k[7] * fkb, k[12] * fkb, k[13] * fkb, k[14] * fkb, k[15] * fkb);
    *(LAS bf16x8*)QD = pack8(q[0] * fq, q[1] * fq, q[2] * fq, q[3] * fq, q[8] * fq, q[9] * fq, q[10] * fq, q[11] * fq);
    *(LAS bf16x8*)(QD + 8) = pack8(q[4] * fq, q[5] * fq, q[6] * fq, q[7] * fq, q[12] * fq, q[13] * fq, q[14] * fq, q[15] * fq);
    LAS bf16* KDT = (LAS bf16*)(buf + DR_KDT) + d0 * 40 + perm16(tt);
#pragma unroll
    for (int e = 0; e < 16; ++e) KDT[e * 40] = (bf16)f2bf(k[e] * fkd);
    LAS float* VB = (LAS float*)(buf + DR_VB) + tt * 132 + d0;
#pragma unroll
    for (int e4 = 0; e4 < 4; ++e4) *(LAS f32x4*)(VB + 4 * e4) = (f32x4){v[4 * e4] * bet, v[4 * e4 + 1] * bet, v[4 * e4 + 2] * bet, v[4 * e4 + 3] * bet};
}

constexpr int DR_OB = 2 * DR_BUF;
static_assert(DR_OB + 2 * 32 * 132 * 4 <= LDS_BYTES - 64, "delta recurrence LDS map");
__device__ __forceinline__ void delta_out_norm(const LAS float* ob, int pt, const float* dn16, const u32x4 z0, const u32x4 z1, bf16* dst) {
    const LAS float* p = ob + (pt >> 3) * 132 + (pt & 7) * 16;
    float o[16], z[16];
#pragma unroll
    for (int e4 = 0; e4 < 4; ++e4) { const f32x4 t = *(const LAS f32x4*)(p + 4 * e4); o[4 * e4] = t[0]; o[4 * e4 + 1] = t[1]; o[4 * e4 + 2] = t[2]; o[4 * e4 + 3] = t[3]; }
    float ss = 0.f;
#pragma unroll
    for (int e = 0; e < 16; ++e) ss += o[e] * o[e];
    ss = red8(ss);
    const float rstd = rsq_f(ss * (1.f / 128.f) + EPS);
    unpack8(z0, z); unpack8(z1, z + 8);
#pragma unroll
    for (int e = 0; e < 16; ++e) o[e] = o[e] * rstd * dn16[e] * z[e];
    *(bf16x8*)dst = pack8(o[0], o[1], o[2], o[3], o[4], o[5], o[6], o[7]); *(bf16x8*)(dst + 8) = pack8(o[8], o[9], o[10], o[11], o[12], o[13], o[14], o[15]);
}
__device__ __forceinline__ void delta_rec_task(const Params& P, LAS unsigned char* lds, int b, int h, int tid) {
    const int lane = tid & 63, wave = tid >> 6, n = lane & 31, hh = lane >> 5, bh = b * 8 + h, pt = tid - 256;
    const bool producer = wave >= 4;
    constexpr int NC = SEQ / 32;
    f32x16 S[4];
#pragma unroll
    for (int kb = 0; kb < 4; ++kb)
#pragma unroll
        for (int r = 0; r < 16; ++r) S[kb][r] = 0.f;
    DeltaPre dcur, dnxt;
    if (producer) { delta_pre_load(b, h, 0, pt, dcur); delta_pre_load(b, h, 1, pt, dnxt); delta_rec_stage(lds, pt, dcur); dcur = dnxt; }
    __syncthreads();
    if (producer) {
        const int pt = opq(tid) - 256;
        float dn16[16];
#pragma unroll
        for (int e = 0; e < 16; ++e) dn16[e] = INP(25)[(pt & 7) * 16 + e];
        bf16* zgp = (bf16*)(karg_ws() + WS_Z + 5 * ZB) + ((size_t)b * SEQ + (pt >> 3)) * D + h * 128 + (pt & 7) * 16;
        u32x4 zc0 = {0u, 0u, 0u, 0u}, zc1 = zc0, zn0, zn1;
#define DR_BAR() do { asm volatile("s_waitcnt lgkmcnt(0)" ::: "memory"); __builtin_amdgcn_s_barrier(); asm volatile("" ::: "memory"); } while (0)
        for (int c = 0; c < NC; ++c) {
            if (c > 0) { dcur = dnxt; zc0 = zn0; zc1 = zn1; }
            if (c + 2 < NC) delta_pre_load(b, h, c + 2, pt, dnxt);
            zn0 = *(const u32x4*)(zgp + (size_t)c * 32 * D); zn1 = *(const u32x4*)(zgp + (size_t)c * 32 * D + 8);
            if (c + 1 < NC) delta_rec_stage(lds + ((c + 1) & 1) * DR_BUF, pt, dcur);
            if (c > 0) delta_out_norm((const LAS float*)(lds + DR_OB) + ((c - 1) & 1) * 32 * 132, pt, dn16, zc0, zc1, zgp + (size_t)(c - 1) * 32 * D);
            DR_BAR();
        }
        delta_out_norm((const LAS float*)(lds + DR_OB) + ((NC - 1) & 1) * 32 * 132, pt, dn16, zn0, zn1, zgp + (size_t)(NC - 1) * 32 * D);
    } else {
        const int lane = opq(tid) & 63, n = lane & 31, hh = lane >> 5;
        for (int c = 0; c < NC; ++c) {
            LAS unsigned char* buf = lds + (c & 1) * DR_BUF;
            const int vb = wave;
            bf16x8 SB[8];
#pragma unroll
            for (int s = 0; s < 8; ++s) { const int kb = s >> 1, o = 8 * (s & 1); SB[s] = pack8(S[kb][o], S[kb][o + 1], S[kb][o + 2], S[kb][o + 3], S[kb][o + 4], S[kb][o + 5], S[kb][o + 6], S[kb][o + 7]); }
            f32x16 X1, P1;
#pragma unroll
            for (int r = 0; r < 16; ++r) { X1[r] = 0.f; P1[r] = 0.f; }
            const LAS bf16* KB = (const LAS bf16*)(buf + DR_KB) + n * 136 + 8 * hh; const LAS bf16* QD = (const LAS bf16*)(buf + DR_QD) + n * 136 + 8 * hh;
#pragma unroll
            for (int s = 0; s < 8; ++s) { X1 = __builtin_amdgcn_mfma_f32_32x32x16_bf16(*(const LAS bf16x8*)(KB + 16 * s), SB[s], X1, 0, 0, 0);
                P1 = __builtin_amdgcn_mfma_f32_32x32x16_bf16(*(const LAS bf16x8*)(QD + 16 * s), SB[s], P1, 0, 0, 0); }
            const LAS float* VB = (const LAS float*)(buf + DR_VB) + 32 * vb + n;
            float Y[16];
#pragma unroll
            for (int r = 0; r < 16; ++r) Y[r] = VB[((r & 3) + 8 * (r >> 2) + 4 * hh) * 132] - X1[r];
            const bf16x8 YB0 = pack8(Y[0], Y[1], Y[2], Y[3], Y[4], Y[5], Y[6], Y[7]), YB1 = pack8(Y[8], Y[9], Y[10], Y[11], Y[12], Y[13], Y[14], Y[15]);
            f32x16 VN;
#pragma unroll
            for (int r = 0; r < 16; ++r) VN[r] = 0.f;
            const LAS bf16* TI = (const LAS bf16*)(buf + DR_TI) + n * 40 + 8 * hh; const LAS bf16* AT = (const LAS bf16*)(buf + DR_AT) + n * 40 + 8 * hh;
            VN = __builtin_amdgcn_mfma_f32_32x32x16_bf16(*(const LAS bf16x8*)TI, YB0, VN, 0, 0, 0);
            VN = __builtin_amdgcn_mfma_f32_32x32x16_bf16(*(const LAS bf16x8*)(TI + 16), YB1, VN, 0, 0, 0);
            const bf16x8 VB0 = pack8(VN[0], VN[1], VN[2], VN[3], VN[4], VN[5], VN[6], VN[7]), VB1 = pack8(VN[8], VN[9], VN[10], VN[11], VN[12], VN[13], VN[14], VN[15]);
            P1 = __builtin_amdgcn_mfma_f32_32x32x16_bf16(*(const LAS bf16x8*)AT, VB0, P1, 0, 0, 0);
            P1 = __builtin_amdgcn_mfma_f32_32x32x16_bf16(*(const LAS bf16x8*)(AT + 16), VB1, P1, 0, 0, 0);
            const float egl = *(const LAS float*)(buf + DR_EGL);
            const LAS bf16* KDT = (const LAS bf16*)(buf + DR_KDT) + n * 40 + 8 * hh;
#pragma unroll
            for (int kb = 0; kb < 4; ++kb) {
#pragma unroll
                for (int r = 0; r < 16; ++r) S[kb][r] *= egl;
                S[kb] = __builtin_amdgcn_mfma_f32_32x32x16_bf16(*(const LAS bf16x8*)(KDT + kb * 32 * 40), VB0, S[kb], 0, 0, 0);
                S[kb] = __builtin_amdgcn_mfma_f32_32x32x16_bf16(*(const LAS bf16x8*)(KDT + kb * 32 * 40 + 16), VB1, S[kb], 0, 0, 0); }
            LAS float* op = (LAS float*)(lds + DR_OB) + (c & 1) * 32 * 132 + 4 * hh * 132 + 32 * vb + n;
#pragma unroll
            for (int r = 0; r < 16; ++r) op[((r & 3) + 8 * (r >> 2)) * 132] = P1[r];
            DR_BAR();
        }
    }
    if (!producer) { float* So = karg_out() + O_SP + ((size_t)bh * 128 + 4 * hh) * 128 + 32 * wave + n;
#pragma unroll
        for (int kb = 0; kb < 4; ++kb)
#pragma unroll
            for (int r = 0; r < 16; ++r) So[(size_t)(32 * kb + (r & 3) + 8 * (r >> 2)) * 128] = S[kb][r]; }
    __syncthreads();
}

template <int MODE>
__device__ __forceinline__ void delta_sample_item(const Params& P, LAS unsigned char* lds, int item, int tid) {
    LAS float* tmp = (LAS float*)lds;
    LAS float* scl = (LAS float*)(lds + 1536);
    LAS float* rpk = (LAS float*)(lds + 2048);
    LAS float* rpq = (LAS float*)(lds + 4096);
    const int bs = item >> 3, h = item & 7, lane = tid & 63, wave = tid >> 6; const size_t row = (size_t)MPR + bs;
    const bf16* Zq = (const bf16*)(karg_ws() + WS_Z + 2 * ZB);
    if (tid < 384) { const int which = tid >> 7, d = tid & 127; const int c3 = which * 1024 + h * 128 + d;
        const float raw = bf2f(Zq[(size_t)which * (ZB / 2) + row * D + h * 128 + d]);
        const float* cs = INP(7) + (size_t)bs * 3 * 3072 + c3; const float* w = INP(22) + c3;
        tmp[tid] = silu_f(cs[0] * w[0] + cs[3072] * w[3072] + cs[2 * 3072] * w[2 * 3072] + raw * w[3 * 3072]); }
    __syncthreads();
    if (wave < 3) { float s;
        if (wave == 0) s = tmp[lane] * tmp[lane] + tmp[lane + 64] * tmp[lane + 64];
        else if (wave == 1) s = tmp[128 + lane] * tmp[128 + lane] + tmp[192 + lane] * tmp[192 + lane];
        else s = tmp[lane] * tmp[128 + lane] + tmp[64 + lane] * tmp[192 + lane];
        s = wave_sum(s);
        if (lane == 0) scl[wave] = wave == 0 ? rsq_f(s + EPS) * 0.08838834764831845f : (wave == 1 ? rsq_f(s + EPS) : s); }
    __syncthreads();
    const float sq = scl[0], sk = scl[1], kq = scl[2] * sq * sk;
    const int v = tid & 127, kg = tid >> 7;
    const float* S0 = INP(6) + ((size_t)(bs * NH + h) * 128 + kg * 32) * 128 + v;
    float S[32];
#pragma unroll
    for (int j = 0; j < 32; ++j) S[j] = MODE == 1 ? __builtin_nontemporal_load(S0 + (size_t)j * 128) : S0[(size_t)j * 128];
    float pk = 0.f, pq = 0.f;
#pragma unroll
    for (int j = 0; j < 32; ++j) { pk += S[j] * tmp[128 + kg * 32 + j]; pq += S[j] * tmp[kg * 32 + j]; }
    rpk[kg * 128 + v] = pk * sk; rpq[kg * 128 + v] = pq * sq;
    __syncthreads();
    pk = (rpk[v] + rpk[128 + v]) + (rpk[256 + v] + rpk[384 + v]); pq = (rpq[v] + rpq[128 + v]) + (rpq[256 + v] + rpq[384 + v]);
    const float* ABL = (const float*)(karg_ws() + WS_ABL);
    const float al = ABL[row * 16 + h], bl = ABL[row * 16 + 8 + h];
    const float dc = __expf(-__expf(INP(23)[h]) * softplus_f(al + INP(24)[h])), be = sigmoid_f(bl);
    const float delta = be * (tmp[256 + v] - dc * pk);
    if (MODE == 0) {
        const float o = dc * pq + kq * delta; const float so = wave_sum(o * o);
        if (lane == 0 && wave < 2) scl[4 + wave] = so;
        __syncthreads();
        if (kg == 0) { bf16* zp = (bf16*)(karg_ws() + WS_Z + 5 * ZB) + row * D + h * 128 + v;
            *zp = (bf16)f2bf(o * rsq_f((scl[4] + scl[5]) * (1.f / 128.f) + EPS) * INP(25)[v] * bf2f(*zp)); } }
    else { float* So = karg_out() + O_SS + ((size_t)(bs * NH + h) * 128 + kg * 32) * 128 + v;
#pragma unroll
        for (int j = 0; j < 32; ++j) __builtin_nontemporal_store(dc * S[j] + (tmp[128 + kg * 32 + j] * sk) * delta, So + (size_t)j * 128); }
    __syncthreads();
}

#define XB_TMO      128
#define XB_XCNT(j)  (256  + 64 * (j))
#define XB_XSUB(j)  (1280 + 64 * (j))
#define XB_XGEN(j)  (2304 + 64 * (j))
#define XB_TOP      3328
#define XB_TOPGEN   3392
#define XCD_BAR_WORDS 3456
#define XB_SPIN_CAP (1u << 22)
__device__ __forceinline__ unsigned xb_ld(unsigned* p)              { return __hip_atomic_load(p, __ATOMIC_RELAXED, __HIP_MEMORY_SCOPE_AGENT); }
__device__ __forceinline__ unsigned xb_add(unsigned* p, unsigned v) { return __hip_atomic_fetch_add(p, v, __ATOMIC_RELAXED, __HIP_MEMORY_SCOPE_AGENT); }
__device__ __forceinline__ unsigned xb_xcc_id() { return (unsigned)__builtin_amdgcn_s_getreg((3 << 11) | 20) & 0xFu; }
#define XB_SPIN(cond, bar) do { unsigned _sp = 0; while (cond) { __builtin_amdgcn_s_sleep(1); \
    if ((++_sp & 255u) == 0u) { if (xb_ld(&(bar)[XB_TMO])) break; if (_sp > XB_SPIN_CAP) { atomicAdd(&(bar)[XB_TMO], 1u); break; } } } } while (0)
struct XcdBarrier { unsigned* bar; unsigned x; volatile LAS unsigned* st; };
__device__ __forceinline__ XcdBarrier xcd_barrier_post(unsigned* bar, volatile LAS unsigned* st, bool leader) {
    XcdBarrier b; b.bar = bar; b.x = xb_xcc_id(); b.st = st;
    if (leader) (void)xb_add(&bar[XB_XCNT(b.x)], 1u);
    return b;
}
__device__ __forceinline__ void xcd_barrier_complete(unsigned* bar, unsigned x, unsigned& nloc, unsigned& nx) {
    const unsigned G = gridDim.x * gridDim.y * gridDim.z;
    unsigned sum, cnt, mine, sp = 0u;
    for (;;) {
        sum = 0u; cnt = 0u; mine = 0u;
#pragma unroll
        for (unsigned j = 0; j < 16; ++j) { const unsigned c = xb_ld(&bar[XB_XCNT(j)]); sum += c; cnt += (c > 0u) ? 1u : 0u; mine = (j == x) ? c : mine; }
        if (sum == G) break;
        __builtin_amdgcn_s_sleep(1);
        if ((++sp & 255u) == 0u) { if (xb_ld(&bar[XB_TMO])) break; if (sp > XB_SPIN_CAP) { atomicAdd(&bar[XB_TMO], 1u); break; } }
    }
    nloc = mine > 0u ? mine : 1u; nx = cnt > 0u ? cnt : 1u;
}
__device__ __forceinline__ void xcd_barrier(const XcdBarrier& b, bool leader) {
    asm volatile("s_waitcnt vmcnt(0)" ::: "memory");
    __syncthreads();
    if (leader) {
        unsigned* bar = b.bar;
        __builtin_amdgcn_s_waitcnt(0);
        unsigned nloc = b.st[0], nx = b.st[1];
        if (nloc == 0u) { xcd_barrier_complete(bar, b.x, nloc, nx); b.st[0] = nloc; b.st[1] = nx; }
        const unsigned old = xb_add(&bar[XB_XSUB(b.x)], 1u);
        const unsigned gen = old / nloc;
        if (old + 1u == (gen + 1u) * nloc) {
            __builtin_amdgcn_fence(__ATOMIC_RELEASE, "agent");
            asm volatile("s_waitcnt vmcnt(0)" ::: "memory");
            const unsigned og = xb_add(&bar[XB_TOP], 1u);
            const unsigned tg = og / nx;
            if (og + 1u == (tg + 1u) * nx) xb_add(&bar[XB_TOPGEN], 1u);
            else XB_SPIN(xb_ld(&bar[XB_TOPGEN]) == tg, bar);
            __builtin_amdgcn_fence(__ATOMIC_ACQUIRE, "agent");
            xb_add(&bar[XB_XGEN(b.x)], 1u);
            asm volatile("s_waitcnt vmcnt(0)" ::: "memory");
        } else {
            XB_SPIN(xb_ld(&bar[XB_XGEN(b.x)]) == gen, bar);
            __builtin_amdgcn_fence(__ATOMIC_ACQUIRE, "agent");
            asm volatile("s_waitcnt vmcnt(0)" ::: "memory");
        }
    }
    __syncthreads();
}

__global__ void __launch_bounds__(NTHR, 2) fwd_megakernel(Params P) {
    extern __shared__ __attribute__((aligned(16))) unsigned char lds_raw[];
    LAS unsigned char* lds = (LAS unsigned char*)lds_raw;
    cg::grid_group grid = cg::this_grid();
    const int wave = __builtin_amdgcn_readfirstlane((int)threadIdx.x >> 6);
#define lane opq(lane_now())
#define tid opq((wave << 6) | lane_now())
    const int G = gridDim.x, wg = blockIdx.x;
    const int gw = wg * NWAVES + wave, NGW = G * NWAVES;
    unsigned char* ws = karg_ws();
    float* ADA = (float*)(ws + WS_ADA);
    bf16* H = (bf16*)(ws + WS_H);
    bf16* Z = (bf16*)(ws + WS_Z);
    bf16* ACT = (bf16*)(ws + WS_ACT);
    bf16* MG = (bf16*)(karg_out() + O_SS);
    volatile LAS unsigned* MISC = (volatile LAS unsigned*)(lds + LDS_BYTES - 64);
    if (tid < 16) MISC[tid] = 0u;
    __syncthreads();
    const XcdBarrier xbar = xcd_barrier_post((unsigned*)ws, MISC, wave == 0 && lane_now() == 0);
#define GBAR() xcd_barrier(xbar, wave == 0 && lane_now() == 0)

    if constexpr ((PHM >> 0) & 1) {
    prologue<0>(P, lds, gw, NGW, wave, lane);
    }
    GBAR();
    if constexpr ((PHM >> 1) & 1) {
    { pg8::Gemm g{(const bf16*)(ws + WS_CB), (const bf16*)(ws + WS_WADA), nullptr, nullptr, D}; pg8::StaticOrder S; S.init(256, NADA, G, wg);
      EpiAda E{ADA, INP(9)}; pg8::gemm_phase(lds, g, S, E, wave);
      if (wg >= 36) prologue<1>(P, lds, (wg - 36) * NWAVES + wave, (G - 36) * NWAVES, wave, lane); }
    }
    GBAR();
    if constexpr ((PHM >> 2) & 1) {
    norm_mod_pass<0>(P, INP(10), 0, gw, NGW, lane);
    { const int gt = wg * NTHR + tid;
      if (gt < 2 * NB * 3 * (D / 8)) { const int m = gt / (NB * 3 * (D / 8)), r = gt % (NB * 3 * (D / 8)), c8 = r & 127, j = (r >> 7) % 3, bb = (r >> 7) / 3;
          *(u32x4*)((bf16*)((unsigned char*)karg_out() + (m ? OSB_HV : OSB_HK)) + ((size_t)(bb * 32) * 3 + j) * D + c8 * 8) = (u32x4){0u, 0u, 0u, 0u}; } }
    }
    GBAR();
    if constexpr ((PHM >> 3) & 1) {
    { pg8::Gemm g{H, (const bf16*)(ws + WS_WUP1), nullptr, nullptr, D}; pg8::StaticOrder S; S.init(MPAD, 2 * FF, G, wg);
      EpiSwiglu E{ACT}; pg8::gemm_phase(lds, g, S, E, wave); }
    }
    GBAR();
    if constexpr ((PHM >> 4) & 1) {
    { pg8::Gemm g{ACT, (const bf16*)(ws + WS_WDN1), nullptr, nullptr, FF}; pg8::StaticOrder S; S.init(MPR, D, G, wg);
      EpiResidNorm<0> E{karg_out(), INP(0), ADA + 2 * D, 0.5f, INP(13), ADA + 3 * D, H, (float*)(ws + WS_PART), (unsigned*)(ws + WS_CNT), (LAS float*)(lds + 131072)}; pg8::gemm_phase(lds, g, S, E, wave);
      float* X = karg_out(); const float* xs = INP(1); const float* gate = ADA + 2 * D;
      mini_gemm(lds, ACT, (const bf16*)(ws + WS_WDN1), nullptr, nullptr, FF, wg, G, tid, [=](int row, int col, f32x4 v, f32x4) {
          const f32x4 xv = *(const f32x4*)(xs + (size_t)(row - MPR) * D + col), gv = *(const f32x4*)(gate + (size_t)cond_of_row(row) * NADA + col);
          *(f32x4*)(X + (size_t)row * D + col) = xv + (gv * 0.5f) * v; }); }
    }
    GBAR();
    if constexpr ((PHM >> 5) & 1) {
    sample_norm_rows<0>(INP(13), 3, gw, lane);
    }
    GBAR();
    if constexpr ((PHM >> 6) & 1) {
    { pg8::Gemm g{H, (const bf16*)(ws + WS_WIN), nullptr, nullptr, D}; pg8::StaticOrder S; S.init(MPAD, NIN, G, wg);
      EpiIn E{Z, MG, (float*)(ws + WS_ABL), karg_out()}; pg8::gemm_phase(lds, g, S, E, wave); }
    }
    GBAR();
    if constexpr ((PHM >> 7) & 1) {
        { const int bh0 = (wg * NWAVES) >> 5, h0 = bh0 & 7; LAS float* w = (LAS float*)lds; const float* cwq = INP(22);
          for (int i = tid; i < 1536; i += NTHR) { const int which = i >> 9, j = (i >> 7) & 3, d = i & 127; w[i] = cwq[(size_t)j * 3072 + which * 1024 + h0 * 128 + d]; }
          __syncthreads();
          delta_prep_wave(P, lds, gw, wave, lane);
          __syncthreads(); }
        if (G == 256) { const int task = (wg & 7) * 32 + (wg >> 3); rglru_task(P, lds, task >> 5, (task >> 2) & 7, task & 3, tid, 0, RG_SPLIT); }
        else for (int task = wg; task < 256; task += G) rglru_task(P, lds, task >> 5, (task >> 2) & 7, task & 3, tid, 0, RG_SPLIT);
    }
    GBAR();
    if constexpr ((PHM >> 7) & 1) {
        if (wg < 64) delta_rec_task(P, lds, wg >> 3, wg & 7, tid);
        else {
            if (G == 256) { const int slot = (wg - 64) >> 3;
                { const int task = (wg & 7) * 32 + slot; rglru_task(P, lds, task >> 5, (task >> 2) & 7, task & 3, tid, RG_SPLIT, 16); }
                if (slot < 8) { const int task = (wg & 7) * 32 + 24 + slot; rglru_task(P, lds, task >> 5, (task >> 2) & 7, task & 3, tid, RG_SPLIT, 16); } }
            else for (int task = wg - 64; task < 256; task += G - 64) rglru_task(P, lds, task >> 5, (task >> 2) & 7, task & 3, tid, RG_SPLIT, 16);
            if (wg < 96) rglru_task(P, lds, -1, (wg - 64) >> 2, (wg - 64) & 3, tid, 0, 1);
            if (wg >= 128) for (int item = wg - 128; item < NS * NH; item += G - 128) delta_sample_item<0>(P, lds, item, tid);
        }
    }
    GBAR();
    if constexpr ((PHM >> 9) & 1) {
    { pg8::Gemm g{Z + 1 * (ZB / 2), (const bf16*)(ws + WS_WBR), Z + 5 * (ZB / 2), (const bf16*)(ws + WS_WBR) + (size_t)D * D, D};
      pg8::PairOrder S; S.base.init(MPR, D, G, wg);
      EpiBranch E{MG, MG + ZB / 2, Z}; pg8::gemm_phase(lds, g, S, E, wave);
      const bf16* mga = MG; const bf16* mgb = MG + ZB / 2; bf16* Gm = Z;
      mini_gemm(lds, g.A0, g.B0, g.A1, g.B1, D, wg, G, tid, [=](int row, int col, f32x4 ya, f32x4 yb) {
          const size_t o = (size_t)row * D + col; const u32x2 a = *(const u32x2*)(mga + o), b = *(const u32x2*)(mgb + o);
          u32x2 w; w.x = pk2(bflo(a.x) * ya[0] + bflo(b.x) * yb[0], bfhi(a.x) * ya[1] + bfhi(b.x) * yb[1]);
          w.y = pk2(bflo(a.y) * ya[2] + bflo(b.y) * yb[2], bfhi(a.y) * ya[3] + bfhi(b.y) * yb[3]);
          *(u32x2*)(Gm + o) = w; }); }
    }
    GBAR();
    if constexpr ((PHM >> 10) & 1) {
    { pg8::Gemm g{Z, (const bf16*)(ws + WS_WOUT), nullptr, nullptr, D}; pg8::StaticOrder S; S.init(MPR, D, G, wg);
      EpiResidNorm<0> E{karg_out(), nullptr, ADA + 5 * D, 1.0f, INP(28), ADA + 6 * D, H, (float*)(ws + WS_PART) + 65536, (unsigned*)(ws + WS_CNT) + 64, (LAS float*)(lds + 131072)}; pg8::gemm_phase(lds, g, S, E, wave);
      float* X = karg_out(); const float* gate = ADA + 5 * D;
      mini_gemm(lds, Z, (const bf16*)(ws + WS_WOUT), nullptr, nullptr, D, wg, G, tid, [=](int row, int col, f32x4 v, f32x4) {
          float* xp = X + (size_t)row * D + col; const f32x4 gv = *(const f32x4*)(gate + (size_t)cond_of_row(row) * NADA + col);
          *(f32x4*)xp = *(const f32x4*)xp + gv * v; }); }
    }
    GBAR();
    if constexpr ((PHM >> 11) & 1) {
    sample_norm_rows<0>(INP(28), 6, gw, lane);
    {
        for (int item = (G == 256 ? SS_TAIL : 0) + wg; item < NS * NH; item += G) delta_sample_item<1>(P, lds, item, tid);
        const int gt = wg * NTHR + tid, NGT = G * NTHR;
        for (int i = gt; i < NS * 3 * 3072; i += NGT) { const int bs = i / 9216, j = (i / 3072) % 3, c3 = i % 3072;
            karg_out()[O_CQS + i] = j < 2 ? INP(7)[(size_t)bs * 9216 + (j + 1) * 3072 + c3] : bf2f(Z[(size_t)(2 + (c3 >> 10)) * (ZB / 2) + ((size_t)MPR + bs) * D + (c3 & 1023)]); }
    }
    }
    GBAR();
    if constexpr ((PHM >> 12) & 1) {
    { pg8::Gemm g{H, (const bf16*)(ws + WS_WUP2), nullptr, nullptr, D}; pg8::StaticOrder S; S.init(MPAD, 2 * FF, G, wg);
      EpiSwiglu E{ACT}; pg8::gemm_phase(lds, g, S, E, wave);
      if (G == 256 && wg >= 150) for (int item = wg - 150; item < SS_TAIL; item += 106) delta_sample_item<1>(P, lds, item, tid); }
    }
    GBAR();
    if constexpr ((PHM >> 13) & 1) {
    { pg8::Gemm g{ACT, (const bf16*)(ws + WS_WDN2), nullptr, nullptr, FF}; pg8::StaticOrder S; S.init(MPR, D, G, wg);
      EpiResidNorm<1> E{karg_out(), nullptr, ADA + 8 * D, 0.5f, INP(31), nullptr, nullptr, (float*)(ws + WS_PART) + 131072, (unsigned*)(ws + WS_CNT) + 128, (LAS float*)(lds + 131072)}; pg8::gemm_phase(lds, g, S, E, wave);
      float* X = karg_out(); const float* gate = ADA + 8 * D;
      mini_gemm(lds, ACT, (const bf16*)(ws + WS_WDN2), nullptr, nullptr, FF, wg, G, tid, [=](int row, int col, f32x4 v, f32x4) {
          float* xp = X + (size_t)row * D + col; const f32x4 gv = *(const f32x4*)(gate + (size_t)cond_of_row(row) * NADA + col);
          *(f32x4*)xp = *(const f32x4*)xp + (gv * 0.5f) * v; }); }
    }
    GBAR();
    if constexpr ((PHM >> 14) & 1) {
    sample_norm_rows<1>(INP(31), 0, gw, lane);
    }
}

extern "C" void kernel_launch(void* const* d_in, const int* in_sizes, int n_in, void* d_out, int out_size, void* d_ws, size_t ws_size, hipStream_t stream) {
    static int grid = 0;
    if (grid == 0) {
        if (n_in != 32 || (size_t)out_size != O_END || ws_size < WS_END) { fprintf(stderr, "kernel_launch: unexpected shapes: n_in %d out %d ws %zu (need %zu)\n", n_in, out_size, ws_size, (size_t)WS_END); grid = -1; return; }
        int dev = 0, cus = 0, per_cu = 0;
        hipGetDevice(&dev); hipDeviceGetAttribute(&cus, hipDeviceAttributeMultiprocessorCount, dev);
        if (hipFuncSetAttribute((const void*)fwd_megakernel, hipFuncAttributeMaxDynamicSharedMemorySize, LDS_BYTES) != hipSuccess) { fprintf(stderr, "kernel_launch: hipFuncSetAttribute failed\n"); grid = -1; return; }
        if (hipOccupancyMaxActiveBlocksPerMultiprocessor(&per_cu, (const void*)fwd_megakernel, NTHR, LDS_BYTES) != hipSuccess || per_cu < 1) { fprintf(stderr, "kernel_launch: occupancy query says %d\n", per_cu); per_cu = 1; }
        (void)hipGetLastError();
        grid = cus * 1;
        if (grid > 256) grid = 256;
    }
    if (grid < 0) return;
    if (hipMemsetAsync(d_ws, 0, 16384, stream) != hipSuccess) { fprintf(stderr, "kernel_launch: memset failed\n"); return; }
    Params p{};
    for (int i = 0; i < 32; ++i) p.in[i] = (const float*)d_in[i];
    p.out = (float*)d_out; p.ws = (unsigned char*)d_ws;
    void* args[] = {&p};
    hipError_t e = hipLaunchCooperativeKernel((const void*)fwd_megakernel, dim3(grid), dim3(NTHR), args, LDS_BYTES, stream);
    if (e != hipSuccess) fprintf(stderr, "kernel_launch: cooperative launch failed: %s (grid %d)\n", hipGetErrorString(e), grid);
}
```

```cpp
#include <hip/hip_runtime.h>
#include <hip/hip_cooperative_groups.h>
#include <cstdio>
#include <cstdint>
namespace cg = cooperative_groups;

#define LAS __attribute__((address_space(3)))
typedef unsigned short bf16;
typedef short bf16x8 __attribute__((ext_vector_type(8)));
typedef float f32x4 __attribute__((ext_vector_type(4)));
typedef float f32x16 __attribute__((ext_vector_type(16)));
typedef unsigned u32x4 __attribute__((ext_vector_type(4)));
typedef unsigned u32x2 __attribute__((ext_vector_type(2)));

constexpr int D = 1024, SEQ = 2048, NB = 8, MPR = NB * SEQ, NS = 128, M = MPR + NS, MPAD = 16640;
constexpr int FF = 2816, NADA = 9216, NCOND = NB + NS, NIN = 8448, NH = 8;
constexpr float EPS = 1e-6f;
constexpr int NWAVES = 8, NTHR = 512;

constexpr size_t MiB = 1u << 20;
constexpr size_t ZB = (size_t)M * D * 2;
constexpr size_t WS_WUP2 = 1 * MiB;
constexpr size_t WS_WDN2 = 12 * MiB;
constexpr size_t WS_WIN = WS_WDN2 + (size_t)D * FF * 2;
constexpr size_t WS_WBR = 34 * MiB;
constexpr size_t WS_WOUT = 38 * MiB;
constexpr size_t WS_WRG = 40 * MiB;
constexpr size_t WS_CB = WS_WRG + 512 * 1024;
constexpr size_t WS_ADA = 41 * MiB;
constexpr size_t WS_ABL = 46 * MiB;
constexpr size_t WS_H = 48 * MiB;
constexpr size_t WS_Z = WS_H + ZB;
constexpr size_t WS_ACT = WS_Z;
constexpr size_t WS_WUP1 = WS_Z + 96 * MiB;
constexpr size_t WS_WDN1 = WS_Z + 107 * MiB;
constexpr size_t WS_WADA = WS_Z + 113 * MiB;
constexpr size_t WS_END = WS_Z + 6 * ZB + 1 * MiB;
static_assert(WS_WIN + (size_t)NIN * D * 2 <= WS_WBR, "ws map");
static_assert((size_t)M * 16 * 4 <= 2 * MiB, "ws map");
static_assert((size_t)MPAD * FF * 2 <= 96 * MiB, "ws map");
static_assert(WS_WADA + (size_t)NADA * D * 2 <= WS_Z + 6 * ZB, "ws map");

constexpr size_t O_Y = 0, O_HP = (size_t)M * D, O_CRP = O_HP + NB * D, O_SP = O_CRP + NB * 3 * D, O_CQP = O_SP + (size_t)NB * NH * 128 * 128,
                 O_HS = O_CQP + NB * 3 * 3072, O_CRS = O_HS + NS * D, O_SS = O_CRS + NS * 3 * D, O_CQS = O_SS + (size_t)NS * NH * 128 * 128,
                 O_END = O_CQS + (size_t)NS * 3 * 3072;
static_assert(2 * ZB <= (O_END - O_SS) * 4, "scratch in d_out");
constexpr size_t OSB = O_SS * 4 + 2 * ZB, OSB_HK = OSB, OSB_HV = OSB + 3 * MiB / 2, OSB_NK = OSB + 3 * MiB, OSB_NQ = OSB + 7 * MiB / 2;
static_assert(OSB + 4 * MiB <= O_END * 4, "d_out scratch");

__device__ __forceinline__ unsigned pk2(float lo, float hi);
__device__ __forceinline__ unsigned f2bf(float f) { return pk2(f, f) & 0xffffu; }
typedef float f32x2_t __attribute__((ext_vector_type(2))); typedef __bf16 bf16x2_t __attribute__((ext_vector_type(2)));
__device__ __forceinline__ unsigned pk2(float lo, float hi) { f32x2_t v = {lo, hi}; bf16x2_t b = __builtin_convertvector(v, bf16x2_t); return __builtin_bit_cast(unsigned, b); }
__device__ __forceinline__ float bf2f(unsigned short b) { return __builtin_bit_cast(float, (unsigned)b << 16); }
__device__ __forceinline__ float bflo(unsigned u) { return __builtin_bit_cast(float, u << 16); }
__device__ __forceinline__ float bfhi(unsigned u) { return __builtin_bit_cast(float, u & 0xffff0000u); }
__device__ __forceinline__ float rcp_f(float x) { return __builtin_amdgcn_rcpf(x); }
__device__ __forceinline__ float rsq_f(float x) { return __builtin_amdgcn_rsqf(x); }
__device__ __forceinline__ float sigmoid_f(float x) { return rcp_f(1.f + __expf(-x)); }
__device__ __forceinline__ float neg_expm1_f(float x) {
    const float p = -x * (1.f + x * (0.5f + x * (0.16666667f + x * (0.041666668f + x * (0.0083333338f + x * 0.0013888889f)))));
    return x > -0.3f ? p : 1.f - __expf(x);
}
__device__ __forceinline__ float silu_f(float x) { return x * sigmoid_f(x); }
__device__ __forceinline__ float gelu_tanh_f(float x) { return x * sigmoid_f(1.5957691216057308f * (x + 0.044715f * x * x * x)); }
__device__ __forceinline__ float softplus_f(float x) { return x > 20.f ? x : log1pf(__expf(x)); }
template <int CTRL> __device__ __forceinline__ float dpp_f(float x) {
    return __builtin_bit_cast(float, __builtin_amdgcn_update_dpp(0, __builtin_bit_cast(int, x), CTRL, 0xF, 0xF, true));
}
__device__ __forceinline__ float red8(float x) { x += dpp_f<0xB1>(x); x += dpp_f<0x4E>(x); x += dpp_f<0x141>(x); return x; }
__device__ __forceinline__ float red16(float x) { x = red8(x); x += dpp_f<0x140>(x); return x; }
__device__ __forceinline__ float wave_sum(float v) { v = red16(v);
    return ((__builtin_bit_cast(float, __builtin_amdgcn_readlane(__builtin_bit_cast(int, v), 0)) + __builtin_bit_cast(float, __builtin_amdgcn_readlane(__builtin_bit_cast(int, v), 16))) +
            (__builtin_bit_cast(float, __builtin_amdgcn_readlane(__builtin_bit_cast(int, v), 32)) + __builtin_bit_cast(float, __builtin_amdgcn_readlane(__builtin_bit_cast(int, v), 48)))); }
__device__ __forceinline__ int lane_now();
__device__ __forceinline__ int opq(int x);
__device__ __forceinline__ float shfl_xor_l(float v, int o) { const int idx = (opq(lane_now()) ^ o) << 2; return __builtin_bit_cast(float, __builtin_amdgcn_ds_bpermute(idx, __builtin_bit_cast(int, v))); }
__device__ __forceinline__ void unpack8(const u32x4 u, float* x) { x[0] = bflo(u.x); x[1] = bfhi(u.x); x[2] = bflo(u.y); x[3] = bfhi(u.y); x[4] = bflo(u.z); x[5] = bfhi(u.z); x[6] = bflo(u.w); x[7] = bfhi(u.w); }
__device__ __forceinline__ bf16x8 pack8(float a0, float a1, float a2, float a3, float a4, float a5, float a6, float a7) {
    u32x4 w; w.x = pk2(a0, a1); w.y = pk2(a2, a3); w.z = pk2(a4, a5); w.w = pk2(a6, a7); return __builtin_bit_cast(bf16x8, w);
}
#define LDS_WAIT() asm volatile("s_waitcnt lgkmcnt(0)" ::: "memory")
__device__ __forceinline__ int lane_now() { return (int)__builtin_amdgcn_mbcnt_hi(~0u, __builtin_amdgcn_mbcnt_lo(~0u, 0u)); }
__device__ __forceinline__ int opq(int x) { asm volatile("" : "+v"(x)); return x; }

namespace pg8 {
constexpr int BM = 256, BK = 64, HALF = 128, HTB = HALF * BK * 2, NXCD = 8, WGM = 4;
__host__ __device__ __forceinline__ int lds_byte(int r, int c) { const int st = (r >> 4) * 2 + (c >> 5), rr = r & 15, cc = c & 31, ob = rr * 64 + cc * 2; return st * 1024 + (ob ^ (((ob >> 9) & 1) << 5)); }
__host__ __device__ __forceinline__ void stage_rc(int b, int& R, int& C) { const int st = b / 1024, sb = b % 1024, swz = sb ^ (((sb >> 9) & 1) << 5); R = (st >> 1) * 16 + swz / 64; C = (st & 1) * 32 + (swz % 64) / 2; }
__host__ __device__ __forceinline__ int perm32(int rho) { const int n = rho >> 4, i = rho & 15; return 8 * (i >> 2) + 4 * n + (i & 3); }

struct Unit { int pm, pn, sub; };
struct Gemm { const bf16* A0; const bf16* B0; const bf16* A1; const bf16* B1; int K; };

struct StaticOrder {
    int nM, nN, nwg, G, c;
    __device__ void init(int Mp, int N, int G_, int c_) { nM = Mp / BM; nN = N / BM; nwg = nM * nN; G = G_; c = c_; }
    __device__ bool next(int i, Unit& u) const {
        const long L = (long)i * G + c; if (L >= nwg) return false;
        int wgid = (int)L; { const int q = nwg / NXCD, r = nwg % NXCD, xcd = wgid % NXCD, off = wgid / NXCD; wgid = (xcd < r ? xcd * (q + 1) : r * (q + 1) + (xcd - r) * q) + off; }
        const int nig = WGM * nN, gid = wgid / nig, fm = gid * WGM, gsz = (nM - fm) < WGM ? (nM - fm) : WGM;
        u.pm = fm + ((wgid % nig) % gsz); u.pn = (wgid % nig) / gsz; u.sub = 0; return true;
    }
};
struct PairOrder {
    StaticOrder base;
    __device__ bool next(int i, Unit& u) const { const bool ok = base.next(i >> 1, u); u.sub = i & 1; return ok; }
};

template <class Epi, class Sched>
__device__ __forceinline__ void gemm_phase(LAS unsigned char* lds, const Gemm g, const Sched& S, const Epi& E, int wid) {
    const int lane = opq(lane_now()), tid = (wid << 6) | lane, wr = wid >> 2, wc = wid & 3, fr = lane & 15, fq = lane >> 4;
    const int K = g.K, nt = K / BK;
    unsigned voffA[2], voffB[2];
#pragma unroll
    for (int i = 0; i < 2; ++i) { int R, C; stage_rc(tid * 16 + i * 8192, R, C); const int Rb = (R & ~31) + perm32(R & 31);
        voffA[i] = (unsigned)(R * K + C) * 2u; voffB[i] = (unsigned)(Rb * K + C) * 2u; }
    const size_t kstep = (size_t)(BK * 2);
    const size_t hstep = (size_t)HALF * K * 2;
    const size_t tstep = 2 * hstep;
    const unsigned ldsw = (unsigned)wid * 1024u;
    const int aoff = lds_byte(wr * 64 + fr, fq * 8), boff = lds_byte(wc * 32 + fr, fq * 8);
#define PG8_SA(b, h) (((b) * 2 + (h)) * HTB)
#define PG8_SB(b, h) ((4 + (b) * 2 + (h)) * HTB)
#define PG8_STAGE(bufoff, gbase, voff) do { _Pragma("unroll") for (int _i = 0; _i < 2; ++_i) \
        __builtin_amdgcn_global_load_lds((const unsigned*)((const char*)(gbase) + (voff)[_i]), (LAS unsigned*)(lds + (bufoff) + ldsw + _i * 8192), 16, 0, 0); } while (0)
#define PG8_LDA(dst, b, h) do { _Pragma("unroll") for (int m = 0; m < 4; ++m) _Pragma("unroll") for (int k = 0; k < 2; ++k) dst[m][k] = *(const LAS bf16x8*)(lds + PG8_SA(b, h) + aoff + m * 2048 + k * 1024); } while (0)
#define PG8_LDB(dst, b, h) do { _Pragma("unroll") for (int n = 0; n < 2; ++n) _Pragma("unroll") for (int k = 0; k < 2; ++k) dst[n][k] = *(const LAS bf16x8*)(lds + PG8_SB(b, h) + boff + n * 2048 + k * 1024); } while (0)
#define PG8_MMA(ai, bj, At, Bt) do { __builtin_amdgcn_s_setprio(1); _Pragma("unroll") for (int m = 0; m < 4; ++m) _Pragma("unroll") for (int n = 0; n < 2; ++n) _Pragma("unroll") for (int k = 0; k < 2; ++k) \
        acc[ai][bj][m][n] = __builtin_amdgcn_mfma_f32_16x16x32_bf16(Bt[n][k], At[m][k], acc[ai][bj][m][n], 0, 0, 0); __builtin_amdgcn_s_setprio(0); } while (0)
#define PG8_WAIT_V(n) asm volatile("s_waitcnt vmcnt(" #n ")" ::: "memory")
#define PG8_WAIT_L(n) asm volatile("s_waitcnt lgkmcnt(" #n ")" ::: "memory")
#define PG8_BAR __builtin_amdgcn_s_barrier()
#define PG8_SCHED __builtin_amdgcn_sched_barrier(0)
#define PG8_ZERO() do { _Pragma("unroll") for (int a = 0; a < 2; ++a) _Pragma("unroll") for (int b = 0; b < 2; ++b) _Pragma("unroll") for (int m = 0; m < 4; ++m) _Pragma("unroll") for (int n = 0; n < 2; ++n) acc[a][b][m][n] = (f32x4){0.f, 0.f, 0.f, 0.f}; } while (0)
    Unit cur, nxt; int ui = 0;
    if (!S.next(0, cur)) return;
    f32x4 acc[2][2][4][2];
    PG8_ZERO();
    bf16x8 At[4][2], B0[2][2], B1[2][2];
    const char* cA = (const char*)(cur.sub ? g.A1 : g.A0) + (size_t)cur.pm * tstep; const char* cB = (const char*)(cur.sub ? g.B1 : g.B0) + (size_t)cur.pn * tstep;
    PG8_STAGE(PG8_SB(0, 0), cB, voffB); PG8_STAGE(PG8_SB(0, 1), cB + hstep, voffB); PG8_STAGE(PG8_SA(0, 0), cA, voffA); PG8_STAGE(PG8_SA(0, 1), cA + hstep, voffA);
    if (wr == 1) PG8_BAR;
    PG8_WAIT_V(2); PG8_BAR;
    PG8_STAGE(PG8_SB(1, 0), cB + kstep, voffB); PG8_STAGE(PG8_SA(1, 0), cA + kstep, voffA); PG8_STAGE(PG8_SB(1, 1), cB + hstep + kstep, voffB);
    PG8_WAIT_V(6); PG8_BAR;
    for (;;) {
        const bool has_next = S.next(ui + 1, nxt);
        const char* nA = has_next ? (const char*)(nxt.sub ? g.A1 : g.A0) + (size_t)nxt.pm * tstep : cA; const char* nB = has_next ? (const char*)(nxt.sub ? g.B1 : g.B0) + (size_t)nxt.pn * tstep : cB;
        for (int t = 0; t < nt; t += 2) {
            const bool last = (t == nt - 2);
            const char* a1 = cA + (size_t)(t + 1) * kstep;
            const char* a2 = last ? nA : cA + (size_t)(t + 2) * kstep; const char* b2 = last ? nB : cB + (size_t)(t + 2) * kstep;
            const char* a3 = a2 + kstep; const char* b3 = b2 + kstep;
            PG8_LDB(B0, 0, 0); PG8_LDB(B1, 0, 1); PG8_SCHED; PG8_LDA(At, 0, 0); PG8_STAGE(PG8_SA(1, 1), a1 + hstep, voffA);
            PG8_WAIT_V(8); PG8_WAIT_L(0); PG8_BAR; PG8_MMA(0, 0, At, B0); PG8_MMA(0, 1, At, B1); PG8_BAR; PG8_SCHED;
            PG8_LDA(At, 0, 1); PG8_STAGE(PG8_SB(0, 0), b2, voffB); PG8_STAGE(PG8_SB(0, 1), b2 + hstep, voffB); PG8_STAGE(PG8_SA(0, 0), a2, voffA);
            PG8_WAIT_V(8); PG8_WAIT_L(0); PG8_BAR; PG8_MMA(1, 0, At, B0); PG8_MMA(1, 1, At, B1); PG8_BAR; PG8_SCHED;
            PG8_LDB(B0, 1, 0); PG8_LDB(B1, 1, 1); PG8_SCHED; PG8_LDA(At, 1, 0); PG8_STAGE(PG8_SA(0, 1), a2 + hstep, voffA);
            PG8_WAIT_V(8); PG8_WAIT_L(0); PG8_BAR; PG8_MMA(0, 0, At, B0); PG8_MMA(0, 1, At, B1); PG8_BAR; PG8_SCHED;
            PG8_LDA(At, 1, 1); PG8_STAGE(PG8_SB(1, 0), b3, voffB); PG8_STAGE(PG8_SB(1, 1), b3 + hstep, voffB); PG8_STAGE(PG8_SA(1, 0), a3, voffA);
            PG8_WAIT_V(8); PG8_WAIT_L(0); PG8_BAR; PG8_MMA(1, 0, At, B0); PG8_MMA(1, 1, At, B1); PG8_BAR; PG8_SCHED;
        }
        if (wr == 0) PG8_BAR;
        bool keep = false;
        if constexpr (Epi::KEEP) { if (cur.sub == 0) { E.mid(acc, cur, wr, wc, fr, fq); keep = true; } else E(acc, cur, wr, wc, fr, fq); }
        else E(acc, cur, wr, wc, fr, fq);
        if (!has_next) break;
        if (!keep) PG8_ZERO();
        cur = nxt; cA = nA; cB = nB; ++ui;
        if (wr == 1) PG8_BAR;
    }
    PG8_WAIT_V(0);
    PG8_BAR;
#undef PG8_SA
#undef PG8_SB
#undef PG8_STAGE
#undef PG8_LDA
#undef PG8_LDB
#undef PG8_MMA
#undef PG8_WAIT_V
#undef PG8_WAIT_L
#undef PG8_BAR
#undef PG8_SCHED
#undef PG8_ZERO
}
}

typedef f32x4 AccT[2][2][4][2];
__device__ __forceinline__ int cond_of_row(int row) { return row < MPR ? (row >> 11) : (NB + row - MPR); }

struct EpiAda {
    static constexpr bool KEEP = false;
    float* ada; const float* bias;
    __device__ __forceinline__ void operator()(const AccT& acc, const pg8::Unit& u, int wr, int wc, int fr, int fq) const {
#pragma unroll
        for (int ai = 0; ai < 2; ++ai)
#pragma unroll
            for (int m = 0; m < 4; ++m) { const int row = u.pm * 256 + ai * 128 + wr * 64 + m * 16 + fr; if (row >= NCOND) continue;
#pragma unroll
                for (int bj = 0; bj < 2; ++bj)
#pragma unroll
                    for (int n = 0; n < 2; ++n) { const int col = u.pn * 256 + bj * 128 + wc * 32 + 8 * fq + 4 * n;
                        *(f32x4*)(ada + (size_t)row * NADA + col) = acc[ai][bj][m][n] + *(const f32x4*)(bias + col); } }
    }
};
struct EpiSwiglu {
    static constexpr bool KEEP = false;
    bf16* act;
    __device__ __forceinline__ void operator()(const AccT& acc, const pg8::Unit& u, int wr, int wc, int fr, int fq) const {
#pragma unroll
        for (int ai = 0; ai < 2; ++ai)
#pragma unroll
            for (int m = 0; m < 4; ++m) { const int row = u.pm * 256 + ai * 128 + wr * 64 + m * 16 + fr; if (row >= M) continue;
                const f32x4 g0 = acc[ai][0][m][0], g1 = acc[ai][0][m][1], v0 = acc[ai][1][m][0], v1 = acc[ai][1][m][1];
                u32x4 w; w.x = pk2(silu_f(g0[0]) * v0[0], silu_f(g0[1]) * v0[1]); w.y = pk2(silu_f(g0[2]) * v0[2], silu_f(g0[3]) * v0[3]);
                w.z = pk2(silu_f(g1[0]) * v1[0], silu_f(g1[1]) * v1[1]); w.w = pk2(silu_f(g1[2]) * v1[2], silu_f(g1[3]) * v1[3]);
                *(u32x4*)(act + (size_t)row * FF + u.pn * 128 + wc * 32 + 8 * fq) = w; }
    }
};
struct EpiResid {
    static constexpr bool KEEP = false;
    float* X; const float* xp; const float* xs; const float* gate; float coef;
    __device__ __forceinline__ void operator()(const AccT& acc, const pg8::Unit& u, int wr, int wc, int fr, int fq) const {
#pragma unroll
        for (int ai = 0; ai < 2; ++ai)
#pragma unroll
            for (int m = 0; m < 4; ++m) { const int row = u.pm * 256 + ai * 128 + wr * 64 + m * 16 + fr; if (row >= M) continue;
                const float* xin = xp ? (row < MPR ? xp + (size_t)row * D : xs + (size_t)(row - MPR) * D) : X + (size_t)row * D;
                const float* gt = gate + (size_t)cond_of_row(row) * NADA;
#pragma unroll
                for (int bj = 0; bj < 2; ++bj)
#pragma unroll
                    for (int n = 0; n < 2; ++n) { const int col = u.pn * 256 + bj * 128 + wc * 32 + 8 * fq + 4 * n;
                        const f32x4 xv = *(const f32x4*)(xin + col), gv = *(const f32x4*)(gt + col);
                        *(f32x4*)(X + (size_t)row * D + col) = xv + (gv * coef) * acc[ai][bj][m][n]; } }
    }
};
constexpr size_t WS_CNT = 14336, WS_PART = 65536;
template <int MODE> struct EpiResidNorm {
    static constexpr bool KEEP = false;
    float* X; const float* xp; const float* gate; float coef; const float* gvec; const float* shift; bf16* Hout; float* part; unsigned* cnt; LAS float* sred;
    __device__ __forceinline__ void operator()(AccT& acc, const pg8::Unit& u, int wr, int wc, int fr_, int fq_) const {
        const int fr = opq(fr_), fq = opq(fq_);
        const int tid = wr * 256 + wc * 64 + fq * 16 + fr, bidx = u.pm >> 3;
        const float* gt = gate + (size_t)bidx * NADA;
        float ss[2][4]; int zoff = 0;
#pragma unroll
        for (int ai = 0; ai < 2; ++ai)
#pragma unroll
            for (int m = 0; m < 4; ++m) { const int row = u.pm * 256 + ai * 128 + wr * 64 + m * 16 + fr + zoff;
                const float* xin = xp ? xp + (size_t)row * D : X + (size_t)row * D; float sacc = 0.f;
#pragma unroll
                for (int bj = 0; bj < 2; ++bj)
#pragma unroll
                    for (int n = 0; n < 2; ++n) { const int col = u.pn * 256 + bj * 128 + wc * 32 + 8 * fq + 4 * n;
                        const f32x4 xv = *(const f32x4*)(xin + col), gv = *(const f32x4*)(gt + col);
                        const f32x4 xn = xv + (gv * coef) * acc[ai][bj][m][n]; acc[ai][bj][m][n] = xn;
                        if (MODE == 0) *(f32x4*)(X + (size_t)row * D + col) = xn;
                        sacc += (xn[0] * xn[0] + xn[1] * xn[1]) + (xn[2] * xn[2] + xn[3] * xn[3]); }
                asm volatile("" : "+v"(zoff) : "v"(sacc));
                sacc += shfl_xor_l(sacc, 16); sacc += shfl_xor_l(sacc, 32);
                ss[ai][m] = sacc; __builtin_amdgcn_sched_barrier(0); }
        if (fq == 0) {
#pragma unroll
            for (int ai = 0; ai < 2; ++ai)
#pragma unroll
                for (int m = 0; m < 4; ++m) sred[wc * 256 + ai * 128 + wr * 64 + m * 16 + fr] = ss[ai][m]; }
        __syncthreads();
        if (tid < 256) __hip_atomic_store((unsigned*)part + ((size_t)u.pm * 4 + u.pn) * 256 + tid, __builtin_bit_cast(unsigned, (sred[tid] + sred[256 + tid]) + (sred[512 + tid] + sred[768 + tid])), __ATOMIC_RELAXED, __HIP_MEMORY_SCOPE_AGENT);
        asm volatile("s_waitcnt vmcnt(0)" ::: "memory");
        __syncthreads();
        if (tid == 0) { __hip_atomic_fetch_add(cnt + u.pm, 1u, __ATOMIC_RELAXED, __HIP_MEMORY_SCOPE_AGENT);
            unsigned sp = 0; while (__hip_atomic_load(cnt + u.pm, __ATOMIC_RELAXED, __HIP_MEMORY_SCOPE_AGENT) < 4u && ++sp < (1u << 24)) __builtin_amdgcn_s_sleep(1); }
        __syncthreads();
        if (tid < 256) { unsigned* pp = (unsigned*)part + (size_t)u.pm * 4 * 256 + tid;
            const float p0 = __builtin_bit_cast(float, __hip_atomic_load(pp, __ATOMIC_RELAXED, __HIP_MEMORY_SCOPE_AGENT)), p1 = __builtin_bit_cast(float, __hip_atomic_load(pp + 256, __ATOMIC_RELAXED, __HIP_MEMORY_SCOPE_AGENT));
            const float p2 = __builtin_bit_cast(float, __hip_atomic_load(pp + 512, __ATOMIC_RELAXED, __HIP_MEMORY_SCOPE_AGENT)), p3 = __builtin_bit_cast(float, __hip_atomic_load(pp + 768, __ATOMIC_RELAXED, __HIP_MEMORY_SCOPE_AGENT));
            sred[1024 + tid] = rsq_f(((p0 + p1) + (p2 + p3)) * (1.f / D) + EPS); }
        __syncthreads();
        const float* sh = MODE == 0 ? shift + (size_t)bidx * NADA : nullptr;
#pragma unroll
        for (int bj = 0; bj < 2; ++bj) { const int col = u.pn * 256 + bj * 128 + wc * 32 + 8 * fq;
            const f32x4 g0 = *(const f32x4*)(gvec + col), g1 = *(const f32x4*)(gvec + col + 4);
            f32x4 a0 = g0, a1 = g1, b0 = {0.f, 0.f, 0.f, 0.f}, b1 = b0;
            if (MODE == 0) { a0 = g0 * (*(const f32x4*)(sh + D + col) + 1.f); a1 = g1 * (*(const f32x4*)(sh + D + col + 4) + 1.f); b0 = *(const f32x4*)(sh + col); b1 = *(const f32x4*)(sh + col + 4); }
#pragma unroll
            for (int ai = 0; ai < 2; ++ai)
#pragma unroll
                for (int m = 0; m < 4; ++m) { const int rl = ai * 128 + wr * 64 + m * 16 + fr; const size_t row = (size_t)u.pm * 256 + rl; const float rstd = sred[1024 + rl];
                    const f32x4 y0 = acc[ai][bj][m][0] * rstd * a0 + b0, y1 = acc[ai][bj][m][1] * rstd * a1 + b1;
                    if (MODE == 0) *(bf16x8*)(Hout + row * D + col) = pack8(y0[0], y0[1], y0[2], y0[3], y1[0], y1[1], y1[2], y1[3]);
                    else { __builtin_nontemporal_store(y0, (f32x4*)(X + row * D + col)); __builtin_nontemporal_store(y1, (f32x4*)(X + row * D + col + 4)); }
                    __builtin_amdgcn_sched_barrier(0); }
        }
        __syncthreads();
    }
};
struct EpiIn {
    static constexpr bool KEEP = false;
    bf16* z; bf16* mg; float* abl; float* out;
    __device__ __forceinline__ void operator()(const AccT& acc, const pg8::Unit& u, int wr, int wc, int fr, int fq) const {
        const int bi = u.pn >> 2;
        if (bi == 8) {
            if (wc == 0 && fq < 2) {
#pragma unroll
                for (int ai = 0; ai < 2; ++ai)
#pragma unroll
                    for (int m = 0; m < 4; ++m) { const int row = u.pm * 256 + ai * 128 + wr * 64 + m * 16 + fr; if (row >= M) continue;
                        *(f32x4*)(abl + (size_t)row * 16 + 8 * fq) = acc[ai][0][m][0]; *(f32x4*)(abl + (size_t)row * 16 + 8 * fq + 4) = acc[ai][0][m][1]; }
            }
            return;
        }
        bf16* base = bi < 6 ? z + (size_t)bi * (ZB / 2) : mg + (size_t)(bi - 6) * (ZB / 2);
        const int act = (bi == 1) ? 1 : (bi == 5) ? 2 : (bi >= 6) ? 3 : 0;
        const int colt = (u.pn & 3) * 256 + wc * 32 + 8 * fq;
#pragma unroll
        for (int ai = 0; ai < 2; ++ai)
#pragma unroll
            for (int m = 0; m < 4; ++m) { const int row = u.pm * 256 + ai * 128 + wr * 64 + m * 16 + fr; if (row >= M) continue;
#pragma unroll
                for (int bj = 0; bj < 2; ++bj) { f32x4 v0 = acc[ai][bj][m][0], v1 = acc[ai][bj][m][1];
                    if (act == 1) {
#pragma unroll
                        for (int j = 0; j < 4; ++j) { v0[j] = gelu_tanh_f(v0[j]); v1[j] = gelu_tanh_f(v1[j]); } }
                    else if (act == 2) {
#pragma unroll
                        for (int j = 0; j < 4; ++j) { v0[j] = silu_f(v0[j]); v1[j] = silu_f(v1[j]); } }
                    else if (act == 3) {
#pragma unroll
                        for (int j = 0; j < 4; ++j) { v0[j] = sigmoid_f(v0[j]); v1[j] = sigmoid_f(v1[j]); } }
                    u32x4 w; w.x = pk2(v0[0], v0[1]); w.y = pk2(v0[2], v0[3]); w.z = pk2(v1[0], v1[1]); w.w = pk2(v1[2], v1[3]);
                    if (bi >= 6) __builtin_nontemporal_store(w, (u32x4*)(base + (size_t)row * D + colt + bj * 128));
                    else *(u32x4*)(base + (size_t)row * D + colt + bj * 128) = w;
                    if (act == 0 && row < MPR) { const int rs = row & (SEQ - 1), r64 = row & 63, bb = row >> 11, col = colt + bj * 128;
                        if (bi >= 3 && r64 >= 61 && rs < SEQ - 3)
                            *(u32x4*)((bf16*)((unsigned char*)out + (bi == 3 ? OSB_HK : OSB_HV)) + ((size_t)(bb * 32 + (rs >> 6) + 1) * 3 + (r64 - 61)) * D + col) = w;
                        if (rs >= SEQ - 3) { float* dst = bi == 0 ? out + O_CRP + ((size_t)bb * 3 + (rs - (SEQ - 3))) * D + col : out + O_CQP + ((size_t)bb * 3 + (rs - (SEQ - 3))) * 3072 + (bi - 2) * 1024 + col;
                            *(f32x4*)dst = v0; *(f32x4*)(dst + 4) = v1; } }
                } }
    }
};
struct EpiBranch {
    static constexpr bool KEEP = true;
    const bf16* mga; const bf16* mgb; bf16* G;
    __device__ __forceinline__ void mid(AccT& acc, const pg8::Unit& u, int wr, int wc, int fr, int fq) const {
#pragma unroll
        for (int ai = 0; ai < 2; ++ai)
#pragma unroll
            for (int m = 0; m < 4; ++m) { int row = u.pm * 256 + ai * 128 + wr * 64 + m * 16 + fr; if (row >= M) row = M - 1;
#pragma unroll
                for (int bj = 0; bj < 2; ++bj) { const size_t o = (size_t)row * D + u.pn * 256 + bj * 128 + wc * 32 + 8 * fq;
                    const u32x4 a = *(const u32x4*)(mga + o), b = *(const u32x4*)(mgb + o);
                    f32x4 r0, r1;
                    r0[0] = bflo(a.x) * rcp_f(bflo(b.x)); r0[1] = bfhi(a.x) * rcp_f(bfhi(b.x)); r0[2] = bflo(a.y) * rcp_f(bflo(b.y)); r0[3] = bfhi(a.y) * rcp_f(bfhi(b.y));
                    r1[0] = bflo(a.z) * rcp_f(bflo(b.z)); r1[1] = bfhi(a.z) * rcp_f(bfhi(b.z)); r1[2] = bflo(a.w) * rcp_f(bflo(b.w)); r1[3] = bfhi(a.w) * rcp_f(bfhi(b.w));
                    acc[ai][bj][m][0] = acc[ai][bj][m][0] * r0; acc[ai][bj][m][1] = acc[ai][bj][m][1] * r1; } }
    }
    __device__ __forceinline__ void operator()(const AccT& acc, const pg8::Unit& u, int wr, int wc, int fr, int fq) const {
#pragma unroll
        for (int ai = 0; ai < 2; ++ai)
#pragma unroll
            for (int m = 0; m < 4; ++m) { const int row = u.pm * 256 + ai * 128 + wr * 64 + m * 16 + fr; if (row >= M) continue;
#pragma unroll
                for (int bj = 0; bj < 2; ++bj) { const size_t o = (size_t)row * D + u.pn * 256 + bj * 128 + wc * 32 + 8 * fq;
                    const u32x4 b = *(const u32x4*)(mgb + o);
                    const f32x4 v0 = acc[ai][bj][m][0], v1 = acc[ai][bj][m][1];
                    u32x4 w; w.x = pk2(v0[0] * bflo(b.x), v0[1] * bfhi(b.x)); w.y = pk2(v0[2] * bflo(b.y), v0[3] * bfhi(b.y));
                    w.z = pk2(v1[0] * bflo(b.z), v1[1] * bfhi(b.z)); w.w = pk2(v1[2] * bflo(b.w), v1[3] * bfhi(b.w));
                    *(u32x4*)(G + o) = w; } }
    }
};

__device__ __forceinline__ f32x4 mini_partial(const bf16* A, const bf16* Bt, int K, int row0, int col0, int ks, int lane) {
    const int kq = K >> 2;
    const bf16* ap = A + (size_t)(MPR + row0 + (lane & 15)) * K + ks * kq + (lane >> 4) * 8;
    const bf16* bp = Bt + (size_t)(col0 + (lane & 15)) * K + ks * kq + (lane >> 4) * 8;
    f32x4 acc = {0.f, 0.f, 0.f, 0.f};
#pragma unroll 1
    for (int k0 = 0; k0 < kq; k0 += 256) {
        bf16x8 a[8], b[8];
#pragma unroll
        for (int i = 0; i < 8; ++i) if (k0 + 32 * i < kq) { a[i] = *(const bf16x8*)(ap + k0 + 32 * i); b[i] = *(const bf16x8*)(bp + k0 + 32 * i); }
#pragma unroll
        for (int i = 0; i < 8; ++i) if (k0 + 32 * i < kq) acc = __builtin_amdgcn_mfma_f32_16x16x32_bf16(b[i], a[i], acc, 0, 0, 0);
    }
    return acc;
}
template <class F>
__device__ __forceinline__ void mini_gemm(LAS unsigned char* lds, const bf16* A0, const bf16* B0, const bf16* A1, const bf16* B1, int K, int wg, int G, int tid_, const F& epi) {
    const int tid = opq(tid_), lane = tid & 63, wave = tid >> 6, ks = wave & 3;
    LAS f32x4* red = (LAS f32x4*)lds;
    for (int t0 = wg * 2; t0 < 512; t0 += G * 2) {
        const int tile = t0 + (wave >> 2), row0 = (tile >> 6) * 16, col0 = (tile & 63) * 16;
        f32x4 p0 = mini_partial(A0, B0, K, row0, col0, ks, lane), p1 = {0.f, 0.f, 0.f, 0.f};
        if (A1) p1 = mini_partial(A1, B1, K, row0, col0, ks, lane);
        red[(wave * 2) * 64 + lane] = p0; red[(wave * 2 + 1) * 64 + lane] = p1;
        __syncthreads();
        if (ks == 0) {
#pragma unroll
            for (int w = 1; w < 4; ++w) { p0 = p0 + red[((wave + w) * 2) * 64 + lane]; p1 = p1 + red[((wave + w) * 2 + 1) * 64 + lane]; }
            epi(MPR + row0 + (lane & 15), col0 + 4 * (lane >> 4), p0, p1);
        }
        __syncthreads();
    }
}

struct Params { const float* in[32]; float* out; unsigned char* ws; };
constexpr int LDS_BYTES = 147456;
#ifndef PHM
#define PHM 0xFFFF
#endif
#ifndef P7M
#define P7M 0xF
#endif

struct Ctx {
    const float* const* in; float* out; unsigned char* ws; LAS unsigned char* lds;
    int tid, lane, wave, wg, G;
};
#define KAS __attribute__((address_space(4)))
typedef const float* cfptr_t; typedef float* fptr_t; typedef unsigned char* ucptr_t;
__device__ __forceinline__ const float* karg_in(int k) { return *(volatile KAS cfptr_t*)((const KAS char*)__builtin_amdgcn_kernarg_segment_ptr() + 8 * k); }
__device__ __forceinline__ float* karg_out() { return *(volatile KAS fptr_t*)((const KAS char*)__builtin_amdgcn_kernarg_segment_ptr() + 256); }
__device__ __forceinline__ unsigned char* karg_ws() { return *(volatile KAS ucptr_t*)((const KAS char*)__builtin_amdgcn_kernarg_segment_ptr() + 264); }
#define INP(k) karg_in(k)

template <int MODE>
__device__ __forceinline__ void sample_norm_rows(const float* gvec, int ish, int gw, int lane) {
    if (gw >= NS) return;
    const int row = MPR + gw; float* X = karg_out() + (size_t)row * D;
    f32x4 v[4]; float s = 0.f;
#pragma unroll
    for (int j = 0; j < 4; ++j) { v[j] = *(const f32x4*)(X + 4 * (lane + 64 * j)); s += (v[j][0] * v[j][0] + v[j][1] * v[j][1]) + (v[j][2] * v[j][2] + v[j][3] * v[j][3]); }
    const float rstd = rsq_f(wave_sum(s) * (1.f / D) + EPS);
    const float* sh = (const float*)(karg_ws() + WS_ADA) + (size_t)cond_of_row(row) * NADA + ish * D;
#pragma unroll
    for (int j = 0; j < 4; ++j) { const int col = 4 * (lane + 64 * j); const f32x4 g = *(const f32x4*)(gvec + col);
        if (MODE == 0) { const f32x4 y = (v[j] * rstd * g) * (*(const f32x4*)(sh + D + col) + 1.f) + *(const f32x4*)(sh + col);
            u32x2 o; o.x = pk2(y[0], y[1]); o.y = pk2(y[2], y[3]); *(u32x2*)((bf16*)(karg_ws() + WS_H) + (size_t)row * D + col) = o; }
        else *(f32x4*)(X + col) = v[j] * rstd * g; }
}
__device__ __forceinline__ void transpose_item(const float* W, int ldw, int k0, int n0, int nvalid, bf16* WT, int ldt, int drow0, LAS float* scr, int lane) {
    const int cc = lane & 31;
#pragma unroll 8
    for (int i = 0; i < 32; ++i) { const int kk = 2 * i + (lane >> 5); scr[kk * 33 + cc] = (cc < nvalid) ? __builtin_nontemporal_load(W + (size_t)(k0 + kk) * ldw + n0 + cc) : 0.f; }
    LDS_WAIT(); asm volatile("" ::: "memory");
    const int c = lane & 7;
#pragma unroll
    for (int j = 0; j < 4; ++j) { const int n = (lane >> 3) + 8 * j; const LAS float* s = scr + (8 * c) * 33 + n;
        u32x4 o; o.x = pk2(s[0 * 33], s[1 * 33]); o.y = pk2(s[2 * 33], s[3 * 33]); o.z = pk2(s[4 * 33], s[5 * 33]); o.w = pk2(s[6 * 33], s[7 * 33]);
        if (n < nvalid) *(u32x4*)(WT + (size_t)(drow0 + n) * ldt + k0 + 8 * c) = o; }
    LDS_WAIT(); asm volatile("" ::: "memory");
}

template <int PART>
__device__ __forceinline__ void prologue(const Params& P, LAS unsigned char* lds, int gw, int NGW, int wave, int lane) {
    LAS float* scr = (LAS float*)(lds + wave * 16384);
    unsigned char* ws = karg_ws();
    constexpr int I_UP = 16 * 176, I_DN = 44 * 32, I_IN = 16 * 257, I_BR = 2 * 16 * 32, I_OUT = 16 * 32, I_ADA = 16 * 288, I_RG = 128;
    constexpr int NITEMS = 2 * I_UP + 2 * I_DN + I_IN + I_BR + I_OUT + I_ADA + I_RG;
    constexpr int I_FIRST = 2 * I_UP + 2 * I_DN + I_IN + I_BR + I_OUT;
    for (int it = gw; it < NITEMS; it += NGW) {
        int r = it;
        if (PART == 0) { if (r >= I_ADA) break; r += I_FIRST; } else { if (r >= NITEMS - I_ADA) break; if (r >= I_FIRST) r += I_ADA; }
        if (r < 2 * I_UP) { const int which = r / I_UP; r -= which * I_UP; const int kb = r / 176, nb = r % 176, n0 = nb * 32; const int half = n0 >= FF ? 1 : 0, np = n0 - half * FF;
            transpose_item(INP(which ? 29 : 11), 2 * FF, kb * 64, n0, 32, (bf16*)(ws + (which ? WS_WUP2 : WS_WUP1)), D, (np >> 7) * 256 + half * 128 + (np & 127), scr, lane); continue; }
        r -= 2 * I_UP;
        if (r < 2 * I_DN) { const int which = r / I_DN; r -= which * I_DN; const int kb = r / 32, nb = r % 32;
            transpose_item(INP(which ? 30 : 12), D, kb * 64, nb * 32, 32, (bf16*)(ws + (which ? WS_WDN2 : WS_WDN1)), FF, nb * 32, scr, lane); continue; }
        r -= 2 * I_DN;
        if (r < I_IN) { const int kb = r / 257, nb = r % 257; int n0, nv, dr;
            if (nb < 160) { n0 = nb * 32; nv = 32; dr = n0; } else if (nb == 160) { n0 = 5120; nv = 16; dr = 8192; } else { n0 = 5136 + (nb - 161) * 32; nv = 32; dr = 5120 + (nb - 161) * 32; }
            transpose_item(INP(14), 8208, kb * 64, n0, nv, (bf16*)(ws + WS_WIN), D, dr, scr, lane); continue; }
        r -= I_IN;
        if (r < I_BR) { const int which = r / 512; r -= which * 512; const int kb = r / 32, nb = r % 32;
            transpose_item(INP(26) + (size_t)which * D * D, D, kb * 64, nb * 32, 32, (bf16*)(ws + WS_WBR), D, which * D + nb * 32, scr, lane); continue; }
        r -= I_BR;
        if (r < I_OUT) { const int kb = r / 32, nb = r % 32; transpose_item(INP(27), D, kb * 64, nb * 32, 32, (bf16*)(ws + WS_WOUT), D, nb * 32, scr, lane); continue; }
        r -= I_OUT;
        if (r < I_ADA) { const int kb = r / 288, nb = r % 288; transpose_item(INP(8), NADA, kb * 64, nb * 32, 32, (bf16*)(ws + WS_WADA), D, nb * 32, scr, lane); continue; }
        r -= I_ADA;
        { const int gx = r >> 6, n = (r >> 3) & 7, kb = (r >> 2) & 1, nb = r & 3;
          transpose_item(INP(gx ? 19 : 17) + (size_t)n * 128 * 128, 128, kb * 64, nb * 32, 32, (bf16*)(ws + WS_WRG), 128, n * 256 + gx * 128 + nb * 32, scr, lane); }
    }
    bf16* cb = (bf16*)(ws + WS_CB);
    if (PART == 0) for (int row = gw; row < 256; row += NGW) {
        const float* src = row < NB ? INP(2) + (size_t)row * D : (row < NCOND ? INP(3) + (size_t)(row - NB) * D : nullptr);
#pragma unroll
        for (int j = 0; j < 4; ++j) { const int col = 4 * (lane + 64 * j); f32x4 v = src ? *(const f32x4*)(src + col) : (f32x4){0.f, 0.f, 0.f, 0.f};
            u32x2 o; o.x = pk2(v[0], v[1]); o.y = pk2(v[2], v[3]); *(u32x2*)(cb + (size_t)row * D + col) = o; }
    }
}

template <int MODE>
__device__ __forceinline__ void norm_mod_pass(const Params& P, const float* gvec, int ish, int gw, int NGW, int lane) {
    const float* ada = (const float*)(karg_ws() + WS_ADA); bf16* H = (bf16*)(karg_ws() + WS_H);
    const float* xp = INP(0); const float* xs = INP(1); const float* X = karg_out();
    for (int row0 = 2 * gw; row0 < M; row0 += 2 * NGW) {
        f32x4 v[2][4]; float s[2] = {0.f, 0.f};
#pragma unroll
        for (int u = 0; u < 2; ++u) { const int row = row0 + u;
            const float* xr = MODE == 0 ? (row < MPR ? xp + (size_t)row * D : xs + (size_t)(row - MPR) * D) : X + (size_t)row * D;
#pragma unroll
            for (int j = 0; j < 4; ++j) v[u][j] = *(const f32x4*)(xr + 4 * (lane + 64 * j)); }
#pragma unroll
        for (int u = 0; u < 2; ++u)
#pragma unroll
            for (int j = 0; j < 4; ++j) s[u] += (v[u][j][0] * v[u][j][0] + v[u][j][1] * v[u][j][1]) + (v[u][j][2] * v[u][j][2] + v[u][j][3] * v[u][j][3]);
        s[0] = wave_sum(s[0]); s[1] = wave_sum(s[1]);
#pragma unroll
        for (int u = 0; u < 2; ++u) { const int row = row0 + u; const float rstd = rsq_f(s[u] * (1.f / D) + EPS);
            const float* sh = ada + (size_t)cond_of_row(row) * NADA + ish * D; const float* sc = sh + D;
#pragma unroll
            for (int j = 0; j < 4; ++j) { const int col = 4 * (lane + 64 * j); const f32x4 g = *(const f32x4*)(gvec + col), a = *(const f32x4*)(sc + col), bb = *(const f32x4*)(sh + col);
                const f32x4 y = (v[u][j] * rstd * g) * (a + 1.f) + bb; u32x2 o; o.x = pk2(y[0], y[1]); o.y = pk2(y[2], y[3]); *(u32x2*)(H + (size_t)row * D + col) = o; } }
    }
}
__device__ __forceinline__ void final_norm_pass(const Params& P, int gw, int NGW, int lane) {
    const float* gvec = INP(31); float* X = karg_out();
    for (int row0 = 2 * gw; row0 < M; row0 += 2 * NGW) {
        f32x4 v[2][4]; float s[2] = {0.f, 0.f};
#pragma unroll
        for (int u = 0; u < 2; ++u)
#pragma unroll
            for (int j = 0; j < 4; ++j) v[u][j] = *(const f32x4*)(X + (size_t)(row0 + u) * D + 4 * (lane + 64 * j));
#pragma unroll
        for (int u = 0; u < 2; ++u)
#pragma unroll
            for (int j = 0; j < 4; ++j) s[u] += (v[u][j][0] * v[u][j][0] + v[u][j][1] * v[u][j][1]) + (v[u][j][2] * v[u][j][2] + v[u][j][3] * v[u][j][3]);
        s[0] = wave_sum(s[0]); s[1] = wave_sum(s[1]);
#pragma unroll
        for (int u = 0; u < 2; ++u) { const float rstd = rsq_f(s[u] * (1.f / D) + EPS);
#pragma unroll
            for (int j = 0; j < 4; ++j) { const int col = 4 * (lane + 64 * j); *(f32x4*)(X + (size_t)(row0 + u) * D + col) = v[u][j] * rstd * *(const f32x4*)(gvec + col); } }
    }
}
__device__ __forceinline__ void onorm_pass(const Params& P, int gw, int NGW, int lane) {
    const bf16* O = (const bf16*)(karg_ws() + WS_H); bf16* ZG = (bf16*)(karg_ws() + WS_Z + 5 * ZB); const float* dn = INP(25);
    const int dc = (lane & 7) * 16;
    for (int row0 = 2 * gw; row0 < M; row0 += 2 * NGW) {
        u32x4 a[2][2], z[2][2];
#pragma unroll
        for (int u = 0; u < 2; ++u) { const size_t o = (size_t)(row0 + u) * D + lane * 16;
            a[u][0] = *(const u32x4*)(O + o); a[u][1] = *(const u32x4*)(O + o + 8); z[u][0] = *(const u32x4*)(ZG + o); z[u][1] = *(const u32x4*)(ZG + o + 8); }
#pragma unroll
        for (int u = 0; u < 2; ++u) { const size_t o = (size_t)(row0 + u) * D + lane * 16;
            float v[16], zz[16]; unpack8(a[u][0], v); unpack8(a[u][1], v + 8); unpack8(z[u][0], zz); unpack8(z[u][1], zz + 8);
            float s = 0.f;
#pragma unroll
            for (int e = 0; e < 16; ++e) s += v[e] * v[e];
            s = red8(s);
            const float rstd = rsq_f(s * (1.f / 128.f) + EPS);
#pragma unroll
            for (int e = 0; e < 16; ++e) v[e] = v[e] * rstd * dn[dc + e] * zz[e];
            *(bf16x8*)(ZG + o) = pack8(v[0], v[1], v[2], v[3], v[4], v[5], v[6], v[7]); *(bf16x8*)(ZG + o + 8) = pack8(v[8], v[9], v[10], v[11], v[12], v[13], v[14], v[15]); }
    }
}

constexpr int SS_TAIL = 530;
constexpr int RG_SPLIT = 7;
constexpr size_t WS_HCARRY = 917504;
__device__ __forceinline__ void rglru_task(const Params& P, LAS unsigned char* lds, int b, int n, int qd, int tid, int t0, int t1) {
    const int lane = tid & 63, wave = tid >> 6;
    LAS bf16* xcA = (LAS bf16*)lds;
    LAS float* xcf = (LAS float*)(lds + 34816);
    LAS float* rb = (LAS float*)(lds + 51200);
    LAS float* ib = (LAS float*)(lds + 67584);
    LAS float* segA = (LAS float*)(lds + 83968);
    LAS float* segB = (LAS float*)(lds + 86016);
    LAS float* hc = (LAS float*)(lds + 88064);
    LAS float* cw = (LAS float*)(lds + 88192);
    LAS bf16* rawt = (LAS bf16*)(lds + 90752);
    bf16* XR = (bf16*)(karg_ws() + WS_Z); bf16* GR = (bf16*)(karg_ws() + WS_Z + ZB);
    const bf16* WRG = (const bf16*)(karg_ws() + WS_WRG);
    const int cb0 = n * 128, oc0 = cb0 + qd * 32;
    const bool prompt = b >= 0;
    for (int i = tid; i < 640; i += NTHR) cw[i] = i < 512 ? INP(15)[(size_t)(i >> 7) * D + cb0 + (i & 127)] : INP(16)[cb0 + (i - 512)];
    if (tid < 32) hc[tid] = t0 > 0 ? ((const float*)(karg_ws() + WS_HCARRY))[(size_t)b * D + oc0 + tid] : 0.f;
    const int tb = wave & 3, cbk = wave >> 2;
    bf16x8 Bf[8];
    { const bf16* wrow = WRG + (size_t)(n * 256 + cbk * 128 + qd * 32 + (lane & 31)) * 128 + (lane >> 5) * 8;
#pragma unroll
      for (int ks = 0; ks < 8; ++ks) Bf[ks] = *(const bf16x8*)(wrow + ks * 16); }
    const float gbias = INP(cbk ? 20 : 18)[oc0 + (lane & 31)];
    const int ch = tid & 31, seg = tid >> 5;
    const float sp = softplus_f(-INP(21)[oc0 + ch]);
    float hlast = 0.f;
    u32x4 pre[5];
#define RG_RAW_LOAD(tile_) do { _Pragma("unroll") for (int i = 0; i < 5; ++i) { const int q = tid + 512 * i, row = q >> 4, c16 = q & 15, tl = (tile_) * 128 - 3 + row; \
        pre[i] = (q < 131 * 16 && tl >= 0) ? *(const u32x4*)(XR + ((size_t)b * SEQ + tl) * D + cb0 + c16 * 8) : (u32x4){0u, 0u, 0u, 0u}; } } while (0)
#define RG_RAW_STORE() do { _Pragma("unroll") for (int i = 0; i < 5; ++i) { const int q = tid + 512 * i; if (q < 131 * 16) *(LAS u32x4*)(rawt + (q >> 4) * 136 + (q & 15) * 8) = pre[i]; } } while (0)
    if (prompt) { RG_RAW_LOAD(t0); RG_RAW_STORE(); }
    __syncthreads();
    const int ntiles = t1;
    for (int tile = t0; tile < ntiles; ++tile) {
        const int row0 = prompt ? b * SEQ + tile * 128 : MPR;
        if (prompt && tile + 1 < ntiles) RG_RAW_LOAD(tile + 1);
        { const int t = tid >> 2, cq = tid & 3, c0 = cq * 32;
#pragma unroll 2
          for (int q = 0; q < 4; ++q) {
              const int cc = c0 + q * 8;
              float a[8];
#pragma unroll
              for (int e = 0; e < 8; ++e) a[e] = cw[512 + cc + e];
#pragma unroll
              for (int j = 0; j < 4; ++j) {
                  if (prompt || j == 3) {
                      {
                          const u32x4 u = prompt ? *(const LAS u32x4*)(rawt + (t + j) * 136 + cc) : *(const u32x4*)(XR + (size_t)(MPR + t) * D + cb0 + cc);
                          const float x8[8] = {bflo(u.x), bfhi(u.x), bflo(u.y), bfhi(u.y), bflo(u.z), bfhi(u.z), bflo(u.w), bfhi(u.w)};
#pragma unroll
                          for (int e = 0; e < 8; ++e) a[e] += x8[e] * cw[j * 128 + cc + e];
                      }
                  } else {
                      const float* p = INP(5) + ((size_t)t * 3 + j) * D + cb0 + cc;
                      const f32x4 u0 = *(const f32x4*)p, u1 = *(const f32x4*)(p + 4);
#pragma unroll
                      for (int e = 0; e < 4; ++e) { a[e] += u0[e] * cw[j * 128 + cc + e]; a[4 + e] += u1[e] * cw[j * 128 + cc + 4 + e]; }
                  }
              }
              u32x4 w; w.x = pk2(a[0], a[1]); w.y = pk2(a[2], a[3]); w.z = pk2(a[4], a[5]); w.w = pk2(a[6], a[7]);
              *(LAS u32x4*)(xcA + t * 136 + cc) = w;
              if (cq == qd) { *(LAS f32x4*)(xcf + t * 32 + q * 8) = (f32x4){a[0], a[1], a[2], a[3]}; *(LAS f32x4*)(xcf + t * 32 + q * 8 + 4) = (f32x4){a[4], a[5], a[6], a[7]}; }
          }
        }
        __syncthreads();
        { f32x16 c;
#pragma unroll
          for (int r = 0; r < 16; ++r) c[r] = 0.f;
          const LAS bf16* ap = xcA + (tb * 32 + (lane & 31)) * 136 + (lane >> 5) * 8;
#pragma unroll
          for (int ks = 0; ks < 8; ++ks) { const bf16x8 af = *(const LAS bf16x8*)(ap + ks * 16); c = __builtin_amdgcn_mfma_f32_32x32x16_bf16(af, Bf[ks], c, 0, 0, 0); }
          LAS float* dst = cbk ? ib : rb;
#pragma unroll
          for (int r = 0; r < 16; ++r) { const int tok = tb * 32 + (r & 3) + 8 * (r >> 2) + 4 * (lane >> 5); dst[tok * 32 + (lane & 31)] = sigmoid_f(c[r] + gbias); }
        }
        __syncthreads();
        float Aacc = 1.f, h = 0.f;
#pragma unroll 4
        for (int e = 0; e < 8; ++e) { const int t = seg * 8 + e;
            const float r = rb[t * 32 + ch], ig = ib[t * 32 + ch], x = xcf[t * 32 + ch];
            const float la = -8.f * r * sp; const float a = __expf(la);
            const float x2 = 2.f * la, ser = -x2 * (1.f + x2 * (0.5f + x2 * (0.16666667f + x2 * (0.041666668f + x2 * (0.0083333338f + x2 * 0.0013888889f)))));
            float mult = __builtin_amdgcn_sqrtf(x2 > -0.3f ? ser : 1.f - a * a);
            if (prompt && tile == 0 && t == 0) mult = 1.f;
            const float bt = mult * ig * x;
            rb[t * 32 + ch] = a; ib[t * 32 + ch] = bt;
            h = a * h + bt; Aacc *= a;
        }
        float hin = 0.f;
        if (prompt) {
            segA[seg * 32 + ch] = Aacc; segB[seg * 32 + ch] = h;
            __syncthreads();
            hin = hc[ch];
            float sa[15], sb[15];
#pragma unroll
            for (int s = 0; s < 15; ++s) { sa[s] = segA[s * 32 + ch]; sb[s] = segB[s * 32 + ch]; }
#pragma unroll
            for (int s = 0; s < 15; ++s) hin = s < seg ? sa[s] * hin + sb[s] : hin;
        }
        h = hin;
        { float gr[8], h0v[8];
#pragma unroll
          for (int e = 0; e < 8; ++e) { const int t = seg * 8 + e; gr[e] = bf2f(GR[(size_t)(row0 + t) * D + oc0 + ch]); h0v[e] = prompt ? 0.f : INP(4)[(size_t)t * D + oc0 + ch]; }
#pragma unroll
          for (int e = 0; e < 8; ++e) { const int t = seg * 8 + e;
              const float a = rb[t * 32 + ch], bt = ib[t * 32 + ch];
              if (prompt) h = a * h + bt; else h = a * h0v[e] + bt;
              GR[(size_t)(row0 + t) * D + oc0 + ch] = (bf16)f2bf(h * gr[e]);
              if (!prompt) { karg_out()[O_HS + (size_t)t * D + oc0 + ch] = h;
                  const float* cs = INP(5) + (size_t)t * 3 * D + oc0 + ch; float* co = karg_out() + O_CRS + (size_t)t * 3 * D + oc0 + ch;
                  co[0] = cs[D]; co[D] = cs[2 * D]; co[2 * D] = bf2f(XR[(size_t)(MPR + t) * D + oc0 + ch]); }
          } }
        hlast = h;
        if (prompt && tile + 1 < ntiles) RG_RAW_STORE();
        __syncthreads();
        if (prompt && seg == 15) hc[ch] = hlast;
    }
    if (prompt && seg == 15) { if (t1 == 16) karg_out()[O_HP + (size_t)b * D + oc0 + ch] = hlast; else ((float*)(karg_ws() + WS_HCARRY))[(size_t)b * D + oc0 + ch] = hlast; }
    __syncthreads();
}

constexpr size_t WS_TINV = WS_WIN, WS_ATT = WS_WIN + 8 * MiB, WS_GC = WS_CB, WS_BETA = 47 * MiB + 65536;
static_assert(WS_ABL + (size_t)M * 16 * 4 <= WS_BETA && WS_BETA + 64 * 2048 * 4 <= WS_H, "ws map (beta)");
__device__ __forceinline__ int perm16(int e) { return (e & ~12) | ((e >> 1) & 4) | ((e << 1) & 8); }

__device__ __forceinline__ void conv8(const bf16* p, int tl, const LAS float* w, float* a) {
#pragma unroll
    for (int e = 0; e < 8; ++e) a[e] = 0.f;
#pragma unroll
    for (int j = 0; j < 4; ++j) {
        const bool ok = tl - 3 + j >= 0;
        const u32x4 u = *(const u32x4*)(ok ? p - (ptrdiff_t)(3 - j) * D : p);
        f32x4 w0 = *(const LAS f32x4*)(w + j * 128), w1 = *(const LAS f32x4*)(w + j * 128 + 4);
        if (!ok) { w0 = (f32x4){0.f, 0.f, 0.f, 0.f}; w1 = w0; }
        a[0] += bflo(u.x) * w0[0]; a[1] += bfhi(u.x) * w0[1]; a[2] += bflo(u.y) * w0[2]; a[3] += bfhi(u.y) * w0[3];
        a[4] += bflo(u.z) * w1[0]; a[5] += bfhi(u.z) * w1[1]; a[6] += bflo(u.w) * w1[2]; a[7] += bfhi(u.w) * w1[3];
    }
#pragma unroll
    for (int e = 0; e < 8; ++e) a[e] = silu_f(a[e]);
}

__device__ __forceinline__ void conv8h(const bf16* p, const bf16* halo, int nloc, const LAS float* w, float* a) {
#pragma unroll
    for (int e = 0; e < 8; ++e) a[e] = 0.f;
#pragma unroll
    for (int j = 0; j < 4; ++j) {
        const int r = nloc - 3 + j;
        const u32x4 u = *(const u32x4*)(r >= 0 ? p - (ptrdiff_t)(3 - j) * D : halo + (r + 3) * D);
        const f32x4 w0 = *(const LAS f32x4*)(w + j * 128), w1 = *(const LAS f32x4*)(w + j * 128 + 4);
        a[0] += bflo(u.x) * w0[0]; a[1] += bfhi(u.x) * w0[1]; a[2] += bflo(u.y) * w0[2]; a[3] += bfhi(u.y) * w0[3];
        a[4] += bflo(u.z) * w1[0]; a[5] += bfhi(u.z) * w1[1]; a[6] += bflo(u.w) * w1[2]; a[7] += bfhi(u.w) * w1[3];
    }
#pragma unroll
    for (int e = 0; e < 8; ++e) a[e] = silu_f(a[e]);
}
__device__ __forceinline__ void delta_prep_wave(const Params& P, LAS unsigned char* lds, int idx, int wave, int lane) {
    const int bh = idx >> 5, b = bh >> 3, h = bh & 7, span = idx & 31, n = lane & 31, hh = lane >> 5;
    const LAS float* wq = (const LAS float*)lds; const LAS float* wk = wq + 512; const LAS float* wv = wq + 1024;
    LAS float* Lm = (LAS float*)(lds + 6144 + wave * 10240);
    LAS float* gcs = Lm + 2 * 1152; LAS float* bts = gcs + 64;
    const bf16* Qb = (const bf16*)(karg_ws() + WS_Z + 2 * ZB); bf16* Kb = (bf16*)(karg_ws() + WS_Z + 3 * ZB); bf16* Vb = (bf16*)(karg_ws() + WS_Z + 4 * ZB);
    bf16* QT = (bf16*)(karg_ws() + WS_H);
    const bf16* HK = (const bf16*)((const unsigned char*)karg_out() + OSB_HK) + (size_t)(b * 32 + span) * 3 * D + h * 128;
    const bf16* HV = (const bf16*)((const unsigned char*)karg_out() + OSB_HV) + (size_t)(b * 32 + span) * 3 * D + h * 128;
    const float* ABL = (const float*)(karg_ws() + WS_ABL);
    bf16* TINV = (bf16*)(karg_ws() + WS_TINV); bf16* ATT = (bf16*)(karg_ws() + WS_ATT);
    { const size_t row = (size_t)b * SEQ + span * 64 + lane;
      float g = -__expf(INP(23)[h]) * softplus_f(ABL[row * 16 + h] + INP(24)[h]); const float be = sigmoid_f(ABL[row * 16 + 8 + h]);
#pragma unroll
      for (int off = 1; off < 32; off <<= 1) { const float t = __shfl_up(g, off); if (n >= off) g += t; }
      gcs[lane] = g; bts[lane] = be;
      ((float*)(karg_ws() + WS_GC))[(size_t)bh * SEQ + span * 64 + lane] = g; ((float*)(karg_ws() + WS_BETA))[(size_t)bh * SEQ + span * 64 + lane] = be; }
    LAS float* nks = bts + 64; LAS float* nqs = nks + 64;
#pragma unroll 1
    for (int it = 7; it >= 0; --it) {
        const int nloc = it * 8 + (lane >> 3), tl = span * 64 + nloc, d0 = (lane & 7) * 16; const size_t ro = ((size_t)b * SEQ + tl) * D + h * 128 + d0;
        float kv[16], qv[16], vv[16];
        conv8h(Kb + ro, HK + d0, nloc, wk + d0, kv); conv8h(Kb + ro + 8, HK + d0 + 8, nloc, wk + d0 + 8, kv + 8);
        conv8(Qb + ro, tl, wq + d0, qv); conv8(Qb + ro + 8, tl, wq + d0 + 8, qv + 8);
        conv8h(Vb + ro, HV + d0, nloc, wv + d0, vv); conv8h(Vb + ro + 8, HV + d0 + 8, nloc, wv + d0 + 8, vv + 8);
        float ssk = 0.f, ssq = 0.f;
#pragma unroll
        for (int e = 0; e < 16; ++e) { ssk += kv[e] * kv[e]; ssq += qv[e] * qv[e]; }
        ssk = red8(ssk); ssq = red8(ssq);
        if ((lane & 7) == 0) { const float nkj = rsq_f(ssk + EPS), nqj = 0.08838834764831845f * rsq_f(ssq + EPS); nks[nloc] = nkj; nqs[nloc] = nqj;
            ((float*)((unsigned char*)karg_out() + OSB_NK))[(size_t)bh * SEQ + tl] = nkj; ((float*)((unsigned char*)karg_out() + OSB_NQ))[(size_t)bh * SEQ + tl] = nqj; }
        *(bf16x8*)(Kb + ro) = pack8(kv[0], kv[1], kv[2], kv[3], kv[4], kv[5], kv[6], kv[7]); *(bf16x8*)(Kb + ro + 8) = pack8(kv[8], kv[9], kv[10], kv[11], kv[12], kv[13], kv[14], kv[15]);
        *(bf16x8*)(QT + ro) = pack8(qv[0], qv[1], qv[2], qv[3], qv[4], qv[5], qv[6], qv[7]); *(bf16x8*)(QT + ro + 8) = pack8(qv[8], qv[9], qv[10], qv[11], qv[12], qv[13], qv[14], qv[15]);
        *(bf16x8*)(Vb + ro) = pack8(vv[0], vv[1], vv[2], vv[3], vv[4], vv[5], vv[6], vv[7]); *(bf16x8*)(Vb + ro + 8) = pack8(vv[8], vv[9], vv[10], vv[11], vv[12], vv[13], vv[14], vv[15]);
    }
    asm volatile("s_waitcnt vmcnt(0)" ::: "memory"); __builtin_amdgcn_fence(__ATOMIC_ACQUIRE, "agent");
#pragma unroll 1
    for (int tile = 0; tile < 2; ++tile) {
        const int tl = span * 64 + tile * 32 + n; const size_t ro = ((size_t)b * SEQ + tl) * D + h * 128 + 8 * hh;
        f32x16 ckk, cqk;
#pragma unroll
        for (int r = 0; r < 16; ++r) { ckk[r] = 0.f; cqk[r] = 0.f; }
#pragma unroll
        for (int s8 = 0; s8 < 8; ++s8) {
            const bf16x8 kf = *(const bf16x8*)(Kb + ro + 16 * s8), qf = *(const bf16x8*)(QT + ro + 16 * s8);
            ckk = __builtin_amdgcn_mfma_f32_32x32x16_bf16(kf, kf, ckk, 0, 0, 0); cqk = __builtin_amdgcn_mfma_f32_32x32x16_bf16(qf, kf, cqk, 0, 0, 0);
        }
        const float nkj = nks[tile * 32 + n];
        const float gcj = gcs[tile * 32 + n];
        bf16* att = ATT + ((size_t)bh * 64 + span * 2 + tile) * 1024 + perm16(n);
#pragma unroll
        for (int r = 0; r < 16; ++r) { const int i = (r & 3) + 8 * (r >> 2) + 4 * hh;
            const float dm = i >= n ? __expf(gcs[tile * 32 + i] - gcj) * nkj : 0.f;
            Lm[tile * 1152 + i * 36 + n] = i > n ? bts[tile * 32 + i] * nks[tile * 32 + i] * ckk[r] * dm : 0.f;
            att[i * 32] = (bf16)f2bf(nqs[tile * 32 + i] * cqk[r] * dm); }
    }
    LDS_WAIT(); asm volatile("" ::: "memory");
    { int loff = hh * 1152;
      float x[32];
#pragma unroll
      for (int i = 0; i < 32; ++i) { float sacc = (i == n) ? 1.f : 0.f;
          const LAS float* Lb = Lm + loff;
#pragma unroll
          for (int j4 = 0; j4 < (i + 3) / 4; ++j4) { const f32x4 l = *(const LAS f32x4*)(Lb + i * 36 + 4 * j4);
#pragma unroll
              for (int jj = 0; jj < 4; ++jj) if (4 * j4 + jj < i) sacc -= l[jj] * x[4 * j4 + jj]; }
          x[i] = sacc;
          if ((i & 1) == 1) asm volatile("" : "+v"(loff) : "v"(sacc)); }
      bf16* ti = TINV + ((size_t)bh * 64 + span * 2 + hh) * 1024 + perm16(n);
#pragma unroll
      for (int i = 0; i < 32; ++i) ti[i * 32] = (bf16)f2bf(x[i]); }
    LDS_WAIT(); asm volatile("" ::: "memory");
}

constexpr int DR_KB = 0, DR_QD = 8704, DR_KDT = 17408, DR_TI = 27648, DR_AT = 30208, DR_VB = 32768, DR_EGL = 49664, DR_BUF = 49680;
struct DeltaPre { u32x4 k0, k1, q0, q1, v0, v1, tia; float gct, gl, bet, nk, nq; };
__device__ __forceinline__ void delta_pre_load(int b, int h, int c, int pt, DeltaPre& dp) {
    const int bh = b * 8 + h, tt = pt >> 3, d0 = (pt & 7) * 16; const size_t t = (size_t)bh * SEQ + c * 32 + tt;
    const size_t ro = ((size_t)b * SEQ + c * 32 + tt) * D + h * 128 + d0;
    const bf16* Kt = (const bf16*)(karg_ws() + WS_Z + 3 * ZB) + ro; const bf16* Qt = (const bf16*)(karg_ws() + WS_H) + ro; const bf16* Vt = (const bf16*)(karg_ws() + WS_Z + 4 * ZB) + ro;
    dp.k0 = *(const u32x4*)Kt; dp.k1 = *(const u32x4*)(Kt + 8); dp.q0 = *(const u32x4*)Qt; dp.q1 = *(const u32x4*)(Qt + 8); dp.v0 = *(const u32x4*)Vt; dp.v1 = *(const u32x4*)(Vt + 8);
    const float* GC = (const float*)(karg_ws() + WS_GC);
    dp.gct = GC[t]; dp.gl = GC[(size_t)bh * SEQ + c * 32 + 31]; dp.bet = ((const float*)(karg_ws() + WS_BETA))[t];
    dp.nk = ((const float*)((const unsigned char*)karg_out() + OSB_NK))[t]; dp.nq = ((const float*)((const unsigned char*)karg_out() + OSB_NQ))[t];
    dp.tia = *(const u32x4*)((const bf16*)(karg_ws() + (pt < 128 ? WS_TINV : WS_ATT)) + ((size_t)bh * 64 + c) * 1024 + (pt & 127) * 8);
}
__device__ __forceinline__ void delta_rec_stage(LAS unsigned char* buf, int pt, const DeltaPre& dp) {
    const int tt = pt >> 3, dg = pt & 7, d0 = dg * 16;
    { LAS bf16* dst = (LAS bf16*)(buf + (pt < 128 ? DR_TI : DR_AT)) + ((pt & 127) >> 2) * 40 + (pt & 3) * 8; *(LAS u32x4*)dst = dp.tia; }
    if (pt == 0) *(LAS float*)(buf + DR_EGL) = __expf(dp.gl);
    const float eg = __expf(dp.gct), ekd = __expf(dp.gl - dp.gct);
    const float fq = dp.nq * eg, fkb = dp.nk * dp.bet * eg, fkd = dp.nk * ekd, bet = dp.bet;
    float k[16], q[16], v[16];
    unpack8(dp.k0, k); unpack8(dp.k1, k + 8); unpack8(dp.q0, q); unpack8(dp.q1, q + 8); unpack8(dp.v0, v); unpack8(dp.v1, v + 8);
    LAS bf16* KB = (LAS bf16*)(buf + DR_KB) + tt * 136 + d0; LAS bf16* QD = (LAS bf16*)(buf + DR_QD) + tt * 136 + d0;
    *(LAS bf16x8*)KB = pack8(k[0] * fkb, k[1] * fkb, k[2] * fkb, k[3] * fkb, k[8] * fkb, k[9] * fkb, k[10] * fkb, k[11] * fkb);
    *(LAS bf16x8*)(KB + 8) = pack8(k[4] * fkb, k[5] * fkb, k[6] * fkb, k[7] * fkb, k[12] * fkb, k[13] * fkb, k[14] * fkb, k[15] * fkb);
    *(LAS bf16x8*)QD = pack8(q[0] * fq, q[1] * fq, q[2] * fq, q[3] * fq, q[8] * fq, q[9] * fq, q[10] * fq, q[11] * fq);
    *(LAS bf16x8*)(QD + 8) = pack8(q[4] * fq, q[5] * fq, q[6] * fq, q[7] * fq, q[12] * fq, q[13] * fq, q[14] * fq, q[15] * fq);
    LAS bf16* KDT = (LAS bf16*)(buf + DR_KDT) + d0 * 40 + perm16(tt);
#pragma unroll
    for (int e = 0; e < 16; ++e) KDT[e * 40] = (bf16)f2bf(k[e] * fkd);
    LAS float* VB = (LAS float*)(buf + DR_VB) + tt * 132 + d0;
#pragma unroll
    for (int e4 = 0; e4 < 4; ++e4) *(LAS f32x4*)(VB + 4 * e4) = (f32x4){v[4 * e4] * bet, v[4 * e4 + 1] * bet, v[4 * e4 + 2] * bet, v[4 * e4 + 3] * bet};
}

constexpr int DR_OB = 2 * DR_BUF;
static_assert(DR_OB + 2 * 32 * 132 * 4 <= LDS_BYTES - 64, "delta recurrence LDS map");
__device__ __forceinline__ void delta_out_norm(const LAS float* ob, int pt, const float* dn16, const u32x4 z0, const u32x4 z1, bf16* dst) {
    const LAS float* p = ob + (pt >> 3) * 132 + (pt & 7) * 16;
    float o[16], z[16];
#pragma unroll
    for (int e4 = 0; e4 < 4; ++e4) { const f32x4 t = *(const LAS f32x4*)(p + 4 * e4); o[4 * e4] = t[0]; o[4 * e4 + 1] = t[1]; o[4 * e4 + 2] = t[2]; o[4 * e4 + 3] = t[3]; }
    float ss = 0.f;
#pragma unroll
    for (int e = 0; e < 16; ++e) ss += o[e] * o[e];
    ss = red8(ss);
    const float rstd = rsq_f(ss * (1.f / 128.f) + EPS);
    unpack8(z0, z); unpack8(z1, z + 8);
#pragma unroll
    for (int e = 0; e < 16; ++e) o[e] = o[e] * rstd * dn16[e] * z[e];
    *(bf16x8*)dst = pack8(o[0], o[1], o[2], o[3], o[4], o[5], o[6], o[7]); *(bf16x8*)(dst + 8) = pack8(o[8], o[9], o[10], o[11], o[12], o[13], o[14], o[15]);
}
__device__ __forceinline__ void delta_rec_task(const Params& P, LAS unsigned char* lds, int b, int h, int tid) {
    const int lane = tid & 63, wave = tid >> 6, n = lane & 31, hh = lane >> 5, bh = b * 8 + h, pt = tid - 256;
    const bool producer = wave >= 4;
    constexpr int NC = SEQ / 32;
    f32x16 S[4];
#pragma unroll
    for (int kb = 0; kb < 4; ++kb)
#pragma unroll
        for (int r = 0; r < 16; ++r) S[kb][r] = 0.f;
    DeltaPre dcur, dnxt;
    if (producer) { delta_pre_load(b, h, 0, pt, dcur); delta_pre_load(b, h, 1, pt, dnxt); delta_rec_stage(lds, pt, dcur); dcur = dnxt; }
    __syncthreads();
    if (producer) {
        const int pt = opq(tid) - 256;
        float dn16[16];
#pragma unroll
        for (int e = 0; e < 16; ++e) dn16[e] = INP(25)[(pt & 7) * 16 + e];
        bf16* zgp = (bf16*)(karg_ws() + WS_Z + 5 * ZB) + ((size_t)b * SEQ + (pt >> 3)) * D + h * 128 + (pt & 7) * 16;
        u32x4 zc0 = {0u, 0u, 0u, 0u}, zc1 = zc0, zn0, zn1;
#define DR_BAR() do { asm volatile("s_waitcnt lgkmcnt(0)" ::: "memory"); __builtin_amdgcn_s_barrier(); asm volatile("" ::: "memory"); } while (0)
        for (int c = 0; c < NC; ++c) {
            if (c > 0) { dcur = dnxt; zc0 = zn0; zc1 = zn1; }
            if (c + 2 < NC) delta_pre_load(b, h, c + 2, pt, dnxt);
            zn0 = *(const u32x4*)(zgp + (size_t)c * 32 * D); zn1 = *(const u32x4*)(zgp + (size_t)c * 32 * D + 8);
            if (c + 1 < NC) delta_rec_stage(lds + ((c + 1) & 1) * DR_BUF, pt, dcur);
            if (c > 0) delta_out_norm((const LAS float*)(lds + DR_OB) + ((c - 1) & 1) * 32 * 132, pt, dn16, zc0, zc1, zgp + (size_t)(c - 1) * 32 * D);
            DR_BAR();
        }
        delta_out_norm((const LAS float*)(lds + DR_OB) + ((NC - 1) & 1) * 32 * 132, pt, dn16, zn0, zn1, zgp + (size_t)(NC - 1) * 32 * D);
    } else {
        const int lane = opq(tid) & 63, n = lane & 31, hh = lane >> 5;
        for (int c = 0; c < NC; ++c) {
            LAS unsigned char* buf = lds + (c & 1) * DR_BUF;
            const int vb = wave;
            bf16x8 SB[8];
#pragma unroll
            for (int s = 0; s < 8; ++s) { const int kb = s >> 1, o = 8 * (s & 1); SB[s] = pack8(S[kb][o], S[kb][o + 1], S[kb][o + 2], S[kb][o + 3], S[kb][o + 4], S[kb][o + 5], S[kb][o + 6], S[kb][o + 7]); }
            f32x16 X1, P1;
#pragma unroll
            for (int r = 0; r < 16; ++r) { X1[r] = 0.f; P1[r] = 0.f; }
            const LAS bf16* KB = (const LAS bf16*)(buf + DR_KB) + n * 136 + 8 * hh; const LAS bf16* QD = (const LAS bf16*)(buf + DR_QD) + n * 136 + 8 * hh;
#pragma unroll
            for (int s = 0; s < 8; ++s) { X1 = __builtin_amdgcn_mfma_f32_32x32x16_bf16(*(const LAS bf16x8*)(KB + 16 * s), SB[s], X1, 0, 0, 0);
                P1 = __builtin_amdgcn_mfma_f32_32x32x16_bf16(*(const LAS bf16x8*)(QD + 16 * s), SB[s], P1, 0, 0, 0); }
            const LAS float* VB = (const LAS float*)(buf + DR_VB) + 32 * vb + n;
            float Y[16];
#pragma unroll
            for (int r = 0; r < 16; ++r) Y[r] = VB[((r & 3) + 8 * (r >> 2) + 4 * hh) * 132] - X1[r];
            const bf16x8 YB0 = pack8(Y[0], Y[1], Y[2], Y[3], Y[4], Y[5], Y[6], Y[7]), YB1 = pack8(Y[8], Y[9], Y[10], Y[11], Y[12], Y[13], Y[14], Y[15]);
            f32x16 VN;
#pragma unroll
            for (int r = 0; r < 16; ++r) VN[r] = 0.f;
            const LAS bf16* TI = (const LAS bf16*)(buf + DR_TI) + n * 40 + 8 * hh; const LAS bf16* AT = (const LAS bf16*)(buf + DR_AT) + n * 40 + 8 * hh;
            VN = __builtin_amdgcn_mfma_f32_32x32x16_bf16(*(const LAS bf16x8*)TI, YB0, VN, 0, 0, 0);
            VN = __builtin_amdgcn_mfma_f32_32x32x16_bf16(*(const LAS bf16x8*)(TI + 16), YB1, VN, 0, 0, 0);
            const bf16x8 VB0 = pack8(VN[0], VN[1], VN[2], VN[3], VN[4], VN[5], VN[6], VN[7]), VB1 = pack8(VN[8], VN[9], VN[10], VN[11], VN[12], VN[13], VN[14], VN[15]);
            P1 = __builtin_amdgcn_mfma_f32_32x32x16_bf16(*(const LAS bf16x8*)AT, VB0, P1, 0, 0, 0);
            P1 = __builtin_amdgcn_mfma_f32_32x32x16_bf16(*(const LAS bf16x8*)(AT + 16), VB1, P1, 0, 0, 0);
            const float egl = *(const LAS float*)(buf + DR_EGL);
            const LAS bf16* KDT = (const LAS bf16*)(buf + DR_KDT) + n * 40 + 8 * hh;
#pragma unroll
            for (int kb = 0; kb < 4; ++kb) {
#pragma unroll
                for (int r = 0; r < 16; ++r) S[kb][r] *= egl;
                S[kb] = __builtin_amdgcn_mfma_f32_32x32x16_bf16(*(const LAS bf16x8*)(KDT + kb * 32 * 40), VB0, S[kb], 0, 0, 0);
                S[kb] = __builtin_amdgcn_mfma_f32_32x32x16_bf16(*(const LAS bf16x8*)(KDT + kb * 32 * 40 + 16), VB1, S[kb], 0, 0, 0); }
            LAS float* op = (LAS float*)(lds + DR_OB) + (c & 1) * 32 * 132 + 4 * hh * 132 + 32 * vb + n;
#pragma unroll
            for (int r = 0; r < 16; ++r) op[((r & 3) + 8 * (r >> 2)) * 132] = P1[r];
            DR_BAR();
        }
    }
    if (!producer) { float* So = karg_out() + O_SP + ((size_t)bh * 128 + 4 * hh) * 128 + 32 * wave + n;
#pragma unroll
        for (int kb = 0; kb < 4; ++kb)
#pragma unroll
            for (int r = 0; r < 16; ++r) So[(size_t)(32 * kb + (r & 3) + 8 * (r >> 2)) * 128] = S[kb][r]; }
    __syncthreads();
}

template <int MODE>
__device__ __forceinline__ void delta_sample_item(const Params& P, LAS unsigned char* lds, int item, int tid) {
    LAS float* tmp = (LAS float*)lds;
    LAS float* scl = (LAS float*)(lds + 1536);
    LAS float* rpk = (LAS float*)(lds + 2048);
    LAS float* rpq = (LAS float*)(lds + 4096);
    const int bs = item >> 3, h = item & 7, lane = tid & 63, wave = tid >> 6; const size_t row = (size_t)MPR + bs;
    const bf16* Zq = (const bf16*)(karg_ws() + WS_Z + 2 * ZB);
    if (tid < 384) { const int which = tid >> 7, d = tid & 127; const int c3 = which * 1024 + h * 128 + d;
        const float raw = bf2f(Zq[(size_t)which * (ZB / 2) + row * D + h * 128 + d]);
        const float* cs = INP(7) + (size_t)bs * 3 * 3072 + c3; const float* w = INP(22) + c3;
        tmp[tid] = silu_f(cs[0] * w[0] + cs[3072] * w[3072] + cs[2 * 3072] * w[2 * 3072] + raw * w[3 * 3072]); }
    __syncthreads();
    if (wave < 3) { float s;
        if (wave == 0) s = tmp[lane] * tmp[lane] + tmp[lane + 64] * tmp[lane + 64];
        else if (wave == 1) s = tmp[128 + lane] * tmp[128 + lane] + tmp[192 + lane] * tmp[192 + lane];
        else s = tmp[lane] * tmp[128 + lane] + tmp[64 + lane] * tmp[192 + lane];
        s = wave_sum(s);
        if (lane == 0) scl[wave] = wave == 0 ? rsq_f(s + EPS) * 0.08838834764831845f : (wave == 1 ? rsq_f(s + EPS) : s); }
    __syncthreads();
    const float sq = scl[0], sk = scl[1], kq = scl[2] * sq * sk;
    const int v = tid & 127, kg = tid >> 7;
    const float* S0 = INP(6) + ((size_t)(bs * NH + h) * 128 + kg * 32) * 128 + v;
    float S[32];
#pragma unroll
    for (int j = 0; j < 32; ++j) S[j] = MODE == 1 ? __builtin_nontemporal_load(S0 + (size_t)j * 128) : S0[(size_t)j * 128];
    float pk = 0.f, pq = 0.f;
#pragma unroll
    for (int j = 0; j < 32; ++j) { pk += S[j] * tmp[128 + kg * 32 + j]; pq += S[j] * tmp[kg * 32 + j]; }
    rpk[kg * 128 + v] = pk * sk; rpq[kg * 128 + v] = pq * sq;
    __syncthreads();
    pk = (rpk[v] + rpk[128 + v]) + (rpk[256 + v] + rpk[384 + v]); pq = (rpq[v] + rpq[128 + v]) + (rpq[256 + v] + rpq[384 + v]);
    const float* ABL = (const float*)(karg_ws() + WS_ABL);
    const float al = ABL[row * 16 + h], bl = ABL[row * 16 + 8 + h];
    const float dc = __expf(-__expf(INP(23)[h]) * softplus_f(al + INP(24)[h])), be = sigmoid_f(bl);
    const float delta = be * (tmp[256 + v] - dc * pk);
    if (MODE == 0) {
        const float o = dc * pq + kq * delta; const float so = wave_sum(o * o);
        if (lane == 0 && wave < 2) scl[4 + wave] = so;
        __syncthreads();
        if (kg == 0) { bf16* zp = (bf16*)(karg_ws() + WS_Z + 5 * ZB) + row * D + h * 128 + v;
            *zp = (bf16)f2bf(o * rsq_f((scl[4] + scl[5]) * (1.f / 128.f) + EPS) * INP(25)[v] * bf2f(*zp)); } }
    else { float* So = karg_out() + O_SS + ((size_t)(bs * NH + h) * 128 + kg * 32) * 128 + v;
#pragma unroll
        for (int j = 0; j < 32; ++j) __builtin_nontemporal_store(dc * S[j] + (tmp[128 + kg * 32 + j] * sk) * delta, So + (size_t)j * 128); }
    __syncthreads();
}

#define XB_TMO      128
#define XB_XCNT(j)  (256  + 64 * (j))
#define XB_XSUB(j)  (1280 + 64 * (j))
#define XB_XGEN(j)  (2304 + 64 * (j))
#define XB_TOP      3328
#define XB_TOPGEN   3392
#define XCD_BAR_WORDS 3456
#define XB_SPIN_CAP (1u << 22)
__device__ __forceinline__ unsigned xb_ld(unsigned* p)              { return __hip_atomic_load(p, __ATOMIC_RELAXED, __HIP_MEMORY_SCOPE_AGENT); }
__device__ __forceinline__ unsigned xb_add(unsigned* p, unsigned v) { return __hip_atomic_fetch_add(p, v, __ATOMIC_RELAXED, __HIP_MEMORY_SCOPE_AGENT); }
__device__ __forceinline__ unsigned xb_xcc_id() { return (unsigned)__builtin_amdgcn_s_getreg((3 << 11) | 20) & 0xFu; }
#define XB_SPIN(cond, bar) do { unsigned _sp = 0; while (cond) { __builtin_amdgcn_s_sleep(1); \
    if ((++_sp & 255u) == 0u) { if (xb_ld(&(bar)[XB_TMO])) break; if (_sp > XB_SPIN_CAP) { atomicAdd(&(bar)[XB_TMO], 1u); break; } } } } while (0)
struct XcdBarrier { unsigned* bar; unsigned x; volatile LAS unsigned* st; };
__device__ __forceinline__ XcdBarrier xcd_barrier_post(unsigned* bar, volatile LAS unsigned* st, bool leader) {
    XcdBarrier b; b.bar = bar; b.x = xb_xcc_id(); b.st = st;
    if (leader) (void)xb_add(&bar[XB_XCNT(b.x)], 1u);
    return b;
}
__device__ __forceinline__ void xcd_barrier_complete(unsigned* bar, unsigned x, unsigned& nloc, unsigned& nx) {
    const unsigned G = gridDim.x * gridDim.y * gridDim.z;
    unsigned sum, cnt, mine, sp = 0u;
    for (;;) {
        sum = 0u; cnt = 0u; mine = 0u;
#pragma unroll
        for (unsigned j = 0; j < 16; ++j) { const unsigned c = xb_ld(&bar[XB_XCNT(j)]); sum += c; cnt += (c > 0u) ? 1u : 0u; mine = (j == x) ? c : mine; }
        if (sum == G) break;
        __builtin_amdgcn_s_sleep(1);
        if ((++sp & 255u) == 0u) { if (xb_ld(&bar[XB_TMO])) break; if (sp > XB_SPIN_CAP) { atomicAdd(&bar[XB_TMO], 1u); break; } }
    }
    nloc = mine > 0u ? mine : 1u; nx = cnt > 0u ? cnt : 1u;
}
__device__ __forceinline__ void xcd_barrier(const XcdBarrier& b, bool leader) {
    asm volatile("s_waitcnt vmcnt(0)" ::: "memory");
    __syncthreads();
    if (leader) {
        unsigned* bar = b.bar;
        __builtin_amdgcn_s_waitcnt(0);
        unsigned nloc = b.st[0], nx = b.st[1];
        if (nloc == 0u) { xcd_barrier_complete(bar, b.x, nloc, nx); b.st[0] = nloc; b.st[1] = nx; }
        const unsigned old = xb_add(&bar[XB_XSUB(b.x)], 1u);
        const unsigned gen = old / nloc;
        if (old + 1u == (gen + 1u) * nloc) {
            __builtin_amdgcn_fence(__ATOMIC_RELEASE, "agent");
            asm volatile("s_waitcnt vmcnt(0)" ::: "memory");
            const unsigned og = xb_add(&bar[XB_TOP], 1u);
            const unsigned tg = og / nx;
            if (og + 1u == (tg + 1u) * nx) xb_add(&bar[XB_TOPGEN], 1u);
            else XB_SPIN(xb_ld(&bar[XB_TOPGEN]) == tg, bar);
            __builtin_amdgcn_fence(__ATOMIC_ACQUIRE, "agent");
            xb_add(&bar[XB_XGEN(b.x)], 1u);
            asm volatile("s_waitcnt vmcnt(0)" ::: "memory");
        } else {
            XB_SPIN(xb_ld(&bar[XB_XGEN(b.x)]) == gen, bar);
            __builtin_amdgcn_fence(__ATOMIC_ACQUIRE, "agent");
            asm volatile("s_waitcnt vmcnt(0)" ::: "memory");
        }
    }
    __syncthreads();
}

__global__ void __launch_bounds__(NTHR, 2) fwd_megakernel(Params P) {
    extern __shared__ __attribute__((aligned(16))) unsigned char lds_raw[];
    LAS unsigned char* lds = (LAS unsigned char*)lds_raw;
    cg::grid_group grid = cg::this_grid();
    const int wave = __builtin_amdgcn_readfirstlane((int)threadIdx.x >> 6);
#define lane opq(lane_now())
#define tid opq((wave << 6) | lane_now())
    const int G = gridDim.x, wg = blockIdx.x;
    const int gw = wg * NWAVES + wave, NGW = G * NWAVES;
    unsigned char* ws = karg_ws();
    float* ADA = (float*)(ws + WS_ADA);
    bf16* H = (bf16*)(ws + WS_H);
    bf16* Z = (bf16*)(ws + WS_Z);
    bf16* ACT = (bf16*)(ws + WS_ACT);
    bf16* MG = (bf16*)(karg_out() + O_SS);
    volatile LAS unsigned* MISC = (volatile LAS unsigned*)(lds + LDS_BYTES - 64);
    if (tid < 16) MISC[tid] = 0u;
    __syncthreads();
    const XcdBarrier xbar = xcd_barrier_post((unsigned*)ws, MISC, wave == 0 && lane_now() == 0);
#define GBAR() xcd_barrier(xbar, wave == 0 && lane_now() == 0)

    if constexpr ((PHM >> 0) & 1) {
    prologue<0>(P, lds, gw, NGW, wave, lane);
    }
    GBAR();
    if constexpr ((PHM >> 1) & 1) {
    { pg8::Gemm g{(const bf16*)(ws + WS_CB), (const bf16*)(ws + WS_WADA), nullptr, nullptr, D}; pg8::StaticOrder S; S.init(256, NADA, G, wg);
      EpiAda E{ADA, INP(9)}; pg8::gemm_phase(lds, g, S, E, wave);
      if (wg >= 36) prologue<1>(P, lds, (wg - 36) * NWAVES + wave, (G - 36) * NWAVES, wave, lane); }
    }
    GBAR();
    if constexpr ((PHM >> 2) & 1) {
    norm_mod_pass<0>(P, INP(10), 0, gw, NGW, lane);
    { const int gt = wg * NTHR + tid;
      if (gt < 2 * NB * 3 * (D / 8)) { const int m = gt / (NB * 3 * (D / 8)), r = gt % (NB * 3 * (D / 8)), c8 = r & 127, j = (r >> 7) % 3, bb = (r >> 7) / 3;
          *(u32x4*)((bf16*)((unsigned char*)karg_out() + (m ? OSB_HV : OSB_HK)) + ((size_t)(bb * 32) * 3 + j) * D + c8 * 8) = (u32x4){0u, 0u, 0u, 0u}; } }
    }
    GBAR();
    if constexpr ((PHM >> 3) & 1) {
    { pg8::Gemm g{H, (const bf16*)(ws + WS_WUP1), nullptr, nullptr, D}; pg8::StaticOrder S; S.init(MPAD, 2 * FF, G, wg);
      EpiSwiglu E{ACT}; pg8::gemm_phase(lds, g, S, E, wave); }
    }
    GBAR();
    if constexpr ((PHM >> 4) & 1) {
    { pg8::Gemm g{ACT, (const bf16*)(ws + WS_WDN1), nullptr, nullptr, FF}; pg8::StaticOrder S; S.init(MPR, D, G, wg);
      EpiResidNorm<0> E{karg_out(), INP(0), ADA + 2 * D, 0.5f, INP(13), ADA + 3 * D, H, (float*)(ws + WS_PART), (unsigned*)(ws + WS_CNT), (LAS float*)(lds + 131072)}; pg8::gemm_phase(lds, g, S, E, wave);
      float* X = karg_out(); const float* xs = INP(1); const float* gate = ADA + 2 * D;
      mini_gemm(lds, ACT, (const bf16*)(ws + WS_WDN1), nullptr, nullptr, FF, wg, G, tid, [=](int row, int col, f32x4 v, f32x4) {
          const f32x4 xv = *(const f32x4*)(xs + (size_t)(row - MPR) * D + col), gv = *(const f32x4*)(gate + (size_t)cond_of_row(row) * NADA + col);
          *(f32x4*)(X + (size_t)row * D + col) = xv + (gv * 0.5f) * v; }); }
    }
    GBAR();
    if constexpr ((PHM >> 5) & 1) {
    sample_norm_rows<0>(INP(13), 3, gw, lane);
    }
    GBAR();
    if constexpr ((PHM >> 6) & 1) {
    { pg8::Gemm g{H, (const bf16*)(ws + WS_WIN), nullptr, nullptr, D}; pg8::StaticOrder S; S.init(MPAD, NIN, G, wg);
      EpiIn E{Z, MG, (float*)(ws + WS_ABL), karg_out()}; pg8::gemm_phase(lds, g, S, E, wave); }
    }
    GBAR();
    if constexpr ((PHM >> 7) & 1) {
        { const int bh0 = (wg * NWAVES) >> 5, h0 = bh0 & 7; LAS float* w = (LAS float*)lds; const float* cwq = INP(22);
          for (int i = tid; i < 1536; i += NTHR) { const int which = i >> 9, j = (i >> 7) & 3, d = i & 127; w[i] = cwq[(size_t)j * 3072 + which * 1024 + h0 * 128 + d]; }
          __syncthreads();
          delta_prep_wave(P, lds, gw, wave, lane);
          __syncthreads(); }
        if (G == 256) { const int task = (wg & 7) * 32 + (wg >> 3); rglru_task(P, lds, task >> 5, (task >> 2) & 7, task & 3, tid, 0, RG_SPLIT); }
        else for (int task = wg; task < 256; task += G) rglru_task(P, lds, task >> 5, (task >> 2) & 7, task & 3, tid, 0, RG_SPLIT);
    }
    GBAR();
    if constexpr ((PHM >> 7) & 1) {
        if (wg < 64) delta_rec_task(P, lds, wg >> 3, wg & 7, tid);
        else {
            if (G == 256) { const int slot = (wg - 64) >> 3;
                { const int task = (wg & 7) * 32 + slot; rglru_task(P, lds, task >> 5, (task >> 2) & 7, task & 3, tid, RG_SPLIT, 16); }
                if (slot < 8) { const int task = (wg & 7) * 32 + 24 + slot; rglru_task(P, lds, task >> 5, (task >> 2) & 7, task & 3, tid, RG_SPLIT, 16); } }
            else for (int task = wg - 64; task < 256; task += G - 64) rglru_task(P, lds, task >> 5, (task >> 2) & 7, task & 3, tid, RG_SPLIT, 16);
            if (wg < 96) rglru_task(P, lds, -1, (wg - 64) >> 2, (wg - 64) & 3, tid, 0, 1);
            if (wg >= 128) for (int item = wg - 128; item < NS * NH; item += G - 128) delta_sample_item<0>(P, lds, item, tid);
        }
    }
    GBAR();
    if constexpr ((PHM >> 9) & 1) {
    { pg8::Gemm g{Z + 1 * (ZB / 2), (const bf16*)(ws + WS_WBR), Z + 5 * (ZB / 2), (const bf16*)(ws + WS_WBR) + (size_t)D * D, D};
      pg8::PairOrder S; S.base.init(MPR, D, G, wg);
      EpiBranch E{MG, MG + ZB / 2, Z}; pg8::gemm_phase(lds, g, S, E, wave);
      const bf16* mga = MG; const bf16* mgb = MG + ZB / 2; bf16* Gm = Z;
      mini_gemm(lds, g.A0, g.B0, g.A1, g.B1, D, wg, G, tid, [=](int row, int col, f32x4 ya, f32x4 yb) {
          const size_t o = (size_t)row * D + col; const u32x2 a = *(const u32x2*)(mga + o), b = *(const u32x2*)(mgb + o);
          u32x2 w; w.x = pk2(bflo(a.x) * ya[0] + bflo(b.x) * yb[0], bfhi(a.x) * ya[1] + bfhi(b.x) * yb[1]);
          w.y = pk2(bflo(a.y) * ya[2] + bflo(b.y) * yb[2], bfhi(a.y) * ya[3] + bfhi(b.y) * yb[3]);
          *(u32x2*)(Gm + o) = w; }); }
    }
    GBAR();
    if constexpr ((PHM >> 10) & 1) {
    { pg8::Gemm g{Z, (const bf16*)(ws + WS_WOUT), nullptr, nullptr, D}; pg8::StaticOrder S; S.init(MPR, D, G, wg);
      EpiResidNorm<0> E{karg_out(), nullptr, ADA + 5 * D, 1.0f, INP(28), ADA + 6 * D, H, (float*)(ws + WS_PART) + 65536, (unsigned*)(ws + WS_CNT) + 64, (LAS float*)(lds + 131072)}; pg8::gemm_phase(lds, g, S, E, wave);
      float* X = karg_out(); const float* gate = ADA + 5 * D;
      mini_gemm(lds, Z, (const bf16*)(ws + WS_WOUT), nullptr, nullptr, D, wg, G, tid, [=](int row, int col, f32x4 v, f32x4) {
          float* xp = X + (size_t)row * D + col; const f32x4 gv = *(const f32x4*)(gate + (size_t)cond_of_row(row) * NADA + col);
          *(f32x4*)xp = *(const f32x4*)xp + gv * v; }); }
    }
    GBAR();
    if constexpr ((PHM >> 11) & 1) {
    sample_norm_rows<0>(INP(28), 6, gw, lane);
    {
        for (int item = (G == 256 ? SS_TAIL : 0) + wg; item < NS * NH; item += G) delta_sample_item<1>(P, lds, item, tid);
        const int gt = wg * NTHR + tid, NGT = G * NTHR;
        for (int i = gt; i < NS * 3 * 3072; i += NGT) { const int bs = i / 9216, j = (i / 3072) % 3, c3 = i % 3072;
            karg_out()[O_CQS + i] = j < 2 ? INP(7)[(size_t)bs * 9216 + (j + 1) * 3072 + c3] : bf2f(Z[(size_t)(2 + (c3 >> 10)) * (ZB / 2) + ((size_t)MPR + bs) * D + (c3 & 1023)]); }
    }
    }
    GBAR();
    if constexpr ((PHM >> 12) & 1) {
    { pg8::Gemm g{H, (const bf16*)(ws + WS_WUP2), nullptr, nullptr, D}; pg8::StaticOrder S; S.init(MPAD, 2 * FF, G, wg);
      EpiSwiglu E{ACT}; pg8::gemm_phase(lds, g, S, E, wave);
      if (G == 256 && wg >= 150) for (int item = wg - 150; item < SS_TAIL; item += 106) delta_sample_item<1>(P, lds, item, tid); }
    }
    GBAR();
    if constexpr ((PHM >> 13) & 1) {
    { pg8::Gemm g{ACT, (const bf16*)(ws + WS_WDN2), nullptr, nullptr, FF}; pg8::StaticOrder S; S.init(MPR, D, G, wg);
      EpiResidNorm<1> E{karg_out(), nullptr, ADA + 8 * D, 0.5f, INP(31), nullptr, nullptr, (float*)(ws + WS_PART) + 131072, (unsigned*)(ws + WS_CNT) + 128, (LAS float*)(lds + 131072)}; pg8::gemm_phase(lds, g, S, E, wave);
      float* X = karg_out(); const float* gate = ADA + 8 * D;
      mini_gemm(lds, ACT, (const bf16*)(ws + WS_WDN2), nullptr, nullptr, FF, wg, G, tid, [=](int row, int col, f32x4 v, f32x4) {
          float* xp = X + (size_t)row * D + col; const f32x4 gv = *(const f32x4*)(gate + (size_t)cond_of_row(row) * NADA + col);
          *(f32x4*)xp = *(const f32x4*)xp + (gv * 0.5f) * v; }); }
    }
    GBAR();
    if constexpr ((PHM >> 14) & 1) {
    sample_norm_rows<1>(INP(31), 0, gw, lane);
    }
}

extern "C" void kernel_launch(void* const* d_in, const int* in_sizes, int n_in, void* d_out, int out_size, void* d_ws, size_t ws_size, hipStream_t stream) {
    static int grid = 0;
    if (grid == 0) {
        if (n_in != 32 || (size_t)out_size != O_END || ws_size < WS_END) { fprintf(stderr, "kernel_launch: unexpected shapes: n_in %d out %d ws %zu (need %zu)\n", n_in, out_size, ws_size, (size_t)WS_END); grid = -1; return; }
        int dev = 0, cus = 0, per_cu = 0;
        hipGetDevice(&dev); hipDeviceGetAttribute(&cus, hipDeviceAttributeMultiprocessorCount, dev);
        if (hipFuncSetAttribute((const void*)fwd_megakernel, hipFuncAttributeMaxDynamicSharedMemorySize, LDS_BYTES) != hipSuccess) { fprintf(stderr, "kernel_launch: hipFuncSetAttribute failed\n"); grid = -1; return; }
        if (hipOccupancyMaxActiveBlocksPerMultiprocessor(&per_cu, (const void*)fwd_megakernel, NTHR, LDS_BYTES) != hipSuccess || per_cu < 1) { fprintf(stderr, "kernel_launch: occupancy query says %d\n", per_cu); per_cu = 1; }
        (void)hipGetLastError();
        grid = cus * 1;
        if (grid > 256) grid = 256;
    }
    if (grid < 0) return;
    if (hipMemsetAsync(d_ws, 0, 16384, stream) != hipSuccess) { fprintf(stderr, "kernel_launch: memset failed\n"); return; }
    Params p{};
    for (int i = 0; i < 32; ++i) p.in[i] = (const float*)d_in[i];
    p.out = (float*)d_out; p.ws = (unsigned char*)d_ws;
    void* args[] = {&p};
    hipError_t e = hipLaunchCooperativeKernel((const void*)fwd_megakernel, dim3(grid), dim3(NTHR), args, LDS_BYTES, stream);
    if (e != hipSuccess) fprintf(stderr, "kernel_launch: cooperative launch failed: %s (grid %d)\n", hipGetErrorString(e), grid);
}
```
